# Optimizing an MI355X kernel written in HIP

```python
import jax, jax.numpy as jnp
from jax import lax
import numpy as np

D_MODEL = 1024
BATCH = 4
SEQ = 8192
DEPTH = 1

MOBA_HEADS = 8
HEAD_DIM = 64
MOBA_WIDTH = MOBA_HEADS * HEAD_DIM
MOBA_BLOCK = 256
MOBA_TOPK = 3
MOBA_Q_CHUNK = 32
ROPE_THETA = 500000.0
ROPE_DIM = HEAD_DIM // 4
RWKV_HEADS = 8
RWKV_WIDTH = RWKV_HEADS * HEAD_DIM
RWKV_DECAY_LORA = 64
RWKV_AAA_LORA = 64
RWKV_GATE_LORA = 128
RWKV_SHIFT_WIDTH = 3 * RWKV_WIDTH + RWKV_DECAY_LORA + RWKV_AAA_LORA + RWKV_GATE_LORA
GN_EPS = 64e-5
IN_SIZES = (MOBA_WIDTH, MOBA_WIDTH, MOBA_WIDTH, RWKV_SHIFT_WIDTH, 2 * D_MODEL)
IN_WIDTH = sum(IN_SIZES)
PEER_HEADS = 8
PEER_NKEYS = 128
PEER_EXPERTS = PEER_NKEYS * PEER_NKEYS
PEER_QDIM = 256
PEER_HALF = PEER_QDIM // 2
PEER_TOPK = 16
PEER_CHUNK = 128
RMS_EPS = 1e-6
NEG_INF = -1e30

kernel_name = 'hybrid_moba_rwkv7_peer_adaln'


def rms_norm(x, g, eps=RMS_EPS):
    x32 = x.astype(jnp.float32)
    y = x32 * lax.rsqrt(jnp.mean(x32 * x32, axis=-1, keepdims=True) + eps)
    return (y * g.astype(jnp.float32)).astype(x.dtype)


def rope_partial(x, pos):
    half = ROPE_DIM // 2
    inv = ROPE_THETA ** (-(jnp.arange(half, dtype=jnp.float32) * 2.0) / ROPE_DIM)
    ang = pos.astype(jnp.float32)[..., None] * inv
    cos = jnp.cos(ang)[:, :, None, :]
    sin = jnp.sin(ang)[:, :, None, :]
    x32 = x.astype(jnp.float32)
    x1 = x32[..., :half]
    x2 = x32[..., half:ROPE_DIM]
    out = jnp.concatenate([x1 * cos - x2 * sin, x2 * cos + x1 * sin, x32[..., ROPE_DIM:]], axis=-1)
    return out.astype(x.dtype)


def moba_attention(q, k, v):
    B, S, H, Dh = q.shape
    nb = -(-S // MOBA_BLOCK)
    sp = nb * MOBA_BLOCK
    pad = ((0, 0), (0, 0), (0, sp - S), (0, 0))
    q, k, v = (jnp.pad(t.transpose(0, 2, 1, 3), pad) for t in (q, k, v))
    kb = k.reshape(B, H, nb, MOBA_BLOCK, Dh)
    vb = v.reshape(B, H, nb, MOBA_BLOCK, Dh)
    scale = Dh ** -0.5
    qblk = jnp.arange(sp) // MOBA_BLOCK
    n_sel = min(MOBA_TOPK, nb - 1)
    if n_sel > 0:
        kmean = jnp.mean(kb.astype(jnp.float32), axis=3)
        gscore = jnp.einsum('bhsd,bhnd->bhsn', q.astype(jnp.float32), kmean)
        past = jnp.arange(nb)[None, :] < qblk[:, None]
        gscore = jnp.where(past, gscore, NEG_INF)
        _, sel = lax.top_k(gscore, n_sel)
        sel_ok = jnp.arange(n_sel)[None, :] < qblk[:, None]
    bi = jnp.arange(B)[:, None, None, None]
    hi = jnp.arange(H)[None, :, None, None]

    def attend_chunk(i):
        s0 = i * MOBA_Q_CHUNK
        qc = lax.dynamic_slice_in_dim(q, s0, MOBA_Q_CHUNK, axis=2)
        qpos = s0 + jnp.arange(MOBA_Q_CHUNK)
        own = s0 // MOBA_BLOCK
        k_own = lax.dynamic_index_in_dim(kb, own, axis=2, keepdims=False)
        v_own = lax.dynamic_index_in_dim(vb, own, axis=2, keepdims=False)
        kpos = own * MOBA_BLOCK + jnp.arange(MOBA_BLOCK)
        s_own = jnp.einsum('bhcd,bhkd->bhck', qc, k_own).astype(jnp.float32) * scale
        s_own = jnp.where(kpos[None, :] <= qpos[:, None], s_own, NEG_INF)
        if n_sel == 0:
            p = jax.nn.softmax(s_own, axis=-1).astype(v.dtype)
            return jnp.einsum('bhck,bhkd->bhcd', p, v_own)
        selc = lax.dynamic_slice_in_dim(sel, s0, MOBA_Q_CHUNK, axis=2)
        ok = lax.dynamic_slice_in_dim(sel_ok, s0, MOBA_Q_CHUNK, axis=0)
        k_sel = kb[bi, hi, selc]
        v_sel = vb[bi, hi, selc]
        s_sel = jnp.einsum('bhcd,bhcnkd->bhcnk', qc, k_sel).astype(jnp.float32) * scale
        s_sel = jnp.where(ok[None, None, :, :, None], s_sel, NEG_INF)
        s_all = jnp.concatenate([s_sel.reshape(B, H, MOBA_Q_CHUNK, n_sel * MOBA_BLOCK), s_own], axis=-1)
        p = jax.nn.softmax(s_all, axis=-1).astype(v.dtype)
        p_sel = p[..., :n_sel * MOBA_BLOCK].reshape(B, H, MOBA_Q_CHUNK, n_sel, MOBA_BLOCK)
        p_own = p[..., n_sel * MOBA_BLOCK:]
        return (jnp.einsum('bhcnk,bhcnkd->bhcd', p_sel, v_sel)
                + jnp.einsum('bhck,bhkd->bhcd', p_own, v_own))

    out = lax.map(attend_chunk, jnp.arange(sp // MOBA_Q_CHUNK))
    out = out.transpose(1, 0, 3, 2, 4).reshape(B, sp, H, Dh)
    return out[:, :S]


def token_shift(z, mu):
    prev = jnp.pad(z, ((0, 0), (1, 0), (0, 0)))[:, :-1]
    return z + (prev - z) * mu


def rwkv7_time_mix(zr, zk, zv, zw, za, zg, w0, w2, a0, a2, g2, k_k, k_a, r_k, ln_g, ln_b):
    B, S, _ = zr.shape
    H, N = RWKV_HEADS, HEAD_DIM
    f32 = jnp.float32
    w = -jax.nn.softplus(-(w0 + jnp.tanh(zw) @ w2)) - 0.5
    decay = jnp.exp(-jnp.exp(w.astype(f32)))
    a = jax.nn.sigmoid(a0 + za @ a2)
    g = jax.nn.sigmoid(zg) @ g2
    heads = lambda t: t.reshape(B, S, H, N).astype(f32)
    kk = heads(zk * k_k)
    kk = kk / jnp.maximum(jnp.sqrt(jnp.sum(kk * kk, axis=-1, keepdims=True)), 1e-12)
    k = zk * (1.0 + (a - 1.0) * k_a)
    r_h, k_h, v_h, a_h, d_h = heads(zr), heads(k), heads(zv), heads(a), heads(decay)

    def step(state, inp):
        r_t, d_t, k_t, v_t, kk_t, a_t = inp
        sa = jnp.einsum('bhij,bhj->bhi', state, -kk_t)
        state = (state * d_t[:, :, None, :] + sa[..., None] * (kk_t * a_t)[:, :, None, :]
                 + v_t[..., None] * k_t[:, :, None, :])
        return state, jnp.einsum('bhij,bhj->bhi', state, r_t)

    xs = tuple(t.transpose(1, 0, 2, 3) for t in (r_h, d_h, k_h, v_h, kk, a_h))
    _, y = lax.scan(step, jnp.zeros((B, H, N, N), f32), xs)
    y = y.transpose(1, 0, 2, 3)
    mean = jnp.mean(y, axis=-1, keepdims=True)
    var = jnp.mean(jnp.square(y - mean), axis=-1, keepdims=True)
    y = ((y - mean) * lax.rsqrt(var + GN_EPS)).reshape(B, S, H * N)
    y = y * ln_g.astype(f32) + ln_b.astype(f32)
    bonus = jnp.sum(r_h * k_h * r_k.astype(f32), axis=-1, keepdims=True) * v_h
    y = y + bonus.reshape(B, S, H * N)
    return (y * g.astype(f32)).astype(zr.dtype)


def peer_ffn(xn, wq, subkeys, u_tab, v_tab):
    B, S, D = xn.shape
    T = B * S
    xt = xn.reshape(T, D)
    q = (xt @ wq).reshape(T, PEER_HEADS, 2, PEER_HALF)
    s = jnp.einsum('thpd,hpnd->thpn', q, subkeys).astype(jnp.float32)
    top_s, top_i = lax.top_k(s, PEER_TOPK)
    cand_s = (top_s[:, :, 0, :, None] + top_s[:, :, 1, None, :]).reshape(T, PEER_HEADS, PEER_TOPK * PEER_TOPK)
    cand_i = (top_i[:, :, 0, :, None] * PEER_NKEYS + top_i[:, :, 1, None, :]).reshape(T, PEER_HEADS, PEER_TOPK * PEER_TOPK)
    best_s, best_j = lax.top_k(cand_s, PEER_TOPK)
    idx = jnp.take_along_axis(cand_i, best_j, axis=-1)
    gates = jax.nn.softmax(best_s, axis=-1)
    nc = T // PEER_CHUNK

    def retrieve(args):
        xc, ic, gc = args
        uc = u_tab[ic]
        vc = v_tab[ic]
        hdn = jax.nn.gelu(jnp.einsum('cd,chkd->chk', xc, uc).astype(jnp.float32), approximate=False) * gc
        return jnp.einsum('chk,chkd->cd', hdn.astype(vc.dtype), vc)

    out = lax.map(retrieve, (xt.reshape(nc, PEER_CHUNK, D),
                             idx.reshape(nc, PEER_CHUNK, PEER_HEADS, PEER_TOPK),
                             gates.reshape(nc, PEER_CHUNK, PEER_HEADS, PEER_TOPK)))
    return out.reshape(B, S, D).astype(xn.dtype)


def setup_inputs(seed: int = 0) -> dict:
    key = jax.random.key(seed)
    ks = iter(jax.random.split(key, 40))
    L = DEPTH
    D = D_MODEL
    nrm = lambda shape, sc: jax.random.normal(next(ks), shape, jnp.float32) * sc
    unif = lambda shape, lo, hi: jax.random.uniform(next(ks), shape, jnp.float32, lo, hi)
    x = nrm((BATCH, SEQ, D), 1.0)
    c = nrm((BATCH, D), 1.0)
    positions = jnp.tile(jnp.arange(SEQ, dtype=jnp.int32)[None, :], (BATCH, 1))
    return {
        'x': x, 'c': c, 'positions': positions,
        'w_ada': nrm((L, D, 6 * D), 0.5 * D ** -0.5),
        'b_ada': nrm((L, 6 * D), 0.02),
        'norm1_g': 1.0 + nrm((L, D), 0.05),
        'w_in': nrm((L, D, IN_WIDTH), D ** -0.5),
        'q_norm_g': 1.0 + nrm((L, HEAD_DIM), 0.05),
        'k_norm_g': 1.0 + nrm((L, HEAD_DIM), 0.05),
        'rwkv_mu': unif((L, RWKV_SHIFT_WIDTH), 0.0, 1.0),
        'rwkv_w0': nrm((L, RWKV_WIDTH), 1.0) - 2.0,
        'rwkv_w2': nrm((L, RWKV_DECAY_LORA, RWKV_WIDTH), 0.5 * RWKV_DECAY_LORA ** -0.5),
        'rwkv_a0': nrm((L, RWKV_WIDTH), 0.5),
        'rwkv_a2': nrm((L, RWKV_AAA_LORA, RWKV_WIDTH), 0.5 * RWKV_AAA_LORA ** -0.5),
        'rwkv_g2': nrm((L, RWKV_GATE_LORA, RWKV_WIDTH), RWKV_GATE_LORA ** -0.5),
        'rwkv_k_k': 0.85 + nrm((L, RWKV_WIDTH), 0.1),
        'rwkv_k_a': 1.0 + nrm((L, RWKV_WIDTH), 0.1),
        'rwkv_r_k': nrm((L, RWKV_HEADS, HEAD_DIM), 0.1),
        'rwkv_ln_g': 1.0 + nrm((L, RWKV_WIDTH), 0.05),
        'rwkv_ln_b': nrm((L, RWKV_WIDTH), 0.02),
        'w_proj_moba': nrm((L, MOBA_WIDTH, D), MOBA_WIDTH ** -0.5),
        'w_proj_rwkv': nrm((L, RWKV_WIDTH, D), RWKV_WIDTH ** -0.5),
        'w_out': nrm((L, D, D), D ** -0.5),
        'norm2_g': 1.0 + nrm((L, D), 0.05),
        'peer_wq': nrm((L, D, PEER_HEADS * PEER_QDIM), D ** -0.5),
        'peer_subkeys': nrm((L, PEER_HEADS, 2, PEER_NKEYS, PEER_HALF), PEER_HALF ** -0.5),
        'peer_u': nrm((L, PEER_EXPERTS, D), D ** -0.5),
        'peer_v': nrm((L, PEER_EXPERTS, D), PEER_HEADS ** -0.5),
    }


def reference(x, c, positions, w_ada, b_ada, norm1_g, w_in, q_norm_g, k_norm_g, rwkv_mu,
              rwkv_w0, rwkv_w2, rwkv_a0, rwkv_a2, rwkv_g2, rwkv_k_k, rwkv_k_a, rwkv_r_k,
              rwkv_ln_g, rwkv_ln_b, w_proj_moba, w_proj_rwkv, w_out, norm2_g, peer_wq,
              peer_subkeys, peer_u, peer_v):
    B, S, D = x.shape
    split_at = [int(v) for v in np.cumsum(IN_SIZES)[:-1]]
    rwkv_split = [int(v) for v in np.cumsum((RWKV_WIDTH, RWKV_WIDTH, RWKV_WIDTH, RWKV_DECAY_LORA, RWKV_AAA_LORA))]
    h = x
    for l in range(DEPTH):
        mod = (jax.nn.silu(c) @ w_ada[l] + b_ada[l])[:, None, :]
        sh1, sc1, gt1, sh2, sc2, gt2 = jnp.split(mod, 6, axis=-1)
        xn = rms_norm(h, norm1_g[l]) * (1.0 + sc1) + sh1
        proj = xn @ w_in[l]
        qm, km, vm, zrw, gate_logits = jnp.split(proj, split_at, axis=-1)
        qm = rope_partial(rms_norm(qm.reshape(B, S, MOBA_HEADS, HEAD_DIM), q_norm_g[l]), positions)
        km = rope_partial(rms_norm(km.reshape(B, S, MOBA_HEADS, HEAD_DIM), k_norm_g[l]), positions)
        vm = vm.reshape(B, S, MOBA_HEADS, HEAD_DIM)
        o_moba = moba_attention(qm, km, vm).reshape(B, S, MOBA_WIDTH)
        zrw = token_shift(zrw, rwkv_mu[l])
        zr, zk, zv, zw, za, zg = jnp.split(zrw, rwkv_split, axis=-1)
        o_rwkv = rwkv7_time_mix(zr, zk, zv, zw, za, zg, rwkv_w0[l], rwkv_w2[l], rwkv_a0[l],
                                rwkv_a2[l], rwkv_g2[l], rwkv_k_k[l], rwkv_k_a[l], rwkv_r_k[l],
                                rwkv_ln_g[l], rwkv_ln_b[l])
        g_moba, g_rwkv = jnp.split(jax.nn.sigmoid(gate_logits), 2, axis=-1)
        mixed = g_moba * (o_moba @ w_proj_moba[l]) + g_rwkv * (o_rwkv @ w_proj_rwkv[l])
        h = h + gt1 * (mixed @ w_out[l])
        xn2 = rms_norm(h, norm2_g[l]) * (1.0 + sc2) + sh2
        h = h + gt2 * peer_ffn(xn2, peer_wq[l], peer_subkeys[l], peer_u[l], peer_v[l])
    return h
```

```cpp
#include <hip/hip_runtime.h>
#include <hip/hip_cooperative_groups.h>
#include <cstdio>
#include <cstdint>
namespace cg = cooperative_groups;

namespace pg8 {
#define PG8_LAS __attribute__((address_space(3)))
typedef unsigned short bf16_t;
typedef short bf16x8 __attribute__((ext_vector_type(8)));
typedef float f32x4 __attribute__((ext_vector_type(4)));
typedef unsigned u32x4 __attribute__((ext_vector_type(4)));
constexpr int BM = 256, BK = 64, HALF = 128, HTB = HALF * BK * 2  , STAGE_BYTES = 8 * HTB, NXCD = 8, WGM = 8;

__host__ __device__ __forceinline__ int lds_byte(int r, int c) { const int st = (r >> 4) * 2 + (c >> 5), rr = r & 15, cc = c & 31, ob = rr * 64 + cc * 2; return st * 1024 + (ob ^ (((ob >> 9) & 1) << 5)); }
__host__ __device__ __forceinline__ void stage_rc(int b, int& R, int& C) { const int st = b / 1024, sb = b % 1024, swz = sb ^ (((sb >> 9) & 1) << 5); R = (st >> 1) * 16 + swz / 64; C = (st & 1) * 32 + (swz % 64) / 2; }
__host__ __device__ __forceinline__ int perm32(int rho) { const int n = rho >> 4, i = rho & 15; return 8 * (i >> 2) + 4 * n + (i & 3); }

struct Unit { int pm, pn; };
struct Gemm { const bf16_t* A; const bf16_t* Bt; int M, N, K; };

struct StaticOrder {
    int nM, nN, nwg, G, c;
    __host__ __device__ void init(int M, int N, int G_, int c_) { nM = M / BM; nN = N / BM; nwg = nM * nN; G = G_; c = c_; }
    __host__ __device__ bool next(int i, Unit& u) const {
        const long L = (long)i * G + c; if (L >= nwg) return false;
        int wgid = (int)L; { const int q = nwg / NXCD, r = nwg % NXCD, xcd = wgid % NXCD, off = wgid / NXCD; wgid = (xcd < r ? xcd * (q + 1) : r * (q + 1) + (xcd - r) * q) + off; }
        const int nig = WGM * nN, gid = wgid / nig, fm = gid * WGM, gsz = (nM - fm) < WGM ? (nM - fm) : WGM;
        u.pm = fm + ((wgid % nig) % gsz); u.pn = (wgid % nig) / gsz; return true;
    }
    __device__ __forceinline__ void a_ready(const Unit&) const {}
    __device__ __forceinline__ void done(const Unit&) const {}
};
template <class Epi, class Sched, bool ALIGN_EPI = false, bool SP2 = false>
__device__ __forceinline__ void gemm_phase(PG8_LAS unsigned char* lds, const Gemm g, const Sched& S, const Epi& E) {
    const int tid = threadIdx.x, wid = __builtin_amdgcn_readfirstlane(tid >> 6), lane = tid & 63, wr = wid >> 2, wc = wid & 3, fr = lane & 15, fq = lane >> 4;
    const int K = g.K, nt = K / BK;
    unsigned voffA[2], voffB[2];
#pragma unroll
    for (int i = 0; i < 2; ++i) { int R, C; stage_rc(tid * 16 + i * 8192, R, C); const int Rb = Epi::PERM ? ((R & ~31) + perm32(R & 31)) : R;
        voffA[i] = (unsigned)(R * K + C) * 2u; voffB[i] = (unsigned)(Rb * K + C) * 2u; }
    const size_t kstep = (size_t)(BK * 2);
    const size_t hstep = (size_t)HALF * K * 2;
    const size_t tstep = 2 * hstep;
    const unsigned ldsw = (unsigned)wid * 1024u;
    const int aoff = lds_byte(wr * 64 + fr, fq * 8), boff = lds_byte(wc * 32 + fr, fq * 8);
#define PG8_SA(b, h) (((b) * 2 + (h)) * HTB)
#define PG8_SB(b, h) ((4 + (b) * 2 + (h)) * HTB)
#define PG8_STAGE(bufoff, gbase, voff) do { _Pragma("unroll") for (int _i = 0; _i < 2; ++_i) \
        __builtin_amdgcn_global_load_lds((const unsigned*)((const char*)(gbase) + (voff)[_i]), (PG8_LAS unsigned*)(lds + (bufoff) + ldsw + _i * 8192), 16, 0, 0); } while (0)
#define PG8_LDA(dst, b, h) do { _Pragma("unroll") for (int m = 0; m < 4; ++m) _Pragma("unroll") for (int k = 0; k < 2; ++k) dst[m][k] = *(const PG8_LAS bf16x8*)(lds + PG8_SA(b, h) + aoff + m * 2048 + k * 1024); } while (0)
#define PG8_LDB(dst, b, h) do { _Pragma("unroll") for (int n = 0; n < 2; ++n) _Pragma("unroll") for (int k = 0; k < 2; ++k) dst[n][k] = *(const PG8_LAS bf16x8*)(lds + PG8_SB(b, h) + boff + n * 2048 + k * 1024); } while (0)
#define PG8_MMA(ai, bj, At, Bt) do { __builtin_amdgcn_s_setprio(1); _Pragma("unroll") for (int m = 0; m < 4; ++m) _Pragma("unroll") for (int n = 0; n < 2; ++n) _Pragma("unroll") for (int k = 0; k < 2; ++k) \
        acc[ai][bj][m][n] = __builtin_amdgcn_mfma_f32_16x16x32_bf16(Bt[n][k], At[m][k], acc[ai][bj][m][n], 0, 0, 0); __builtin_amdgcn_s_setprio(0); } while (0)
#define PG8_WAIT_V(n) asm volatile("s_waitcnt vmcnt(" #n ")" ::: "memory")
#define PG8_WAIT_L(n) asm volatile("s_waitcnt lgkmcnt(" #n ")" ::: "memory")
#define PG8_BAR __builtin_amdgcn_s_barrier()
#define PG8_SCHED __builtin_amdgcn_sched_barrier(0)
    Unit cur, nxt; int ui = 0;
    if (!S.next(0, cur)) return;
    f32x4 acc[2][2][4][2];
#pragma unroll
    for (int a = 0; a < 2; ++a)
#pragma unroll
        for (int b = 0; b < 2; ++b)
#pragma unroll
            for (int m = 0; m < 4; ++m)
#pragma unroll
                for (int n = 0; n < 2; ++n) acc[a][b][m][n] = (f32x4){0.f, 0.f, 0.f, 0.f};
    bf16x8 At[4][2], B0[2][2], B1[2][2];
    const char* cA = (const char*)g.A + (size_t)cur.pm * tstep; const char* cB = (const char*)g.Bt + (size_t)cur.pn * tstep;
    S.a_ready(cur);
    if constexpr (SP2) {
        PG8_STAGE(PG8_SB(0, 0), cB, voffB); PG8_STAGE(PG8_SB(0, 1), cB + hstep, voffB); PG8_STAGE(PG8_SA(0, 0), cA, voffA); PG8_STAGE(PG8_SA(0, 1), cA + hstep, voffA);
        if (wr == 1) PG8_BAR;
        PG8_WAIT_V(2); PG8_BAR;
        PG8_STAGE(PG8_SB(1, 0), cB + kstep, voffB); PG8_STAGE(PG8_SA(1, 0), cA + kstep, voffA); PG8_STAGE(PG8_SB(1, 1), cB + hstep + kstep, voffB);
        PG8_WAIT_V(6); PG8_BAR;
    } else {
        PG8_STAGE(PG8_SB(0, 0), cB, voffB); PG8_STAGE(PG8_SA(0, 0), cA, voffA); PG8_STAGE(PG8_SB(0, 1), cB + hstep, voffB); PG8_STAGE(PG8_SA(0, 1), cA + hstep, voffA);
        if (wr == 1) PG8_BAR;
        PG8_WAIT_V(4); PG8_BAR;
        PG8_STAGE(PG8_SB(1, 0), cB + kstep, voffB); PG8_STAGE(PG8_SA(1, 0), cA + kstep, voffA); PG8_STAGE(PG8_SB(1, 1), cB + hstep + kstep, voffB);
        PG8_WAIT_V(6); PG8_BAR;
    }
    for (;;) {
        const bool has_next = S.next(ui + 1, nxt);
        const char* nA = has_next ? (const char*)g.A + (size_t)nxt.pm * tstep : cA; const char* nB = has_next ? (const char*)g.Bt + (size_t)nxt.pn * tstep : cB;
        for (int t = 0; t < nt; t += 2) {
            if constexpr (Epi::HAS_MID) { if (t == Epi::MID_T) E.mid(acc, cur, wr, wc, fr, fq); }
            const bool last = (t == nt - 2);
            const char* a1 = cA + (size_t)(t + 1) * kstep;
            const char* a2 = last ? nA : cA + (size_t)(t + 2) * kstep; const char* b2 = last ? nB : cB + (size_t)(t + 2) * kstep;
            const char* a3 = a2 + kstep; const char* b3 = b2 + kstep;
            if (last && has_next) S.a_ready(nxt);
            if constexpr (SP2) {
            PG8_LDB(B0, 0, 0); PG8_LDB(B1, 0, 1); PG8_SCHED; PG8_LDA(At, 0, 0); PG8_STAGE(PG8_SA(1, 1), a1 + hstep, voffA);
            PG8_WAIT_V(8); PG8_WAIT_L(0); PG8_BAR; PG8_MMA(0, 0, At, B0); PG8_MMA(0, 1, At, B1); PG8_BAR; PG8_SCHED;
            PG8_LDA(At, 0, 1); PG8_STAGE(PG8_SB(0, 0), b2, voffB); PG8_STAGE(PG8_SB(0, 1), b2 + hstep, voffB); PG8_STAGE(PG8_SA(0, 0), a2, voffA);
            PG8_WAIT_V(8); PG8_WAIT_L(0); PG8_BAR; PG8_MMA(1, 0, At, B0); PG8_MMA(1, 1, At, B1); PG8_BAR; PG8_SCHED;
            PG8_LDB(B0, 1, 0); PG8_LDB(B1, 1, 1); PG8_SCHED; PG8_LDA(At, 1, 0); PG8_STAGE(PG8_SA(0, 1), a2 + hstep, voffA);
            PG8_WAIT_V(8); PG8_WAIT_L(0); PG8_BAR; PG8_MMA(0, 0, At, B0); PG8_MMA(0, 1, At, B1); PG8_BAR; PG8_SCHED;
            PG8_LDA(At, 1, 1); PG8_STAGE(PG8_SB(1, 0), b3, voffB); PG8_STAGE(PG8_SB(1, 1), b3 + hstep, voffB); PG8_STAGE(PG8_SA(1, 0), a3, voffA);
            PG8_WAIT_V(8); PG8_WAIT_L(0); PG8_BAR; PG8_MMA(1, 0, At, B0); PG8_MMA(1, 1, At, B1); PG8_BAR; PG8_SCHED;
            } else {
            PG8_LDB(B0, 0, 0); PG8_SCHED; PG8_LDA(At, 0, 0); PG8_STAGE(PG8_SA(1, 1), a1 + hstep, voffA);
            PG8_WAIT_L(8); PG8_BAR; PG8_WAIT_L(0); PG8_MMA(0, 0, At, B0); PG8_BAR; PG8_SCHED;
            PG8_LDB(B1, 0, 1); PG8_STAGE(PG8_SB(0, 0), b2, voffB);
            PG8_BAR; PG8_WAIT_L(0); PG8_MMA(0, 1, At, B1); PG8_BAR;
            PG8_LDA(At, 0, 1); PG8_STAGE(PG8_SA(0, 0), a2, voffA);
            PG8_BAR; PG8_WAIT_L(0); PG8_MMA(1, 0, At, B0); PG8_BAR; PG8_SCHED;
            PG8_STAGE(PG8_SB(0, 1), b2 + hstep, voffB);
            PG8_WAIT_V(6); PG8_BAR; PG8_MMA(1, 1, At, B1); PG8_BAR;
            PG8_LDB(B0, 1, 0); PG8_SCHED; PG8_LDA(At, 1, 0); PG8_STAGE(PG8_SA(0, 1), a2 + hstep, voffA);
            PG8_WAIT_L(8); PG8_BAR; PG8_WAIT_L(0); PG8_MMA(0, 0, At, B0); PG8_BAR; PG8_SCHED;
            PG8_LDB(B1, 1, 1); PG8_STAGE(PG8_SB(1, 0), b3, voffB);
            PG8_BAR; PG8_WAIT_L(0); PG8_MMA(0, 1, At, B1); PG8_BAR;
            PG8_LDA(At, 1, 1); PG8_STAGE(PG8_SA(1, 0), a3, voffA);
            PG8_BAR; PG8_WAIT_L(0); PG8_MMA(1, 0, At, B0); PG8_BAR; PG8_SCHED;
            PG8_STAGE(PG8_SB(1, 1), b3 + hstep, voffB);
            PG8_WAIT_V(6); PG8_BAR; PG8_MMA(1, 1, At, B1); PG8_BAR;
            }
        }
        if constexpr (ALIGN_EPI) { if (wr == 0) PG8_BAR; }
        if constexpr (!Epi::AFTER_DRAIN) { E(acc, cur, wr, wc, fr, fq); S.done(cur); }
        if (!has_next) break;
#pragma unroll
        for (int a = 0; a < 2; ++a)
#pragma unroll
            for (int b = 0; b < 2; ++b)
#pragma unroll
                for (int m = 0; m < 4; ++m)
#pragma unroll
                    for (int n = 0; n < 2; ++n) acc[a][b][m][n] = (f32x4){0.f, 0.f, 0.f, 0.f};
        cur = nxt; cA = nA; cB = nB; ++ui;
        if constexpr (ALIGN_EPI) { if (wr == 1) PG8_BAR; }
    }
    PG8_WAIT_V(0);
    if constexpr (!ALIGN_EPI) { if (wr == 0) PG8_BAR; }
    PG8_BAR;
    if constexpr (Epi::AFTER_DRAIN) { E.fused(acc, cur, wr, wc, fr, fq, lds, wid, lane); S.done(cur); }
#undef PG8_SA
#undef PG8_SB
#undef PG8_STAGE
#undef PG8_LDA
#undef PG8_LDB
#undef PG8_MMA
#undef PG8_WAIT_V
#undef PG8_WAIT_L
#undef PG8_BAR
#undef PG8_SCHED
}
}

constexpr int NWAVES = 8, NTHR = 512;
constexpr int BATCH = 4, SEQ = 8192, DM = 1024, T = BATCH * SEQ;
constexpr int NH = 8, HD = 64, NBLK = 32, BLK = 256;
constexpr int BH = BATCH * NH;
constexpr int INW = 5376;
constexpr int ZR = 1536, ZL = 256;
constexpr int PEER_N = 2048;
constexpr float RMS_EPS = 1e-6f, GN_EPS = 64e-5f;
constexpr int OSTR = 1024;

constexpr size_t MiB = 1u << 20;
constexpr size_t WS_CTL = 0, CTL_ZERO_BYTES = 1 * MiB;
constexpr size_t WS_MOD = 1 * MiB;
constexpr size_t WS_KMEAN = 1 * MiB + 128 * 1024;
constexpr size_t WS_WIN = 2 * MiB;
constexpr size_t WS_WLORA = 13 * MiB;
constexpr size_t WS_WPM = 14 * MiB, WS_WPR = 15 * MiB;
constexpr size_t WS_WOUT = 16 * MiB;
constexpr size_t WS_WEFF = 18 * MiB;
constexpr size_t WS_XN = 24 * MiB;
constexpr size_t WS_EW = 24 * MiB, WS_AA = 56 * MiB;
constexpr size_t WS_Q = 88 * MiB, WS_K = 120 * MiB, WS_VT = 152 * MiB;
constexpr size_t WS_ZRKV = 184 * MiB;
constexpr size_t WS_GT = 280 * MiB;
constexpr size_t WS_ZLORA = 408 * MiB;
constexpr size_t WS_ALORA = 424 * MiB;
constexpr size_t WS_OCAT = 408 * MiB;
constexpr size_t WS_GG = 472 * MiB;
constexpr size_t WS_MIXED = 216 * MiB;
constexpr size_t WS_U8 = 2 * MiB, WS_V8 = 88 * MiB;
constexpr size_t WS_SCORES = 96 * MiB;
constexpr size_t WS_END = 512 * MiB;
constexpr size_t DO_OPART = 0, DO_LISTS = 96 * MiB, DO_LPART = 112 * MiB;
constexpr int LIST_PER_BH = 256 * 496;
__host__ __device__ constexpr int list_off(int n) { return 256 * (31 * n - n * (n - 1) / 2); }
constexpr int CW_QUEUE = 64;
constexpr int CW_CURSOR = 1024;
constexpr int CW_BAR = 4096;

constexpr int RING_BYTES = 131072;
constexpr int LDS_BYTES = 163840;
constexpr int MISC_OFF = LDS_BYTES - 512;

#define GAS __attribute__((address_space(1)))
#define LAS __attribute__((address_space(3)))
typedef unsigned short bf16;
typedef unsigned v4u __attribute__((ext_vector_type(4)));
typedef unsigned v2u __attribute__((ext_vector_type(2)));
typedef float f32x4 __attribute__((ext_vector_type(4)));
typedef float f32x2 __attribute__((ext_vector_type(2)));
typedef float f32x16 __attribute__((ext_vector_type(16)));
typedef short bf16x8 __attribute__((ext_vector_type(8)));
typedef short s16x4 __attribute__((ext_vector_type(4)));
#define RLX_AGENT __ATOMIC_RELAXED, __HIP_MEMORY_SCOPE_AGENT
#define LDS_WAIT() asm volatile("s_waitcnt lgkmcnt(0)" ::: "memory")
#define VM_WAIT() asm volatile("s_waitcnt vmcnt(0)" ::: "memory")
typedef __bf16 bf16x2_t __attribute__((ext_vector_type(2)));
__device__ __forceinline__ unsigned cvtpk(float lo, float hi) { f32x2 v = {lo, hi}; bf16x2_t b = __builtin_convertvector(v, bf16x2_t); return __builtin_bit_cast(unsigned, b); }
__device__ __forceinline__ unsigned pk2(float lo, float hi) { return cvtpk(lo, hi); }
__device__ __forceinline__ unsigned f2bf(float f) { return cvtpk(f, 0.f) & 0xffffu; }
__device__ __forceinline__ float bflo(unsigned u) { return __builtin_bit_cast(float, u << 16); }
__device__ __forceinline__ float bfhi(unsigned u) { return __builtin_bit_cast(float, u & 0xffff0000u); }
__device__ __forceinline__ float bf2f(bf16 h) { return __builtin_bit_cast(float, (unsigned)h << 16); }
__device__ __forceinline__ float wave_sum(float v) {
#pragma unroll
    for (int o = 1; o < 64; o <<= 1) v += __shfl_xor(v, o);
    return v;
}
__device__ __forceinline__ float sigmoidf_(float x) { return __builtin_amdgcn_rcpf(1.0f + __expf(-x)); }
#define XB_TMO      128
#define XB_XCNT(j)  (256  + 64 * (j))
#define XB_XSUB(j)  (1280 + 64 * (j))
#define XB_XGEN(j)  (2304 + 64 * (j))
#define XB_TOP      3328
#define XB_TOPGEN   3392
#define XCD_BAR_WORDS 3456
#define XB_SPIN_CAP (1u << 18)

__device__ __forceinline__ unsigned xb_ld(unsigned* p)              { return __hip_atomic_load(p, __ATOMIC_RELAXED, __HIP_MEMORY_SCOPE_AGENT); }
__device__ __forceinline__ unsigned xb_add(unsigned* p, unsigned v) { return __hip_atomic_fetch_add(p, v, __ATOMIC_RELAXED, __HIP_MEMORY_SCOPE_AGENT); }
__device__ __forceinline__ unsigned xb_xcc_id() { return (unsigned)__builtin_amdgcn_s_getreg((3 << 11) | 20) & 0xFu; }
#define XB_SPIN(cond, bar) do { unsigned _sp = 0; while (cond) { __builtin_amdgcn_s_sleep(1); \
    if ((++_sp & 255u) == 0u) { if (xb_ld(&(bar)[XB_TMO])) break; if (_sp > XB_SPIN_CAP) { atomicAdd(&(bar)[XB_TMO], 1u); break; } } } } while (0)

struct XcdBarrier {
    unsigned* bar; unsigned x;
    volatile LAS unsigned* st;
};

__device__ __forceinline__ XcdBarrier xcd_barrier_post(unsigned* bar, volatile LAS unsigned* st) {
    XcdBarrier b; b.bar = bar; b.x = xb_xcc_id(); b.st = st;
    if (threadIdx.x == 0) (void)xb_add(&bar[XB_XCNT(b.x)], 1u);
    return b;
}
__device__ __forceinline__ void xcd_barrier_complete(unsigned* bar, unsigned x, unsigned& nloc, unsigned& nx) {
    const unsigned G = gridDim.x * gridDim.y * gridDim.z;
    unsigned sum, cnt, mine, sp = 0u;
    for (;;) {
        sum = 0u; cnt = 0u; mine = 0u;
#pragma unroll
        for (unsigned j = 0; j < 16; ++j) { const unsigned c = xb_ld(&bar[XB_XCNT(j)]); sum += c; cnt += (c > 0u) ? 1u : 0u; mine = (j == x) ? c : mine; }
        if (sum == G) break;
        __builtin_amdgcn_s_sleep(1);
        if ((++sp & 255u) == 0u) { if (xb_ld(&bar[XB_TMO])) break; if (sp > XB_SPIN_CAP) { atomicAdd(&bar[XB_TMO], 1u); break; } }
    }
    nloc = mine > 0u ? mine : 1u; nx = cnt > 0u ? cnt : 1u;
}

__device__ __forceinline__ void xcd_barrier(const XcdBarrier& b) {
    asm volatile("s_waitcnt vmcnt(0)" ::: "memory");
    __syncthreads();
    if (threadIdx.x == 0) {
        unsigned* bar = b.bar;
        __builtin_amdgcn_s_waitcnt(0);
        unsigned nloc = b.st[0], nx = b.st[1];
        if (nloc == 0u) { xcd_barrier_complete(bar, b.x, nloc, nx); b.st[0] = nloc; b.st[1] = nx; }
        const unsigned old = xb_add(&bar[XB_XSUB(b.x)], 1u);
        const unsigned gen = old / nloc;
        if (old + 1u == (gen + 1u) * nloc) {
            __builtin_amdgcn_fence(__ATOMIC_RELEASE, "agent");
            asm volatile("s_waitcnt vmcnt(0)" ::: "memory");
            const unsigned og = xb_add(&bar[XB_TOP], 1u);
            const unsigned tg = og / nx;
            if (og + 1u == (tg + 1u) * nx) xb_add(&bar[XB_TOPGEN], 1u);
            else XB_SPIN(xb_ld(&bar[XB_TOPGEN]) == tg, bar);
            __builtin_amdgcn_fence(__ATOMIC_ACQUIRE, "agent");
            xb_add(&bar[XB_XGEN(b.x)], 1u);
            asm volatile("s_waitcnt vmcnt(0)" ::: "memory");
        } else {
            XB_SPIN(xb_ld(&bar[XB_XGEN(b.x)]) == gen, bar);
            __builtin_amdgcn_fence(__ATOMIC_ACQUIRE, "agent");
            asm volatile("s_waitcnt vmcnt(0)" ::: "memory");
        }
    }
    __syncthreads();
}

__device__ __forceinline__ void p0_transpose_item(const float* W, int K, int N, bf16* WT, int ldk, int koff, LAS float* scr, int item, int lane) {
    const int nblk = N / 32, kb = item / nblk, nb = item % nblk, k0 = 64 * kb, n0 = 32 * nb;
#pragma unroll 8
    for (int i = 0; i < 32; ++i) { const int kk = 2 * i + (lane >> 5); scr[kk * 33 + (lane & 31)] = W[(size_t)(k0 + kk) * N + n0 + (lane & 31)]; }
    LDS_WAIT(); asm volatile("" ::: "memory");
    const int c = lane & 7;
#pragma unroll
    for (int j = 0; j < 4; ++j) { const int n = (lane >> 3) + 8 * j; const LAS float* s = scr + (8 * c) * 33 + n;
        v4u o; o.x = pk2(s[0 * 33], s[1 * 33]); o.y = pk2(s[2 * 33], s[3 * 33]); o.z = pk2(s[4 * 33], s[5 * 33]); o.w = pk2(s[6 * 33], s[7 * 33]);
#ifdef EMU_FP8_G2
        if (N == INW) { float f_[8];
            for (int e_ = 0; e_ < 8; e_ += 2) { int w_ = __builtin_amdgcn_cvt_pk_fp8_f32(s[e_ * 33] * 256.f, s[(e_ + 1) * 33] * 256.f, 0, false); const f32x2 l_ = __builtin_amdgcn_cvt_pk_f32_fp8(w_, false); f_[e_] = l_.x * (1.f / 256.f); f_[e_ + 1] = l_.y * (1.f / 256.f); }
            o.x = pk2(f_[0], f_[1]); o.y = pk2(f_[2], f_[3]); o.z = pk2(f_[4], f_[5]); o.w = pk2(f_[6], f_[7]); }
#endif
        *(GAS v4u*)(WT + (size_t)(n0 + n) * ldk + koff + k0 + 8 * c) = o; }
    LDS_WAIT(); asm volatile("" ::: "memory");
}
__device__ __forceinline__ void p0_mod_item(const float* c, const float* w_ada, const float* b_ada, float* modp, LAS float* red  , int item, int wave, int lane) {
    const int j = item * 64 + lane;
    float a0 = 0.f, a1 = 0.f, a2 = 0.f, a3 = 0.f;
#pragma unroll 8
    for (int k = 128 * wave; k < 128 * wave + 128; ++k) {
        const float w = w_ada[(size_t)k * 6144 + j];
        const float c0 = c[k], c1 = c[1024 + k], c2 = c[2048 + k], c3 = c[3072 + k];
        a0 += c0 / (1.f + __expf(-c0)) * w; a1 += c1 / (1.f + __expf(-c1)) * w; a2 += c2 / (1.f + __expf(-c2)) * w; a3 += c3 / (1.f + __expf(-c3)) * w;
    }
    red[(wave * 4 + 0) * 64 + lane] = a0; red[(wave * 4 + 1) * 64 + lane] = a1; red[(wave * 4 + 2) * 64 + lane] = a2; red[(wave * 4 + 3) * 64 + lane] = a3;
    LDS_WAIT(); __syncthreads();
    if (wave < 4) { float s = b_ada[j];
#pragma unroll
        for (int w = 0; w < 8; ++w) s += red[(w * 4 + wave) * 64 + lane];
        modp[wave * 6144 + j] = s; }
    __syncthreads();
}
__device__ __forceinline__ void p0_weff_item(const float* wq, const float* sk, bf16* weff, int item, int lane) {
    const int nq = item & 3, kb = (item >> 2) & 31, hp = item >> 7;
    const int k = kb * 32 + (lane & 31), dh = lane >> 5;
    float w[64];
    const f32x4* src = (const f32x4*)(wq + (size_t)k * 2048 + hp * 128 + 64 * dh);
#pragma unroll
    for (int i = 0; i < 16; ++i) { const f32x4 v = src[i]; w[4 * i] = v.x; w[4 * i + 1] = v.y; w[4 * i + 2] = v.z; w[4 * i + 3] = v.w; }
#pragma unroll 1
    for (int n = nq * 32; n < nq * 32 + 32; n += 2) {
        float acc[2] = {0.f, 0.f};
#pragma unroll
        for (int u = 0; u < 2; ++u) {
            const f32x4* s = (const f32x4*)(sk + ((size_t)hp * 128 + n + u) * 128 + 64 * dh);
#pragma unroll
            for (int d = 0; d < 16; ++d) { const f32x4 s4 = s[d]; acc[u] += w[4 * d] * s4.x; acc[u] += w[4 * d + 1] * s4.y; acc[u] += w[4 * d + 2] * s4.z; acc[u] += w[4 * d + 3] * s4.w; }
        }
#pragma unroll
        for (int u = 0; u < 2; ++u) { acc[u] += __shfl_xor(acc[u], 32); if (dh == 0) weff[((size_t)hp * 128 + n + u) * 1024 + k] = (bf16)f2bf(acc[u]); }
    }
}
template <int NR> __device__ __forceinline__ void rms_mod_rows(const float* xrow, bf16* orow, unsigned* o8row  , const float* g, const float* sc, const float* sh, int lane) {
    f32x4 v[NR][4]; float ss[NR];
#pragma unroll
    for (int rr = 0; rr < NR; ++rr) { const f32x4* xr = (const f32x4*)(xrow + (size_t)rr * 1024) + lane; ss[rr] = 0.f;
#pragma unroll
        for (int j = 0; j < 4; ++j) v[rr][j] = xr[64 * j]; }
#pragma unroll
    for (int rr = 0; rr < NR; ++rr)
#pragma unroll
        for (int j = 0; j < 4; ++j) ss[rr] += (v[rr][j].x * v[rr][j].x + v[rr][j].y * v[rr][j].y) + (v[rr][j].z * v[rr][j].z + v[rr][j].w * v[rr][j].w);
#pragma unroll
    for (int o = 1; o < 64; o <<= 1) {
#pragma unroll
        for (int rr = 0; rr < NR; ++rr) ss[rr] += __shfl_xor(ss[rr], o);
    }
#pragma unroll
    for (int j = 0; j < 4; ++j) { const int col = 4 * lane + 256 * j;
        const f32x4 g4 = *(const f32x4*)(g + col), s4 = *(const f32x4*)(sc + col), h4 = *(const f32x4*)(sh + col);
#pragma unroll
        for (int rr = 0; rr < NR; ++rr) {
            const float rstd = 1.f / sqrtf(ss[rr] * (1.f / 1024.f) + RMS_EPS);
            const float o0 = v[rr][j].x * rstd * g4.x * (1.f + s4.x) + h4.x, o1 = v[rr][j].y * rstd * g4.y * (1.f + s4.y) + h4.y;
            const float o2 = v[rr][j].z * rstd * g4.z * (1.f + s4.z) + h4.z, o3 = v[rr][j].w * rstd * g4.w * (1.f + s4.w) + h4.w;
            ((unsigned long long*)(orow + (size_t)rr * 1024))[lane + 64 * j] = (unsigned long long)pk2(o0, o1) | ((unsigned long long)pk2(o2, o3) << 32);
            if (o8row) { int w = 0; w = __builtin_amdgcn_cvt_pk_fp8_f32(fminf(fmaxf(o0 * 8.f, -448.f), 448.f), fminf(fmaxf(o1 * 8.f, -448.f), 448.f), w, false);
                w = __builtin_amdgcn_cvt_pk_fp8_f32(fminf(fmaxf(o2 * 8.f, -448.f), 448.f), fminf(fmaxf(o3 * 8.f, -448.f), 448.f), w, true); (o8row + (size_t)rr * 256)[lane + 64 * j] = (unsigned)w; }
        }
    }
}

__device__ __forceinline__ v4u pack8(const f32x4 a, const f32x4 b) { v4u w; w.x = pk2(a.x, a.y); w.y = pk2(a.z, a.w); w.z = pk2(b.x, b.y); w.w = pk2(b.z, b.w); return w; }
__device__ __forceinline__ size_t gt_off(int pm, int pt, int frag, int wave, int lane) { return ((((size_t)(pm * 8 + pt) * 16 + frag) * 8 + wave) * 64 + lane) * 8; }
struct EpiIn {
    static constexpr bool PERM = true, AFTER_DRAIN = false, HAS_MID = false;
    bf16 *Q, *K, *VT, *ZRKV, *ZLORA, *GT;
    __device__ __forceinline__ void operator()(const f32x4 (&acc)[2][2][4][2], const pg8::Unit& u, int wr, int wc, int fr, int fq) const {
        const int pn = u.pn;
#pragma unroll
        for (int ai = 0; ai < 2; ++ai)
#pragma unroll
            for (int m = 0; m < 4; ++m) {
                const int row = u.pm * 256 + ai * 128 + wr * 64 + m * 16 + fr;
                const int b = row >> 13, s = row & 8191;
#pragma unroll
                for (int bj = 0; bj < 2; ++bj) {
                    const int colt = bj * 128 + wc * 32 + 8 * fq;
                    const f32x4 v0 = acc[ai][bj][m][0], v1 = acc[ai][bj][m][1];
                    if (pn < 4) {
                        bf16* base = pn < 2 ? Q : K; const int h = 4 * (pn & 1) + (colt >> 6), d0 = colt & 63;
                        *(v4u*)(base + ((size_t)((b * 8 + h) * 8192 + s)) * 64 + d0) = pack8(v0, v1);
                    } else if (pn < 6) {
                        const int h = 4 * (pn - 4) + (colt >> 6), dv0 = colt & 63;
                        bf16* p = VT + ((size_t)((b * 8 + h) * 64 + dv0)) * 8192 + s;
                        p[0 * 8192] = (bf16)f2bf(v0.x); p[1 * 8192] = (bf16)f2bf(v0.y); p[2 * 8192] = (bf16)f2bf(v0.z); p[3 * 8192] = (bf16)f2bf(v0.w);
                        p[4 * 8192] = (bf16)f2bf(v1.x); p[5 * 8192] = (bf16)f2bf(v1.y); p[6 * 8192] = (bf16)f2bf(v1.z); p[7 * 8192] = (bf16)f2bf(v1.w);
                    } else if (pn < 12) {
                        *(v4u*)(ZRKV + (size_t)row * ZR + 256 * (pn - 6) + colt) = pack8(v0, v1);
                    } else if (pn == 12) {
                        *(v4u*)(ZLORA + (size_t)row * ZL + colt) = pack8(v0, v1);
                    } else {
                        f32x4 s0, s1;
                        s0.x = sigmoidf_(v0.x); s0.y = sigmoidf_(v0.y); s0.z = sigmoidf_(v0.z); s0.w = sigmoidf_(v0.w);
                        s1.x = sigmoidf_(v1.x); s1.y = sigmoidf_(v1.y); s1.z = sigmoidf_(v1.z); s1.w = sigmoidf_(v1.w);
                        *(v4u*)(GT + gt_off(u.pm, pn - 13, 0, wr * 4 + wc, fq * 16 + fr) + (size_t)(((ai * 4 + m) * 2 + bj) * 4096)) = pack8(s0, s1);
                    }
                }
            }
    }
};
struct EpiLora {
    static constexpr bool PERM = true, AFTER_DRAIN = false, HAS_MID = false;
    bf16 *EW, *AA, *GG; const float *w0, *a0;
    __device__ __forceinline__ void operator()(const f32x4 (&acc)[2][2][4][2], const pg8::Unit& u, int wr, int wc, int fr, int fq) const {
        const int pn = u.pn;
#pragma unroll
        for (int ai = 0; ai < 2; ++ai)
#pragma unroll
            for (int m = 0; m < 4; ++m) {
                const int row = u.pm * 256 + ai * 128 + wr * 64 + m * 16 + fr;
#pragma unroll
                for (int bj = 0; bj < 2; ++bj) {
                    const int c = 256 * (pn & 1) + bj * 128 + wc * 32 + 8 * fq;
                    const f32x4 v0 = acc[ai][bj][m][0], v1 = acc[ai][bj][m][1];
                    float v[8] = {v0.x, v0.y, v0.z, v0.w, v1.x, v1.y, v1.z, v1.w};
                    bf16* dst;
                    if (pn < 2) {
#pragma unroll
                        for (int i = 0; i < 8; ++i) v[i] = 0.60653065971263342f * sigmoidf_(w0[c + i] + v[i]);
                        dst = EW;
                    } else if (pn < 4) {
#pragma unroll
                        for (int i = 0; i < 8; ++i) v[i] = sigmoidf_(a0[c + i] + v[i]);
                        dst = AA;
                    } else dst = GG;
                    v4u w; w.x = pk2(v[0], v[1]); w.y = pk2(v[2], v[3]); w.z = pk2(v[4], v[5]); w.w = pk2(v[6], v[7]);
                    *(v4u*)(dst + (size_t)row * 512 + c) = w;
                }
            }
    }
};
struct EpiMix {
    static constexpr bool PERM = true, AFTER_DRAIN = false, HAS_MID = true; static constexpr int MID_T = 8;
    const bf16* GT; bf16* MIXED; int probe;
    __device__ __forceinline__ void mid(f32x4 (&acc)[2][2][4][2], const pg8::Unit& u, int wr, int wc, int fr, int fq) const {
        if (probe & 1) return;
        const bf16* pm_ = GT + gt_off(u.pm, u.pn, 0, wr * 4 + wc, fq * 16 + fr); const bf16* pr_ = GT + gt_off(u.pm, u.pn + 4, 0, wr * 4 + wc, fq * 16 + fr);
#pragma unroll
        for (int ai = 0; ai < 2; ++ai)
#pragma unroll
            for (int m = 0; m < 4; ++m)
#pragma unroll
                for (int bj = 0; bj < 2; ++bj) {
                    const v4u gm = *(const v4u*)pm_, gr = *(const v4u*)pr_;
                    pm_ += 4096; pr_ += 4096; asm volatile("" : "+v"(pm_), "+v"(pr_));
                    f32x4 r0, r1;
                    r0.x = bflo(gm.x) * __builtin_amdgcn_rcpf(fmaxf(bflo(gr.x), 1e-30f)); r0.y = bfhi(gm.x) * __builtin_amdgcn_rcpf(fmaxf(bfhi(gr.x), 1e-30f));
                    r0.z = bflo(gm.y) * __builtin_amdgcn_rcpf(fmaxf(bflo(gr.y), 1e-30f)); r0.w = bfhi(gm.y) * __builtin_amdgcn_rcpf(fmaxf(bfhi(gr.y), 1e-30f));
                    r1.x = bflo(gm.z) * __builtin_amdgcn_rcpf(fmaxf(bflo(gr.z), 1e-30f)); r1.y = bfhi(gm.z) * __builtin_amdgcn_rcpf(fmaxf(bfhi(gr.z), 1e-30f));
                    r1.z = bflo(gm.w) * __builtin_amdgcn_rcpf(fmaxf(bflo(gr.w), 1e-30f)); r1.w = bfhi(gm.w) * __builtin_amdgcn_rcpf(fmaxf(bfhi(gr.w), 1e-30f));
                    acc[ai][bj][m][0] = acc[ai][bj][m][0] * r0; acc[ai][bj][m][1] = acc[ai][bj][m][1] * r1;
                }
    }
    __device__ __forceinline__ void operator()(const f32x4 (&acc)[2][2][4][2], const pg8::Unit& u, int wr, int wc, int fr, int fq) const {
        const bf16* pr_ = GT + gt_off(u.pm, u.pn + 4, 0, wr * 4 + wc, fq * 16 + fr);
#pragma unroll
        for (int ai = 0; ai < 2; ++ai)
#pragma unroll
            for (int m = 0; m < 4; ++m) {
                const int row = u.pm * 256 + ai * 128 + wr * 64 + m * 16 + fr;
#pragma unroll
                for (int bj = 0; bj < 2; ++bj) {
                    const int c = u.pn * 256 + bj * 128 + wc * 32 + 8 * fq;
                    v4u g = {0x3f803f80u, 0x3f803f80u, 0x3f803f80u, 0x3f803f80u};
                    if (!(probe & 2)) g = *(const v4u*)pr_;
                    pr_ += 4096; asm volatile("" : "+v"(pr_));
                    const f32x4 v0 = acc[ai][bj][m][0], v1 = acc[ai][bj][m][1];
                    f32x4 o0, o1;
                    o0.x = bflo(g.x) * v0.x; o0.y = bfhi(g.x) * v0.y; o0.z = bflo(g.y) * v0.z; o0.w = bfhi(g.y) * v0.w;
                    o1.x = bflo(g.z) * v1.x; o1.y = bfhi(g.z) * v1.y; o1.z = bflo(g.w) * v1.z; o1.w = bfhi(g.w) * v1.w;
                    *(v4u*)(MIXED + (size_t)row * 1024 + c) = pack8(o0, o1);
                }
            }
    }
};
struct EpiOut {
    static constexpr bool PERM = true, AFTER_DRAIN = false, HAS_MID = false;
    const float* X; const float* MOD; float* OUT;
    __device__ __forceinline__ void operator()(const f32x4 (&acc)[2][2][4][2], const pg8::Unit& u, int wr, int wc, int fr, int fq) const {
#pragma unroll
        for (int ai = 0; ai < 2; ++ai)
#pragma unroll
            for (int m = 0; m < 4; ++m) {
                const int row = u.pm * 256 + ai * 128 + wr * 64 + m * 16 + fr;
                const float* gt1 = MOD + (size_t)(row >> 13) * 6144 + 2048;
#pragma unroll
                for (int bj = 0; bj < 2; ++bj) {
                    const int c = u.pn * 256 + bj * 128 + wc * 32 + 8 * fq;
                    const float* xp = X + (size_t)row * 1024 + c;
                    const f32x4 x0 = *(const f32x4*)xp, x1 = *(const f32x4*)(xp + 4);
                    const f32x4 g0 = *(const f32x4*)(gt1 + c), g1 = *(const f32x4*)(gt1 + c + 4);
                    const f32x4 v0 = acc[ai][bj][m][0], v1 = acc[ai][bj][m][1];
                    float* d = OUT + (size_t)row * 1024 + c;
                    *(f32x4*)d = x0 + g0 * v0; *(f32x4*)(d + 4) = x1 + g1 * v1;
                }
            }
    }
};
struct EpiScores {
    static constexpr bool PERM = true, AFTER_DRAIN = false, HAS_MID = false;
    bf16* SC;
    __device__ __forceinline__ void operator()(const f32x4 (&acc)[2][2][4][2], const pg8::Unit& u, int wr, int wc, int fr, int fq) const {
#pragma unroll
        for (int ai = 0; ai < 2; ++ai)
#pragma unroll
            for (int m = 0; m < 4; ++m) {
                const int row = u.pm * 256 + ai * 128 + wr * 64 + m * 16 + fr;
#pragma unroll
                for (int bj = 0; bj < 2; ++bj) {
                    const int c = u.pn * 256 + bj * 128 + wc * 32 + 8 * fq;
                    *(v4u*)(SC + (size_t)row * 2048 + c) = pack8(acc[ai][bj][m][0], acc[ai][bj][m][1]);
                }
            }
    }
};


__device__ __forceinline__ void p2_qk_load(v4u (&raw)[4], int (&ps)[4], const bf16* buf, const int* pos, int bh, int n, int wave, int lane) {
#pragma unroll
    for (int it = 0; it < 4; ++it) { const int row = n * 256 + wave * 32 + it * 8 + (lane >> 3);
        raw[it] = *(const v4u*)(buf + ((size_t)(bh * 8192 + row)) * 64 + 8 * (lane & 7)); ps[it] = pos[(bh >> 3) * 8192 + row]; }
}
__device__ __forceinline__ void p2_qk_item(const v4u (&rawin)[4], const int (&psin)[4], bf16* obuf, const float* g, float* kmean, int bh, int n, LAS float* red, int tid, int wave, int lane) {
    const int c = lane & 7, rsub = lane >> 3;
    float gg[8], ks[8];
#pragma unroll
    for (int i = 0; i < 8; ++i) { gg[i] = g[8 * c + i]; ks[i] = 0.f; }
#pragma unroll
    for (int it = 0; it < 4; ++it) {
        const int row = n * 256 + wave * 32 + it * 8 + rsub;
        const size_t po = ((size_t)(bh * 8192 + row)) * 64 + 8 * c;
        const v4u raw = rawin[it];
        float x[8] = {bflo(raw.x), bfhi(raw.x), bflo(raw.y), bfhi(raw.y), bflo(raw.z), bfhi(raw.z), bflo(raw.w), bfhi(raw.w)};
        float ss = 0.f;
#pragma unroll
        for (int i = 0; i < 8; ++i) ss += x[i] * x[i];
        ss += __shfl_xor(ss, 1); ss += __shfl_xor(ss, 2); ss += __shfl_xor(ss, 4);
        const float rstd = 1.f / sqrtf(ss * (1.f / 64.f) + RMS_EPS);
        float y[8], py[8];
#pragma unroll
        for (int i = 0; i < 8; ++i) y[i] = x[i] * rstd * gg[i];
#pragma unroll
        for (int i = 0; i < 8; ++i) py[i] = __shfl_xor(y[i], 1);
        {
            const float myang = (float)psin[it] * exp2f(-(float)c * (18.931568569324174f / 8.f));
            const float mys = __sinf(myang), myc = __cosf(myang);
            float sn[8], cs[8];
#pragma unroll
            for (int i = 0; i < 8; ++i) { sn[i] = __shfl(mys, (lane & ~7) + i); cs[i] = __shfl(myc, (lane & ~7) + i); }
            if (c < 2) {
#pragma unroll
                for (int i = 0; i < 8; ++i) y[i] = (c == 0) ? (y[i] * cs[i] - py[i] * sn[i]) : (y[i] * cs[i] + py[i] * sn[i]);
            }
        }
        v4u o; o.x = pk2(y[0], y[1]); o.y = pk2(y[2], y[3]); o.z = pk2(y[4], y[5]); o.w = pk2(y[6], y[7]);
        *(v4u*)(obuf + po) = o;
#pragma unroll
        for (int i = 0; i < 8; ++i) ks[i] += y[i];
    }
    if (kmean) {
#pragma unroll
        for (int i = 0; i < 8; ++i) { ks[i] += __shfl_xor(ks[i], 8); ks[i] += __shfl_xor(ks[i], 16); ks[i] += __shfl_xor(ks[i], 32); }
        if (lane < 8) {
#pragma unroll
            for (int i = 0; i < 8; ++i) red[wave * 64 + 8 * lane + i] = ks[i];
        }
        __syncthreads();
        if (tid < 64) { float s = 0.f;
#pragma unroll
            for (int w = 0; w < 8; ++w) s += red[w * 64 + tid];
            kmean[(size_t)(bh * 32 + n) * 64 + tid] = s * (1.f / 256.f); }
        __syncthreads();
    }
}
__device__ __forceinline__ void p2_prep(const bf16* ZL_, const float* mu, bf16* AL, int gtid, int ntot) {
#pragma unroll 2
    for (int idx = gtid; idx < T * 32; idx += ntot) {
        const int t = idx >> 5, col = (idx & 31) * 8, s = t & 8191;
        const v4u cur = *(const v4u*)(ZL_ + (size_t)t * ZL + col);
        v4u prv = *(const v4u*)(ZL_ + (size_t)(s ? t - 1 : t) * ZL + col);
        prv = prv & (s ? 0xffffffffu : 0u);
        const float cz[8] = {bflo(cur.x), bfhi(cur.x), bflo(cur.y), bfhi(cur.y), bflo(cur.z), bfhi(cur.z), bflo(cur.w), bfhi(cur.w)};
        const float pz[8] = {bflo(prv.x), bfhi(prv.x), bflo(prv.y), bfhi(prv.y), bflo(prv.z), bfhi(prv.z), bflo(prv.w), bfhi(prv.w)};
        float o[8];
#pragma unroll
        for (int i = 0; i < 8; ++i) { const float z = cz[i] + (pz[i] - cz[i]) * mu[1536 + col + i];
            o[i] = (col < 64) ? tanhf(z) : ((col < 128) ? z : sigmoidf_(z)); }
        v4u w; w.x = pk2(o[0], o[1]); w.y = pk2(o[2], o[3]); w.z = pk2(o[4], o[5]); w.w = pk2(o[6], o[7]);
        *(v4u*)(AL + (size_t)t * ZL + col) = w;
    }
}

__device__ __forceinline__ void p3_top3_item(const bf16* Q, const float* kmean, unsigned* cursor, unsigned* lists, int bh0, int qb, LAS float* kmbase, int tid, int wave, int lane) {
    if (qb == 0) return;
    const int hf = wave >> 2, bh = bh0 + hf, w4 = wave & 3;
    LAS float* km = kmbase + hf * 2048;
    for (int i = (tid & 255); i < qb * 64; i += 256) km[i] = kmean[(size_t)bh * 2048 + i];
    __syncthreads();
    {
        const int s = qb * 256 + w4 * 64 + lane;
        float q[64];
        const v4u* qp = (const v4u*)(Q + ((size_t)(bh * 8192 + s)) * 64);
#pragma unroll
        for (int i = 0; i < 8; ++i) { const v4u r = qp[i];
            q[8 * i] = bflo(r.x); q[8 * i + 1] = bfhi(r.x); q[8 * i + 2] = bflo(r.y); q[8 * i + 3] = bfhi(r.y);
            q[8 * i + 4] = bflo(r.z); q[8 * i + 5] = bfhi(r.z); q[8 * i + 6] = bflo(r.w); q[8 * i + 7] = bfhi(r.w); }
        float v0 = -INFINITY, v1 = -INFINITY, v2 = -INFINITY; int i0 = -1, i1 = -1, i2 = -1;
        for (int n = 0; n < qb; ++n) {
            float dot = 0.f;
#pragma unroll
            for (int d4 = 0; d4 < 16; ++d4) { const f32x4 kk = *(const LAS f32x4*)(km + n * 64 + 4 * d4);
                dot += q[4 * d4] * kk.x; dot += q[4 * d4 + 1] * kk.y; dot += q[4 * d4 + 2] * kk.z; dot += q[4 * d4 + 3] * kk.w; }
            if (dot > v0) { v2 = v1; i2 = i1; v1 = v0; i1 = i0; v0 = dot; i0 = n; }
            else if (dot > v1) { v2 = v1; i2 = i1; v1 = dot; i1 = n; }
            else if (dot > v2) { v2 = dot; i2 = n; }
        }
        for (int n = 0; n < qb; ++n) {
            const int slot = (i0 == n) ? 0 : ((i1 == n) ? 1 : ((i2 == n) ? 2 : -1));
            const unsigned long long mask = __ballot(slot >= 0);
            if (mask == 0ull) continue;
            const unsigned cnt = (unsigned)__popcll(mask);
            unsigned base = 0u;
            if (lane == 0) base = __hip_atomic_fetch_add(cursor + bh * 32 + n, cnt, RLX_AGENT);
            base = (unsigned)__shfl((int)base, 0);
            if (slot >= 0) { const unsigned pos = base + (unsigned)__popcll(mask & ((1ull << lane) - 1ull));
                lists[(size_t)bh * LIST_PER_BH + list_off(n) + pos] = ((unsigned)s << 2) | (unsigned)slot; }
        }
    }
    __syncthreads();
}

template <int CTRL> __device__ __forceinline__ float dppf(float v) { return __builtin_bit_cast(float, __builtin_amdgcn_update_dpp(0, __builtin_bit_cast(int, v), CTRL, 0xF, 0xF, true)); }
__device__ __forceinline__ float allreduce16(float v) {
    v += dppf<0xB1>(v); v += dppf<0x4E>(v); v += dppf<0x141>(v); v += dppf<0x140>(v); return v;
}
constexpr int CK = 64, NCHK = SEQ / CK, CS = 72, SLOT = CK * CS;
struct ScanRaw { v4u zr, zk, zv, pr, pk, pv, a, ew; };
__device__ __forceinline__ void scan_load(ScanRaw& R, const bf16* Z, const bf16* AA, const bf16* EW, int b, int hc0, int t) {
    const bf16* p = Z + (size_t)(b * 8192 + t) * ZR + hc0;
    const bf16* pp = (t > 0) ? p - ZR : p;
    R.zr = *(const v4u*)p; R.zk = *(const v4u*)(p + 512); R.zv = *(const v4u*)(p + 1024);
    R.pr = *(const v4u*)pp; R.pk = *(const v4u*)(pp + 512); R.pv = *(const v4u*)(pp + 1024);
    const unsigned m = (t > 0) ? 0xffffffffu : 0u;
    R.pr = R.pr & m; R.pk = R.pk & m; R.pv = R.pv & m;
    const size_t o = (size_t)(b * 8192 + t) * 512 + hc0;
    R.a = *(const v4u*)(AA + o); R.ew = *(const v4u*)(EW + o);
}
__device__ __forceinline__ void unpack8(const v4u w, float (&f)[8]) { f[0] = bflo(w.x); f[1] = bfhi(w.x); f[2] = bflo(w.y); f[3] = bfhi(w.y); f[4] = bflo(w.z); f[5] = bfhi(w.z); f[6] = bflo(w.w); f[7] = bfhi(w.w); }
__device__ __forceinline__ v4u pack8f(const float (&f)[8]) { v4u w; w.x = cvtpk(f[0], f[1]); w.y = cvtpk(f[2], f[3]); w.z = cvtpk(f[4], f[5]); w.w = cvtpk(f[6], f[7]); return w; }
__device__ __forceinline__ f32x4 mm_tile(const LAS bf16* A, const LAS bf16* BT, int mt, int nt, int r, int q, f32x4 acc) {
#pragma unroll
    for (int ks = 0; ks < 2; ++ks) {
        const bf16x8 a = *(const LAS bf16x8*)(A + (16 * mt + r) * CS + 32 * ks + 8 * q);
        const bf16x8 b = *(const LAS bf16x8*)(BT + (16 * nt + r) * CS + 32 * ks + 8 * q);
        acc = __builtin_amdgcn_mfma_f32_16x16x32_bf16(a, b, acc, 0, 0, 0);
    }
    return acc;
}
struct PairF { bf16x8 b0, b1, a00, a01, a10, a11; };
__device__ __forceinline__ void mm_load(PairF& f, const LAS bf16* A, const LAS bf16* BT, int mt, int nt, int r, int q) {
    f.b0 = *(const LAS bf16x8*)(BT + (16 * nt + r) * CS + 8 * q); f.b1 = *(const LAS bf16x8*)(BT + (16 * nt + r) * CS + 32 + 8 * q);
    f.a00 = *(const LAS bf16x8*)(A + (16 * mt + r) * CS + 8 * q); f.a01 = *(const LAS bf16x8*)(A + (16 * mt + r) * CS + 32 + 8 * q);
    f.a10 = *(const LAS bf16x8*)(A + (16 * mt + 32 + r) * CS + 8 * q); f.a11 = *(const LAS bf16x8*)(A + (16 * mt + 32 + r) * CS + 32 + 8 * q);
}
__device__ __forceinline__ void mm_mul(const PairF& f, f32x4& c0, f32x4& c1) {
    c0 = __builtin_amdgcn_mfma_f32_16x16x32_bf16(f.a00, f.b0, c0, 0, 0, 0); c1 = __builtin_amdgcn_mfma_f32_16x16x32_bf16(f.a10, f.b0, c1, 0, 0, 0);
    c0 = __builtin_amdgcn_mfma_f32_16x16x32_bf16(f.a01, f.b1, c0, 0, 0, 0); c1 = __builtin_amdgcn_mfma_f32_16x16x32_bf16(f.a11, f.b1, c1, 0, 0, 0);
}
__device__ __forceinline__ void mm_pair(const LAS bf16* A, const LAS bf16* BT, int mt, int nt, int r, int q, f32x4& c0, f32x4& c1) { PairF f; mm_load(f, A, BT, mt, nt, r, q); mm_mul(f, c0, c1); }
__device__ __forceinline__ void st_T(LAS bf16* D, int mt, int nt, int r, int q, const f32x4 v) {
    v2u w; w.x = cvtpk(v.x, v.y); w.y = cvtpk(v.z, v.w);
    *(LAS v2u*)(D + (16 * nt + r) * CS + 16 * mt + 4 * q) = w;
}
__device__ __forceinline__ void st_Tg(bf16* D  , int mt, int nt, int r, int q, const f32x4 v) {
    v2u w; w.x = cvtpk(v.x, v.y); w.y = cvtpk(v.z, v.w);
    *(v2u*)(D + (16 * nt + r) * 64 + 16 * mt + 4 * q) = w;
}
__device__ __forceinline__ f32x4 mask_lt(f32x4 v, int R0, int Cc, bool incl) {
    const int lim = incl ? Cc + 1 : Cc;
    v.x = (R0 < lim) ? v.x : 0.f; v.y = (R0 + 1 < lim) ? v.y : 0.f; v.z = (R0 + 2 < lim) ? v.z : 0.f; v.w = (R0 + 3 < lim) ? v.w : 0.f; return v;
}
__device__ __forceinline__ void rwkv_cp_item(const bf16* Z, const bf16* AAg, const bf16* EWg, const float* mu, const float* k_k, const float* k_a,
                                             bf16* RW, bf16* MM, bf16* Y0T, bf16* GAT, float* PC, int chain, int c, ScanRaw& R, int nchain, int nc, LAS unsigned char* lds, int tid, int wave, int lane, int probe) {
    LAS bf16* S_ = (LAS bf16*)lds;
#define SL(k) (S_ + (k) * SLOT)
    LAS float* Ef = (LAS float*)(SL(12));
    LAS float* Red = (LAS float*)(SL(8));
    LAS float* Seg = Red + 8 * 64;
    constexpr int EFS = 68;
    const int b = chain >> 3, h = chain & 7;
    const int r = lane & 15, q = lane >> 4;
    __syncthreads();
    const int t = tid >> 3, c0 = (tid & 7) * 8, hc0 = h * 64 + c0;
    float rr[8], k2[8], al[8], be[8], vv[8], kkr[8], aa[8];
    {
        float zr[8], zk[8], zv[8], pr[8], pk[8], pv[8], a[8], ew[8];
        unpack8(R.zr, zr); unpack8(R.zk, zk); unpack8(R.zv, zv); unpack8(R.pr, pr); unpack8(R.pk, pk); unpack8(R.pv, pv); unpack8(R.a, a); unpack8(R.ew, ew);
        scan_load(R, Z, AAg, EWg, nchain >> 3, (nchain & 7) * 64 + c0, nc * CK + t);
        float ss = 0.f;
#pragma unroll
        for (int i = 0; i < 8; ++i) { aa[i] = a[i]; rr[i] = zr[i] + (pr[i] - zr[i]) * mu[hc0 + i]; const float k = zk[i] + (pk[i] - zk[i]) * mu[512 + hc0 + i]; vv[i] = zv[i] + (pv[i] - zv[i]) * mu[1024 + hc0 + i];
            kkr[i] = k * k_k[hc0 + i]; ss += kkr[i] * kkr[i]; k2[i] = k * (1.f + (a[i] - 1.f) * k_a[hc0 + i]); }
        ss += dppf<0xB1>(ss); ss += dppf<0x4E>(ss); ss += dppf<0x141>(ss);
        if ((tid & 7) == 0) Red[t] = ss;
        *(LAS f32x4*)(Ef + t * EFS + c0) = (f32x4){ew[0], ew[1], ew[2], ew[3]}; *(LAS f32x4*)(Ef + t * EFS + c0 + 4) = (f32x4){ew[4], ew[5], ew[6], ew[7]};
    }
    LDS_WAIT(); __syncthreads();
    {
        const int seg = tid >> 6, j = tid & 63; float s = 0.f;
#pragma unroll
        for (int u = 0; u < 8; ++u) { s += Ef[(8 * seg + u) * EFS + j]; Ef[(8 * seg + u) * EFS + j] = s; }
        Seg[seg * 64 + j] = s;
    }
    LDS_WAIT(); __syncthreads();
    {
        { const float ss = Red[t];
          const float inrm = 1.f / fmaxf(sqrtf(ss), 1e-12f);
#pragma unroll
          for (int i = 0; i < 8; ++i) { const float kk = kkr[i] * inrm; al[i] = -kk; be[i] = kk * aa[i]; } }
        float off[8], Et[8], Ep[8];
#pragma unroll
        for (int i = 0; i < 8; ++i) off[i] = 0.f;
        for (int sg = 0; sg < (t >> 3); ++sg) {
            const f32x4 s0 = *(const LAS f32x4*)(Seg + sg * 64 + c0), s1 = *(const LAS f32x4*)(Seg + sg * 64 + c0 + 4);
            off[0] += s0.x; off[1] += s0.y; off[2] += s0.z; off[3] += s0.w; off[4] += s1.x; off[5] += s1.y; off[6] += s1.z; off[7] += s1.w;
        }
        { const f32x4 e0 = *(const LAS f32x4*)(Ef + t * EFS + c0), e1 = *(const LAS f32x4*)(Ef + t * EFS + c0 + 4);
          Et[0] = e0.x + off[0]; Et[1] = e0.y + off[1]; Et[2] = e0.z + off[2]; Et[3] = e0.w + off[3]; Et[4] = e1.x + off[4]; Et[5] = e1.y + off[5]; Et[6] = e1.z + off[6]; Et[7] = e1.w + off[7]; }
        if (t & 7) { const f32x4 e0 = *(const LAS f32x4*)(Ef + (t - 1) * EFS + c0), e1 = *(const LAS f32x4*)(Ef + (t - 1) * EFS + c0 + 4);
          Ep[0] = e0.x + off[0]; Ep[1] = e0.y + off[1]; Ep[2] = e0.z + off[2]; Ep[3] = e0.w + off[3]; Ep[4] = e1.x + off[4]; Ep[5] = e1.y + off[5]; Ep[6] = e1.z + off[6]; Ep[7] = e1.w + off[7]; }
        else {
#pragma unroll
            for (int i = 0; i < 8; ++i) Ep[i] = off[i];
        }
        float at[8], bt[8], kt[8], rt[8];
#pragma unroll
        for (int i = 0; i < 8; ++i) { const float ep = __expf(Et[i]), en = __expf(-Et[i]); at[i] = al[i] * __expf(-Ep[i]); bt[i] = be[i] * ep; kt[i] = k2[i] * ep; rt[i] = rr[i] * en; }
        *(LAS v4u*)(SL(0) + t * CS + c0) = pack8f(at); *(LAS v4u*)(SL(1) + t * CS + c0) = pack8f(bt); *(LAS v4u*)(SL(2) + t * CS + c0) = pack8f(kt); *(LAS v4u*)(SL(3) + t * CS + c0) = pack8f(rt);
#pragma unroll
        for (int i = 0; i < 8; ++i) { SL(4)[(c0 + i) * CS + t] = (bf16)f2bf(at[i]); SL(5)[(c0 + i) * CS + t] = (bf16)f2bf(bt[i]); SL(6)[(c0 + i) * CS + t] = (bf16)f2bf(kt[i]); SL(7)[(c0 + i) * CS + t] = (bf16)f2bf(vv[i]); }
        if (t == CK - 1) { *(f32x4*)(PC + c0) = (f32x4){__expf(-Et[0]), __expf(-Et[1]), __expf(-Et[2]), __expf(-Et[3])}; *(f32x4*)(PC + c0 + 4) = (f32x4){__expf(-Et[4]), __expf(-Et[5]), __expf(-Et[6]), __expf(-Et[7])}; }
    }
    LDS_WAIT(); __syncthreads();
    if (probe == 4) return;
    const f32x4 z4 = {0.f, 0.f, 0.f, 0.f};
    const int mt = wave >> 2, nt = wave & 3, Cc = 16 * nt + r, R0 = 16 * mt + 4 * q, R1 = R0 + 32;
    { PairF f0, f1, f2, f3, f4;
      mm_load(f0, SL(0), SL(1), mt, nt, r, q); mm_load(f1, SL(1), SL(0), mt, nt, r, q); mm_load(f2, SL(2), SL(0), mt, nt, r, q); mm_load(f3, SL(1), SL(3), mt, nt, r, q); mm_load(f4, SL(2), SL(3), mt, nt, r, q);
      f32x4 a0 = z4, a1 = z4, b0 = z4, b1 = z4, c0 = z4, c1 = z4, d0 = z4, d1 = z4, e0 = z4, e1 = z4;
      mm_mul(f0, a0, a1); mm_mul(f1, b0, b1); mm_mul(f2, c0, c1); mm_mul(f3, d0, d1); mm_mul(f4, e0, e1);
      a0.x = (Cc < R0) ? a0.x : 0.f; a0.y = (Cc < R0 + 1) ? a0.y : 0.f; a0.z = (Cc < R0 + 2) ? a0.z : 0.f; a0.w = (Cc < R0 + 3) ? a0.w : 0.f;
      a1.x = (Cc < R1) ? a1.x : 0.f; a1.y = (Cc < R1 + 1) ? a1.y : 0.f; a1.z = (Cc < R1 + 2) ? a1.z : 0.f; a1.w = (Cc < R1 + 3) ? a1.w : 0.f;
      st_T(SL(12), mt, nt, r, q, a0); st_T(SL(12), mt + 2, nt, r, q, a1);
      b0 = mask_lt(b0, R0, Cc, false); b1 = mask_lt(b1, R1, Cc, false);
      st_T(SL(11), mt, nt, r, q, b0); st_T(SL(11), mt + 2, nt, r, q, b1);
      b0.x += (R0 == Cc) ? 1.f : 0.f; b0.y += (R0 + 1 == Cc) ? 1.f : 0.f; b0.z += (R0 + 2 == Cc) ? 1.f : 0.f; b0.w += (R0 + 3 == Cc) ? 1.f : 0.f;
      b1.x += (R1 == Cc) ? 1.f : 0.f; b1.y += (R1 + 1 == Cc) ? 1.f : 0.f; b1.z += (R1 + 2 == Cc) ? 1.f : 0.f; b1.w += (R1 + 3 == Cc) ? 1.f : 0.f;
      st_T(SL(13), mt, nt, r, q, b0); st_T(SL(13), mt + 2, nt, r, q, b1);
      st_T(SL(8), mt, nt, r, q, mask_lt(c0, R0, Cc, false)); st_T(SL(8), mt + 2, nt, r, q, mask_lt(c1, R1, Cc, false));
      st_T(SL(9), mt, nt, r, q, mask_lt(d0, R0, Cc, true)); st_T(SL(9), mt + 2, nt, r, q, mask_lt(d1, R1, Cc, true));
      st_T(SL(10), mt, nt, r, q, mask_lt(e0, R0, Cc, true)); st_T(SL(10), mt + 2, nt, r, q, mask_lt(e1, R1, Cc, true)); }
    LDS_WAIT(); __syncthreads();
    if (probe == 3) return;
    for (int m = (probe == 2 ? 6 : 0); m < 6; ++m) {
        const int ln = (m & 1) ? 0 : 11, ltn = ln + 1, l2 = (m & 1) ? 11 : 0;
        const int tsrc = (m & 1) ? 13 : 2, tdst = (m & 1) ? 2 : 13;
        PairF f0, f1, f2; v2u o0 = {0u, 0u}, o1 = {0u, 0u};
        if (m < 5) { mm_load(f0, SL(ltn), SL(ln), mt, nt, r, q); mm_load(f1, SL(ln), SL(ltn), mt, nt, r, q); }
        if (m >= 1) { mm_load(f2, SL(ltn), SL(tsrc), mt, nt, r, q);
            o0 = *(const LAS v2u*)(SL(tsrc) + (16 * nt + r) * CS + 16 * mt + 4 * q); o1 = *(const LAS v2u*)(SL(tsrc) + (16 * nt + r) * CS + 16 * mt + 32 + 4 * q); }
        if (m < 5) { f32x4 a0 = z4, a1 = z4, b0 = z4, b1 = z4; mm_mul(f0, a0, a1); mm_mul(f1, b0, b1);
            st_T(SL(l2), mt, nt, r, q, a0); st_T(SL(l2), mt + 2, nt, r, q, a1);
            st_T(SL(l2 + 1), mt, nt, r, q, b0); st_T(SL(l2 + 1), mt + 2, nt, r, q, b1); }
        if (m >= 1) { f32x4 c0 = {bflo(o0.x), bfhi(o0.x), bflo(o0.y), bfhi(o0.y)}, c1 = {bflo(o1.x), bfhi(o1.x), bflo(o1.y), bfhi(o1.y)};
            mm_mul(f2, c0, c1); st_T(SL(tdst), mt, nt, r, q, c0); st_T(SL(tdst), mt + 2, nt, r, q, c1); }
        LDS_WAIT(); __syncthreads();
    }
    { PairF f0, f1; mm_load(f0, SL(2), SL(4), mt, nt, r, q); mm_load(f1, SL(8), SL(7), mt, nt, r, q);
      f32x4 a0 = z4, a1 = z4, b0 = z4, b1 = z4; mm_mul(f0, a0, a1); mm_mul(f1, b0, b1);
      st_T(SL(11), mt, nt, r, q, a0); st_T(SL(11), mt + 2, nt, r, q, a1);
      st_T(SL(12), mt, nt, r, q, b0); st_T(SL(12), mt + 2, nt, r, q, b1); }
    LDS_WAIT(); __syncthreads();
    { PairF f0, f1, f2; mm_load(f0, SL(2), SL(12), mt, nt, r, q); mm_load(f1, SL(11), SL(9), mt, nt, r, q); mm_load(f2, SL(11), SL(5), mt, nt, r, q);
      const v2u o0 = *(const LAS v2u*)(SL(3) + (16 * nt + r) * CS + 16 * mt + 4 * q), o1 = *(const LAS v2u*)(SL(3) + (16 * nt + r) * CS + 16 * mt + 32 + 4 * q);
      f32x4 a0 = z4, a1 = z4, b0 = {bflo(o0.x), bfhi(o0.x), bflo(o0.y), bfhi(o0.y)}, b1 = {bflo(o1.x), bfhi(o1.x), bflo(o1.y), bfhi(o1.y)}, c0 = z4, c1 = z4;
      mm_mul(f0, a0, a1); mm_mul(f1, b0, b1); mm_mul(f2, c0, c1);
      st_T(SL(13), mt, nt, r, q, a0); st_T(SL(13), mt + 2, nt, r, q, a1);
      st_Tg(RW, mt, nt, r, q, b0); st_Tg(RW, mt + 2, nt, r, q, b1);
      st_Tg(MM, mt, nt, r, q, c0); st_Tg(MM, mt + 2, nt, r, q, c1); }
    LDS_WAIT(); __syncthreads();
    { PairF f0, f1, f2, f3; mm_load(f0, SL(9), SL(13), mt, nt, r, q); mm_load(f1, SL(10), SL(7), mt, nt, r, q); mm_load(f2, SL(5), SL(13), mt, nt, r, q); mm_load(f3, SL(6), SL(7), mt, nt, r, q);
      f32x4 a0 = z4, a1 = z4, b0 = z4, b1 = z4; mm_mul(f0, a0, a1); mm_mul(f2, b0, b1); mm_mul(f1, a0, a1); mm_mul(f3, b0, b1);
      st_Tg(Y0T, mt, nt, r, q, a0); st_Tg(Y0T, mt + 2, nt, r, q, a1);
      st_Tg(GAT, mt, nt, r, q, b0); st_Tg(GAT, mt + 2, nt, r, q, b1); }
#undef SL
}
__device__ __forceinline__ void rwkv_seq(const bf16* RW, const bf16* MM, const bf16* Y0T, const bf16* GAT, const float* PC, bf16* Y, int sid, LAS unsigned char* lds, int tid, int wave, int lane) {
    const int chain = sid >> 2, g4 = sid & 3, b = chain >> 3, h = chain & 7;
    const int r = lane & 15, q = lane >> 4, tw = wave & 3;
    LAS bf16* HT = (LAS bf16*)lds;
    for (int i = tid; i < 2 * 16 * CS / 2; i += NTHR) ((LAS unsigned*)HT)[i] = 0u;
    LDS_WAIT(); __syncthreads();
    f32x4 Hreg = {0.f, 0.f, 0.f, 0.f};
    const bool isH = wave < 4;
    const bf16* Abase = isH ? MM : RW;
    const bf16* Ebase = isH ? GAT : Y0T;
    const size_t ci0 = (size_t)chain * NCHK;
    struct SeqOp { bf16x8 a0, a1; v2u ad; f32x4 pc; };
    SeqOp op[4];
#define SEQ_LD(S, C) do { const size_t ci_ = ci0 + (C); const bf16* ap_ = Abase + ci_ * 4096 + (16 * tw + r) * 64 + 8 * q; S.a0 = *(const bf16x8*)ap_; S.a1 = *(const bf16x8*)(ap_ + 32); \
        S.ad = *(const v2u*)(Ebase + ci_ * 4096 + (16 * g4 + r) * 64 + 16 * tw + 4 * q); S.pc = *(const f32x4*)(PC + ci_ * 64 + 16 * tw + 4 * q); } while (0)
#define SEQ_STEP(S, C) do { const LAS bf16* hb = HT + ((C) & 1) * 16 * CS; \
        const bf16x8 b0 = *(const LAS bf16x8*)(hb + r * CS + 8 * q), b1 = *(const LAS bf16x8*)(hb + r * CS + 32 + 8 * q); \
        f32x4 acc = {bflo(S.ad.x), bfhi(S.ad.x), bflo(S.ad.y), bfhi(S.ad.y)}; \
        acc = __builtin_amdgcn_mfma_f32_16x16x32_bf16(S.a0, b0, acc, 0, 0, 0); acc = __builtin_amdgcn_mfma_f32_16x16x32_bf16(S.a1, b1, acc, 0, 0, 0); \
        const f32x4 pcc = S.pc; \
        SEQ_LD(S, ((C) + 4 < NCHK ? (C) + 4 : NCHK - 1));            \
        if (isH) { Hreg = pcc * (Hreg + acc); v2u w; w.x = cvtpk(Hreg.x, Hreg.y); w.y = cvtpk(Hreg.z, Hreg.w); \
            *(LAS v2u*)(HT + (((C) + 1) & 1) * 16 * CS + r * CS + 16 * tw + 4 * q) = w; } \
        else { bf16* yp = Y + ((size_t)(b * 8192 + (C) * CK + 16 * tw + 4 * q)) * OSTR + h * 64 + 16 * g4 + r; \
            yp[0] = (bf16)f2bf(acc.x); yp[OSTR] = (bf16)f2bf(acc.y); yp[2 * OSTR] = (bf16)f2bf(acc.z); yp[3 * OSTR] = (bf16)f2bf(acc.w); } \
        LDS_WAIT(); __syncthreads(); } while (0)
    SEQ_LD(op[0], 0); SEQ_LD(op[1], 1); SEQ_LD(op[2], 2); SEQ_LD(op[3], 3);
#pragma unroll 1
    for (int c = 0; c < NCHK; c += 4) { SEQ_STEP(op[0], c); SEQ_STEP(op[1], c + 1); SEQ_STEP(op[2], c + 2); SEQ_STEP(op[3], c + 3); }
#undef SEQ_LD
#undef SEQ_STEP
}

__device__ __forceinline__ int crow(int r, int hi) { return (r & 3) + 8 * (r >> 2) + 4 * hi; }
constexpr int AT_KT_STRIDE = 72, AT_VL_STRIDE = 260, AT_VL_OFF = 256 * AT_KT_STRIDE * 2, AT_MISC_OFF = AT_VL_OFF + 64 * AT_VL_STRIDE * 2;
struct AttnStage { v4u k[4], v[4]; };
__device__ __forceinline__ void attn_stage_load(AttnStage& S, const bf16* K, const bf16* VT, int bh, int blk, int tid) {
#pragma unroll
    for (int i = 0; i < 4; ++i) { const int idx = tid + NTHR * i, row = idx >> 3, c8 = idx & 7;
        S.k[i] = *(const v4u*)(K + ((size_t)(bh * 8192 + blk * 256 + row)) * 64 + 8 * c8); }
#pragma unroll
    for (int i = 0; i < 4; ++i) { const int idx = tid + NTHR * i, dv = idx >> 5, c = idx & 31;
        S.v[i] = *(const v4u*)(VT + ((size_t)(bh * 64 + dv)) * 8192 + blk * 256 + 8 * c); }
}
__device__ __forceinline__ void attn_stage_store(const AttnStage& S, LAS unsigned char* buf, int tid) {
    LAS bf16* KT = (LAS bf16*)buf; LAS bf16* VL = (LAS bf16*)(buf + AT_VL_OFF);
#pragma unroll
    for (int i = 0; i < 4; ++i) { const int idx = tid + NTHR * i, row = idx >> 3, c8 = idx & 7; *(LAS v4u*)(KT + row * AT_KT_STRIDE + 8 * c8) = S.k[i]; }
#pragma unroll
    for (int i = 0; i < 4; ++i) { const int idx = tid + NTHR * i, dv = idx >> 5, c = idx & 31;
        LAS v2u* d = (LAS v2u*)(VL + dv * AT_VL_STRIDE + 8 * c);
        v2u lo = {S.v[i].x, S.v[i].y}, hi = {S.v[i].z, S.v[i].w}; d[0] = lo; d[1] = hi; }
}
__device__ __forceinline__ void attn_tile(const bf16x8 (&qf)[4], const LAS bf16* KT, const LAS bf16* VL, int kt0, int nkt, int dkt, int ql, int half, float c1, float c2, f32x16 (&O)[2], float& lsum) {
    for (int kt = kt0; kt < nkt; ++kt) {
        f32x16 X;
#pragma unroll
        for (int i = 0; i < 16; ++i) X[i] = 0.f;
#pragma unroll
        for (int ks = 0; ks < 4; ++ks) { const bf16x8 kf = *(const LAS bf16x8*)(KT + (32 * kt + ql) * AT_KT_STRIDE + 16 * ks + 8 * half);
            X = __builtin_amdgcn_mfma_f32_32x32x16_bf16(kf, qf[ks], X, 0, 0, 0); }
        float p[16];
#pragma unroll
        for (int i = 0; i < 16; ++i) p[i] = __builtin_amdgcn_exp2f(X[i] * c1 - c2);
        if (kt == dkt) {
#pragma unroll
            for (int i = 0; i < 16; ++i) if (crow(i, half) > ql) p[i] = 0.f;
        }
#pragma unroll
        for (int i = 0; i < 16; ++i) lsum += p[i];
#pragma unroll
        for (int s = 0; s < 2; ++s) {
            v4u pw; pw.x = cvtpk(p[8 * s], p[8 * s + 1]); pw.y = cvtpk(p[8 * s + 2], p[8 * s + 3]); pw.z = cvtpk(p[8 * s + 4], p[8 * s + 5]); pw.w = cvtpk(p[8 * s + 6], p[8 * s + 7]);
            const bf16x8 pa = __builtin_bit_cast(bf16x8, pw);
#pragma unroll
            for (int nt = 0; nt < 2; ++nt) {
                const LAS bf16* vp = VL + (32 * nt + ql) * AT_VL_STRIDE + 32 * kt + 16 * s + 4 * half;
                const s16x4 lo = *(const LAS s16x4*)vp, hi = *(const LAS s16x4*)(vp + 8);
                const bf16x8 vf = __builtin_shufflevector(lo, hi, 0, 1, 2, 3, 4, 5, 6, 7);
                O[nt] = __builtin_amdgcn_mfma_f32_32x32x16_bf16(pa, vf, O[nt], 0, 0, 0);
            }
        }
    }
}
__device__ __forceinline__ int attn_pop(unsigned* queue, unsigned* cursor, volatile LAS int* misc, int tid, int& count) {
    for (;;) {
        __syncthreads();
        if (tid == 0) misc[0] = (int)__hip_atomic_fetch_add(queue, 1u, RLX_AGENT);
        __syncthreads();
        const int item = misc[0];
        if (item >= 992 + 1024) { count = 0; return -1; }
        if (item >= 992) { count = 256; return item; }
        count = (int)__hip_atomic_load(cursor + (item & 31) * 32 + (item >> 5), RLX_AGENT);
        if (count > 0) return item;
    }
}
__device__ __forceinline__ void attn_phase(const bf16* Q, const bf16* K, const bf16* VT, const unsigned* lists, unsigned* cursor, unsigned* queue,
                                           bf16* OPART, float* LPART, bf16* OWN, const float* gq, const float* gk, LAS unsigned char* lds, int tid, int wave, int lane) {
    constexpr int AT_BUF = AT_MISC_OFF;
    volatile LAS int* misc = (volatile LAS int*)(lds + 2 * AT_BUF);
    float mq = fabsf(gq[lane]), mk = fabsf(gk[lane]);
#pragma unroll
    for (int o = 1; o < 64; o <<= 1) { mq = fmaxf(mq, __shfl_xor(mq, o)); mk = fmaxf(mk, __shfl_xor(mk, o)); }
    const float c1 = 0.125f * 1.4426950408889634f, c2 = 8.f * mq * mk * 1.4426950408889634f;
    const int ql = lane & 31, half = lane >> 5;
    int count = 0, ncount = 0;
    int item = attn_pop(queue, cursor, misc, tid, count);
    AttnStage St;
    if (item >= 0) { attn_stage_load(St, K, VT, item < 992 ? (item & 31) : ((item - 992) & 31), item < 992 ? (item >> 5) : ((item - 992) >> 5), tid); attn_stage_store(St, lds, tid); }
    LDS_WAIT();
    __syncthreads();
    int pb = 0;
    bool have = false; unsigned ent_c = 0u; bf16x8 q_c[4];
    while (item >= 0) {
        const int nitem = attn_pop(queue, cursor, misc, tid, ncount);
        { const int li_ = nitem >= 0 ? nitem : item;
          attn_stage_load(St, K, VT, li_ < 992 ? (li_ & 31) : ((li_ - 992) & 31), li_ < 992 ? (li_ >> 5) : ((li_ - 992) >> 5), tid); }
        const LAS bf16* KT = (const LAS bf16*)(lds + pb * AT_BUF); const LAS bf16* VL = (const LAS bf16*)(lds + pb * AT_BUF + AT_VL_OFF);
        const bool own = item >= 992;
        const int bh = own ? ((item - 992) & 31) : (item & 31), blk = own ? ((item - 992) >> 5) : (item >> 5);
        const unsigned* lp = lists + (size_t)bh * LIST_PER_BH + list_off(own ? 0 : blk);
        for (int c = 0;; ++c) {
            const int e0 = own ? 0 : c * 256 + wave * 32;
            if (!own && e0 >= count) break;
            if (!have) {
                if (own) ent_c = (unsigned)(blk * 256 + wave * 32 + ql) << 2;
                else { const int e = e0 + ql; ent_c = lp[e < count ? e : e0]; }
                const bf16* qp = Q + ((size_t)(bh * 8192 + (int)(ent_c >> 2))) * 64 + 8 * half;
#pragma unroll
                for (int ks = 0; ks < 4; ++ks) q_c[ks] = *(const bf16x8*)(qp + 16 * ks);
            }
            bool nhave = false, nown = false; int nbh = bh; unsigned ent_n = ent_c;
            if (!own && (c + 1) * 256 + wave * 32 < count) { nhave = true; nbh = bh; const int e = (c + 1) * 256 + wave * 32 + ql; ent_n = lp[e < count ? e : (c + 1) * 256 + wave * 32]; }
            else if (nitem >= 992) { nhave = true; nown = true; nbh = (nitem - 992) & 31; ent_n = (unsigned)(((nitem - 992) >> 5) * 256 + wave * 32 + ql) << 2; }
            else if (nitem >= 0 && wave * 32 < ncount) { nhave = true; nbh = nitem & 31; const int e = wave * 32 + ql;
                ent_n = (lists + (size_t)nbh * LIST_PER_BH + list_off(nitem >> 5))[e < ncount ? e : wave * 32]; }
            (void)nown;
            const int sq = (int)(ent_c >> 2), slot = (int)(ent_c & 3u);
            const bool valid = own || (e0 + ql < count);
            f32x16 O[2]; float lsum = 0.f;
#pragma unroll
            for (int i = 0; i < 16; ++i) { O[0][i] = 0.f; O[1][i] = 0.f; }
            const int nkt = own ? wave + 1 : 8, dkt = own ? wave : -1, kth = nkt >> 1;
            attn_tile(q_c, KT, VL, 0, kth, dkt, ql, half, c1, c2, O, lsum);
            bf16x8 q_n[4];
            { const bf16* qp = Q + ((size_t)(nbh * 8192 + (int)(ent_n >> 2))) * 64 + 8 * half;
#pragma unroll
                for (int ks = 0; ks < 4; ++ks) q_n[ks] = *(const bf16x8*)(qp + 16 * ks); }
            attn_tile(q_c, KT, VL, kth, nkt, dkt, ql, half, c1, c2, O, lsum);
            const float ltot = lsum + __shfl_xor(lsum, 32);
            if (own) {
                const int b = bh >> 3, h = bh & 7;
                if (half == 0) LPART[(size_t)3 * (BH * SEQ) + bh * 8192 + sq] = ltot;
#pragma unroll
                for (int i = 0; i < 16; ++i) {
                    const int s2 = blk * 256 + wave * 32 + crow(i, half);
                    bf16* op = OWN + ((size_t)(b * 8192 + s2)) * OSTR + h * 64 + ql;
                    op[0] = (bf16)f2bf(O[0][i]); op[32] = (bf16)f2bf(O[1][i]);
                }
            } else {
                if (half == 0 && valid) LPART[(size_t)slot * (BH * SEQ) + bh * 8192 + sq] = ltot;
                const int entv = valid ? (int)ent_c : -1;
#pragma unroll
                for (int i = 0; i < 16; ++i) {
                    const int e2 = __shfl(entv, crow(i, half));
                    if (e2 >= 0) { bf16* op = OPART + ((size_t)(e2 & 3) * (BH * SEQ) + bh * 8192 + (e2 >> 2)) * 64 + ql;
                        op[0] = (bf16)f2bf(O[0][i]); op[32] = (bf16)f2bf(O[1][i]); }
                }
            }
            have = nhave; ent_c = ent_n;
#pragma unroll
            for (int ks = 0; ks < 4; ++ks) q_c[ks] = q_n[ks];
            if (own) break;
        }
        if (nitem >= 0) attn_stage_store(St, lds + (pb ^ 1) * AT_BUF, tid);
        LDS_WAIT();
        __syncthreads();
        item = nitem; count = ncount; pb ^= 1;
    }
}

__device__ __forceinline__ void p5_combine(const bf16* OPART, const float* LPART, const bf16* OM, bf16* OMO, int gtid, int ntot) {
    for (int idx0 = gtid; idx0 < BH * SEQ * 8; idx0 += 2 * ntot) {
        v4u v[2][4]; unsigned lw[2][4]; size_t oo[2]; int nsel[2];
#pragma unroll
        for (int u = 0; u < 2; ++u) {
            const int idx = idx0 + u * ntot < BH * SEQ * 8 ? idx0 + u * ntot : idx0;
            const int qg = idx >> 3, c8 = idx & 7, bh = qg >> 13, s = qg & 8191, b = bh >> 3, h = bh & 7;
            nsel[u] = (s >> 8) < 3 ? (s >> 8) : 3;
            oo[u] = ((size_t)(b * 8192 + s)) * OSTR + h * 64 + 8 * c8;
#pragma unroll
            for (int sl = 0; sl < 3; ++sl) { v[u][sl] = *(const v4u*)(OPART + ((size_t)sl * (BH * SEQ) + qg) * 64 + 8 * c8); lw[u][sl] = *(const unsigned*)(LPART + (size_t)sl * (BH * SEQ) + qg); }
            v[u][3] = *(const v4u*)(OM + oo[u]); lw[u][3] = *(const unsigned*)(LPART + (size_t)3 * (BH * SEQ) + qg);
        }
#pragma unroll
        for (int u = 0; u < 2; ++u) {
            float acc[8] = {0.f, 0.f, 0.f, 0.f, 0.f, 0.f, 0.f, 0.f}; float l = 0.f;
#pragma unroll
            for (int sl = 0; sl < 4; ++sl) {
                const unsigned m = (sl == 3 || sl < nsel[u]) ? 0xffffffffu : 0u;
                const v4u w4 = v[u][sl] & m;
                acc[0] += bflo(w4.x); acc[1] += bfhi(w4.x); acc[2] += bflo(w4.y); acc[3] += bfhi(w4.y); acc[4] += bflo(w4.z); acc[5] += bfhi(w4.z); acc[6] += bflo(w4.w); acc[7] += bfhi(w4.w);
                l += __builtin_bit_cast(float, lw[u][sl] & m);
            }
            const float il = 1.f / l;
            v4u w; w.x = pk2(acc[0] * il, acc[1] * il); w.y = pk2(acc[2] * il, acc[3] * il); w.z = pk2(acc[4] * il, acc[5] * il); w.w = pk2(acc[6] * il, acc[7] * il);
            if (u == 0 || idx0 + ntot < BH * SEQ * 8) *(v4u*)(OMO + oo[u]) = w;
        }
    }
}
__device__ __forceinline__ void unpack4(const v2u w, float (&f)[4]) { f[0] = bflo(w.x); f[1] = bfhi(w.x); f[2] = bflo(w.y); f[3] = bfhi(w.y); }
__device__ __forceinline__ void p5_rwkv_post(const bf16* Z, const bf16* AA, const bf16* GG, const bf16* Y, bf16* YO, const float* mu, const float* k_a, const float* r_k,
                                             const float* ln_g, const float* ln_b, int gw, int ngw, int lane) {
    const int g = lane >> 4, r = lane & 15;
#pragma unroll 2
    for (int it = gw * 4 + g; it < T * NH; it += ngw * 4) {
        const int t = it >> 3, h = it & 7, col = h * 64 + 4 * r, s = t & 8191;
        const bf16* zp = Z + (size_t)t * ZR + col;
        float zr[4], zk[4], zv[4], pr[4] = {0.f, 0.f, 0.f, 0.f}, pk[4] = {0.f, 0.f, 0.f, 0.f}, pv[4] = {0.f, 0.f, 0.f, 0.f}, a[4], y[4], gg[4];
        unpack4(*(const v2u*)zp, zr); unpack4(*(const v2u*)(zp + 512), zk); unpack4(*(const v2u*)(zp + 1024), zv);
        { const bf16* zq = s ? zp - ZR : zp; const unsigned m_ = s ? 0xffffffffu : 0u;
          unpack4(*(const v2u*)(zq) & m_, pr); unpack4(*(const v2u*)(zq + 512) & m_, pk); unpack4(*(const v2u*)(zq + 1024) & m_, pv); }
        unpack4(*(const v2u*)(AA + (size_t)t * 512 + col), a); unpack4(*(const v2u*)(Y + (size_t)t * OSTR + col), y); unpack4(*(const v2u*)(GG + (size_t)t * 512 + col), gg);
        const f32x4 mr = *(const f32x4*)(mu + col), mk = *(const f32x4*)(mu + 512 + col), mv = *(const f32x4*)(mu + 1024 + col);
        const f32x4 ka = *(const f32x4*)(k_a + col), rk = *(const f32x4*)(r_k + col), lg = *(const f32x4*)(ln_g + col), lb = *(const f32x4*)(ln_b + col);
        float vv[4], dot = 0.f, sum = 0.f;
#pragma unroll
        for (int i = 0; i < 4; ++i) { const float rr = zr[i] + (pr[i] - zr[i]) * mr[i], k = zk[i] + (pk[i] - zk[i]) * mk[i]; vv[i] = zv[i] + (pv[i] - zv[i]) * mv[i];
            const float k2 = k * (1.f + (a[i] - 1.f) * ka[i]); dot += rr * k2 * rk[i]; sum += y[i]; }
        const float mean = allreduce16(sum) * (1.f / 64.f);
        float sq = 0.f;
#pragma unroll
        for (int i = 0; i < 4; ++i) { y[i] -= mean; sq += y[i] * y[i]; }
        const float rstd = 1.f / sqrtf(allreduce16(sq) * (1.f / 64.f) + GN_EPS);
        const float bonus = allreduce16(dot);
        float o[4];
#pragma unroll
        for (int i = 0; i < 4; ++i) o[i] = (y[i] * rstd * lg[i] + lb[i] + bonus * vv[i]) * gg[i];
        v2u w; w.x = pk2(o[0], o[1]); w.y = pk2(o[2], o[3]);
        *(v2u*)(YO + (size_t)t * OSTR + col) = w;
    }
}


__device__ __forceinline__ unsigned f2key(float f) { const unsigned u = __builtin_bit_cast(unsigned, f); return (u & 0x80000000u) ? ~u : (u | 0x80000000u); }
__device__ __forceinline__ float key2f(unsigned k) { const unsigned u = (k & 0x80000000u) ? (k & 0x7fffffffu) : ~k; return __builtin_bit_cast(float, u); }
template <int CTRL> __device__ __forceinline__ unsigned dppu(unsigned v) { return (unsigned)__builtin_amdgcn_update_dpp(0, (int)v, CTRL, 0xF, 0xF, true); }
__device__ __forceinline__ unsigned umax_(unsigned a, unsigned b) { return a > b ? a : b; }
__device__ __forceinline__ unsigned allmax16(unsigned v) { v = umax_(v, dppu<0xB1>(v)); v = umax_(v, dppu<0x4E>(v)); v = umax_(v, dppu<0x141>(v)); v = umax_(v, dppu<0x140>(v)); return v; }
__device__ __forceinline__ float dot2bf(unsigned w, unsigned x, float acc) { return __builtin_amdgcn_fdot2_f32_bf16(__builtin_bit_cast(bf16x2_t, w), __builtin_bit_cast(bf16x2_t, x), acc, false); }
__device__ __forceinline__ unsigned cand_word(int r) {
    const unsigned tab[16] = {0x03020100u, 0x07060504u, 0x0b0a0908u, 0x0f0e0d0cu, 0x13121110u, 0x17161514u, 0x23222120u, 0x32313024u,
                              0x42414033u, 0x61605150u, 0x90807170u, 0xd0c0b0a0u, 0xfffff0e0u, 0xffffffffu, 0xffffffffu, 0xffffffffu};
    unsigned w = 0xffffffffu;
#pragma unroll
    for (int i = 0; i < 13; ++i) w = (r == i) ? tab[i] : w;
    return w;
}
template <int NK> __device__ __forceinline__ unsigned top16_keys(unsigned (&k)[NK], int r) {
    unsigned res = 0u;
    for (int rd = 0; rd < 16; ++rd) {
        unsigned m = k[0];
#pragma unroll
        for (int j = 1; j < NK; ++j) m = umax_(m, k[j]);
        const unsigned gm = allmax16(m);
        res = (r == rd) ? gm : res;
#pragma unroll
        for (int j = 0; j < NK; ++j) k[j] = (k[j] == gm) ? 0u : k[j];
    }
    return res;
}
#define PEER_CE(a, b) do { const unsigned hi_ = umax_(k[a], k[b]), lo_ = (k[a] < k[b]) ? k[a] : k[b]; k[a] = hi_; k[b] = lo_; } while (0)
__device__ __forceinline__ unsigned top16_sorted8(unsigned (&k)[8], int r) {
    PEER_CE(0, 1); PEER_CE(2, 3); PEER_CE(4, 5); PEER_CE(6, 7);
    PEER_CE(0, 2); PEER_CE(1, 3); PEER_CE(4, 6); PEER_CE(5, 7);
    PEER_CE(1, 2); PEER_CE(5, 6);
    PEER_CE(0, 4); PEER_CE(1, 5); PEER_CE(2, 6); PEER_CE(3, 7);
    PEER_CE(2, 4); PEER_CE(3, 5);
    PEER_CE(1, 2); PEER_CE(3, 4); PEER_CE(5, 6);
    unsigned res = 0u;
    for (int rd = 0; rd < 16; ++rd) {
        const unsigned gm = allmax16(k[0]);
        res = (r == rd) ? gm : res;
        const bool pop = k[0] == gm;
#pragma unroll
        for (int j = 0; j < 7; ++j) k[j] = pop ? k[j + 1] : k[j];
        k[7] = pop ? 0u : k[7];
    }
    return res;
}
#undef PEER_CE
#ifdef PROBE_S
typedef int v8i_p __attribute__((ext_vector_type(8)));
__device__ __forceinline__ float mx_probe(int lane) {
    const int q = lane >> 4;
    unsigned aw[4] = {0u, 0u, 0u, 0u};
    if (lane == 16 * PROBE_QA) aw[(PROBE_S) >> 3] = 0x2u << (4 * ((PROBE_S) & 7));
    v8i_p A = {(int)aw[0], (int)aw[1], (int)aw[2], (int)aw[3], 0, 0, 0, 0};
    v8i_p B;
#pragma unroll
    for (int v = 0; v < 8; ++v) {
        float f[4];
#pragma unroll
        for (int b = 0; b < 4; ++b) { const int j = 4 * v + b; f[b] = (PROBE_PAT == 1) ? (float)(q + 1) : ((PROBE_PAT == 2) ? (float)((j & 15) + 1) : (float)((j >> 4) + 1)); }
        int w = 0; w = __builtin_amdgcn_cvt_pk_fp8_f32(f[0], f[1], w, false); w = __builtin_amdgcn_cvt_pk_fp8_f32(f[2], f[3], w, true); B[v] = w;
    }
    f32x4 c = {0.f, 0.f, 0.f, 0.f};
    c = __builtin_amdgcn_mfma_scale_f32_16x16x128_f8f6f4(A, B, c, 4, 0, 0, 0x7f7f7f7f, 0, 0x7f7f7f7f);
    const float r = __shfl(c.x, 0);
    const int code = (int)(r + 0.5f) - 1;
    float off = 0.1f;
    for (int i = 0; i < code && i < 40; ++i) off *= 1.3f;
    if (code < 0) off = 0.05f;
    return off;
}
#endif
typedef int v8i __attribute__((ext_vector_type(8)));
typedef int v4i __attribute__((ext_vector_type(4)));
__device__ __forceinline__ void peer_token_a(const bf16* SC, const unsigned char* XN8, const unsigned char* U8, LAS f32x4* xl, LAS int* pe, LAS float* ph, int t, int tnext, v4u (&scn)[4], v4u& x8n, int lane) {
    const int g = lane >> 4, r = lane & 15;
    int eidx[2]; float egate[2];
    unsigned resA[4];
#pragma unroll
    for (int pass = 0; pass < 4; ++pass) {
        const v4u sw = scn[pass];
        const float v[8] = {bflo(sw.x), bfhi(sw.x), bflo(sw.y), bfhi(sw.y), bflo(sw.z), bfhi(sw.z), bflo(sw.w), bfhi(sw.w)};
        unsigned k[8];
#pragma unroll
        for (int j = 0; j < 8; ++j) k[j] = (f2key(v[j]) & ~0x7Fu) | (unsigned)(127 - (r * 8 + j));
        resA[pass] = top16_sorted8(k, r);
    }
    const v4u x8cur = x8n;
#pragma unroll
    for (int pass = 0; pass < 4; ++pass) scn[pass] = *(const v4u*)(SC + (size_t)tnext * 2048 + (pass * 4 + g) * 128 + r * 8);
    x8n = *(const v4u*)(XN8 + (size_t)tnext * 1024 + 16 * lane);
    const unsigned cw = cand_word(r);
#pragma unroll
    for (int cp = 0; cp < 2; ++cp) {
        const int lbase = 32 * (g & 1); const bool hi = (g >> 1) != 0;
        unsigned ck[4];
#pragma unroll
        for (int m = 0; m < 4; ++m) {
            const unsigned byte = (cw >> (8 * m)) & 0xFFu; const int i = (int)(byte >> 4), j = (int)(byte & 15u);
            const unsigned a0 = (unsigned)__shfl((int)resA[2 * cp], lbase + i), a1 = (unsigned)__shfl((int)resA[2 * cp + 1], lbase + i);
            const unsigned b0 = (unsigned)__shfl((int)resA[2 * cp], lbase + 16 + j), b1 = (unsigned)__shfl((int)resA[2 * cp + 1], lbase + 16 + j);
            const unsigned ak = hi ? a1 : a0, bk = hi ? b1 : b0;
            const float val = key2f(ak & ~0x7Fu) + key2f(bk & ~0x7Fu);
            ck[m] = (byte != 0xFFu) ? ((f2key(val) & ~0xFFu) | (255u - byte)) : 0u;
        }
        const unsigned res = top16_keys<4>(ck, r);
        const unsigned flat = 255u - (res & 0xFFu); const int i = (int)(flat >> 4), j = (int)(flat & 15u);
        const float val = key2f(res & ~0xFFu), vmax = key2f(allmax16(res) & ~0xFFu);
        const float e = __expf(val - vmax);
        const float gate = e / allreduce16(e);
        const unsigned a0 = (unsigned)__shfl((int)resA[2 * cp], lbase + i), a1 = (unsigned)__shfl((int)resA[2 * cp + 1], lbase + i);
        const unsigned b0 = (unsigned)__shfl((int)resA[2 * cp], lbase + 16 + j), b1 = (unsigned)__shfl((int)resA[2 * cp + 1], lbase + 16 + j);
        const unsigned ak = hi ? a1 : a0, bk = hi ? b1 : b0;
        eidx[cp] = (int)((127u - (ak & 127u)) * 128u + (127u - (bk & 127u)));
        egate[cp] = gate;
    }
    LAS float* hl = (LAS float*)xl;
    {
        const int i16 = lane & 15, q = lane >> 4;
        LAS unsigned char* x8l = (LAS unsigned char*)(xl + 64);
        LDS_WAIT(); asm volatile("" ::: "memory");
        *(LAS v4u*)(x8l + 16 * lane) = x8cur;
#define PEER_LD(P, KB) (*(const v4i*)((P) + (KB) * 64))
#define PEER_PTR(GI) (U8 + (size_t)__shfl(eidx[(GI) >> 2], 16 * ((GI) & 3) + i16) * 512 + 16 * q)
        v4i ug[2][8];
        LDS_WAIT(); asm volatile("" ::: "memory");
        {
#pragma unroll
        for (int g0 = 0; g0 < 2; ++g0) { const unsigned char* p0 = PEER_PTR(g0);
#pragma unroll
            for (int kb = 0; kb < 8; ++kb) ug[g0][kb] = PEER_LD(p0, kb); }
#pragma unroll
        for (int gi = 0; gi < 8; ++gi) {
            const unsigned char* pn = PEER_PTR((gi + 2) & 7);
            f32x4 c_ = {0.f, 0.f, 0.f, 0.f};
#pragma unroll
            for (int kb = 0; kb < 8; ++kb) {
                const v8i xb_ = __builtin_shufflevector(*(const LAS v4i*)(x8l + kb * 128 + 16 * q), *(const LAS v4i*)(x8l + kb * 128 + 64 + 16 * q), 0, 1, 2, 3, 4, 5, 6, 7);
                const v8i ua_ = __builtin_shufflevector(ug[gi % 2][kb], (v4i){0, 0, 0, 0}, 0, 1, 2, 3, 4, 5, 6, 7);
                c_ = __builtin_amdgcn_mfma_scale_f32_16x16x128_f8f6f4(ua_, xb_, c_, 4, 0, 0, 0x7f7f7f7f, 0, 0x7f7f7f7f);
                if (gi + 2 < 8) ug[gi % 2][kb] = PEER_LD(pn, kb);
            }
            if (i16 == 0) *(LAS f32x4*)(hl + (gi >> 2) * 64 + 16 * (gi & 3) + 4 * q) = c_;
            __builtin_amdgcn_sched_barrier(0);
        }
        }
#undef PEER_LD
#undef PEER_PTR
    }
    LDS_WAIT(); asm volatile("" ::: "memory");
    float ehs[2];
#pragma unroll
    for (int cp = 0; cp < 2; ++cp) { const float hd = hl[cp * 64 + lane] * (1.f / 512.f); ehs[cp] = 0.5f * hd * (1.f + erff(hd * 0.70710678118654752f)) * egate[cp] * (1.f / 5.656854249f); }
    pe[lane] = eidx[0]; pe[64 + lane] = eidx[1]; ph[lane] = ehs[0]; ph[64 + lane] = ehs[1];
}
__device__ __forceinline__ void peer_token_b(const unsigned char* V8, const float* MOD, const float* OUT, float* OROW, const LAS int* pe, const LAS float* ph, int t, int hf, int lane) {
    const int g = lane >> 4, r = lane & 15;
    int eidx[2]; float ehs[2];
    eidx[0] = pe[lane]; eidx[1] = pe[64 + lane]; ehs[0] = ph[lane]; ehs[1] = ph[64 + lane];
    f32x2 acc[16];
#pragma unroll
    for (int i = 0; i < 16; ++i) acc[i] = (f32x2){0.f, 0.f};
#define PEER_VL(VV, BT) do { const int src_ = 4 * ((BT) & 15) + g; const int e0_ = __shfl(eidx[0], src_), e1_ = __shfl(eidx[1], src_); const int e_ = ((BT) < 16) ? e0_ : e1_; \
        VV = *(const v4u*)(V8 + (size_t)e_ * 512 + hf * 256 + r * 16); } while (0)
#define PEER_AX(W, I, H) do { acc[(I)] += __builtin_amdgcn_cvt_scalef32_pk_f32_fp4((W), 1.0f, 0) * H; acc[(I) + 1] += __builtin_amdgcn_cvt_scalef32_pk_f32_fp4((W), 1.0f, 1) * H; \
        acc[(I) + 2] += __builtin_amdgcn_cvt_scalef32_pk_f32_fp4((W), 1.0f, 2) * H; acc[(I) + 3] += __builtin_amdgcn_cvt_scalef32_pk_f32_fp4((W), 1.0f, 3) * H; } while (0)
#define PEER_VC(VV, BT) do { const int src_ = 4 * ((BT) & 15) + g; const float h0_ = __shfl(ehs[0], src_), h1_ = __shfl(ehs[1], src_); const float hs_ = ((BT) < 16) ? h0_ : h1_; const f32x2 hg_ = {hs_, hs_}; \
        PEER_AX(VV.x, 0, hg_); PEER_AX(VV.y, 4, hg_); PEER_AX(VV.z, 8, hg_); PEER_AX(VV.w, 12, hg_); } while (0)
    {
        v4u vr[8];
#pragma unroll
        for (int i = 0; i < 8; ++i) PEER_VL(vr[i], i);
#pragma unroll 1
        for (int b8 = 0; b8 < 32; b8 += 8) {
#pragma unroll
            for (int i = 0; i < 8; ++i) {
                PEER_VC(vr[i], b8 + i);
                { const int nb_ = (b8 + 8 + i < 32) ? b8 + 8 + i : 31; PEER_VL(vr[i], nb_); }
            }
        }
    }
#undef PEER_VL
#undef PEER_AX
#undef PEER_VC
    const float* gt2 = MOD + (size_t)(t >> 13) * 6144 + 5 * 1024;
    const int col = 512 * hf + 32 * r + 8 * g;
    const float* op = OUT + (size_t)t * 1024 + col; float* op2 = OROW + col;
    f32x4 hv[2], qv[2];
#pragma unroll
    for (int q = 0; q < 2; ++q) { hv[q] = *(const f32x4*)(op + 4 * q); qv[q] = *(const f32x4*)(gt2 + col + 4 * q); }
#pragma unroll
    for (int i = 0; i < 16; ++i) { acc[i].x += __shfl_xor(acc[i].x, 16); acc[i].y += __shfl_xor(acc[i].y, 16); acc[i].x += __shfl_xor(acc[i].x, 32); acc[i].y += __shfl_xor(acc[i].y, 32); }
#pragma unroll
    for (int q = 0; q < 2; ++q) {
        f32x2 a0 = acc[2 * q], a1 = acc[2 * q + 1];
#pragma unroll
        for (int kk = 1; kk < 4; ++kk) { a0 = (g == kk) ? acc[4 * kk + 2 * q] : a0; a1 = (g == kk) ? acc[4 * kk + 2 * q + 1] : a1; }
        f32x4 o0; o0.x = hv[q].x + qv[q].x * a0.x; o0.y = hv[q].y + qv[q].y * a0.y; o0.z = hv[q].z + qv[q].z * a1.x; o0.w = hv[q].w + qv[q].w * a1.y;
        *(f32x4*)(op2 + 4 * q) = o0;
    }
}

#ifndef MK_N_LAUNCHES
#define MK_N_LAUNCHES 1
#endif
constexpr int N_PHASES = 15;
struct Args { const float* in[28]; float* out; unsigned char* ws; int ph_lo, ph_hi, use_bar, rep; };
enum { I_X = 0, I_C, I_POS, I_WADA, I_BADA, I_N1G, I_WIN, I_QNG, I_KNG, I_MU, I_W0, I_W2, I_A0, I_A2, I_G2, I_KK, I_KA, I_RK, I_LNG, I_LNB, I_WPM, I_WPR, I_WOUT, I_N2G, I_WQ, I_SK, I_PU, I_PV };

template <int OFF> __device__ __forceinline__ unsigned long long karg64() { unsigned long long p; asm volatile("s_load_dwordx2 %0, %1, %2\n\ts_waitcnt lgkmcnt(0)" : "=s"(p) : "s"(__builtin_amdgcn_kernarg_segment_ptr()), "n"(OFF)); return p; }
#define KIN(k) ((const float*)(const GAS float*)karg64<8 * (k)>())
#define KOUT ((float*)(GAS float*)karg64<224>())
#define KWS ((unsigned char*)(GAS unsigned char*)karg64<232>())
#define KOB ((unsigned char*)(GAS unsigned char*)karg64<224>())
#define ctl ((unsigned*)(KWS + WS_CTL))
#define mod ((float*)(KWS + WS_MOD))
#define kmean ((float*)(KWS + WS_KMEAN))
#define WinT ((bf16*)(KWS + WS_WIN))
#define WloraT ((bf16*)(KWS + WS_WLORA))
#define WpmT ((bf16*)(KWS + WS_WPM))
#define WprT ((bf16*)(KWS + WS_WPR))
#define WoutT ((bf16*)(KWS + WS_WOUT))
#define WeffT ((bf16*)(KWS + WS_WEFF))
#define XN ((bf16*)(KWS + WS_XN))
#define EW ((bf16*)(KWS + WS_EW))
#define AA ((bf16*)(KWS + WS_AA))
#define Qb ((bf16*)(KWS + WS_Q))
#define Kb ((bf16*)(KWS + WS_K))
#define VTb ((bf16*)(KWS + WS_VT))
#define ZRKV ((bf16*)(KWS + WS_ZRKV))
#define GT ((bf16*)(KWS + WS_GT))
#define ZLORA ((bf16*)(KWS + WS_ZLORA))
#define ALORA ((bf16*)(KWS + WS_ALORA))
#define OMOBA ((bf16*)(KWS + WS_OCAT))
#define GG ((bf16*)(KWS + WS_GG))
#define Yb ((bf16*)(KWS + WS_OCAT) + 512)
#define MIXED ((bf16*)(KWS + WS_MIXED))
#define U8 ((unsigned char*)(KWS + WS_U8))
#define XN8 ((unsigned char*)(KWS + 352 * MiB))
#define V8 ((unsigned char*)(KWS + WS_V8))
#define SCORES ((bf16*)(KWS + WS_SCORES))
#define OPART ((bf16*)(KOB + DO_OPART))
#define LISTS ((unsigned*)(KOB + DO_LISTS))
#define LPART ((float*)(KOB + DO_LPART))
#define CP_RW ((bf16*)(KOB))
#define CP_MM ((bf16*)(KOB + 32 * MiB))
#define CP_Y0T ((bf16*)(KOB + 64 * MiB))
#define CP_GAT ((bf16*)(KOB + 96 * MiB))
#define CP_PC ((float*)(KWS + 504 * MiB))
#if MK_N_LAUNCHES == 1 || defined(PROBE5)
#define REPSEL(a, b) (b)
#else
#define REPSEL(a, b) (args.rep ? (a) : (b))
#endif
#ifdef PROBE5
#define REPSEL5(a, b) (args.rep ? (a) : (b))
#else
#define REPSEL5(a, b) REPSEL(a, b)
#endif
__global__ void __launch_bounds__(NTHR, 2) mk_fwd(Args args) {
    extern __shared__ __attribute__((aligned(16))) unsigned char lds_raw[];
    LAS unsigned char* lds = (LAS unsigned char*)lds_raw;
    volatile LAS unsigned* MISC = (volatile LAS unsigned*)(lds + MISC_OFF);
    const int tid = threadIdx.x, lane = tid & 63, wave = __builtin_amdgcn_readfirstlane(tid >> 6);
    const int G = gridDim.x, bx = blockIdx.x;
    const int vcu = (G % 8 == 0) ? (bx % 8) * (G / 8) + bx / 8 : bx;
    const int gw = vcu * NWAVES + wave, NGW = G * NWAVES;
    const int gtid = vcu * NTHR + tid, NTOT = G * NTHR;
    for (int u = tid; u < (LDS_BYTES - MISC_OFF) / 4; u += NTHR) ((LAS unsigned*)(lds + MISC_OFF))[u] = 0u;
    __syncthreads();
    XcdBarrier bar; bar.bar = ctl + CW_BAR; bar.x = 0; bar.st = nullptr;
    if (args.use_bar) bar = xcd_barrier_post(ctl + CW_BAR, MISC + 8);
    const int lo = args.ph_lo, hi = args.ph_hi;
#ifdef PH_MASK
#define IN(k) ((((PH_MASK) >> (k)) & 1) && lo <= (k) && (k) < hi)
#else
#define IN(k) (lo <= (k) && (k) < hi)
#endif
#define SEAM(k) do { if (IN(k) && IN((k) + 1)) { if (lo < 0) { cg::this_grid().sync(); } xcd_barrier(bar); } } while (0)

    if (IN(0)) {
        LAS float* scr = (LAS float*)(lds + wave * 16384);
        for (int it = vcu; it < 96; it += G) p0_mod_item(KIN(I_C), KIN(I_WADA), KIN(I_BADA), mod, (LAS float*)lds, it, wave, lane);
        constexpr int I_WEFF = 2048, I_MOD = 0, I_T_IN = 16 * 168, I_T_PM = 8 * 32, I_T_OUT = 16 * 32;
        constexpr int NITEMS = I_WEFF + I_MOD + I_T_IN + 2 * I_T_PM + I_T_OUT;
        for (int it = gw; it < NITEMS; it += NGW) {
            int r = it;
            if (r < I_WEFF) { p0_weff_item(KIN(I_WQ), KIN(I_SK), WeffT, r, lane); continue; } r -= I_WEFF;
            if (r < I_T_IN) { p0_transpose_item(KIN(I_WIN), 1024, INW, WinT, 1024, 0, scr, r, lane); continue; } r -= I_T_IN;
            if (r < I_T_PM) { p0_transpose_item(KIN(I_WPM), 512, 1024, WpmT, 1024, 0, scr, r, lane); continue; } r -= I_T_PM;
            if (r < I_T_PM) { p0_transpose_item(KIN(I_WPR), 512, 1024, WpmT, 1024, 512, scr, r, lane); continue; } r -= I_T_PM;
            p0_transpose_item(KIN(I_WOUT), 1024, 1024, WoutT, 1024, 0, scr, r, lane);
        }
        const float* w2 = KIN(I_W2); const float* a2 = KIN(I_A2); const float* g2 = KIN(I_G2);
        for (int i = gtid; i < 1536 * 256; i += NTOT) {
            const int n = i >> 8, k = i & 255; float v = 0.f;
            if (n < 512) { if (k < 64) v = w2[k * 512 + n]; }
            else if (n < 1024) { if (k >= 64 && k < 128) v = a2[(k - 64) * 512 + (n - 512)]; }
            else { if (k >= 128) v = g2[(k - 128) * 512 + (n - 1024)]; }
            WloraT[i] = (bf16)f2bf(v);
        }
     }
    SEAM(0);
    if (IN(1)) {
        for (int m = gw * 4; m < T; m += NGW * 4) { const float* mb = mod + (size_t)(m >> 13) * 6144;
            rms_mod_rows<4>(KIN(I_X) + (size_t)m * DM, XN + (size_t)m * DM, nullptr, KIN(I_N1G), mb + 1024, mb, lane); }
     }
    SEAM(1);
    if (IN(2)) {
        pg8::Gemm g{XN, WinT, T, INW, DM}; pg8::StaticOrder S; S.init(T, INW, G, bx);
        EpiIn E{Qb, Kb, VTb, ZRKV, ZLORA, GT};
        pg8::gemm_phase<EpiIn, pg8::StaticOrder, true, true>(lds, g, S, E);
     }
    SEAM(2);
    if (IN(3)) {
        LAS float* red = (LAS float*)lds;
        v4u raw[4], rawn[4]; int ps[4], psn[4];
        if (vcu < 2048) p2_qk_load(raw, ps, (vcu >> 10) ? Qb : Kb, (const int*)KIN(I_POS), (vcu & 1023) >> 5, vcu & 31, wave, lane);
        for (int it = vcu; it < 2048; it += G) {
            const int isq = it >> 10, r = it & 1023, bh = r >> 5, n = r & 31;
            { const int itn = it + G < 2048 ? it + G : it;
              p2_qk_load(rawn, psn, (itn >> 10) ? Qb : Kb, (const int*)KIN(I_POS), (itn & 1023) >> 5, itn & 31, wave, lane); }
            if (isq) p2_qk_item(raw, ps, REPSEL((bf16*)KOB, Qb), KIN(I_QNG), nullptr, bh, n, red, tid, wave, lane);
            else p2_qk_item(raw, ps, REPSEL((bf16*)(KOB + 32 * MiB), Kb), KIN(I_KNG), REPSEL((float*)(KWS + 1536 * 1024), kmean), bh, n, red, tid, wave, lane);
#pragma unroll
            for (int i = 0; i < 4; ++i) { raw[i] = rawn[i]; ps[i] = psn[i]; }
        }
        p2_prep(ZLORA, KIN(I_MU), REPSEL((bf16*)(KOB + 64 * MiB), ALORA), gtid, NTOT);
    }
    SEAM(3);
    if (IN(4)) {
        { int kdim = 256; asm volatile("" : "+s"(kdim));
          pg8::Gemm g{ALORA, WloraT, T, 1536, kdim}; pg8::StaticOrder S; S.init(T, 1536, G, bx);
          EpiLora E{EW, AA, GG, KIN(I_W0), KIN(I_A0)};
          pg8::gemm_phase<EpiLora, pg8::StaticOrder, true, true>(lds, g, S, E); }
        __syncthreads();
        LAS float* km = (LAS float*)lds;
        for (int it = vcu; it < 512; it += G) p3_top3_item(Qb, kmean, ctl + CW_CURSOR + REPSEL(2048, 0), REPSEL((unsigned*)KOB, LISTS), (2 * it) & 31, (2 * it) >> 5, km, tid, wave, lane);
    }
    SEAM(4);
    if (IN(5)) {
        attn_phase(Qb, Kb, VTb, LISTS, ctl + CW_CURSOR, ctl + CW_QUEUE + REPSEL5(64, 0), OPART, LPART, OMOBA, KIN(I_QNG), KIN(I_KNG), lds, tid, wave, lane);
    }
    SEAM(5);
    if (IN(6)) {
        p5_combine(OPART, LPART, OMOBA, REPSEL(Qb, OMOBA), gtid, NTOT);
    }
    SEAM(6);
    if (IN(7)) {
        ScanRaw R;
        if (vcu < BH * NCHK) scan_load(R, ZRKV, AA, EW, (vcu >> 7) >> 3, ((vcu >> 7) & 7) * 64 + (tid & 7) * 8, (vcu & 127) * CK + (tid >> 3));
        for (int ci = vcu; ci < BH * NCHK; ci += G) {
            const int cn = ci + G;
            rwkv_cp_item(ZRKV, AA, EW, KIN(I_MU), KIN(I_KK), KIN(I_KA), CP_RW + (size_t)ci * 4096, CP_MM + (size_t)ci * 4096, CP_Y0T + (size_t)ci * 4096, CP_GAT + (size_t)ci * 4096,
                         CP_PC + (size_t)ci * 64, ci >> 7, ci & 127, R, (cn < BH * NCHK ? cn : ci) >> 7, (cn < BH * NCHK ? cn : ci) & 127, lds, tid, wave, lane, REPSEL(args.rep, 0));
        }
    }
    SEAM(7);
    if (IN(8)) {
        if (G >= 128) { if (vcu < 128) rwkv_seq(CP_RW, CP_MM, CP_Y0T, CP_GAT, CP_PC, Yb, vcu, lds, tid, wave, lane); }
        else for (int sid = vcu; sid < 128; sid += G) { __syncthreads(); rwkv_seq(CP_RW, CP_MM, CP_Y0T, CP_GAT, CP_PC, Yb, sid, lds, tid, wave, lane); }
        if (G > 128 ? vcu >= 128 : true) {
        const int cgt = (G > 128 ? vcu - 128 : vcu) * NTHR + tid, cnt = (G > 128 ? G - 128 : G) * NTHR;
        const f32x4* pu = (const f32x4*)KIN(I_PU); const f32x4* pv = (const f32x4*)KIN(I_PV);
        for (int i = cgt; i < 16384 * 1024 / 32; i += cnt) {
            v4u wu;
#pragma unroll
            for (int q = 0; q < 4; ++q) {
                f32x4 a = pu[8 * i + 2 * q] * 64.f, c = pu[8 * i + 2 * q + 1] * 64.f;
                a = __builtin_elementwise_min(__builtin_elementwise_max(a, (f32x4){-6.f, -6.f, -6.f, -6.f}), (f32x4){6.f, 6.f, 6.f, 6.f});
                c = __builtin_elementwise_min(__builtin_elementwise_max(c, (f32x4){-6.f, -6.f, -6.f, -6.f}), (f32x4){6.f, 6.f, 6.f, 6.f});
                unsigned w = 0u;
                w = __builtin_amdgcn_cvt_scalef32_pk_fp4_f32(w, a.x, a.y, 1.0f, 0); w = __builtin_amdgcn_cvt_scalef32_pk_fp4_f32(w, a.z, a.w, 1.0f, 1);
                w = __builtin_amdgcn_cvt_scalef32_pk_fp4_f32(w, c.x, c.y, 1.0f, 2); w = __builtin_amdgcn_cvt_scalef32_pk_fp4_f32(w, c.z, c.w, 1.0f, 3);
                wu[q] = w;
            }
            *(v4u*)(U8 + (size_t)i * 16) = wu;
        }
        for (int i = cgt; i < 16384 * 1024 / 32; i += cnt) {
            v4u wv;
#pragma unroll
            for (int q = 0; q < 4; ++q) {
                f32x4 a = pv[8 * i + 2 * q] * 5.656854249f, c = pv[8 * i + 2 * q + 1] * 5.656854249f;
                a = __builtin_elementwise_min(__builtin_elementwise_max(a, (f32x4){-6.f, -6.f, -6.f, -6.f}), (f32x4){6.f, 6.f, 6.f, 6.f});
                c = __builtin_elementwise_min(__builtin_elementwise_max(c, (f32x4){-6.f, -6.f, -6.f, -6.f}), (f32x4){6.f, 6.f, 6.f, 6.f});
                unsigned w = 0u;
                w = __builtin_amdgcn_cvt_scalef32_pk_fp4_f32(w, a.x, a.y, 1.0f, 0); w = __builtin_amdgcn_cvt_scalef32_pk_fp4_f32(w, a.z, a.w, 1.0f, 1);
                w = __builtin_amdgcn_cvt_scalef32_pk_fp4_f32(w, c.x, c.y, 1.0f, 2); w = __builtin_amdgcn_cvt_scalef32_pk_fp4_f32(w, c.z, c.w, 1.0f, 3);
                wv[q] = w;
            }
            *(v4u*)(V8 + (size_t)i * 16) = wv;
        }
        }
    }
    SEAM(8);
    if (IN(9)) {
        p5_rwkv_post(ZRKV, AA, GG, Yb, REPSEL(Qb, Yb), KIN(I_MU), KIN(I_KA), KIN(I_RK), KIN(I_LNG), KIN(I_LNB), gw, NGW, lane);
    }
    SEAM(9);
    if (IN(10)) {
        pg8::Gemm g{OMOBA, WpmT, T, DM, DM}; pg8::StaticOrder S; S.init(T, DM, G, bx);
        EpiMix E{GT, MIXED, REPSEL(args.rep, 0)};
        pg8::gemm_phase<EpiMix, pg8::StaticOrder, true, true>(lds, g, S, E);
    }
    SEAM(10);
    if (IN(11)) {
        pg8::Gemm g{MIXED, WoutT, T, DM, DM}; pg8::StaticOrder S; S.init(T, DM, G, bx);
        EpiOut E{KIN(I_X), mod, KOUT};
        pg8::gemm_phase<EpiOut, pg8::StaticOrder, true, true>(lds, g, S, E);
     }
    SEAM(11);
    if (IN(12)) {
        for (int m = gw * 4; m < T; m += NGW * 4) { const float* mb = mod + (size_t)(m >> 13) * 6144;
            rms_mod_rows<4>(KOUT + (size_t)m * DM, XN + (size_t)m * DM, (unsigned*)(XN8 + (size_t)m * DM), KIN(I_N2G), mb + 4 * 1024, mb + 3 * 1024, lane); }
    }
    SEAM(12);
    if (IN(13)) {
        pg8::Gemm g{XN, WeffT, T, PEER_N, DM}; pg8::StaticOrder S; S.init(T, PEER_N, G, bx);
        EpiScores E{SCORES};
        pg8::gemm_phase<EpiScores, pg8::StaticOrder, true, true>(lds, g, S, E);
     }
    SEAM(13);
    if (IN(14)) {
        LAS f32x4* xl = (LAS f32x4*)(lds + wave * 18432);
        LAS int* pe = (LAS int*)(lds + wave * 18432 + 2048); LAS float* ph = (LAS float*)(lds + wave * 18432 + 2048 + 8192);
        v4u scn[4], x8n;
        { const int g_ = lane >> 4, r_ = lane & 15;
#pragma unroll
          for (int pass = 0; pass < 4; ++pass) scn[pass] = *(const v4u*)(SCORES + (size_t)gw * 2048 + (pass * 4 + g_) * 128 + r_ * 8);
          x8n = *(const v4u*)(XN8 + (size_t)gw * 1024 + 16 * lane); }
        { int k = 0; for (int t = gw; t < T; t += NGW, ++k) peer_token_a(SCORES, XN8, U8, xl, pe + 128 * (k & 15), ph + 128 * (k & 15), t, t + NGW < T ? t + NGW : t, scn, x8n, lane); }
        LDS_WAIT(); asm volatile("" ::: "memory");
        for (int hf = 0; hf < 2; ++hf) { int k = 0; for (int t = gw; t < T; t += NGW, ++k) peer_token_b(V8, mod, KOUT, KOUT + (size_t)t * 1024, pe + 128 * (k & 15), ph + 128 * (k & 15), t, hf, lane); }
    }
#undef IN
#undef SEAM
}

extern "C" void kernel_launch(void* const* d_in, const int* in_sizes, int n_in, void* d_out, int out_size, void* d_ws, size_t ws_size, hipStream_t stream) {
    static int grid = 0;
    if (grid == 0) {
        if (n_in != 28 || in_sizes[0] != T * DM || out_size != T * DM || ws_size < WS_END) {
            fprintf(stderr, "kernel_launch: unexpected problem (n_in %d, in0 %d, out %d, ws %zu); nothing launched\n", n_in, n_in > 0 ? in_sizes[0] : -1, out_size, ws_size); grid = -1; return; }
        int dev = 0, cus = 0, per_cu = 0;
        if (hipGetDevice(&dev) != hipSuccess || hipDeviceGetAttribute(&cus, hipDeviceAttributeMultiprocessorCount, dev) != hipSuccess) { grid = -1; return; }
        if (hipFuncSetAttribute((const void*)mk_fwd, hipFuncAttributeMaxDynamicSharedMemorySize, LDS_BYTES) != hipSuccess) { fprintf(stderr, "kernel_launch: hipFuncSetAttribute failed\n"); grid = -1; return; }
        if (hipOccupancyMaxActiveBlocksPerMultiprocessor(&per_cu, (const void*)mk_fwd, NTHR, LDS_BYTES) != hipSuccess || per_cu < 1) { fprintf(stderr, "kernel_launch: occupancy query says %d\n", per_cu); per_cu = 1; }
        (void)hipGetLastError();
        grid = cus;
    }
    if (grid < 0) return;
    if (hipMemsetAsync((char*)d_ws + WS_CTL, 0, CTL_ZERO_BYTES, stream) != hipSuccess) { fprintf(stderr, "kernel_launch: memset failed\n"); return; }
    Args a{};
    for (int i = 0; i < 28; ++i) a.in[i] = (const float*)d_in[i];
    a.out = (float*)d_out; a.ws = (unsigned char*)d_ws;
#if MK_N_LAUNCHES == 1
    a.ph_lo = 0; a.ph_hi = N_PHASES; a.use_bar = 1;
    void* kargs[] = {&a};
    hipError_t e = hipLaunchCooperativeKernel((const void*)mk_fwd, dim3(grid), dim3(NTHR), kargs, LDS_BYTES, stream);
    if (e != hipSuccess) fprintf(stderr, "kernel_launch: cooperative launch failed: %s (grid %d)\n", hipGetErrorString(e), grid);
#else
#ifndef REP_MASK
#define REP_MASK 0
#endif
#ifndef REP_CODE
#define REP_CODE 1
#endif
    for (int p = 0; p < N_PHASES; ++p) {
        a.ph_lo = p; a.ph_hi = p + 1; a.use_bar = 0;
        if ((REP_MASK >> p) & 1) { a.rep = REP_CODE; hipLaunchKernelGGL(mk_fwd, dim3(grid), dim3(NTHR), LDS_BYTES, stream, a); }
        a.rep = 0;
        hipLaunchKernelGGL(mk_fwd, dim3(grid), dim3(NTHR), LDS_BYTES, stream, a);
    }
#endif
}
```

```cpp
#include <hip/hip_runtime.h>
#include <hip/hip_cooperative_groups.h>
#include <cstdio>
#include <cstdint>
namespace cg = cooperative_groups;

namespace pg8 {
#define PG8_LAS __attribute__((address_space(3)))
typedef unsigned short bf16_t;
typedef short bf16x8 __attribute__((ext_vector_type(8)));
typedef float f32x4 __attribute__((ext_vector_type(4)));
typedef unsigned u32x4 __attribute__((ext_vector_type(4)));
constexpr int BM = 256, BK = 64, HALF = 128, HTB = HALF * BK * 2  , STAGE_BYTES = 8 * HTB, NXCD = 8, WGM = 8;

__host__ __device__ __forceinline__ int lds_byte(int r, int c) { const int st = (r >> 4) * 2 + (c >> 5), rr = r & 15, cc = c & 31, ob = rr * 64 + cc * 2; return st * 1024 + (ob ^ (((ob >> 9) & 1) << 5)); }
__host__ __device__ __forceinline__ void stage_rc(int b, int& R, int& C) { const int st = b / 1024, sb = b % 1024, swz = sb ^ (((sb >> 9) & 1) << 5); R = (st >> 1) * 16 + swz / 64; C = (st & 1) * 32 + (swz % 64) / 2; }
__host__ __device__ __forceinline__ int perm32(int rho) { const int n = rho >> 4, i = rho & 15; return 8 * (i >> 2) + 4 * n + (i & 3); }

struct Unit { int pm, pn; };
struct Gemm { const bf16_t* A; const bf16_t* Bt; int M, N, K; };

struct StaticOrder {
    int nM, nN, nwg, G, c;
    __host__ __device__ void init(int M, int N, int G_, int c_) { nM = M / BM; nN = N / BM; nwg = nM * nN; G = G_; c = c_; }
    __host__ __device__ bool next(int i, Unit& u) const {
        const long L = (long)i * G + c; if (L >= nwg) return false;
        int wgid = (int)L; { const int q = nwg / NXCD, r = nwg % NXCD, xcd = wgid % NXCD, off = wgid / NXCD; wgid = (xcd < r ? xcd * (q + 1) : r * (q + 1) + (xcd - r) * q) + off; }
        const int nig = WGM * nN, gid = wgid / nig, fm = gid * WGM, gsz = (nM - fm) < WGM ? (nM - fm) : WGM;
        u.pm = fm + ((wgid % nig) % gsz); u.pn = (wgid % nig) / gsz; return true;
    }
    __device__ __forceinline__ void a_ready(const Unit&) const {}
    __device__ __forceinline__ void done(const Unit&) const {}
};
template <class Epi, class Sched, bool ALIGN_EPI = false, bool SP2 = false>
__device__ __forceinline__ void gemm_phase(PG8_LAS unsigned char* lds, const Gemm g, const Sched& S, const Epi& E) {
    const int tid = threadIdx.x, wid = __builtin_amdgcn_readfirstlane(tid >> 6), lane = tid & 63, wr = wid >> 2, wc = wid & 3, fr = lane & 15, fq = lane >> 4;
    const int K = g.K, nt = K / BK;
    unsigned voffA[2], voffB[2];
#pragma unroll
    for (int i = 0; i < 2; ++i) { int R, C; stage_rc(tid * 16 + i * 8192, R, C); const int Rb = Epi::PERM ? ((R & ~31) + perm32(R & 31)) : R;
        voffA[i] = (unsigned)(R * K + C) * 2u; voffB[i] = (unsigned)(Rb * K + C) * 2u; }
    const size_t kstep = (size_t)(BK * 2);
    const size_t hstep = (size_t)HALF * K * 2;
    const size_t tstep = 2 * hstep;
    const unsigned ldsw = (unsigned)wid * 1024u;
    const int aoff = lds_byte(wr * 64 + fr, fq * 8), boff = lds_byte(wc * 32 + fr, fq * 8);
#define PG8_SA(b, h) (((b) * 2 + (h)) * HTB)
#define PG8_SB(b, h) ((4 + (b) * 2 + (h)) * HTB)
#define PG8_STAGE(bufoff, gbase, voff) do { _Pragma("unroll") for (int _i = 0; _i < 2; ++_i) \
        __builtin_amdgcn_global_load_lds((const unsigned*)((const char*)(gbase) + (voff)[_i]), (PG8_LAS unsigned*)(lds + (bufoff) + ldsw + _i * 8192), 16, 0, 0); } while (0)
#define PG8_LDA(dst, b, h) do { _Pragma("unroll") for (int m = 0; m < 4; ++m) _Pragma("unroll") for (int k = 0; k < 2; ++k) dst[m][k] = *(const PG8_LAS bf16x8*)(lds + PG8_SA(b, h) + aoff + m * 2048 + k * 1024); } while (0)
#define PG8_LDB(dst, b, h) do { _Pragma("unroll") for (int n = 0; n < 2; ++n) _Pragma("unroll") for (int k = 0; k < 2; ++k) dst[n][k] = *(const PG8_LAS bf16x8*)(lds + PG8_SB(b, h) + boff + n * 2048 + k * 1024); } while (0)
#define PG8_MMA(ai, bj, At, Bt) do { __builtin_amdgcn_s_setprio(1); _Pragma("unroll") for (int m = 0; m < 4; ++m) _Pragma("unroll") for (int n = 0; n < 2; ++n) _Pragma("unroll") for (int k = 0; k < 2; ++k) \
        acc[ai][bj][m][n] = __builtin_amdgcn_mfma_f32_16x16x32_bf16(Bt[n][k], At[m][k], acc[ai][bj][m][n], 0, 0, 0); __builtin_amdgcn_s_setprio(0); } while (0)
#define PG8_WAIT_V(n) asm volatile("s_waitcnt vmcnt(" #n ")" ::: "memory")
#define PG8_WAIT_L(n) asm volatile("s_waitcnt lgkmcnt(" #n ")" ::: "memory")
#define PG8_BAR __builtin_amdgcn_s_barrier()
#define PG8_SCHED __builtin_amdgcn_sched_barrier(0)
    Unit cur, nxt; int ui = 0;
    if (!S.next(0, cur)) return;
    f32x4 acc[2][2][4][2];
#pragma unroll
    for (int a = 0; a < 2; ++a)
#pragma unroll
        for (int b = 0; b < 2; ++b)
#pragma unroll
            for (int m = 0; m < 4; ++m)
#pragma unroll
                for (int n = 0; n < 2; ++n) acc[a][b][m][n] = (f32x4){0.f, 0.f, 0.f, 0.f};
    bf16x8 At[4][2], B0[2][2], B1[2][2];
    const char* cA = (const char*)g.A + (size_t)cur.pm * tstep; const char* cB = (const char*)g.Bt + (size_t)cur.pn * tstep;
    S.a_ready(cur);
    if constexpr (SP2) {
        PG8_STAGE(PG8_SB(0, 0), cB, voffB); PG8_STAGE(PG8_SB(0, 1), cB + hstep, voffB); PG8_STAGE(PG8_SA(0, 0), cA, voffA); PG8_STAGE(PG8_SA(0, 1), cA + hstep, voffA);
        if (wr == 1) PG8_BAR;
        PG8_WAIT_V(2); PG8_BAR;
        PG8_STAGE(PG8_SB(1, 0), cB + kstep, voffB); PG8_STAGE(PG8_SA(1, 0), cA + kstep, voffA); PG8_STAGE(PG8_SB(1, 1), cB + hstep + kstep, voffB);
        PG8_WAIT_V(6); PG8_BAR;
    } else {
        PG8_STAGE(PG8_SB(0, 0), cB, voffB); PG8_STAGE(PG8_SA(0, 0), cA, voffA); PG8_STAGE(PG8_SB(0, 1), cB + hstep, voffB); PG8_STAGE(PG8_SA(0, 1), cA + hstep, voffA);
        if (wr == 1) PG8_BAR;
        PG8_WAIT_V(4); PG8_BAR;
        PG8_STAGE(PG8_SB(1, 0), cB + kstep, voffB); PG8_STAGE(PG8_SA(1, 0), cA + kstep, voffA); PG8_STAGE(PG8_SB(1, 1), cB + hstep + kstep, voffB);
        PG8_WAIT_V(6); PG8_BAR;
    }
    for (;;) {
        const bool has_next = S.next(ui + 1, nxt);
        const char* nA = has_next ? (const char*)g.A + (size_t)nxt.pm * tstep : cA; const char* nB = has_next ? (const char*)g.Bt + (size_t)nxt.pn * tstep : cB;
        for (int t = 0; t < nt; t += 2) {
            if constexpr (Epi::HAS_MID) { if (t == Epi::MID_T) E.mid(acc, cur, wr, wc, fr, fq); }
            const bool last = (t == nt - 2);
            const char* a1 = cA + (size_t)(t + 1) * kstep;
            const char* a2 = last ? nA : cA + (size_t)(t + 2) * kstep; const char* b2 = last ? nB : cB + (size_t)(t + 2) * kstep;
            const char* a3 = a2 + kstep; const char* b3 = b2 + kstep;
            if (last && has_next) S.a_ready(nxt);
            if constexpr (SP2) {
            PG8_LDB(B0, 0, 0); PG8_LDB(B1, 0, 1); PG8_SCHED; PG8_LDA(At, 0, 0); PG8_STAGE(PG8_SA(1, 1), a1 + hstep, voffA);
            PG8_WAIT_V(8); PG8_WAIT_L(0); PG8_BAR; PG8_MMA(0, 0, At, B0); PG8_MMA(0, 1, At, B1); PG8_BAR; PG8_SCHED;
            PG8_LDA(At, 0, 1); PG8_STAGE(PG8_SB(0, 0), b2, voffB); PG8_STAGE(PG8_SB(0, 1), b2 + hstep, voffB); PG8_STAGE(PG8_SA(0, 0), a2, voffA);
            PG8_WAIT_V(8); PG8_WAIT_L(0); PG8_BAR; PG8_MMA(1, 0, At, B0); PG8_MMA(1, 1, At, B1); PG8_BAR; PG8_SCHED;
            PG8_LDB(B0, 1, 0); PG8_LDB(B1, 1, 1); PG8_SCHED; PG8_LDA(At, 1, 0); PG8_STAGE(PG8_SA(0, 1), a2 + hstep, voffA);
            PG8_WAIT_V(8); PG8_WAIT_L(0); PG8_BAR; PG8_MMA(0, 0, At, B0); PG8_MMA(0, 1, At, B1); PG8_BAR; PG8_SCHED;
            PG8_LDA(At, 1, 1); PG8_STAGE(PG8_SB(1, 0), b3, voffB); PG8_STAGE(PG8_SB(1, 1), b3 + hstep, voffB); PG8_STAGE(PG8_SA(1, 0), a3, voffA);
            PG8_WAIT_V(8); PG8_WAIT_L(0); PG8_BAR; PG8_MMA(1, 0, At, B0); PG8_MMA(1, 1, At, B1); PG8_BAR; PG8_SCHED;
            } else {
            PG8_LDB(B0, 0, 0); PG8_SCHED; PG8_LDA(At, 0, 0); PG8_STAGE(PG8_SA(1, 1), a1 + hstep, voffA);
            PG8_WAIT_L(8); PG8_BAR; PG8_WAIT_L(0); PG8_MMA(0, 0, At, B0); PG8_BAR; PG8_SCHED;
            PG8_LDB(B1, 0, 1); PG8_STAGE(PG8_SB(0, 0), b2, voffB);
            PG8_BAR; PG8_WAIT_L(0); PG8_MMA(0, 1, At, B1); PG8_BAR;
            PG8_LDA(At, 0, 1); PG8_STAGE(PG8_SA(0, 0), a2, voffA);
            PG8_BAR; PG8_WAIT_L(0); PG8_MMA(1, 0, At, B0); PG8_BAR; PG8_SCHED;
            PG8_STAGE(PG8_SB(0, 1), b2 + hstep, voffB);
            PG8_WAIT_V(6); PG8_BAR; PG8_MMA(1, 1, At, B1); PG8_BAR;
            PG8_LDB(B0, 1, 0); PG8_SCHED; PG8_LDA(At, 1, 0); PG8_STAGE(PG8_SA(0, 1), a2 + hstep, voffA);
            PG8_WAIT_L(8); PG8_BAR; PG8_WAIT_L(0); PG8_MMA(0, 0, At, B0); PG8_BAR; PG8_SCHED;
            PG8_LDB(B1, 1, 1); PG8_STAGE(PG8_SB(1, 0), b3, voffB);
            PG8_BAR; PG8_WAIT_L(0); PG8_MMA(0, 1, At, B1); PG8_BAR;
            PG8_LDA(At, 1, 1); PG8_STAGE(PG8_SA(1, 0), a3, voffA);
            PG8_BAR; PG8_WAIT_L(0); PG8_MMA(1, 0, At, B0); PG8_BAR; PG8_SCHED;
            PG8_STAGE(PG8_SB(1, 1), b3 + hstep, voffB);
            PG8_WAIT_V(6); PG8_BAR; PG8_MMA(1, 1, At, B1); PG8_BAR;
            }
        }
        if constexpr (ALIGN_EPI) { if (wr == 0) PG8_BAR; }
        if constexpr (!Epi::AFTER_DRAIN) { E(acc, cur, wr, wc, fr, fq); S.done(cur); }
        if (!has_next) break;
#pragma unroll
        for (int a = 0; a < 2; ++a)
#pragma unroll
            for (int b = 0; b < 2; ++b)
#pragma unroll
                for (int m = 0; m < 4; ++m)
#pragma unroll
                    for (int n = 0; n < 2; ++n) acc[a][b][m][n] = (f32x4){0.f, 0.f, 0.f, 0.f};
        cur = nxt; cA = nA; cB = nB; ++ui;
        if constexpr (ALIGN_EPI) { if (wr == 1) PG8_BAR; }
    }
    PG8_WAIT_V(0);
    if constexpr (!ALIGN_EPI) { if (wr == 0) PG8_BAR; }
    PG8_BAR;
    if constexpr (Epi::AFTER_DRAIN) { E.fused(acc, cur, wr, wc, fr, fq, lds, wid, lane); S.done(cur); }
#undef PG8_SA
#undef PG8_SB
#undef PG8_STAGE
#undef PG8_LDA
#undef PG8_LDB
#undef PG8_MMA
#undef PG8_WAIT_V
#undef PG8_WAIT_L
#undef PG8_BAR
#undef PG8_SCHED
}
}

constexpr int NWAVES = 8, NTHR = 512;
constexpr int BATCH = 4, SEQ = 8192, DM = 1024, T = BATCH * SEQ;
constexpr int NH = 8, HD = 64, NBLK = 32, BLK = 256;
constexpr int BH = BATCH * NH;
constexpr int INW = 5376;
constexpr int ZR = 1536, ZL = 256;
constexpr int PEER_N = 2048;
constexpr float RMS_EPS = 1e-6f, GN_EPS = 64e-5f;
constexpr int OSTR = 1024;

constexpr size_t MiB = 1u << 20;
constexpr size_t WS_CTL = 0, CTL_ZERO_BYTES = 1 * MiB;
constexpr size_t WS_MOD = 1 * MiB;
constexpr size_t WS_KMEAN = 1 * MiB + 128 * 1024;
constexpr size_t WS_WIN = 2 * MiB;
constexpr size_t WS_WLORA = 13 * MiB;
constexpr size_t WS_WPM = 14 * MiB, WS_WPR = 15 * MiB;
constexpr size_t WS_WOUT = 16 * MiB;
constexpr size_t WS_WEFF = 18 * MiB;
constexpr size_t WS_XN = 24 * MiB;
constexpr size_t WS_EW = 24 * MiB, WS_AA = 56 * MiB;
constexpr size_t WS_Q = 88 * MiB, WS_K = 120 * MiB, WS_VT = 152 * MiB;
constexpr size_t WS_ZRKV = 184 * MiB;
constexpr size_t WS_GT = 280 * MiB;
constexpr size_t WS_ZLORA = 408 * MiB;
constexpr size_t WS_ALORA = 424 * MiB;
constexpr size_t WS_OCAT = 408 * MiB;
constexpr size_t WS_GG = 472 * MiB;
constexpr size_t WS_MIXED = 216 * MiB;
constexpr size_t WS_U8 = 2 * MiB, WS_V8 = 88 * MiB;
constexpr size_t WS_SCORES = 96 * MiB;
constexpr size_t WS_END = 512 * MiB;
constexpr size_t DO_OPART = 0, DO_LISTS = 96 * MiB, DO_LPART = 112 * MiB;
constexpr int LIST_PER_BH = 256 * 496;
__host__ __device__ constexpr int list_off(int n) { return 256 * (31 * n - n * (n - 1) / 2); }
constexpr int CW_QUEUE = 64;
constexpr int CW_CURSOR = 1024;
constexpr int CW_BAR = 4096;

constexpr int RING_BYTES = 131072;
constexpr int LDS_BYTES = 163840;
constexpr int MISC_OFF = LDS_BYTES - 512;

#define GAS __attribute__((address_space(1)))
#define LAS __attribute__((address_space(3)))
typedef unsigned short bf16;
typedef unsigned v4u __attribute__((ext_vector_type(4)));
typedef unsigned v2u __attribute__((ext_vector_type(2)));
typedef float f32x4 __attribute__((ext_vector_type(4)));
typedef float f32x2 __attribute__((ext_vector_type(2)));
typedef float f32x16 __attribute__((ext_vector_type(16)));
typedef short bf16x8 __attribute__((ext_vector_type(8)));
typedef short s16x4 __attribute__((ext_vector_type(4)));
#define RLX_AGENT __ATOMIC_RELAXED, __HIP_MEMORY_SCOPE_AGENT
#define LDS_WAIT() asm volatile("s_waitcnt lgkmcnt(0)" ::: "memory")
#define VM_WAIT() asm volatile("s_waitcnt vmcnt(0)" ::: "memory")
typedef __bf16 bf16x2_t __attribute__((ext_vector_type(2)));
__device__ __forceinline__ unsigned cvtpk(float lo, float hi) { f32x2 v = {lo, hi}; bf16x2_t b = __builtin_convertvector(v, bf16x2_t); return __builtin_bit_cast(unsigned, b); }
__device__ __forceinline__ unsigned pk2(float lo, float hi) { return cvtpk(lo, hi); }
__device__ __forceinline__ unsigned f2bf(float f) { return cvtpk(f, 0.f) & 0xffffu; }
__device__ __forceinline__ float bflo(unsigned u) { return __builtin_bit_cast(float, u << 16); }
__device__ __forceinline__ float bfhi(unsigned u) { return __builtin_bit_cast(float, u & 0xffff0000u); }
__device__ __forceinline__ float bf2f(bf16 h) { return __builtin_bit_cast(float, (unsigned)h << 16); }
__device__ __forceinline__ float wave_sum(float v) {
#pragma unroll
    for (int o = 1; o < 64; o <<= 1) v += __shfl_xor(v, o);
    return v;
}
__device__ __forceinline__ float sigmoidf_(float x) { return __builtin_amdgcn_rcpf(1.0f + __expf(-x)); }
#define XB_TMO      128
#define XB_XCNT(j)  (256  + 64 * (j))
#define XB_XSUB(j)  (1280 + 64 * (j))
#define XB_XGEN(j)  (2304 + 64 * (j))
#define XB_TOP      3328
#define XB_TOPGEN   3392
#define XCD_BAR_WORDS 3456
#define XB_SPIN_CAP (1u << 18)

__device__ __forceinline__ unsigned xb_ld(unsigned* p)              { return __hip_atomic_load(p, __ATOMIC_RELAXED, __HIP_MEMORY_SCOPE_AGENT); }
__device__ __forceinline__ unsigned xb_add(unsigned* p, unsigned v) { return __hip_atomic_fetch_add(p, v, __ATOMIC_RELAXED, __HIP_MEMORY_SCOPE_AGENT); }
__device__ __forceinline__ unsigned xb_xcc_id() { return (unsigned)__builtin_amdgcn_s_getreg((3 << 11) | 20) & 0xFu; }
#define XB_SPIN(cond, bar) do { unsigned _sp = 0; while (cond) { __builtin_amdgcn_s_sleep(1); \
    if ((++_sp & 255u) == 0u) { if (xb_ld(&(bar)[XB_TMO])) break; if (_sp > XB_SPIN_CAP) { atomicAdd(&(bar)[XB_TMO], 1u); break; } } } } while (0)

struct XcdBarrier {
    unsigned* bar; unsigned x;
    volatile LAS unsigned* st;
};

__device__ __forceinline__ XcdBarrier xcd_barrier_post(unsigned* bar, volatile LAS unsigned* st) {
    XcdBarrier b; b.bar = bar; b.x = xb_xcc_id(); b.st = st;
    if (threadIdx.x == 0) (void)xb_add(&bar[XB_XCNT(b.x)], 1u);
    return b;
}
__device__ __forceinline__ void xcd_barrier_complete(unsigned* bar, unsigned x, unsigned& nloc, unsigned& nx) {
    const unsigned G = gridDim.x * gridDim.y * gridDim.z;
    unsigned sum, cnt, mine, sp = 0u;
    for (;;) {
        sum = 0u; cnt = 0u; mine = 0u;
#pragma unroll
        for (unsigned j = 0; j < 16; ++j) { const unsigned c = xb_ld(&bar[XB_XCNT(j)]); sum += c; cnt += (c > 0u) ? 1u : 0u; mine = (j == x) ? c : mine; }
        if (sum == G) break;
        __builtin_amdgcn_s_sleep(1);
        if ((++sp & 255u) == 0u) { if (xb_ld(&bar[XB_TMO])) break; if (sp > XB_SPIN_CAP) { atomicAdd(&bar[XB_TMO], 1u); break; } }
    }
    nloc = mine > 0u ? mine : 1u; nx = cnt > 0u ? cnt : 1u;
}

__device__ __forceinline__ void xcd_barrier(const XcdBarrier& b) {
    asm volatile("s_waitcnt vmcnt(0)" ::: "memory");
    __syncthreads();
    if (threadIdx.x == 0) {
        unsigned* bar = b.bar;
        __builtin_amdgcn_s_waitcnt(0);
        unsigned nloc = b.st[0], nx = b.st[1];
        if (nloc == 0u) { xcd_barrier_complete(bar, b.x, nloc, nx); b.st[0] = nloc; b.st[1] = nx; }
        const unsigned old = xb_add(&bar[XB_XSUB(b.x)], 1u);
        const unsigned gen = old / nloc;
        if (old + 1u == (gen + 1u) * nloc) {
            __builtin_amdgcn_fence(__ATOMIC_RELEASE, "agent");
            asm volatile("s_waitcnt vmcnt(0)" ::: "memory");
            const unsigned og = xb_add(&bar[XB_TOP], 1u);
            const unsigned tg = og / nx;
            if (og + 1u == (tg + 1u) * nx) xb_add(&bar[XB_TOPGEN], 1u);
            else XB_SPIN(xb_ld(&bar[XB_TOPGEN]) == tg, bar);
            __builtin_amdgcn_fence(__ATOMIC_ACQUIRE, "agent");
            xb_add(&bar[XB_XGEN(b.x)], 1u);
            asm volatile("s_waitcnt vmcnt(0)" ::: "memory");
        } else {
            XB_SPIN(xb_ld(&bar[XB_XGEN(b.x)]) == gen, bar);
            __builtin_amdgcn_fence(__ATOMIC_ACQUIRE, "agent");
            asm volatile("s_waitcnt vmcnt(0)" ::: "memory");
        }
    }
    __syncthreads();
}

__device__ __forceinline__ void p0_transpose_item(const float* W, int K, int N, bf16* WT, int ldk, int koff, LAS float* scr, int item, int lane) {
    const int nblk = N / 32, kb = item / nblk, nb = item % nblk, k0 = 64 * kb, n0 = 32 * nb;
#pragma unroll 8
    for (int i = 0; i < 32; ++i) { const int kk = 2 * i + (lane >> 5); scr[kk * 33 + (lane & 31)] = W[(size_t)(k0 + kk) * N + n0 + (lane & 31)]; }
    LDS_WAIT(); asm volatile("" ::: "memory");
    const int c = lane & 7;
#pragma unroll
    for (int j = 0; j < 4; ++j) { const int n = (lane >> 3) + 8 * j; const LAS float* s = scr + (8 * c) * 33 + n;
        v4u o; o.x = pk2(s[0 * 33], s[1 * 33]); o.y = pk2(s[2 * 33], s[3 * 33]); o.z = pk2(s[4 * 33], s[5 * 33]); o.w = pk2(s[6 * 33], s[7 * 33]);
#ifdef EMU_FP8_G2
        if (N == INW) { float f_[8];
            for (int e_ = 0; e_ < 8; e_ += 2) { int w_ = __builtin_amdgcn_cvt_pk_fp8_f32(s[e_ * 33] * 256.f, s[(e_ + 1) * 33] * 256.f, 0, false); const f32x2 l_ = __builtin_amdgcn_cvt_pk_f32_fp8(w_, false); f_[e_] = l_.x * (1.f / 256.f); f_[e_ + 1] = l_.y * (1.f / 256.f); }
            o.x = pk2(f_[0], f_[1]); o.y = pk2(f_[2], f_[3]); o.z = pk2(f_[4], f_[5]); o.w = pk2(f_[6], f_[7]); }
#endif
        *(GAS v4u*)(WT + (size_t)(n0 + n) * ldk + koff + k0 + 8 * c) = o; }
    LDS_WAIT(); asm volatile("" ::: "memory");
}
__device__ __forceinline__ void p0_mod_item(const float* c, const float* w_ada, const float* b_ada, float* modp, LAS float* red  , int item, int wave, int lane) {
    const int j = item * 64 + lane;
    float a0 = 0.f, a1 = 0.f, a2 = 0.f, a3 = 0.f;
#pragma unroll 8
    for (int k = 128 * wave; k < 128 * wave + 128; ++k) {
        const float w = w_ada[(size_t)k * 6144 + j];
        const float c0 = c[k], c1 = c[1024 + k], c2 = c[2048 + k], c3 = c[3072 + k];
        a0 += c0 / (1.f + __expf(-c0)) * w; a1 += c1 / (1.f + __expf(-c1)) * w; a2 += c2 / (1.f + __expf(-c2)) * w; a3 += c3 / (1.f + __expf(-c3)) * w;
    }
    red[(wave * 4 + 0) * 64 + lane] = a0; red[(wave * 4 + 1) * 64 + lane] = a1; red[(wave * 4 + 2) * 64 + lane] = a2; red[(wave * 4 + 3) * 64 + lane] = a3;
    LDS_WAIT(); __syncthreads();
    if (wave < 4) { float s = b_ada[j];
#pragma unroll
        for (int w = 0; w < 8; ++w) s += red[(w * 4 + wave) * 64 + lane];
        modp[wave * 6144 + j] = s; }
    __syncthreads();
}
__device__ __forceinline__ void p0_weff_item(const float* wq, const float* sk, bf16* weff, int item, int lane) {
    const int nq = item & 3, kb = (item >> 2) & 31, hp = item >> 7;
    const int k = kb * 32 + (lane & 31), dh = lane >> 5;
    float w[64];
    const f32x4* src = (const f32x4*)(wq + (size_t)k * 2048 + hp * 128 + 64 * dh);
#pragma unroll
    for (int i = 0; i < 16; ++i) { const f32x4 v = src[i]; w[4 * i] = v.x; w[4 * i + 1] = v.y; w[4 * i + 2] = v.z; w[4 * i + 3] = v.w; }
#pragma unroll 1
    for (int n = nq * 32; n < nq * 32 + 32; n += 2) {
        float acc[2] = {0.f, 0.f};
#pragma unroll
        for (int u = 0; u < 2; ++u) {
            const f32x4* s = (const f32x4*)(sk + ((size_t)hp * 128 + n + u) * 128 + 64 * dh);
#pragma unroll
            for (int d = 0; d < 16; ++d) { const f32x4 s4 = s[d]; acc[u] += w[4 * d] * s4.x; acc[u] += w[4 * d + 1] * s4.y; acc[u] += w[4 * d + 2] * s4.z; acc[u] += w[4 * d + 3] * s4.w; }
        }
#pragma unroll
        for (int u = 0; u < 2; ++u) { acc[u] += __shfl_xor(acc[u], 32); if (dh == 0) weff[((size_t)hp * 128 + n + u) * 1024 + k] = (bf16)f2bf(acc[u]); }
    }
}
template <int NR> __device__ __forceinline__ void rms_mod_rows(const float* xrow, bf16* orow, unsigned* o8row  , const float* g, const float* sc, const float* sh, int lane) {
    f32x4 v[NR][4]; float ss[NR];
#pragma unroll
    for (int rr = 0; rr < NR; ++rr) { const f32x4* xr = (const f32x4*)(xrow + (size_t)rr * 1024) + lane; ss[rr] = 0.f;
#pragma unroll
        for (int j = 0; j < 4; ++j) v[rr][j] = xr[64 * j]; }
#pragma unroll
    for (int rr = 0; rr < NR; ++rr)
#pragma unroll
        for (int j = 0; j < 4; ++j) ss[rr] += (v[rr][j].x * v[rr][j].x + v[rr][j].y * v[rr][j].y) + (v[rr][j].z * v[rr][j].z + v[rr][j].w * v[rr][j].w);
#pragma unroll
    for (int o = 1; o < 64; o <<= 1) {
#pragma unroll
        for (int rr = 0; rr < NR; ++rr) ss[rr] += __shfl_xor(ss[rr], o);
    }
#pragma unroll
    for (int j = 0; j < 4; ++j) { const int col = 4 * lane + 256 * j;
        const f32x4 g4 = *(const f32x4*)(g + col), s4 = *(const f32x4*)(sc + col), h4 = *(const f32x4*)(sh + col);
#pragma unroll
        for (int rr = 0; rr < NR; ++rr) {
            const float rstd = 1.f / sqrtf(ss[rr] * (1.f / 1024.f) + RMS_EPS);
            const float o0 = v[rr][j].x * rstd * g4.x * (1.f + s4.x) + h4.x, o1 = v[rr][j].y * rstd * g4.y * (1.f + s4.y) + h4.y;
            const float o2 = v[rr][j].z * rstd * g4.z * (1.f + s4.z) + h4.z, o3 = v[rr][j].w * rstd * g4.w * (1.f + s4.w) + h4.w;
            ((unsigned long long*)(orow + (size_t)rr * 1024))[lane + 64 * j] = (unsigned long long)pk2(o0, o1) | ((unsigned long long)pk2(o2, o3) << 32);
            if (o8row) { int w = 0; w = __builtin_amdgcn_cvt_pk_fp8_f32(fminf(fmaxf(o0 * 8.f, -448.f), 448.f), fminf(fmaxf(o1 * 8.f, -448.f), 448.f), w, false);
                w = __builtin_amdgcn_cvt_pk_fp8_f32(fminf(fmaxf(o2 * 8.f, -448.f), 448.f), fminf(fmaxf(o3 * 8.f, -448.f), 448.f), w, true); (o8row + (size_t)rr * 256)[lane + 64 * j] = (unsigned)w; }
        }
    }
}

__device__ __forceinline__ v4u pack8(const f32x4 a, const f32x4 b) { v4u w; w.x = pk2(a.x, a.y); w.y = pk2(a.z, a.w); w.z = pk2(b.x, b.y); w.w = pk2(b.z, b.w); return w; }
__device__ __forceinline__ size_t gt_off(int pm, int pt, int frag, int wave, int lane) { return ((((size_t)(pm * 8 + pt) * 16 + frag) * 8 + wave) * 64 + lane) * 8; }
struct EpiIn {
    static constexpr bool PERM = true, AFTER_DRAIN = false, HAS_MID = false;
    bf16 *Q, *K, *VT, *ZRKV, *ZLORA, *GT;
    __device__ __forceinline__ void operator()(const f32x4 (&acc)[2][2][4][2], const pg8::Unit& u, int wr, int wc, int fr, int fq) const {
        const int pn = u.pn;
#pragma unroll
        for (int ai = 0; ai < 2; ++ai)
#pragma unroll
            for (int m = 0; m < 4; ++m) {
                const int row = u.pm * 256 + ai * 128 + wr * 64 + m * 16 + fr;
                const int b = row >> 13, s = row & 8191;
#pragma unroll
                for (int bj = 0; bj < 2; ++bj) {
                    const int colt = bj * 128 + wc * 32 + 8 * fq;
                    const f32x4 v0 = acc[ai][bj][m][0], v1 = acc[ai][bj][m][1];
                    if (pn < 4) {
                        bf16* base = pn < 2 ? Q : K; const int h = 4 * (pn & 1) + (colt >> 6), d0 = colt & 63;
                        *(v4u*)(base + ((size_t)((b * 8 + h) * 8192 + s)) * 64 + d0) = pack8(v0, v1);
                    } else if (pn < 6) {
                        const int h = 4 * (pn - 4) + (colt >> 6), dv0 = colt & 63;
                        bf16* p = VT + ((size_t)((b * 8 + h) * 64 + dv0)) * 8192 + s;
                        p[0 * 8192] = (bf16)f2bf(v0.x); p[1 * 8192] = (bf16)f2bf(v0.y); p[2 * 8192] = (bf16)f2bf(v0.z); p[3 * 8192] = (bf16)f2bf(v0.w);
                        p[4 * 8192] = (bf16)f2bf(v1.x); p[5 * 8192] = (bf16)f2bf(v1.y); p[6 * 8192] = (bf16)f2bf(v1.z); p[7 * 8192] = (bf16)f2bf(v1.w);
                    } else if (pn < 12) {
                        *(v4u*)(ZRKV + (size_t)row * ZR + 256 * (pn - 6) + colt) = pack8(v0, v1);
                    } else if (pn == 12) {
                        *(v4u*)(ZLORA + (size_t)row * ZL + colt) = pack8(v0, v1);
                    } else {
                        f32x4 s0, s1;
                        s0.x = sigmoidf_(v0.x); s0.y = sigmoidf_(v0.y); s0.z = sigmoidf_(v0.z); s0.w = sigmoidf_(v0.w);
                        s1.x = sigmoidf_(v1.x); s1.y = sigmoidf_(v1.y); s1.z = sigmoidf_(v1.z); s1.w = sigmoidf_(v1.w);
                        *(v4u*)(GT + gt_off(u.pm, pn - 13, 0, wr * 4 + wc, fq * 16 + fr) + (size_t)(((ai * 4 + m) * 2 + bj) * 4096)) = pack8(s0, s1);
                    }
                }
            }
    }
};
struct EpiLora {
    static constexpr bool PERM = true, AFTER_DRAIN = false, HAS_MID = false;
    bf16 *EW, *AA, *GG; const float *w0, *a0;
    __device__ __forceinline__ void operator()(const f32x4 (&acc)[2][2][4][2], const pg8::Unit& u, int wr, int wc, int fr, int fq) const {
        const int pn = u.pn;
#pragma unroll
        for (int ai = 0; ai < 2; ++ai)
#pragma unroll
            for (int m = 0; m < 4; ++m) {
                const int row = u.pm * 256 + ai * 128 + wr * 64 + m * 16 + fr;
#pragma unroll
                for (int bj = 0; bj < 2; ++bj) {
                    const int c = 256 * (pn & 1) + bj * 128 + wc * 32 + 8 * fq;
                    const f32x4 v0 = acc[ai][bj][m][0], v1 = acc[ai][bj][m][1];
                    float v[8] = {v0.x, v0.y, v0.z, v0.w, v1.x, v1.y, v1.z, v1.w};
                    bf16* dst;
                    if (pn < 2) {
#pragma unroll
                        for (int i = 0; i < 8; ++i) v[i] = 0.60653065971263342f * sigmoidf_(w0[c + i] + v[i]);
                        dst = EW;
                    } else if (pn < 4) {
#pragma unroll
                        for (int i = 0; i < 8; ++i) v[i] = sigmoidf_(a0[c + i] + v[i]);
                        dst = AA;
                    } else dst = GG;
                    v4u w; w.x = pk2(v[0], v[1]); w.y = pk2(v[2], v[3]); w.z = pk2(v[4], v[5]); w.w = pk2(v[6], v[7]);
                    *(v4u*)(dst + (size_t)row * 512 + c) = w;
                }
            }
    }
};
struct EpiMix {
    static constexpr bool PERM = true, AFTER_DRAIN = false, HAS_MID = true; static constexpr int MID_T = 8;
    const bf16* GT; bf16* MIXED; int probe;
    __device__ __forceinline__ void mid(f32x4 (&acc)[2][2][4][2], const pg8::Unit& u, int wr, int wc, int fr, int fq) const {
        if (probe & 1) return;
        const bf16* pm_ = GT + gt_off(u.pm, u.pn, 0, wr * 4 + wc, fq * 16 + fr); const bf16* pr_ = GT + gt_off(u.pm, u.pn + 4, 0, wr * 4 + wc, fq * 16 + fr);
#pragma unroll
        for (int ai = 0; ai < 2; ++ai)
#pragma unroll
            for (int m = 0; m < 4; ++m)
#pragma unroll
                for (int bj = 0; bj < 2; ++bj) {
                    const v4u gm = *(const v4u*)pm_, gr = *(const v4u*)pr_;
                    pm_ += 4096; pr_ += 4096; asm volatile("" : "+v"(pm_), "+v"(pr_));
                    f32x4 r0, r1;
                    r0.x = bflo(gm.x) * __builtin_amdgcn_rcpf(fmaxf(bflo(gr.x), 1e-30f)); r0.y = bfhi(gm.x) * __builtin_amdgcn_rcpf(fmaxf(bfhi(gr.x), 1e-30f));
                    r0.z = bflo(gm.y) * __builtin_amdgcn_rcpf(fmaxf(bflo(gr.y), 1e-30f)); r0.w = bfhi(gm.y) * __builtin_amdgcn_rcpf(fmaxf(bfhi(gr.y), 1e-30f));
                    r1.x = bflo(gm.z) * __builtin_amdgcn_rcpf(fmaxf(bflo(gr.z), 1e-30f)); r1.y = bfhi(gm.z) * __builtin_amdgcn_rcpf(fmaxf(bfhi(gr.z), 1e-30f));
                    r1.z = bflo(gm.w) * __builtin_amdgcn_rcpf(fmaxf(bflo(gr.w), 1e-30f)); r1.w = bfhi(gm.w) * __builtin_amdgcn_rcpf(fmaxf(bfhi(gr.w), 1e-30f));
                    acc[ai][bj][m][0] = acc[ai][bj][m][0] * r0; acc[ai][bj][m][1] = acc[ai][bj][m][1] * r1;
                }
    }
    __device__ __forceinline__ void operator()(const f32x4 (&acc)[2][2][4][2], const pg8::Unit& u, int wr, int wc, int fr, int fq) const {
        const bf16* pr_ = GT + gt_off(u.pm, u.pn + 4, 0, wr * 4 + wc, fq * 16 + fr);
#pragma unroll
        for (int ai = 0; ai < 2; ++ai)
#pragma unroll
            for (int m = 0; m < 4; ++m) {
                const int row = u.pm * 256 + ai * 128 + wr * 64 + m * 16 + fr;
#pragma unroll
                for (int bj = 0; bj < 2; ++bj) {
                    const int c = u.pn * 256 + bj * 128 + wc * 32 + 8 * fq;
                    v4u g = {0x3f803f80u, 0x3f803f80u, 0x3f803f80u, 0x3f803f80u};
                    if (!(probe & 2)) g = *(const v4u*)pr_;
                    pr_ += 4096; asm volatile("" : "+v"(pr_));
                    const f32x4 v0 = acc[ai][bj][m][0], v1 = acc[ai][bj][m][1];
                    f32x4 o0, o1;
                    o0.x = bflo(g.x) * v0.x; o0.y = bfhi(g.x) * v0.y; o0.z = bflo(g.y) * v0.z; o0.w = bfhi(g.y) * v0.w;
                    o1.x = bflo(g.z) * v1.x; o1.y = bfhi(g.z) * v1.y; o1.z = bflo(g.w) * v1.z; o1.w = bfhi(g.w) * v1.w;
                    *(v4u*)(MIXED + (size_t)row * 1024 + c) = pack8(o0, o1);
                }
            }
    }
};
struct EpiOut {
    static constexpr bool PERM = true, AFTER_DRAIN = false, HAS_MID = false;
    const float* X; const float* MOD; float* OUT;
    __device__ __forceinline__ void operator()(const f32x4 (&acc)[2][2][4][2], const pg8::Unit& u, int wr, int wc, int fr, int fq) const {
#pragma unroll
        for (int ai = 0; ai < 2; ++ai)
#pragma unroll
            for (int m = 0; m < 4; ++m) {
                const int row = u.pm * 256 + ai * 128 + wr * 64 + m * 16 + fr;
                const float* gt1 = MOD + (size_t)(row >> 13) * 6144 + 2048;
#pragma unroll
                for (int bj = 0; bj < 2; ++bj) {
                    const int c = u.pn * 256 + bj * 128 + wc * 32 + 8 * fq;
                    const float* xp = X + (size_t)row * 1024 + c;
                    const f32x4 x0 = *(const f32x4*)xp, x1 = *(const f32x4*)(xp + 4);
                    const f32x4 g0 = *(const f32x4*)(gt1 + c), g1 = *(const f32x4*)(gt1 + c + 4);
                    const f32x4 v0 = acc[ai][bj][m][0], v1 = acc[ai][bj][m][1];
                    float* d = OUT + (size_t)row * 1024 + c;
                    *(f32x4*)d = x0 + g0 * v0; *(f32x4*)(d + 4) = x1 + g1 * v1;
                }
            }
    }
};
struct EpiScores {
    static constexpr bool PERM = true, AFTER_DRAIN = false, HAS_MID = false;
    bf16* SC;
    __device__ __forceinline__ void operator()(const f32x4 (&acc)[2][2][4][2], const pg8::Unit& u, int wr, int wc, int fr, int fq) const {
#pragma unroll
        for (int ai = 0; ai < 2; ++ai)
#pragma unroll
            for (int m = 0; m < 4; ++m) {
                const int row = u.pm * 256 + ai * 128 + wr * 64 + m * 16 + fr;
#pragma unroll
                for (int bj = 0; bj < 2; ++bj) {
                    const int c = u.pn * 256 + bj * 128 + wc * 32 + 8 * fq;
                    *(v4u*)(SC + (size_t)row * 2048 + c) = pack8(acc[ai][bj][m][0], acc[ai][bj][m][1]);
                }
            }
    }
};


__device__ __forceinline__ void p2_qk_load(v4u (&raw)[4], int (&ps)[4], const bf16* buf, const int* pos, int bh, int n, int wave, int lane) {
#pragma unroll
    for (int it = 0; it < 4; ++it) { const int row = n * 256 + wave * 32 + it * 8 + (lane >> 3);
        raw[it] = *(const v4u*)(buf + ((size_t)(bh * 8192 + row)) * 64 + 8 * (lane & 7)); ps[it] = pos[(bh >> 3) * 8192 + row]; }
}
__device__ __forceinline__ void p2_qk_item(const v4u (&rawin)[4], const int (&psin)[4], bf16* obuf, const float* g, float* kmean, int bh, int n, LAS float* red, int tid, int wave, int lane) {
    const int c = lane & 7, rsub = lane >> 3;
    float gg[8], ks[8];
#pragma unroll
    for (int i = 0; i < 8; ++i) { gg[i] = g[8 * c + i]; ks[i] = 0.f; }
#pragma unroll
    for (int it = 0; it < 4; ++it) {
        const int row = n * 256 + wave * 32 + it * 8 + rsub;
        const size_t po = ((size_t)(bh * 8192 + row)) * 64 + 8 * c;
        const v4u raw = rawin[it];
        float x[8] = {bflo(raw.x), bfhi(raw.x), bflo(raw.y), bfhi(raw.y), bflo(raw.z), bfhi(raw.z), bflo(raw.w), bfhi(raw.w)};
        float ss = 0.f;
#pragma unroll
        for (int i = 0; i < 8; ++i) ss += x[i] * x[i];
        ss += __shfl_xor(ss, 1); ss += __shfl_xor(ss, 2); ss += __shfl_xor(ss, 4);
        const float rstd = 1.f / sqrtf(ss * (1.f / 64.f) + RMS_EPS);
        float y[8], py[8];
#pragma unroll
        for (int i = 0; i < 8; ++i) y[i] = x[i] * rstd * gg[i];
#pragma unroll
        for (int i = 0; i < 8; ++i) py[i] = __shfl_xor(y[i], 1);
        {
            const float myang = (float)psin[it] * exp2f(-(float)c * (18.931568569324174f / 8.f));
            const float mys = __sinf(myang), myc = __cosf(myang);
            float sn[8], cs[8];
#pragma unroll
            for (int i = 0; i < 8; ++i) { sn[i] = __shfl(mys, (lane & ~7) + i); cs[i] = __shfl(myc, (lane & ~7) + i); }
            if (c < 2) {
#pragma unroll
                for (int i = 0; i < 8; ++i) y[i] = (c == 0) ? (y[i] * cs[i] - py[i] * sn[i]) : (y[i] * cs[i] + py[i] * sn[i]);
            }
        }
        v4u o; o.x = pk2(y[0], y[1]); o.y = pk2(y[2], y[3]); o.z = pk2(y[4], y[5]); o.w = pk2(y[6], y[7]);
        *(v4u*)(obuf + po) = o;
#pragma unroll
        for (int i = 0; i < 8; ++i) ks[i] += y[i];
    }
    if (kmean) {
#pragma unroll
        for (int i = 0; i < 8; ++i) { ks[i] += __shfl_xor(ks[i], 8); ks[i] += __shfl_xor(ks[i], 16); ks[i] += __shfl_xor(ks[i], 32); }
        if (lane < 8) {
#pragma unroll
            for (int i = 0; i < 8; ++i) red[wave * 64 + 8 * lane + i] = ks[i];
        }
        __syncthreads();
        if (tid < 64) { float s = 0.f;
#pragma unroll
            for (int w = 0; w < 8; ++w) s += red[w * 64 + tid];
            kmean[(size_t)(bh * 32 + n) * 64 + tid] = s * (1.f / 256.f); }
        __syncthreads();
    }
}
__device__ __forceinline__ void p2_prep(const bf16* ZL_, const float* mu, bf16* AL, int gtid, int ntot) {
#pragma unroll 2
    for (int idx = gtid; idx < T * 32; idx += ntot) {
        const int t = idx >> 5, col = (idx & 31) * 8, s = t & 8191;
        const v4u cur = *(const v4u*)(ZL_ + (size_t)t * ZL + col);
        v4u prv = *(const v4u*)(ZL_ + (size_t)(s ? t - 1 : t) * ZL + col);
        prv = prv & (s ? 0xffffffffu : 0u);
        const float cz[8] = {bflo(cur.x), bfhi(cur.x), bflo(cur.y), bfhi(cur.y), bflo(cur.z), bfhi(cur.z), bflo(cur.w), bfhi(cur.w)};
        const float pz[8] = {bflo(prv.x), bfhi(prv.x), bflo(prv.y), bfhi(prv.y), bflo(prv.z), bfhi(prv.z), bflo(prv.w), bfhi(prv.w)};
        float o[8];
#pragma unroll
        for (int i = 0; i < 8; ++i) { const float z = cz[i] + (pz[i] - cz[i]) * mu[1536 + col + i];
            o[i] = (col < 64) ? tanhf(z) : ((col < 128) ? z : sigmoidf_(z)); }
        v4u w; w.x = pk2(o[0], o[1]); w.y = pk2(o[2], o[3]); w.z = pk2(o[4], o[5]); w.w = pk2(o[6], o[7]);
        *(v4u*)(AL + (size_t)t * ZL + col) = w;
    }
}

__device__ __forceinline__ void p3_top3_item(const bf16* Q, const float* kmean, unsigned* cursor, unsigned* lists, int bh0, int qb, LAS float* kmbase, int tid, int wave, int lane) {
    if (qb == 0) return;
    const int hf = wave >> 2, bh = bh0 + hf, w4 = wave & 3;
    LAS float* km = kmbase + hf * 2048;
    for (int i = (tid & 255); i < qb * 64; i += 256) km[i] = kmean[(size_t)bh * 2048 + i];
    __syncthreads();
    {
        const int s = qb * 256 + w4 * 64 + lane;
        float q[64];
        const v4u* qp = (const v4u*)(Q + ((size_t)(bh * 8192 + s)) * 64);
#pragma unroll
        for (int i = 0; i < 8; ++i) { const v4u r = qp[i];
            q[8 * i] = bflo(r.x); q[8 * i + 1] = bfhi(r.x); q[8 * i + 2] = bflo(r.y); q[8 * i + 3] = bfhi(r.y);
            q[8 * i + 4] = bflo(r.z); q[8 * i + 5] = bfhi(r.z); q[8 * i + 6] = bflo(r.w); q[8 * i + 7] = bfhi(r.w); }
        float v0 = -INFINITY, v1 = -INFINITY, v2 = -INFINITY; int i0 = -1, i1 = -1, i2 = -1;
        for (int n = 0; n < qb; ++n) {
            float dot = 0.f;
#pragma unroll
            for (int d4 = 0; d4 < 16; ++d4) { const f32x4 kk = *(const LAS f32x4*)(km + n * 64 + 4 * d4);
                dot += q[4 * d4] * kk.x; dot += q[4 * d4 + 1] * kk.y; dot += q[4 * d4 + 2] * kk.z; dot += q[4 * d4 + 3] * kk.w; }
            if (dot > v0) { v2 = v1; i2 = i1; v1 = v0; i1 = i0; v0 = dot; i0 = n; }
            else if (dot > v1) { v2 = v1; i2 = i1; v1 = dot; i1 = n; }
            else if (dot > v2) { v2 = dot; i2 = n; }
        }
        for (int n = 0; n < qb; ++n) {
            const int slot = (i0 == n) ? 0 : ((i1 == n) ? 1 : ((i2 == n) ? 2 : -1));
            const unsigned long long mask = __ballot(slot >= 0);
            if (mask == 0ull) continue;
            const unsigned cnt = (unsigned)__popcll(mask);
            unsigned base = 0u;
            if (lane == 0) base = __hip_atomic_fetch_add(cursor + bh * 32 + n, cnt, RLX_AGENT);
            base = (unsigned)__shfl((int)base, 0);
            if (slot >= 0) { const unsigned pos = base + (unsigned)__popcll(mask & ((1ull << lane) - 1ull));
                lists[(size_t)bh * LIST_PER_BH + list_off(n) + pos] = ((unsigned)s << 2) | (unsigned)slot; }
        }
    }
    __syncthreads();
}

template <int CTRL> __device__ __forceinline__ float dppf(float v) { return __builtin_bit_cast(float, __builtin_amdgcn_update_dpp(0, __builtin_bit_cast(int, v), CTRL, 0xF, 0xF, true)); }
__device__ __forceinline__ float allreduce16(float v) {
    v += dppf<0xB1>(v); v += dppf<0x4E>(v); v += dppf<0x141>(v); v += dppf<0x140>(v); return v;
}
constexpr int CK = 64, NCHK = SEQ / CK, CS = 72, SLOT = CK * CS;
struct ScanRaw { v4u zr, zk, zv, pr, pk, pv, a, ew; };
__device__ __forceinline__ void scan_load(ScanRaw& R, const bf16* Z, const bf16* AA, const bf16* EW, int b, int hc0, int t) {
    const bf16* p = Z + (size_t)(b * 8192 + t) * ZR + hc0;
    const bf16* pp = (t > 0) ? p - ZR : p;
    R.zr = *(const v4u*)p; R.zk = *(const v4u*)(p + 512); R.zv = *(const v4u*)(p + 1024);
    R.pr = *(const v4u*)pp; R.pk = *(const v4u*)(pp + 512); R.pv = *(const v4u*)(pp + 1024);
    const unsigned m = (t > 0) ? 0xffffffffu : 0u;
    R.pr = R.pr & m; R.pk = R.pk & m; R.pv = R.pv & m;
    const size_t o = (size_t)(b * 8192 + t) * 512 + hc0;
    R.a = *(const v4u*)(AA + o); R.ew = *(const v4u*)(EW + o);
}
__device__ __forceinline__ void unpack8(const v4u w, float (&f)[8]) { f[0] = bflo(w.x); f[1] = bfhi(w.x); f[2] = bflo(w.y); f[3] = bfhi(w.y); f[4] = bflo(w.z); f[5] = bfhi(w.z); f[6] = bflo(w.w); f[7] = bfhi(w.w); }
__device__ __forceinline__ v4u pack8f(const float (&f)[8]) { v4u w; w.x = cvtpk(f[0], f[1]); w.y = cvtpk(f[2], f[3]); w.z = cvtpk(f[4], f[5]); w.w = cvtpk(f[6], f[7]); return w; }
__device__ __forceinline__ f32x4 mm_tile(const LAS bf16* A, const LAS bf16* BT, int mt, int nt, int r, int q, f32x4 acc) {
#pragma unroll
    for (int ks = 0; ks < 2; ++ks) {
        const bf16x8 a = *(const LAS bf16x8*)(A + (16 * mt + r) * CS + 32 * ks + 8 * q);
        const bf16x8 b = *(const LAS bf16x8*)(BT + (16 * nt + r) * CS + 32 * ks + 8 * q);
        acc = __builtin_amdgcn_mfma_f32_16x16x32_bf16(a, b, acc, 0, 0, 0);
    }
    return acc;
}
struct PairF { bf16x8 b0, b1, a00, a01, a10, a11; };
__device__ __forceinline__ void mm_load(PairF& f, const LAS bf16* A, const LAS bf16* BT, int mt, int nt, int r, int q) {
    f.b0 = *(const LAS bf16x8*)(BT + (16 * nt + r) * CS + 8 * q); f.b1 = *(const LAS bf16x8*)(BT + (16 * nt + r) * CS + 32 + 8 * q);
    f.a00 = *(const LAS bf16x8*)(A + (16 * mt + r) * CS + 8 * q); f.a01 = *(const LAS bf16x8*)(A + (16 * mt + r) * CS + 32 + 8 * q);
    f.a10 = *(const LAS bf16x8*)(A + (16 * mt + 32 + r) * CS + 8 * q); f.a11 = *(const LAS bf16x8*)(A + (16 * mt + 32 + r) * CS + 32 + 8 * q);
}
__device__ __forceinline__ void mm_mul(const PairF& f, f32x4& c0, f32x4& c1) {
    c0 = __builtin_amdgcn_mfma_f32_16x16x32_bf16(f.a00, f.b0, c0, 0, 0, 0); c1 = __builtin_amdgcn_mfma_f32_16x16x32_bf16(f.a10, f.b0, c1, 0, 0, 0);
    c0 = __builtin_amdgcn_mfma_f32_16x16x32_bf16(f.a01, f.b1, c0, 0, 0, 0); c1 = __builtin_amdgcn_mfma_f32_16x16x32_bf16(f.a11, f.b1, c1, 0, 0, 0);
}
__device__ __forceinline__ void mm_pair(const LAS bf16* A, const LAS bf16* BT, int mt, int nt, int r, int q, f32x4& c0, f32x4& c1) { PairF f; mm_load(f, A, BT, mt, nt, r, q); mm_mul(f, c0, c1); }
__device__ __forceinline__ void st_T(LAS bf16* D, int mt, int nt, int r, int q, const f32x4 v) {
    v2u w; w.x = cvtpk(v.x, v.y); w.y = cvtpk(v.z, v.w);
    *(LAS v2u*)(D + (16 * nt + r) * CS + 16 * mt + 4 * q) = w;
}
__device__ __forceinline__ void st_Tg(bf16* D  , int mt, int nt, int r, int q, const f32x4 v) {
    v2u w; w.x = cvtpk(v.x, v.y); w.y = cvtpk(v.z, v.w);
    *(v2u*)(D + (16 * nt + r) * 64 + 16 * mt + 4 * q) = w;
}
__device__ __forceinline__ f32x4 mask_lt(f32x4 v, int R0, int Cc, bool incl) {
    const int lim = incl ? Cc + 1 : Cc;
    v.x = (R0 < lim) ? v.x : 0.f; v.y = (R0 + 1 < lim) ? v.y : 0.f; v.z = (R0 + 2 < lim) ? v.z : 0.f; v.w = (R0 + 3 < lim) ? v.w : 0.f; return v;
}
__device__ __forceinline__ void rwkv_cp_item(const bf16* Z, const bf16* AAg, const bf16* EWg, const float* mu, const float* k_k, const float* k_a,
                                             bf16* RW, bf16* MM, bf16* Y0T, bf16* GAT, float* PC, int chain, int c, ScanRaw& R, int nchain, int nc, LAS unsigned char* lds, int tid, int wave, int lane, int probe) {
    LAS bf16* S_ = (LAS bf16*)lds;
#define SL(k) (S_ + (k) * SLOT)
    LAS float* Ef = (LAS float*)(SL(12));
    LAS float* Red = (LAS float*)(SL(8));
    LAS float* Seg = Red + 8 * 64;
    constexpr int EFS = 68;
    const int b = chain >> 3, h = chain & 7;
    const int r = lane & 15, q = lane >> 4;
    __syncthreads();
    const int t = tid >> 3, c0 = (tid & 7) * 8, hc0 = h * 64 + c0;
    float rr[8], k2[8], al[8], be[8], vv[8], kkr[8], aa[8];
    {
        float zr[8], zk[8], zv[8], pr[8], pk[8], pv[8], a[8], ew[8];
        unpack8(R.zr, zr); unpack8(R.zk, zk); unpack8(R.zv, zv); unpack8(R.pr, pr); unpack8(R.pk, pk); unpack8(R.pv, pv); unpack8(R.a, a); unpack8(R.ew, ew);
        scan_load(R, Z, AAg, EWg, nchain >> 3, (nchain & 7) * 64 + c0, nc * CK + t);
        float ss = 0.f;
#pragma unroll
        for (int i = 0; i < 8; ++i) { aa[i] = a[i]; rr[i] = zr[i] + (pr[i] - zr[i]) * mu[hc0 + i]; const float k = zk[i] + (pk[i] - zk[i]) * mu[512 + hc0 + i]; vv[i] = zv[i] + (pv[i] - zv[i]) * mu[1024 + hc0 + i];
            kkr[i] = k * k_k[hc0 + i]; ss += kkr[i] * kkr[i]; k2[i] = k * (1.f + (a[i] - 1.f) * k_a[hc0 + i]); }
        ss += dppf<0xB1>(ss); ss += dppf<0x4E>(ss); ss += dppf<0x141>(ss);
        if ((tid & 7) == 0) Red[t] = ss;
        *(LAS f32x4*)(Ef + t * EFS + c0) = (f32x4){ew[0], ew[1], ew[2], ew[3]}; *(LAS f32x4*)(Ef + t * EFS + c0 + 4) = (f32x4){ew[4], ew[5], ew[6], ew[7]};
    }
    LDS_WAIT(); __syncthreads();
    {
        const int seg = tid >> 6, j = tid & 63; float s = 0.f;
#pragma unroll
        for (int u = 0; u < 8; ++u) { s += Ef[(8 * seg + u) * EFS + j]; Ef[(8 * seg + u) * EFS + j] = s; }
        Seg[seg * 64 + j] = s;
    }
    LDS_WAIT(); __syncthreads();
    {
        { const float ss = Red[t];
          const float inrm = 1.f / fmaxf(sqrtf(ss), 1e-12f);
#pragma unroll
          for (int i = 0; i < 8; ++i) { const float kk = kkr[i] * inrm; al[i] = -kk; be[i] = kk * aa[i]; } }
        float off[8], Et[8], Ep[8];
#pragma unroll
        for (int i = 0; i < 8; ++i) off[i] = 0.f;
        for (int sg = 0; sg < (t >> 3); ++sg) {
            const f32x4 s0 = *(const LAS f32x4*)(Seg + sg * 64 + c0), s1 = *(const LAS f32x4*)(Seg + sg * 64 + c0 + 4);
            off[0] += s0.x; off[1] += s0.y; off[2] += s0.z; off[3] += s0.w; off[4] += s1.x; off[5] += s1.y; off[6] += s1.z; off[7] += s1.w;
        }
        { const f32x4 e0 = *(const LAS f32x4*)(Ef + t * EFS + c0), e1 = *(const LAS f32x4*)(Ef + t * EFS + c0 + 4);
          Et[0] = e0.x + off[0]; Et[1] = e0.y + off[1]; Et[2] = e0.z + off[2]; Et[3] = e0.w + off[3]; Et[4] = e1.x + off[4]; Et[5] = e1.y + off[5]; Et[6] = e1.z + off[6]; Et[7] = e1.w + off[7]; }
        if (t & 7) { const f32x4 e0 = *(const LAS f32x4*)(Ef + (t - 1) * EFS + c0), e1 = *(const LAS f32x4*)(Ef + (t - 1) * EFS + c0 + 4);
          Ep[0] = e0.x + off[0]; Ep[1] = e0.y + off[1]; Ep[2] = e0.z + off[2]; Ep[3] = e0.w + off[3]; Ep[4] = e1.x + off[4]; Ep[5] = e1.y + off[5]; Ep[6] = e1.z + off[6]; Ep[7] = e1.w + off[7]; }
        else {
#pragma unroll
            for (int i = 0; i < 8; ++i) Ep[i] = off[i];
        }
        float at[8], bt[8], kt[8], rt[8];
#pragma unroll
        for (int i = 0; i < 8; ++i) { const float ep = __expf(Et[i]), en = __expf(-Et[i]); at[i] = al[i] * __expf(-Ep[i]); bt[i] = be[i] * ep; kt[i] = k2[i] * ep; rt[i] = rr[i] * en; }
        *(LAS v4u*)(SL(0) + t * CS + c0) = pack8f(at); *(LAS v4u*)(SL(1) + t * CS + c0) = pack8f(bt); *(LAS v4u*)(SL(2) + t * CS + c0) = pack8f(kt); *(LAS v4u*)(SL(3) + t * CS + c0) = pack8f(rt);
#pragma unroll
        for (int i = 0; i < 8; ++i) { SL(4)[(c0 + i) * CS + t] = (bf16)f2bf(at[i]); SL(5)[(c0 + i) * CS + t] = (bf16)f2bf(bt[i]); SL(6)[(c0 + i) * CS + t] = (bf16)f2bf(kt[i]); SL(7)[(c0 + i) * CS + t] = (bf16)f2bf(vv[i]); }
        if (t == CK - 1) { *(f32x4*)(PC + c0) = (f32x4){__expf(-Et[0]), __expf(-Et[1]), __expf(-Et[2]), __expf(-Et[3])}; *(f32x4*)(PC + c0 + 4) = (f32x4){__expf(-Et[4]), __expf(-Et[5]), __expf(-Et[6]), __expf(-Et[7])}; }
    }
    LDS_WAIT(); __syncthreads();
    if (probe == 4) return;
    const f32x4 z4 = {0.f, 0.f, 0.f, 0.f};
    const int mt = wave >> 2, nt = wave & 3, Cc = 16 * nt + r, R0 = 16 * mt + 4 * q, R1 = R0 + 32;
    { PairF f0, f1, f2, f3, f4;
      mm_load(f0, SL(0), SL(1), mt, nt, r, q); mm_load(f1, SL(1), SL(0), mt, nt, r, q); mm_load(f2, SL(2), SL(0), mt, nt, r, q); mm_load(f3, SL(1), SL(3), mt, nt, r, q); mm_load(f4, SL(2), SL(3), mt, nt, r, q);
      f32x4 a0 = z4, a1 = z4, b0 = z4, b1 = z4, c0 = z4, c1 = z4, d0 = z4, d1 = z4, e0 = z4, e1 = z4;
      mm_mul(f0, a0, a1); mm_mul(f1, b0, b1); mm_mul(f2, c0, c1); mm_mul(f3, d0, d1); mm_mul(f4, e0, e1);
      a0.x = (Cc < R0) ? a0.x : 0.f; a0.y = (Cc < R0 + 1) ? a0.y : 0.f; a0.z = (Cc < R0 + 2) ? a0.z : 0.f; a0.w = (Cc < R0 + 3) ? a0.w : 0.f;
      a1.x = (Cc < R1) ? a1.x : 0.f; a1.y = (Cc < R1 + 1) ? a1.y : 0.f; a1.z = (Cc < R1 + 2) ? a1.z : 0.f; a1.w = (Cc < R1 + 3) ? a1.w : 0.f;
      st_T(SL(12), mt, nt, r, q, a0); st_T(SL(12), mt + 2, nt, r, q, a1);
      b0 = mask_lt(b0, R0, Cc, false); b1 = mask_lt(b1, R1, Cc, false);
      st_T(SL(11), mt, nt, r, q, b0); st_T(SL(11), mt + 2, nt, r, q, b1);
      b0.x += (R0 == Cc) ? 1.f : 0.f; b0.y += (R0 + 1 == Cc) ? 1.f : 0.f; b0.z += (R0 + 2 == Cc) ? 1.f : 0.f; b0.w += (R0 + 3 == Cc) ? 1.f : 0.f;
      b1.x += (R1 == Cc) ? 1.f : 0.f; b1.y += (R1 + 1 == Cc) ? 1.f : 0.f; b1.z += (R1 + 2 == Cc) ? 1.f : 0.f; b1.w += (R1 + 3 == Cc) ? 1.f : 0.f;
      st_T(SL(13), mt, nt, r, q, b0); st_T(SL(13), mt + 2, nt, r, q, b1);
      st_T(SL(8), mt, nt, r, q, mask_lt(c0, R0, Cc, false)); st_T(SL(8), mt + 2, nt, r, q, mask_lt(c1, R1, Cc, false));
      st_T(SL(9), mt, nt, r, q, mask_lt(d0, R0, Cc, true)); st_T(SL(9), mt + 2, nt, r, q, mask_lt(d1, R1, Cc, true));
      st_T(SL(10), mt, nt, r, q, mask_lt(e0, R0, Cc, true)); st_T(SL(10), mt + 2, nt, r, q, mask_lt(e1, R1, Cc, true)); }
    LDS_WAIT(); __syncthreads();
    if (probe == 3) return;
    for (int m = (probe == 2 ? 6 : 0); m < 6; ++m) {
        const int ln = (m & 1) ? 0 : 11, ltn = ln + 1, l2 = (m & 1) ? 11 : 0;
        const int tsrc = (m & 1) ? 13 : 2, tdst = (m & 1) ? 2 : 13;
        PairF f0, f1, f2; v2u o0 = {0u, 0u}, o1 = {0u, 0u};
        if (m < 5) { mm_load(f0, SL(ltn), SL(ln), mt, nt, r, q); mm_load(f1, SL(ln), SL(ltn), mt, nt, r, q); }
        if (m >= 1) { mm_load(f2, SL(ltn), SL(tsrc), mt, nt, r, q);
            o0 = *(const LAS v2u*)(SL(tsrc) + (16 * nt + r) * CS + 16 * mt + 4 * q); o1 = *(const LAS v2u*)(SL(tsrc) + (16 * nt + r) * CS + 16 * mt + 32 + 4 * q); }
        if (m < 5) { f32x4 a0 = z4, a1 = z4, b0 = z4, b1 = z4; mm_mul(f0, a0, a1); mm_mul(f1, b0, b1);
            st_T(SL(l2), mt, nt, r, q, a0); st_T(SL(l2), mt + 2, nt, r, q, a1);
            st_T(SL(l2 + 1), mt, nt, r, q, b0); st_T(SL(l2 + 1), mt + 2, nt, r, q, b1); }
        if (m >= 1) { f32x4 c0 = {bflo(o0.x), bfhi(o0.x), bflo(o0.y), bfhi(o0.y)}, c1 = {bflo(o1.x), bfhi(o1.x), bflo(o1.y), bfhi(o1.y)};
            mm_mul(f2, c0, c1); st_T(SL(tdst), mt, nt, r, q, c0); st_T(SL(tdst), mt + 2, nt, r, q, c1); }
        LDS_WAIT(); __syncthreads();
    }
    { PairF f0, f1; mm_load(f0, SL(2), SL(4), mt, nt, r, q); mm_load(f1, SL(8), SL(7), mt, nt, r, q);
      f32x4 a0 = z4, a1 = z4, b0 = z4, b1 = z4; mm_mul(f0, a0, a1); mm_mul(f1, b0, b1);
      st_T(SL(11), mt, nt, r, q, a0); st_T(SL(11), mt + 2, nt, r, q, a1);
      st_T(SL(12), mt, nt, r, q, b0); st_T(SL(12), mt + 2, nt, r, q, b1); }
    LDS_WAIT(); __syncthreads();
    { PairF f0, f1, f2; mm_load(f0, SL(2), SL(12), mt, nt, r, q); mm_load(f1, SL(11), SL(9), mt, nt, r, q); mm_load(f2, SL(11), SL(5), mt, nt, r, q);
      const v2u o0 = *(const LAS v2u*)(SL(3) + (16 * nt + r) * CS + 16 * mt + 4 * q), o1 = *(const LAS v2u*)(SL(3) + (16 * nt + r) * CS + 16 * mt + 32 + 4 * q);
      f32x4 a0 = z4, a1 = z4, b0 = {bflo(o0.x), bfhi(o0.x), bflo(o0.y), bfhi(o0.y)}, b1 = {bflo(o1.x), bfhi(o1.x), bflo(o1.y), bfhi(o1.y)}, c0 = z4, c1 = z4;
      mm_mul(f0, a0, a1); mm_mul(f1, b0, b1); mm_mul(f2, c0, c1);
      st_T(SL(13), mt, nt, r, q, a0); st_T(SL(13), mt + 2, nt, r, q, a1);
      st_Tg(RW, mt, nt, r, q, b0); st_Tg(RW, mt + 2, nt, r, q, b1);
      st_Tg(MM, mt, nt, r, q, c0); st_Tg(MM, mt + 2, nt, r, q, c1); }
    LDS_WAIT(); __syncthreads();
    { PairF f0, f1, f2, f3; mm_load(f0, SL(9), SL(13), mt, nt, r, q); mm_load(f1, SL(10), SL(7), mt, nt, r, q); mm_load(f2, SL(5), SL(13), mt, nt, r, q); mm_load(f3, SL(6), SL(7), mt, nt, r, q);
      f32x4 a0 = z4, a1 = z4, b0 = z4, b1 = z4; mm_mul(f0, a0, a1); mm_mul(f2, b0, b1); mm_mul(f1, a0, a1); mm_mul(f3, b0, b1);
      st_Tg(Y0T, mt, nt, r, q, a0); st_Tg(Y0T, mt + 2, nt, r, q, a1);
      st_Tg(GAT, mt, nt, r, q, b0); st_Tg(GAT, mt + 2, nt, r, q, b1); }
#undef SL
}
__device__ __forceinline__ void rwkv_seq(const bf16* RW, const bf16* MM, const bf16* Y0T, const bf16* GAT, const float* PC, bf16* Y, int sid, LAS unsigned char* lds, int tid, int wave, int lane) {
    const int chain = sid >> 2, g4 = sid & 3, b = chain >> 3, h = chain & 7;
    const int r = lane & 15, q = lane >> 4, tw = wave & 3;
    LAS bf16* HT = (LAS bf16*)lds;
    for (int i = tid; i < 2 * 16 * CS / 2; i += NTHR) ((LAS unsigned*)HT)[i] = 0u;
    LDS_WAIT(); __syncthreads();
    f32x4 Hreg = {0.f, 0.f, 0.f, 0.f};
    const bool isH = wave < 4;
    const bf16* Abase = isH ? MM : RW;
    const bf16* Ebase = isH ? GAT : Y0T;
    const size_t ci0 = (size_t)chain * NCHK;
    struct SeqOp { bf16x8 a0, a1; v2u ad; f32x4 pc; };
    SeqOp op[4];
#define SEQ_LD(S, C) do { const size_t ci_ = ci0 + (C); const bf16* ap_ = Abase + ci_ * 4096 + (16 * tw + r) * 64 + 8 * q; S.a0 = *(const bf16x8*)ap_; S.a1 = *(const bf16x8*)(ap_ + 32); \
        S.ad = *(const v2u*)(Ebase + ci_ * 4096 + (16 * g4 + r) * 64 + 16 * tw + 4 * q); S.pc = *(const f32x4*)(PC + ci_ * 64 + 16 * tw + 4 * q); } while (0)
#define SEQ_STEP(S, C) do { const LAS bf16* hb = HT + ((C) & 1) * 16 * CS; \
        const bf16x8 b0 = *(const LAS bf16x8*)(hb + r * CS + 8 * q), b1 = *(const LAS bf16x8*)(hb + r * CS + 32 + 8 * q); \
        f32x4 acc = {bflo(S.ad.x), bfhi(S.ad.x), bflo(S.ad.y), bfhi(S.ad.y)}; \
        acc = __builtin_amdgcn_mfma_f32_16x16x32_bf16(S.a0, b0, acc, 0, 0, 0); acc = __builtin_amdgcn_mfma_f32_16x16x32_bf16(S.a1, b1, acc, 0, 0, 0); \
        const f32x4 pcc = S.pc; \
        SEQ_LD(S, ((C) + 4 < NCHK ? (C) + 4 : NCHK - 1));            \
        if (isH) { Hreg = pcc * (Hreg + acc); v2u w; w.x = cvtpk(Hreg.x, Hreg.y); w.y = cvtpk(Hreg.z, Hreg.w); \
            *(LAS v2u*)(HT + (((C) + 1) & 1) * 16 * CS + r * CS + 16 * tw + 4 * q) = w; } \
        else { bf16* yp = Y + ((size_t)(b * 8192 + (C) * CK + 16 * tw + 4 * q)) * OSTR + h * 64 + 16 * g4 + r; \
            yp[0] = (bf16)f2bf(acc.x); yp[OSTR] = (bf16)f2bf(acc.y); yp[2 * OSTR] = (bf16)f2bf(acc.z); yp[3 * OSTR] = (bf16)f2bf(acc.w); } \
        LDS_WAIT(); __syncthreads(); } while (0)
    SEQ_LD(op[0], 0); SEQ_LD(op[1], 1); SEQ_LD(op[2], 2); SEQ_LD(op[3], 3);
#pragma unroll 1
    for (int c = 0; c < NCHK; c += 4) { SEQ_STEP(op[0], c); SEQ_STEP(op[1], c + 1); SEQ_STEP(op[2], c + 2); SEQ_STEP(op[3], c + 3); }
#undef SEQ_LD
#undef SEQ_STEP
}

__device__ __forceinline__ int crow(int r, int hi) { return (r & 3) + 8 * (r >> 2) + 4 * hi; }
constexpr int AT_KT_STRIDE = 72, AT_VL_STRIDE = 260, AT_VL_OFF = 256 * AT_KT_STRIDE * 2, AT_MISC_OFF = AT_VL_OFF + 64 * AT_VL_STRIDE * 2;
struct AttnStage { v4u k[4], v[4]; };
__device__ __forceinline__ void attn_stage_load(AttnStage& S, const bf16* K, const bf16* VT, int bh, int blk, int tid) {
#pragma unroll
    for (int i = 0; i < 4; ++i) { const int idx = tid + NTHR * i, row = idx >> 3, c8 = idx & 7;
        S.k[i] = *(const v4u*)(K + ((size_t)(bh * 8192 + blk * 256 + row)) * 64 + 8 * c8); }
#pragma unroll
    for (int i = 0; i < 4; ++i) { const int idx = tid + NTHR * i, dv = idx >> 5, c = idx & 31;
        S.v[i] = *(const v4u*)(VT + ((size_t)(bh * 64 + dv)) * 8192 + blk * 256 + 8 * c); }
}
__device__ __forceinline__ void attn_stage_store(const AttnStage& S, LAS unsigned char* buf, int tid) {
    LAS bf16* KT = (LAS bf16*)buf; LAS bf16* VL = (LAS bf16*)(buf + AT_VL_OFF);
#pragma unroll
    for (int i = 0; i < 4; ++i) { const int idx = tid + NTHR * i, row = idx >> 3, c8 = idx & 7; *(LAS v4u*)(KT + row * AT_KT_STRIDE + 8 * c8) = S.k[i]; }
#pragma unroll
    for (int i = 0; i < 4; ++i) { const int idx = tid + NTHR * i, dv = idx >> 5, c = idx & 31;
        LAS v2u* d = (LAS v2u*)(VL + dv * AT_VL_STRIDE + 8 * c);
        v2u lo = {S.v[i].x, S.v[i].y}, hi = {S.v[i].z, S.v[i].w}; d[0] = lo; d[1] = hi; }
}
__device__ __forceinline__ void attn_tile(const bf16x8 (&qf)[4], const LAS bf16* KT, const LAS bf16* VL, int kt0, int nkt, int dkt, int ql, int half, float c1, float c2, f32x16 (&O)[2], float& lsum) {
    for (int kt = kt0; kt < nkt; ++kt) {
        f32x16 X;
#pragma unroll
        for (int i = 0; i < 16; ++i) X[i] = 0.f;
#pragma unroll
        for (int ks = 0; ks < 4; ++ks) { const bf16x8 kf = *(const LAS bf16x8*)(KT + (32 * kt + ql) * AT_KT_STRIDE + 16 * ks + 8 * half);
            X = __builtin_amdgcn_mfma_f32_32x32x16_bf16(kf, qf[ks], X, 0, 0, 0); }
        float p[16];
#pragma unroll
        for (int i = 0; i < 16; ++i) p[i] = __builtin_amdgcn_exp2f(X[i] * c1 - c2);
        if (kt == dkt) {
#pragma unroll
            for (int i = 0; i < 16; ++i) if (crow(i, half) > ql) p[i] = 0.f;
        }
#pragma unroll
        for (int i = 0; i < 16; ++i) lsum += p[i];
#pragma unroll
        for (int s = 0; s < 2; ++s) {
            v4u pw; pw.x = cvtpk(p[8 * s], p[8 * s + 1]); pw.y = cvtpk(p[8 * s + 2], p[8 * s + 3]); pw.z = cvtpk(p[8 * s + 4], p[8 * s + 5]); pw.w = cvtpk(p[8 * s + 6], p[8 * s + 7]);
            const bf16x8 pa = __builtin_bit_cast(bf16x8, pw);
#pragma unroll
            for (int nt = 0; nt < 2; ++nt) {
                const LAS bf16* vp = VL + (32 * nt + ql) * AT_VL_STRIDE + 32 * kt + 16 * s + 4 * half;
                const s16x4 lo = *(const LAS s16x4*)vp, hi = *(const LAS s16x4*)(vp + 8);
                const bf16x8 vf = __builtin_shufflevector(lo, hi, 0, 1, 2, 3, 4, 5, 6, 7);
                O[nt] = __builtin_amdgcn_mfma_f32_32x32x16_bf16(pa, vf, O[nt], 0, 0, 0);
            }
        }
    }
}
__device__ __forceinline__ int attn_pop(unsigned* queue, unsigned* cursor, volatile LAS int* misc, int tid, int& count) {
    for (;;) {
        __syncthreads();
        if (tid == 0) misc[0] = (int)__hip_atomic_fetch_add(queue, 1u, RLX_AGENT);
        __syncthreads();
        const int item = misc[0];
        if (item >= 992 + 1024) { count = 0; return -1; }
        if (item >= 992) { count = 256; return item; }
        count = (int)__hip_atomic_load(cursor + (item & 31) * 32 + (item >> 5), RLX_AGENT);
        if (count > 0) return item;
    }
}
__device__ __forceinline__ void attn_phase(const bf16* Q, const bf16* K, const bf16* VT, const unsigned* lists, unsigned* cursor, unsigned* queue,
                                           bf16* OPART, float* LPART, bf16* OWN, const float* gq, const float* gk, LAS unsigned char* lds, int tid, int wave, int lane, int probe) {
    constexpr int AT_BUF = AT_MISC_OFF;
    volatile LAS int* misc = (volatile LAS int*)(lds + 2 * AT_BUF);
    float mq = fabsf(gq[lane]), mk = fabsf(gk[lane]);
#pragma unroll
    for (int o = 1; o < 64; o <<= 1) { mq = fmaxf(mq, __shfl_xor(mq, o)); mk = fmaxf(mk, __shfl_xor(mk, o)); }
    const float c1 = 0.125f * 1.4426950408889634f, c2 = 8.f * mq * mk * 1.4426950408889634f;
    const int ql = lane & 31, half = lane >> 5;
    int count = 0, ncount = 0;
    int item = attn_pop(queue, cursor, misc, tid, count);
    AttnStage St;
    if (item >= 0) { attn_stage_load(St, K, VT, item < 992 ? (item & 31) : ((item - 992) & 31), item < 992 ? (item >> 5) : ((item - 992) >> 5), tid); attn_stage_store(St, lds, tid); }
    LDS_WAIT();
    __syncthreads();
    int pb = 0;
    bool have = false; unsigned ent_c = 0u; bf16x8 q_c[4];
    while (item >= 0) {
        int nitem = -1;
        if (tid == 0) { nitem = (int)__hip_atomic_fetch_add(queue, 1u, RLX_AGENT); ncount = 256;
            if (nitem < 992) ncount = (int)__hip_atomic_load(cursor + (nitem & 31) * 32 + (nitem >> 5), RLX_AGENT);
            if (nitem >= 992 + 1024) { nitem = -1; ncount = 0; } }
        bool published = false;
#define ATTN_PUBLISH() do { __syncthreads(); if (tid == 0) { misc[0] = nitem; misc[1] = ncount; } __syncthreads(); nitem = misc[0]; ncount = misc[1]; published = true; \
            { const int li_ = nitem >= 0 ? nitem : item;                                         \
              attn_stage_load(St, K, VT, li_ < 992 ? (li_ & 31) : ((li_ - 992) & 31), li_ < 992 ? (li_ >> 5) : ((li_ - 992) >> 5), tid); } } while (0)
        const LAS bf16* KT = (const LAS bf16*)(lds + pb * AT_BUF); const LAS bf16* VL = (const LAS bf16*)(lds + pb * AT_BUF + AT_VL_OFF);
        const bool own = item >= 992;
        const int bh = own ? ((item - 992) & 31) : (item & 31), blk = own ? ((item - 992) >> 5) : (item >> 5);
        const unsigned* lp = lists + (size_t)bh * LIST_PER_BH + list_off(own ? 0 : blk);
        for (int c = 0;; ++c) {
            const int e0 = own ? 0 : c * 256 + wave * 32;
            if (!own && e0 >= count) break;
            if (!have) {
                if (own) ent_c = (unsigned)(blk * 256 + wave * 32 + ql) << 2;
                else { const int e = e0 + ql; ent_c = lp[e < count ? e : e0]; }
                const bf16* qp = Q + ((size_t)(bh * 8192 + (int)(ent_c >> 2))) * 64 + 8 * half;
#pragma unroll
                for (int ks = 0; ks < 4; ++ks) q_c[ks] = *(const bf16x8*)(qp + 16 * ks);
            }
            const int sq = (int)(ent_c >> 2), slot = (int)(ent_c & 3u);
            const bool valid = own || (e0 + ql < count);
            f32x16 O[2]; float lsum = 0.f;
#pragma unroll
            for (int i = 0; i < 16; ++i) { O[0][i] = 0.f; O[1][i] = 0.f; }
            const int nkt = own ? wave + 1 : 8, dkt = own ? wave : -1, kth = nkt >> 1;
            const bool more = !own && (c + 1) * 256 + wave * 32 < count;
            unsigned ent_n = ent_c; int nbh = bh; bool nhave = false;
            if (more) { nhave = true; const int e = (c + 1) * 256 + wave * 32 + ql; ent_n = lp[e < count ? e : (c + 1) * 256 + wave * 32]; }
            if (probe != 3 && probe != 4) attn_tile(q_c, KT, VL, 0, kth, dkt, ql, half, c1, c2, O, lsum);
            if (!published) ATTN_PUBLISH();
            if (!more) {
                if (nitem >= 992) { nhave = true; nbh = (nitem - 992) & 31; ent_n = (unsigned)(((nitem - 992) >> 5) * 256 + wave * 32 + ql) << 2; }
                else if (nitem >= 0 && wave * 32 < ncount) { nhave = true; nbh = nitem & 31; const int e = wave * 32 + ql;
                    ent_n = (lists + (size_t)nbh * LIST_PER_BH + list_off(nitem >> 5))[e < ncount ? e : wave * 32]; }
            }
            bf16x8 q_n[4];
            { const bf16* qp = Q + ((size_t)(nbh * 8192 + (int)(ent_n >> 2))) * 64 + 8 * half;
#pragma unroll
                for (int ks = 0; ks < 4; ++ks) q_n[ks] = *(const bf16x8*)(qp + 16 * ks); }
            if (probe != 3 && probe != 4) attn_tile(q_c, KT, VL, kth, nkt, dkt, ql, half, c1, c2, O, lsum);
            const float ltot = lsum + __shfl_xor(lsum, 32);
            if ((probe == 2 || probe == 4) && ltot != 12345.f) { } else
            if (own) {
                const int b = bh >> 3, h = bh & 7;
                if (half == 0) LPART[(size_t)3 * (BH * SEQ) + bh * 8192 + sq] = ltot;
#pragma unroll
                for (int i = 0; i < 16; ++i) {
                    const int s2 = blk * 256 + wave * 32 + crow(i, half);
                    bf16* op = OWN + ((size_t)(b * 8192 + s2)) * OSTR + h * 64 + ql;
                    op[0] = (bf16)f2bf(O[0][i]); op[32] = (bf16)f2bf(O[1][i]);
                }
            } else {
                if (half == 0 && valid) LPART[(size_t)slot * (BH * SEQ) + bh * 8192 + sq] = ltot;
                const int entv = valid ? (int)ent_c : -1;
#pragma unroll
                for (int i = 0; i < 16; ++i) {
                    const int e2 = __shfl(entv, crow(i, half));
                    if (e2 >= 0) { bf16* op = OPART + ((size_t)(e2 & 3) * (BH * SEQ) + bh * 8192 + (e2 >> 2)) * 64 + ql;
                        op[0] = (bf16)f2bf(O[0][i]); op[32] = (bf16)f2bf(O[1][i]); }
                }
            }
            have = nhave; ent_c = ent_n;
#pragma unroll
            for (int ks = 0; ks < 4; ++ks) q_c[ks] = q_n[ks];
            if (own) break;
        }
        if (!published) ATTN_PUBLISH();
#undef ATTN_PUBLISH
        if (nitem >= 0) attn_stage_store(St, lds + (pb ^ 1) * AT_BUF, tid);
        LDS_WAIT();
        __syncthreads();
        item = nitem; count = ncount; pb ^= 1;
    }
}

__device__ __forceinline__ void p5_combine(const bf16* OPART, const float* LPART, const bf16* OM, bf16* OMO, int gtid, int ntot) {
    for (int idx0 = gtid; idx0 < BH * SEQ * 8; idx0 += 2 * ntot) {
        v4u v[2][4]; unsigned lw[2][4]; size_t oo[2]; int nsel[2];
#pragma unroll
        for (int u = 0; u < 2; ++u) {
            const int idx = idx0 + u * ntot < BH * SEQ * 8 ? idx0 + u * ntot : idx0;
            const int qg = idx >> 3, c8 = idx & 7, bh = qg >> 13, s = qg & 8191, b = bh >> 3, h = bh & 7;
            nsel[u] = (s >> 8) < 3 ? (s >> 8) : 3;
            oo[u] = ((size_t)(b * 8192 + s)) * OSTR + h * 64 + 8 * c8;
#pragma unroll
            for (int sl = 0; sl < 3; ++sl) { v[u][sl] = *(const v4u*)(OPART + ((size_t)sl * (BH * SEQ) + qg) * 64 + 8 * c8); lw[u][sl] = *(const unsigned*)(LPART + (size_t)sl * (BH * SEQ) + qg); }
            v[u][3] = *(const v4u*)(OM + oo[u]); lw[u][3] = *(const unsigned*)(LPART + (size_t)3 * (BH * SEQ) + qg);
        }
#pragma unroll
        for (int u = 0; u < 2; ++u) {
            float acc[8] = {0.f, 0.f, 0.f, 0.f, 0.f, 0.f, 0.f, 0.f}; float l = 0.f;
#pragma unroll
            for (int sl = 0; sl < 4; ++sl) {
                const unsigned m = (sl == 3 || sl < nsel[u]) ? 0xffffffffu : 0u;
                const v4u w4 = v[u][sl] & m;
                acc[0] += bflo(w4.x); acc[1] += bfhi(w4.x); acc[2] += bflo(w4.y); acc[3] += bfhi(w4.y); acc[4] += bflo(w4.z); acc[5] += bfhi(w4.z); acc[6] += bflo(w4.w); acc[7] += bfhi(w4.w);
                l += __builtin_bit_cast(float, lw[u][sl] & m);
            }
            const float il = 1.f / l;
            v4u w; w.x = pk2(acc[0] * il, acc[1] * il); w.y = pk2(acc[2] * il, acc[3] * il); w.z = pk2(acc[4] * il, acc[5] * il); w.w = pk2(acc[6] * il, acc[7] * il);
            if (u == 0 || idx0 + ntot < BH * SEQ * 8) *(v4u*)(OMO + oo[u]) = w;
        }
    }
}
__device__ __forceinline__ void unpack4(const v2u w, float (&f)[4]) { f[0] = bflo(w.x); f[1] = bfhi(w.x); f[2] = bflo(w.y); f[3] = bfhi(w.y); }
__device__ __forceinline__ void p5_rwkv_post(const bf16* Z, const bf16* AA, const bf16* GG, const bf16* Y, bf16* YO, const float* mu, const float* k_a, const float* r_k,
                                             const float* ln_g, const float* ln_b, int gw, int ngw, int lane) {
    const int g = lane >> 4, r = lane & 15;
#pragma unroll 2
    for (int it = gw * 4 + g; it < T * NH; it += ngw * 4) {
        const int t = it >> 3, h = it & 7, col = h * 64 + 4 * r, s = t & 8191;
        const bf16* zp = Z + (size_t)t * ZR + col;
        float zr[4], zk[4], zv[4], pr[4] = {0.f, 0.f, 0.f, 0.f}, pk[4] = {0.f, 0.f, 0.f, 0.f}, pv[4] = {0.f, 0.f, 0.f, 0.f}, a[4], y[4], gg[4];
        unpack4(*(const v2u*)zp, zr); unpack4(*(const v2u*)(zp + 512), zk); unpack4(*(const v2u*)(zp + 1024), zv);
        { const bf16* zq = s ? zp - ZR : zp; const unsigned m_ = s ? 0xffffffffu : 0u;
          unpack4(*(const v2u*)(zq) & m_, pr); unpack4(*(const v2u*)(zq + 512) & m_, pk); unpack4(*(const v2u*)(zq + 1024) & m_, pv); }
        unpack4(*(const v2u*)(AA + (size_t)t * 512 + col), a); unpack4(*(const v2u*)(Y + (size_t)t * OSTR + col), y); unpack4(*(const v2u*)(GG + (size_t)t * 512 + col), gg);
        const f32x4 mr = *(const f32x4*)(mu + col), mk = *(const f32x4*)(mu + 512 + col), mv = *(const f32x4*)(mu + 1024 + col);
        const f32x4 ka = *(const f32x4*)(k_a + col), rk = *(const f32x4*)(r_k + col), lg = *(const f32x4*)(ln_g + col), lb = *(const f32x4*)(ln_b + col);
        float vv[4], dot = 0.f, sum = 0.f;
#pragma unroll
        for (int i = 0; i < 4; ++i) { const float rr = zr[i] + (pr[i] - zr[i]) * mr[i], k = zk[i] + (pk[i] - zk[i]) * mk[i]; vv[i] = zv[i] + (pv[i] - zv[i]) * mv[i];
            const float k2 = k * (1.f + (a[i] - 1.f) * ka[i]); dot += rr * k2 * rk[i]; sum += y[i]; }
        const float mean = allreduce16(sum) * (1.f / 64.f);
        float sq = 0.f;
#pragma unroll
        for (int i = 0; i < 4; ++i) { y[i] -= mean; sq += y[i] * y[i]; }
        const float rstd = 1.f / sqrtf(allreduce16(sq) * (1.f / 64.f) + GN_EPS);
        const float bonus = allreduce16(dot);
        float o[4];
#pragma unroll
        for (int i = 0; i < 4; ++i) o[i] = (y[i] * rstd * lg[i] + lb[i] + bonus * vv[i]) * gg[i];
        v2u w; w.x = pk2(o[0], o[1]); w.y = pk2(o[2], o[3]);
        *(v2u*)(YO + (size_t)t * OSTR + col) = w;
    }
}


__device__ __forceinline__ unsigned f2key(float f) { const unsigned u = __builtin_bit_cast(unsigned, f); return (u & 0x80000000u) ? ~u : (u | 0x80000000u); }
__device__ __forceinline__ float key2f(unsigned k) { const unsigned u = (k & 0x80000000u) ? (k & 0x7fffffffu) : ~k; return __builtin_bit_cast(float, u); }
template <int CTRL> __device__ __forceinline__ unsigned dppu(unsigned v) { return (unsigned)__builtin_amdgcn_update_dpp(0, (int)v, CTRL, 0xF, 0xF, true); }
__device__ __forceinline__ unsigned umax_(unsigned a, unsigned b) { return a > b ? a : b; }
__device__ __forceinline__ unsigned allmax16(unsigned v) { v = umax_(v, dppu<0xB1>(v)); v = umax_(v, dppu<0x4E>(v)); v = umax_(v, dppu<0x141>(v)); v = umax_(v, dppu<0x140>(v)); return v; }
__device__ __forceinline__ float dot2bf(unsigned w, unsigned x, float acc) { return __builtin_amdgcn_fdot2_f32_bf16(__builtin_bit_cast(bf16x2_t, w), __builtin_bit_cast(bf16x2_t, x), acc, false); }
__device__ __forceinline__ unsigned cand_word(int r) {
    const unsigned tab[16] = {0x03020100u, 0x07060504u, 0x0b0a0908u, 0x0f0e0d0cu, 0x13121110u, 0x17161514u, 0x23222120u, 0x32313024u,
                              0x42414033u, 0x61605150u, 0x90807170u, 0xd0c0b0a0u, 0xfffff0e0u, 0xffffffffu, 0xffffffffu, 0xffffffffu};
    unsigned w = 0xffffffffu;
#pragma unroll
    for (int i = 0; i < 13; ++i) w = (r == i) ? tab[i] : w;
    return w;
}
template <int NK> __device__ __forceinline__ unsigned top16_keys(unsigned (&k)[NK], int r) {
    unsigned res = 0u;
    for (int rd = 0; rd < 16; ++rd) {
        unsigned m = k[0];
#pragma unroll
        for (int j = 1; j < NK; ++j) m = umax_(m, k[j]);
        const unsigned gm = allmax16(m);
        res = (r == rd) ? gm : res;
#pragma unroll
        for (int j = 0; j < NK; ++j) k[j] = (k[j] == gm) ? 0u : k[j];
    }
    return res;
}
#define PEER_CE(a, b) do { const unsigned hi_ = umax_(k[a], k[b]), lo_ = (k[a] < k[b]) ? k[a] : k[b]; k[a] = hi_; k[b] = lo_; } while (0)
__device__ __forceinline__ unsigned top16_sorted8(unsigned (&k)[8], int r) {
    PEER_CE(0, 1); PEER_CE(2, 3); PEER_CE(4, 5); PEER_CE(6, 7);
    PEER_CE(0, 2); PEER_CE(1, 3); PEER_CE(4, 6); PEER_CE(5, 7);
    PEER_CE(1, 2); PEER_CE(5, 6);
    PEER_CE(0, 4); PEER_CE(1, 5); PEER_CE(2, 6); PEER_CE(3, 7);
    PEER_CE(2, 4); PEER_CE(3, 5);
    PEER_CE(1, 2); PEER_CE(3, 4); PEER_CE(5, 6);
    unsigned res = 0u;
    for (int rd = 0; rd < 16; ++rd) {
        const unsigned gm = allmax16(k[0]);
        res = (r == rd) ? gm : res;
        const bool pop = k[0] == gm;
#pragma unroll
        for (int j = 0; j < 7; ++j) k[j] = pop ? k[j + 1] : k[j];
        k[7] = pop ? 0u : k[7];
    }
    return res;
}
#undef PEER_CE
#ifdef PROBE_S
typedef int v8i_p __attribute__((ext_vector_type(8)));
__device__ __forceinline__ float mx_probe(int lane) {
    const int q = lane >> 4;
    unsigned aw[4] = {0u, 0u, 0u, 0u};
    if (lane == 16 * PROBE_QA) aw[(PROBE_S) >> 3] = 0x2u << (4 * ((PROBE_S) & 7));
    v8i_p A = {(int)aw[0], (int)aw[1], (int)aw[2], (int)aw[3], 0, 0, 0, 0};
    v8i_p B;
#pragma unroll
    for (int v = 0; v < 8; ++v) {
        float f[4];
#pragma unroll
        for (int b = 0; b < 4; ++b) { const int j = 4 * v + b; f[b] = (PROBE_PAT == 1) ? (float)(q + 1) : ((PROBE_PAT == 2) ? (float)((j & 15) + 1) : (float)((j >> 4) + 1)); }
        int w = 0; w = __builtin_amdgcn_cvt_pk_fp8_f32(f[0], f[1], w, false); w = __builtin_amdgcn_cvt_pk_fp8_f32(f[2], f[3], w, true); B[v] = w;
    }
    f32x4 c = {0.f, 0.f, 0.f, 0.f};
    c = __builtin_amdgcn_mfma_scale_f32_16x16x128_f8f6f4(A, B, c, 4, 0, 0, 0x7f7f7f7f, 0, 0x7f7f7f7f);
    const float r = __shfl(c.x, 0);
    const int code = (int)(r + 0.5f) - 1;
    float off = 0.1f;
    for (int i = 0; i < code && i < 40; ++i) off *= 1.3f;
    if (code < 0) off = 0.05f;
    return off;
}
#endif
typedef int v8i __attribute__((ext_vector_type(8)));
typedef int v4i __attribute__((ext_vector_type(4)));
__device__ __forceinline__ void peer_token_a(const bf16* SC, const unsigned char* XN8, const unsigned char* U8, LAS f32x4* xl, LAS int* pe, LAS float* ph, int t, int tnext, v4u (&scn)[4], v4u& x8n, int lane) {
    const int g = lane >> 4, r = lane & 15;
    int eidx[2]; float egate[2];
    unsigned resA[4];
#pragma unroll
    for (int pass = 0; pass < 4; ++pass) {
        const v4u sw = scn[pass];
        const float v[8] = {bflo(sw.x), bfhi(sw.x), bflo(sw.y), bfhi(sw.y), bflo(sw.z), bfhi(sw.z), bflo(sw.w), bfhi(sw.w)};
        unsigned k[8];
#pragma unroll
        for (int j = 0; j < 8; ++j) k[j] = (f2key(v[j]) & ~0x7Fu) | (unsigned)(127 - (r * 8 + j));
        resA[pass] = top16_sorted8(k, r);
    }
    const v4u x8cur = x8n;
#pragma unroll
    for (int pass = 0; pass < 4; ++pass) scn[pass] = *(const v4u*)(SC + (size_t)tnext * 2048 + (pass * 4 + g) * 128 + r * 8);
    x8n = *(const v4u*)(XN8 + (size_t)tnext * 1024 + 16 * lane);
    const unsigned cw = cand_word(r);
#pragma unroll
    for (int cp = 0; cp < 2; ++cp) {
        const int lbase = 32 * (g & 1); const bool hi = (g >> 1) != 0;
        unsigned ck[4];
#pragma unroll
        for (int m = 0; m < 4; ++m) {
            const unsigned byte = (cw >> (8 * m)) & 0xFFu; const int i = (int)(byte >> 4), j = (int)(byte & 15u);
            const unsigned a0 = (unsigned)__shfl((int)resA[2 * cp], lbase + i), a1 = (unsigned)__shfl((int)resA[2 * cp + 1], lbase + i);
            const unsigned b0 = (unsigned)__shfl((int)resA[2 * cp], lbase + 16 + j), b1 = (unsigned)__shfl((int)resA[2 * cp + 1], lbase + 16 + j);
            const unsigned ak = hi ? a1 : a0, bk = hi ? b1 : b0;
            const float val = key2f(ak & ~0x7Fu) + key2f(bk & ~0x7Fu);
            ck[m] = (byte != 0xFFu) ? ((f2key(val) & ~0xFFu) | (255u - byte)) : 0u;
        }
        const unsigned res = top16_keys<4>(ck, r);
        const unsigned flat = 255u - (res & 0xFFu); const int i = (int)(flat >> 4), j = (int)(flat & 15u);
        const float val = key2f(res & ~0xFFu), vmax = key2f(allmax16(res) & ~0xFFu);
        const float e = __expf(val - vmax);
        const float gate = e / allreduce16(e);
        const unsigned a0 = (unsigned)__shfl((int)resA[2 * cp], lbase + i), a1 = (unsigned)__shfl((int)resA[2 * cp + 1], lbase + i);
        const unsigned b0 = (unsigned)__shfl((int)resA[2 * cp], lbase + 16 + j), b1 = (unsigned)__shfl((int)resA[2 * cp + 1], lbase + 16 + j);
        const unsigned ak = hi ? a1 : a0, bk = hi ? b1 : b0;
        eidx[cp] = (int)((127u - (ak & 127u)) * 128u + (127u - (bk & 127u)));
        egate[cp] = gate;
    }
    LAS float* hl = (LAS float*)xl;
    {
        const int i16 = lane & 15, q = lane >> 4;
        LAS unsigned char* x8l = (LAS unsigned char*)(xl + 64);
        LDS_WAIT(); asm volatile("" ::: "memory");
        *(LAS v4u*)(x8l + 16 * lane) = x8cur;
#define PEER_LD(P, KB) (*(const v4i*)((P) + (KB) * 64))
#define PEER_PTR(GI) (U8 + (size_t)__shfl(eidx[(GI) >> 2], 16 * ((GI) & 3) + i16) * 512 + 16 * q)
        v4i ug[2][8];
        LDS_WAIT(); asm volatile("" ::: "memory");
        {
#pragma unroll
        for (int g0 = 0; g0 < 2; ++g0) { const unsigned char* p0 = PEER_PTR(g0);
#pragma unroll
            for (int kb = 0; kb < 8; ++kb) ug[g0][kb] = PEER_LD(p0, kb); }
#pragma unroll
        for (int gi = 0; gi < 8; ++gi) {
            const unsigned char* pn = PEER_PTR((gi + 2) & 7);
            f32x4 c_ = {0.f, 0.f, 0.f, 0.f};
#pragma unroll
            for (int kb = 0; kb < 8; ++kb) {
                const v8i xb_ = __builtin_shufflevector(*(const LAS v4i*)(x8l + kb * 128 + 16 * q), *(const LAS v4i*)(x8l + kb * 128 + 64 + 16 * q), 0, 1, 2, 3, 4, 5, 6, 7);
                const v8i ua_ = __builtin_shufflevector(ug[gi % 2][kb], (v4i){0, 0, 0, 0}, 0, 1, 2, 3, 4, 5, 6, 7);
                c_ = __builtin_amdgcn_mfma_scale_f32_16x16x128_f8f6f4(ua_, xb_, c_, 4, 0, 0, 0x7f7f7f7f, 0, 0x7f7f7f7f);
                if (gi + 2 < 8) ug[gi % 2][kb] = PEER_LD(pn, kb);
            }
            if (i16 == 0) *(LAS f32x4*)(hl + (gi >> 2) * 64 + 16 * (gi & 3) + 4 * q) = c_;
            __builtin_amdgcn_sched_barrier(0);
        }
        }
#undef PEER_LD
#undef PEER_PTR
    }
    LDS_WAIT(); asm volatile("" ::: "memory");
    float ehs[2];
#pragma unroll
    for (int cp = 0; cp < 2; ++cp) { const float hd = hl[cp * 64 + lane] * (1.f / 512.f); ehs[cp] = 0.5f * hd * (1.f + erff(hd * 0.70710678118654752f)) * egate[cp] * (1.f / 5.656854249f); }
    pe[lane] = eidx[0]; pe[64 + lane] = eidx[1]; ph[lane] = ehs[0]; ph[64 + lane] = ehs[1];
}
__device__ __forceinline__ void peer_token_b(const unsigned char* V8, const float* MOD, const float* OUT, float* OROW, const LAS int* pe, const LAS float* ph, int t, int lane) {
    const int g = lane >> 4, r = lane & 15;
    int eidx[2]; float ehs[2];
    eidx[0] = pe[lane]; eidx[1] = pe[64 + lane]; ehs[0] = ph[lane]; ehs[1] = ph[64 + lane];
    f32x2 acc[32];
#pragma unroll
    for (int i = 0; i < 32; ++i) acc[i] = (f32x2){0.f, 0.f};
#define PEER_VL(VV, BT) do { const int src_ = 4 * ((BT) & 15) + g; const int e0_ = __shfl(eidx[0], src_), e1_ = __shfl(eidx[1], src_); const int e_ = ((BT) < 16) ? e0_ : e1_; \
        const unsigned char* vp_ = V8 + (size_t)e_ * 512 + r * 16; VV[0] = *(const v4u*)(vp_); VV[1] = *(const v4u*)(vp_ + 256); } while (0)
#define PEER_AX(W, I, H) do { acc[(I)] += __builtin_amdgcn_cvt_scalef32_pk_f32_fp4((W), 1.0f, 0) * H; acc[(I) + 1] += __builtin_amdgcn_cvt_scalef32_pk_f32_fp4((W), 1.0f, 1) * H; \
        acc[(I) + 2] += __builtin_amdgcn_cvt_scalef32_pk_f32_fp4((W), 1.0f, 2) * H; acc[(I) + 3] += __builtin_amdgcn_cvt_scalef32_pk_f32_fp4((W), 1.0f, 3) * H; } while (0)
#define PEER_VC(VV, BT) do { const int src_ = 4 * ((BT) & 15) + g; const float h0_ = __shfl(ehs[0], src_), h1_ = __shfl(ehs[1], src_); const float hs_ = ((BT) < 16) ? h0_ : h1_; const f32x2 hg_ = {hs_, hs_}; \
        _Pragma("unroll") for (int k = 0; k < 2; ++k) { PEER_AX(VV[k].x, 16 * k, hg_); PEER_AX(VV[k].y, 16 * k + 4, hg_); PEER_AX(VV[k].z, 16 * k + 8, hg_); PEER_AX(VV[k].w, 16 * k + 12, hg_); } } while (0)
    {
        v4u vr[4][2];
#pragma unroll
        for (int i = 0; i < 4; ++i) PEER_VL(vr[i], i);
#pragma unroll 1
        for (int b4 = 0; b4 < 32; b4 += 4) {
#pragma unroll
            for (int i = 0; i < 4; ++i) {
                PEER_VC(vr[i], b4 + i);
                { const int nb_ = (b4 + 4 + i < 32) ? b4 + 4 + i : 31; PEER_VL(vr[i], nb_); }
            }
        }
    }
#undef PEER_VL
#undef PEER_AX
#undef PEER_VC
    const float* gt2 = MOD + (size_t)(t >> 13) * 6144 + 5 * 1024;
    const int col = (16 * (g >> 1) + r) * 32 + 16 * (g & 1);
    const float* op = OUT + (size_t)t * 1024 + col; float* op2 = OROW + col;
    f32x4 hv[4], qv[4];
#pragma unroll
    for (int q = 0; q < 4; ++q) { hv[q] = *(const f32x4*)(op + 4 * q); qv[q] = *(const f32x4*)(gt2 + col + 4 * q); }
#pragma unroll
    for (int i = 0; i < 32; ++i) { acc[i].x += __shfl_xor(acc[i].x, 16); acc[i].y += __shfl_xor(acc[i].y, 16); acc[i].x += __shfl_xor(acc[i].x, 32); acc[i].y += __shfl_xor(acc[i].y, 32); }
#pragma unroll
    for (int q = 0; q < 4; ++q) {
        f32x2 a0 = acc[2 * q], a1 = acc[2 * q + 1];
#pragma unroll
        for (int kk = 1; kk < 4; ++kk) { a0 = (g == kk) ? acc[8 * kk + 2 * q] : a0; a1 = (g == kk) ? acc[8 * kk + 2 * q + 1] : a1; }
        f32x4 o0; o0.x = hv[q].x + qv[q].x * a0.x; o0.y = hv[q].y + qv[q].y * a0.y; o0.z = hv[q].z + qv[q].z * a1.x; o0.w = hv[q].w + qv[q].w * a1.y;
        *(f32x4*)(op2 + 4 * q) = o0;
    }
}


#ifndef MK_N_LAUNCHES
#define MK_N_LAUNCHES 1
#endif
constexpr int N_PHASES = 15;
struct Args { const float* in[28]; float* out; unsigned char* ws; int ph_lo, ph_hi, use_bar, rep; };
enum { I_X = 0, I_C, I_POS, I_WADA, I_BADA, I_N1G, I_WIN, I_QNG, I_KNG, I_MU, I_W0, I_W2, I_A0, I_A2, I_G2, I_KK, I_KA, I_RK, I_LNG, I_LNB, I_WPM, I_WPR, I_WOUT, I_N2G, I_WQ, I_SK, I_PU, I_PV };

template <int OFF> __device__ __forceinline__ unsigned long long karg64() { unsigned long long p; asm volatile("s_load_dwordx2 %0, %1, %2\n\ts_waitcnt lgkmcnt(0)" : "=s"(p) : "s"(__builtin_amdgcn_kernarg_segment_ptr()), "n"(OFF)); return p; }
#define KIN(k) ((const float*)(const GAS float*)karg64<8 * (k)>())
#define KOUT ((float*)(GAS float*)karg64<224>())
#define KWS ((unsigned char*)(GAS unsigned char*)karg64<232>())
#define KOB ((unsigned char*)(GAS unsigned char*)karg64<224>())
#define ctl ((unsigned*)(KWS + WS_CTL))
#define mod ((float*)(KWS + WS_MOD))
#define kmean ((float*)(KWS + WS_KMEAN))
#define WinT ((bf16*)(KWS + WS_WIN))
#define WloraT ((bf16*)(KWS + WS_WLORA))
#define WpmT ((bf16*)(KWS + WS_WPM))
#define WprT ((bf16*)(KWS + WS_WPR))
#define WoutT ((bf16*)(KWS + WS_WOUT))
#define WeffT ((bf16*)(KWS + WS_WEFF))
#define XN ((bf16*)(KWS + WS_XN))
#define EW ((bf16*)(KWS + WS_EW))
#define AA ((bf16*)(KWS + WS_AA))
#define Qb ((bf16*)(KWS + WS_Q))
#define Kb ((bf16*)(KWS + WS_K))
#define VTb ((bf16*)(KWS + WS_VT))
#define ZRKV ((bf16*)(KWS + WS_ZRKV))
#define GT ((bf16*)(KWS + WS_GT))
#define ZLORA ((bf16*)(KWS + WS_ZLORA))
#define ALORA ((bf16*)(KWS + WS_ALORA))
#define OMOBA ((bf16*)(KWS + WS_OCAT))
#define GG ((bf16*)(KWS + WS_GG))
#define Yb ((bf16*)(KWS + WS_OCAT) + 512)
#define MIXED ((bf16*)(KWS + WS_MIXED))
#define U8 ((unsigned char*)(KWS + WS_U8))
#define XN8 ((unsigned char*)(KWS + 352 * MiB))
#define V8 ((unsigned char*)(KWS + WS_V8))
#define SCORES ((bf16*)(KWS + WS_SCORES))
#define OPART ((bf16*)(KOB + DO_OPART))
#define LISTS ((unsigned*)(KOB + DO_LISTS))
#define LPART ((float*)(KOB + DO_LPART))
#define CP_RW ((bf16*)(KOB))
#define CP_MM ((bf16*)(KOB + 32 * MiB))
#define CP_Y0T ((bf16*)(KOB + 64 * MiB))
#define CP_GAT ((bf16*)(KOB + 96 * MiB))
#define CP_PC ((float*)(KWS + 504 * MiB))
#define REPSEL(a, b) (PRB ? (a) : (b))
#define REPSEL5(a, b) REPSEL(a, b)
template <int PRB> __global__ void __launch_bounds__(NTHR, 2) mk_fwd_t(Args args) {
    extern __shared__ __attribute__((aligned(16))) unsigned char lds_raw[];
    LAS unsigned char* lds = (LAS unsigned char*)lds_raw;
    volatile LAS unsigned* MISC = (volatile LAS unsigned*)(lds + MISC_OFF);
    const int tid = threadIdx.x, lane = tid & 63, wave = __builtin_amdgcn_readfirstlane(tid >> 6);
    const int G = gridDim.x, bx = blockIdx.x;
    const int vcu = (G % 8 == 0) ? (bx % 8) * (G / 8) + bx / 8 : bx;
    const int gw = vcu * NWAVES + wave, NGW = G * NWAVES;
    const int gtid = vcu * NTHR + tid, NTOT = G * NTHR;
    for (int u = tid; u < (LDS_BYTES - MISC_OFF) / 4; u += NTHR) ((LAS unsigned*)(lds + MISC_OFF))[u] = 0u;
    __syncthreads();
    XcdBarrier bar; bar.bar = ctl + CW_BAR; bar.x = 0; bar.st = nullptr;
    if (args.use_bar) bar = xcd_barrier_post(ctl + CW_BAR, MISC + 8);
    const int lo = args.ph_lo, hi = args.ph_hi;
#ifdef PH_MASK
#define IN(k) ((((PH_MASK) >> (k)) & 1) && lo <= (k) && (k) < hi)
#else
#define IN(k) (lo <= (k) && (k) < hi)
#endif
#define SEAM(k) do { if (IN(k) && IN((k) + 1)) { if (lo < 0) { cg::this_grid().sync(); } xcd_barrier(bar); } } while (0)

    if (IN(0)) {
        LAS float* scr = (LAS float*)(lds + wave * 16384);
        for (int it = vcu; it < 96; it += G) p0_mod_item(KIN(I_C), KIN(I_WADA), KIN(I_BADA), mod, (LAS float*)lds, it, wave, lane);
        constexpr int I_WEFF = 2048, I_MOD = 0, I_T_IN = 16 * 168, I_T_PM = 8 * 32, I_T_OUT = 16 * 32;
        constexpr int NITEMS = I_WEFF + I_MOD + I_T_IN + 2 * I_T_PM + I_T_OUT;
        for (int it = gw; it < NITEMS; it += NGW) {
            int r = it;
            if (r < I_WEFF) { p0_weff_item(KIN(I_WQ), KIN(I_SK), WeffT, r, lane); continue; } r -= I_WEFF;
            if (r < I_T_IN) { p0_transpose_item(KIN(I_WIN), 1024, INW, WinT, 1024, 0, scr, r, lane); continue; } r -= I_T_IN;
            if (r < I_T_PM) { p0_transpose_item(KIN(I_WPM), 512, 1024, WpmT, 1024, 0, scr, r, lane); continue; } r -= I_T_PM;
            if (r < I_T_PM) { p0_transpose_item(KIN(I_WPR), 512, 1024, WpmT, 1024, 512, scr, r, lane); continue; } r -= I_T_PM;
            p0_transpose_item(KIN(I_WOUT), 1024, 1024, WoutT, 1024, 0, scr, r, lane);
        }
        const float* w2 = KIN(I_W2); const float* a2 = KIN(I_A2); const float* g2 = KIN(I_G2);
        for (int i = gtid; i < 1536 * 256; i += NTOT) {
            const int n = i >> 8, k = i & 255; float v = 0.f;
            if (n < 512) { if (k < 64) v = w2[k * 512 + n]; }
            else if (n < 1024) { if (k >= 64 && k < 128) v = a2[(k - 64) * 512 + (n - 512)]; }
            else { if (k >= 128) v = g2[(k - 128) * 512 + (n - 1024)]; }
            WloraT[i] = (bf16)f2bf(v);
        }
     }
    SEAM(0);
    if (IN(1)) {
        for (int m = gw * 4; m < T; m += NGW * 4) { const float* mb = mod + (size_t)(m >> 13) * 6144;
            rms_mod_rows<4>(KIN(I_X) + (size_t)m * DM, XN + (size_t)m * DM, nullptr, KIN(I_N1G), mb + 1024, mb, lane); }
     }
    SEAM(1);
    if (IN(2)) {
        pg8::Gemm g{XN, WinT, T, INW, DM}; pg8::StaticOrder S; S.init(T, INW, G, bx);
        EpiIn E{Qb, Kb, VTb, ZRKV, ZLORA, GT};
        pg8::gemm_phase<EpiIn, pg8::StaticOrder, true, true>(lds, g, S, E);
     }
    SEAM(2);
    if (IN(3)) {
        LAS float* red = (LAS float*)lds;
        v4u raw[4], rawn[4]; int ps[4], psn[4];
        if (vcu < 2048) p2_qk_load(raw, ps, (vcu >> 10) ? Qb : Kb, (const int*)KIN(I_POS), (vcu & 1023) >> 5, vcu & 31, wave, lane);
        for (int it = vcu; it < 2048; it += G) {
            const int isq = it >> 10, r = it & 1023, bh = r >> 5, n = r & 31;
            { const int itn = it + G < 2048 ? it + G : it;
              p2_qk_load(rawn, psn, (itn >> 10) ? Qb : Kb, (const int*)KIN(I_POS), (itn & 1023) >> 5, itn & 31, wave, lane); }
            if (isq) p2_qk_item(raw, ps, REPSEL((bf16*)KOB, Qb), KIN(I_QNG), nullptr, bh, n, red, tid, wave, lane);
            else p2_qk_item(raw, ps, REPSEL((bf16*)(KOB + 32 * MiB), Kb), KIN(I_KNG), REPSEL((float*)(KWS + 1536 * 1024), kmean), bh, n, red, tid, wave, lane);
#pragma unroll
            for (int i = 0; i < 4; ++i) { raw[i] = rawn[i]; ps[i] = psn[i]; }
        }
        p2_prep(ZLORA, KIN(I_MU), REPSEL((bf16*)(KOB + 64 * MiB), ALORA), gtid, NTOT);
    }
    SEAM(3);
    if (IN(4)) {
        { int kdim = 256; asm volatile("" : "+s"(kdim));
          pg8::Gemm g{ALORA, WloraT, T, 1536, kdim}; pg8::StaticOrder S; S.init(T, 1536, G, bx);
          EpiLora E{EW, AA, GG, KIN(I_W0), KIN(I_A0)};
          pg8::gemm_phase<EpiLora, pg8::StaticOrder, true, true>(lds, g, S, E); }
        __syncthreads();
        LAS float* km = (LAS float*)lds;
        for (int it = vcu; it < 512; it += G) p3_top3_item(Qb, kmean, ctl + CW_CURSOR + REPSEL(2048, 0), REPSEL((unsigned*)KOB, LISTS), (2 * it) & 31, (2 * it) >> 5, km, tid, wave, lane);
    }
    SEAM(4);
    if (IN(5)) {
        attn_phase(Qb, Kb, VTb, LISTS, ctl + CW_CURSOR, ctl + CW_QUEUE + REPSEL5(64, 0), OPART, LPART, OMOBA, KIN(I_QNG), KIN(I_KNG), lds, tid, wave, lane, PRB);
    }
    SEAM(5);
    if (IN(6)) {
        p5_combine(OPART, LPART, OMOBA, REPSEL(Qb, OMOBA), gtid, NTOT);
    }
    SEAM(6);
    if (IN(7)) {
        ScanRaw R;
        if (vcu < BH * NCHK) scan_load(R, ZRKV, AA, EW, (vcu >> 7) >> 3, ((vcu >> 7) & 7) * 64 + (tid & 7) * 8, (vcu & 127) * CK + (tid >> 3));
        for (int ci = vcu; ci < BH * NCHK; ci += G) {
            const int cn = ci + G;
            rwkv_cp_item(ZRKV, AA, EW, KIN(I_MU), KIN(I_KK), KIN(I_KA), CP_RW + (size_t)ci * 4096, CP_MM + (size_t)ci * 4096, CP_Y0T + (size_t)ci * 4096, CP_GAT + (size_t)ci * 4096,
                         CP_PC + (size_t)ci * 64, ci >> 7, ci & 127, R, (cn < BH * NCHK ? cn : ci) >> 7, (cn < BH * NCHK ? cn : ci) & 127, lds, tid, wave, lane, PRB);
        }
    }
    SEAM(7);
    if (IN(8)) {
        if (G >= 128) { if (vcu < 128) rwkv_seq(CP_RW, CP_MM, CP_Y0T, CP_GAT, CP_PC, Yb, vcu, lds, tid, wave, lane); }
        else for (int sid = vcu; sid < 128; sid += G) { __syncthreads(); rwkv_seq(CP_RW, CP_MM, CP_Y0T, CP_GAT, CP_PC, Yb, sid, lds, tid, wave, lane); }
        if (G > 128 ? vcu >= 128 : true) {
        const int cgt = (G > 128 ? vcu - 128 : vcu) * NTHR + tid, cnt = (G > 128 ? G - 128 : G) * NTHR;
        const f32x4* pu = (const f32x4*)KIN(I_PU); const f32x4* pv = (const f32x4*)KIN(I_PV);
        for (int i = cgt; i < 16384 * 1024 / 32; i += cnt) {
            v4u wu;
#pragma unroll
            for (int q = 0; q < 4; ++q) {
                f32x4 a = pu[8 * i + 2 * q] * 64.f, c = pu[8 * i + 2 * q + 1] * 64.f;
                a = __builtin_elementwise_min(__builtin_elementwise_max(a, (f32x4){-6.f, -6.f, -6.f, -6.f}), (f32x4){6.f, 6.f, 6.f, 6.f});
                c = __builtin_elementwise_min(__builtin_elementwise_max(c, (f32x4){-6.f, -6.f, -6.f, -6.f}), (f32x4){6.f, 6.f, 6.f, 6.f});
                unsigned w = 0u;
                w = __builtin_amdgcn_cvt_scalef32_pk_fp4_f32(w, a.x, a.y, 1.0f, 0); w = __builtin_amdgcn_cvt_scalef32_pk_fp4_f32(w, a.z, a.w, 1.0f, 1);
                w = __builtin_amdgcn_cvt_scalef32_pk_fp4_f32(w, c.x, c.y, 1.0f, 2); w = __builtin_amdgcn_cvt_scalef32_pk_fp4_f32(w, c.z, c.w, 1.0f, 3);
                wu[q] = w;
            }
            *(v4u*)(U8 + (size_t)i * 16) = wu;
        }
        for (int i = cgt; i < 16384 * 1024 / 32; i += cnt) {
            v4u wv;
#pragma unroll
            for (int q = 0; q < 4; ++q) {
                f32x4 a = pv[8 * i + 2 * q] * 5.656854249f, c = pv[8 * i + 2 * q + 1] * 5.656854249f;
                a = __builtin_elementwise_min(__builtin_elementwise_max(a, (f32x4){-6.f, -6.f, -6.f, -6.f}), (f32x4){6.f, 6.f, 6.f, 6.f});
                c = __builtin_elementwise_min(__builtin_elementwise_max(c, (f32x4){-6.f, -6.f, -6.f, -6.f}), (f32x4){6.f, 6.f, 6.f, 6.f});
                unsigned w = 0u;
                w = __builtin_amdgcn_cvt_scalef32_pk_fp4_f32(w, a.x, a.y, 1.0f, 0); w = __builtin_amdgcn_cvt_scalef32_pk_fp4_f32(w, a.z, a.w, 1.0f, 1);
                w = __builtin_amdgcn_cvt_scalef32_pk_fp4_f32(w, c.x, c.y, 1.0f, 2); w = __builtin_amdgcn_cvt_scalef32_pk_fp4_f32(w, c.z, c.w, 1.0f, 3);
                wv[q] = w;
            }
            *(v4u*)(V8 + (size_t)i * 16) = wv;
        }
        }
    }
    SEAM(8);
    if (IN(9)) {
        p5_rwkv_post(ZRKV, AA, GG, Yb, REPSEL(Qb, Yb), KIN(I_MU), KIN(I_KA), KIN(I_RK), KIN(I_LNG), KIN(I_LNB), gw, NGW, lane);
    }
    SEAM(9);
    if (IN(10)) {
        pg8::Gemm g{OMOBA, WpmT, T, DM, DM}; pg8::StaticOrder S; S.init(T, DM, G, bx);
        EpiMix E{GT, MIXED, PRB};
        pg8::gemm_phase<EpiMix, pg8::StaticOrder, true, true>(lds, g, S, E);
    }
    SEAM(10);
    if (IN(11)) {
        pg8::Gemm g{MIXED, WoutT, T, DM, DM}; pg8::StaticOrder S; S.init(T, DM, G, bx);
        EpiOut E{KIN(I_X), mod, KOUT};
        pg8::gemm_phase<EpiOut, pg8::StaticOrder, true, true>(lds, g, S, E);
     }
    SEAM(11);
    if (IN(12)) {
        for (int m = gw * 4; m < T; m += NGW * 4) { const float* mb = mod + (size_t)(m >> 13) * 6144;
            rms_mod_rows<4>(KOUT + (size_t)m * DM, XN + (size_t)m * DM, (unsigned*)(XN8 + (size_t)m * DM), KIN(I_N2G), mb + 4 * 1024, mb + 3 * 1024, lane); }
    }
    SEAM(12);
    if (IN(13)) {
        pg8::Gemm g{XN, WeffT, T, PEER_N, DM}; pg8::StaticOrder S; S.init(T, PEER_N, G, bx);
        EpiScores E{SCORES};
        pg8::gemm_phase<EpiScores, pg8::StaticOrder, true, true>(lds, g, S, E);
     }
    SEAM(13);
    if (IN(14)) {
        LAS f32x4* xl = (LAS f32x4*)(lds + wave * 18432);
        LAS int* pe = (LAS int*)(lds + wave * 18432 + 2048); LAS float* ph = (LAS float*)(lds + wave * 18432 + 2048 + 8192);
        v4u scn[4], x8n;
        { const int g_ = lane >> 4, r_ = lane & 15;
#pragma unroll
          for (int pass = 0; pass < 4; ++pass) scn[pass] = *(const v4u*)(SCORES + (size_t)gw * 2048 + (pass * 4 + g_) * 128 + r_ * 8);
          x8n = *(const v4u*)(XN8 + (size_t)gw * 1024 + 16 * lane); }
        { int k = 0; for (int t = gw; t < T; t += NGW, ++k) peer_token_a(SCORES, XN8, U8, xl, pe + 128 * (k & 15), ph + 128 * (k & 15), t, t + NGW < T ? t + NGW : t, scn, x8n, lane); }
        LDS_WAIT(); asm volatile("" ::: "memory");
        { int k = 0; for (int t = gw; t < T; t += NGW, ++k) peer_token_b(V8, mod, KOUT, KOUT + (size_t)t * 1024, pe + 128 * (k & 15), ph + 128 * (k & 15), t, lane); }
    }
#undef IN
#undef SEAM
}

extern "C" void kernel_launch(void* const* d_in, const int* in_sizes, int n_in, void* d_out, int out_size, void* d_ws, size_t ws_size, hipStream_t stream) {
    static int grid = 0;
    if (grid == 0) {
        if (n_in != 28 || in_sizes[0] != T * DM || out_size != T * DM || ws_size < WS_END) {
            fprintf(stderr, "kernel_launch: unexpected problem (n_in %d, in0 %d, out %d, ws %zu); nothing launched\n", n_in, n_in > 0 ? in_sizes[0] : -1, out_size, ws_size); grid = -1; return; }
        int dev = 0, cus = 0, per_cu = 0;
        if (hipGetDevice(&dev) != hipSuccess || hipDeviceGetAttribute(&cus, hipDeviceAttributeMultiprocessorCount, dev) != hipSuccess) { grid = -1; return; }
        if (hipFuncSetAttribute((const void*)mk_fwd_t<0>, hipFuncAttributeMaxDynamicSharedMemorySize, LDS_BYTES) != hipSuccess) { fprintf(stderr, "kernel_launch: hipFuncSetAttribute failed\n"); grid = -1; return; }
        if (hipOccupancyMaxActiveBlocksPerMultiprocessor(&per_cu, (const void*)mk_fwd_t<0>, NTHR, LDS_BYTES) != hipSuccess || per_cu < 1) { fprintf(stderr, "kernel_launch: occupancy query says %d\n", per_cu); per_cu = 1; }
        (void)hipGetLastError();
        grid = cus;
    }
    if (grid < 0) return;
    if (hipMemsetAsync((char*)d_ws + WS_CTL, 0, CTL_ZERO_BYTES, stream) != hipSuccess) { fprintf(stderr, "kernel_launch: memset failed\n"); return; }
    Args a{};
    for (int i = 0; i < 28; ++i) a.in[i] = (const float*)d_in[i];
    a.out = (float*)d_out; a.ws = (unsigned char*)d_ws;
#if MK_N_LAUNCHES == 1
    a.ph_lo = 0; a.ph_hi = N_PHASES; a.use_bar = 1;
    void* kargs[] = {&a};
    hipError_t e = hipLaunchCooperativeKernel((const void*)mk_fwd_t<0>, dim3(grid), dim3(NTHR), kargs, LDS_BYTES, stream);
    if (e != hipSuccess) fprintf(stderr, "kernel_launch: cooperative launch failed: %s (grid %d)\n", hipGetErrorString(e), grid);
#else
#ifndef REP_MASK
#define REP_MASK 0
#endif
#ifndef REP_CODE
#define REP_CODE 1
#endif
    for (int p = 0; p < N_PHASES; ++p) {
        a.ph_lo = p; a.ph_hi = p + 1; a.use_bar = 0;
#if REP_MASK != 0
        if ((REP_MASK >> p) & 1) { static bool once = false; if (!once) { once = true; (void)hipFuncSetAttribute((const void*)mk_fwd_t<REP_CODE>, hipFuncAttributeMaxDynamicSharedMemorySize, LDS_BYTES); }
            a.rep = REP_CODE; hipLaunchKernelGGL(mk_fwd_t<REP_CODE>, dim3(grid), dim3(NTHR), LDS_BYTES, stream, a); }
#endif
        a.rep = 0;
        hipLaunchKernelGGL(mk_fwd_t<0>, dim3(grid), dim3(NTHR), LDS_BYTES, stream, a);
    }
#endif
}
```

```cpp
#include <hip/hip_runtime.h>
#include <hip/hip_cooperative_groups.h>
#include <cstdio>
#include <cstdint>
namespace cg = cooperative_groups;

namespace pg8 {
#define PG8_LAS __attribute__((address_space(3)))
typedef unsigned short bf16_t;
typedef short bf16x8 __attribute__((ext_vector_type(8)));
typedef float f32x4 __attribute__((ext_vector_type(4)));
typedef unsigned u32x4 __attribute__((ext_vector_type(4)));
constexpr int BM = 256, BK = 64, HALF = 128, HTB = HALF * BK * 2  , STAGE_BYTES = 8 * HTB, NXCD = 8, WGM = 8;

__host__ __device__ __forceinline__ int lds_byte(int r, int c) { const int st = (r >> 4) * 2 + (c >> 5), rr = r & 15, cc = c & 31, ob = rr * 64 + cc * 2; return st * 1024 + (ob ^ (((ob >> 9) & 1) << 5)); }
__host__ __device__ __forceinline__ void stage_rc(int b, int& R, int& C) { const int st = b / 1024, sb = b % 1024, swz = sb ^ (((sb >> 9) & 1) << 5); R = (st >> 1) * 16 + swz / 64; C = (st & 1) * 32 + (swz % 64) / 2; }
__host__ __device__ __forceinline__ int perm32(int rho) { const int n = rho >> 4, i = rho & 15; return 8 * (i >> 2) + 4 * n + (i & 3); }

struct Unit { int pm, pn; };
struct Gemm { const bf16_t* A; const bf16_t* Bt; int M, N, K; };

struct StaticOrder {
    int nM, nN, nwg, G, c;
    __host__ __device__ void init(int M, int N, int G_, int c_) { nM = M / BM; nN = N / BM; nwg = nM * nN; G = G_; c = c_; }
    __host__ __device__ bool next(int i, Unit& u) const {
        const long L = (long)i * G + c; if (L >= nwg) return false;
        int wgid = (int)L; { const int q = nwg / NXCD, r = nwg % NXCD, xcd = wgid % NXCD, off = wgid / NXCD; wgid = (xcd < r ? xcd * (q + 1) : r * (q + 1) + (xcd - r) * q) + off; }
        const int nig = WGM * nN, gid = wgid / nig, fm = gid * WGM, gsz = (nM - fm) < WGM ? (nM - fm) : WGM;
        u.pm = fm + ((wgid % nig) % gsz); u.pn = (wgid % nig) / gsz; return true;
    }
    __device__ __forceinline__ void a_ready(const Unit&) const {}
    __device__ __forceinline__ void done(const Unit&) const {}
};
template <class Epi, class Sched, bool ALIGN_EPI = false, bool SP2 = false>
__device__ __forceinline__ void gemm_phase(PG8_LAS unsigned char* lds, const Gemm g, const Sched& S, const Epi& E) {
    const int tid = threadIdx.x, wid = __builtin_amdgcn_readfirstlane(tid >> 6), lane = tid & 63, wr = wid >> 2, wc = wid & 3, fr = lane & 15, fq = lane >> 4;
    const int K = g.K, nt = K / BK;
    unsigned voffA[2], voffB[2];
#pragma unroll
    for (int i = 0; i < 2; ++i) { int R, C; stage_rc(tid * 16 + i * 8192, R, C); const int Rb = Epi::PERM ? ((R & ~31) + perm32(R & 31)) : R;
        voffA[i] = (unsigned)(R * K + C) * 2u; voffB[i] = (unsigned)(Rb * K + C) * 2u; }
    const size_t kstep = (size_t)(BK * 2);
    const size_t hstep = (size_t)HALF * K * 2;
    const size_t tstep = 2 * hstep;
    const unsigned ldsw = (unsigned)wid * 1024u;
    const int aoff = lds_byte(wr * 64 + fr, fq * 8), boff = lds_byte(wc * 32 + fr, fq * 8);
#define PG8_SA(b, h) (((b) * 2 + (h)) * HTB)
#define PG8_SB(b, h) ((4 + (b) * 2 + (h)) * HTB)
#define PG8_STAGE(bufoff, gbase, voff) do { _Pragma("unroll") for (int _i = 0; _i < 2; ++_i) \
        __builtin_amdgcn_global_load_lds((const unsigned*)((const char*)(gbase) + (voff)[_i]), (PG8_LAS unsigned*)(lds + (bufoff) + ldsw + _i * 8192), 16, 0, 0); } while (0)
#define PG8_LDA(dst, b, h) do { _Pragma("unroll") for (int m = 0; m < 4; ++m) _Pragma("unroll") for (int k = 0; k < 2; ++k) dst[m][k] = *(const PG8_LAS bf16x8*)(lds + PG8_SA(b, h) + aoff + m * 2048 + k * 1024); } while (0)
#define PG8_LDB(dst, b, h) do { _Pragma("unroll") for (int n = 0; n < 2; ++n) _Pragma("unroll") for (int k = 0; k < 2; ++k) dst[n][k] = *(const PG8_LAS bf16x8*)(lds + PG8_SB(b, h) + boff + n * 2048 + k * 1024); } while (0)
#define PG8_MMA(ai, bj, At, Bt) do { __builtin_amdgcn_s_setprio(1); _Pragma("unroll") for (int m = 0; m < 4; ++m) _Pragma("unroll") for (int n = 0; n < 2; ++n) _Pragma("unroll") for (int k = 0; k < 2; ++k) \
        acc[ai][bj][m][n] = __builtin_amdgcn_mfma_f32_16x16x32_bf16(Bt[n][k], At[m][k], acc[ai][bj][m][n], 0, 0, 0); __builtin_amdgcn_s_setprio(0); } while (0)
#define PG8_WAIT_V(n) asm volatile("s_waitcnt vmcnt(" #n ")" ::: "memory")
#define PG8_WAIT_L(n) asm volatile("s_waitcnt lgkmcnt(" #n ")" ::: "memory")
#define PG8_BAR __builtin_amdgcn_s_barrier()
#define PG8_SCHED __builtin_amdgcn_sched_barrier(0)
    Unit cur, nxt; int ui = 0;
    if (!S.next(0, cur)) return;
    f32x4 acc[2][2][4][2];
#pragma unroll
    for (int a = 0; a < 2; ++a)
#pragma unroll
        for (int b = 0; b < 2; ++b)
#pragma unroll
            for (int m = 0; m < 4; ++m)
#pragma unroll
                for (int n = 0; n < 2; ++n) acc[a][b][m][n] = (f32x4){0.f, 0.f, 0.f, 0.f};
    bf16x8 At[4][2], B0[2][2], B1[2][2];
    const char* cA = (const char*)g.A + (size_t)cur.pm * tstep; const char* cB = (const char*)g.Bt + (size_t)cur.pn * tstep;
    S.a_ready(cur);
    if constexpr (SP2) {
        PG8_STAGE(PG8_SB(0, 0), cB, voffB); PG8_STAGE(PG8_SB(0, 1), cB + hstep, voffB); PG8_STAGE(PG8_SA(0, 0), cA, voffA); PG8_STAGE(PG8_SA(0, 1), cA + hstep, voffA);
        if (wr == 1) PG8_BAR;
        PG8_WAIT_V(2); PG8_BAR;
        PG8_STAGE(PG8_SB(1, 0), cB + kstep, voffB); PG8_STAGE(PG8_SA(1, 0), cA + kstep, voffA); PG8_STAGE(PG8_SB(1, 1), cB + hstep + kstep, voffB);
        PG8_WAIT_V(6); PG8_BAR;
    } else {
        PG8_STAGE(PG8_SB(0, 0), cB, voffB); PG8_STAGE(PG8_SA(0, 0), cA, voffA); PG8_STAGE(PG8_SB(0, 1), cB + hstep, voffB); PG8_STAGE(PG8_SA(0, 1), cA + hstep, voffA);
        if (wr == 1) PG8_BAR;
        PG8_WAIT_V(4); PG8_BAR;
        PG8_STAGE(PG8_SB(1, 0), cB + kstep, voffB); PG8_STAGE(PG8_SA(1, 0), cA + kstep, voffA); PG8_STAGE(PG8_SB(1, 1), cB + hstep + kstep, voffB);
        PG8_WAIT_V(6); PG8_BAR;
    }
    for (;;) {
        const bool has_next = S.next(ui + 1, nxt);
        const char* nA = has_next ? (const char*)g.A + (size_t)nxt.pm * tstep : cA; const char* nB = has_next ? (const char*)g.Bt + (size_t)nxt.pn * tstep : cB;
        for (int t = 0; t < nt; t += 2) {
            if constexpr (Epi::HAS_MID) { if (t == Epi::MID_T) E.mid(acc, cur, wr, wc, fr, fq); }
            const bool last = (t == nt - 2);
            const char* a1 = cA + (size_t)(t + 1) * kstep;
            const char* a2 = last ? nA : cA + (size_t)(t + 2) * kstep; const char* b2 = last ? nB : cB + (size_t)(t + 2) * kstep;
            const char* a3 = a2 + kstep; const char* b3 = b2 + kstep;
            if (last && has_next) S.a_ready(nxt);
            if constexpr (SP2) {
            PG8_LDB(B0, 0, 0); PG8_LDB(B1, 0, 1); PG8_SCHED; PG8_LDA(At, 0, 0); PG8_STAGE(PG8_SA(1, 1), a1 + hstep, voffA);
            PG8_WAIT_V(8); PG8_WAIT_L(0); PG8_BAR; PG8_MMA(0, 0, At, B0); PG8_MMA(0, 1, At, B1); PG8_BAR; PG8_SCHED;
            PG8_LDA(At, 0, 1); PG8_STAGE(PG8_SB(0, 0), b2, voffB); PG8_STAGE(PG8_SB(0, 1), b2 + hstep, voffB); PG8_STAGE(PG8_SA(0, 0), a2, voffA);
            PG8_WAIT_V(8); PG8_WAIT_L(0); PG8_BAR; PG8_MMA(1, 0, At, B0); PG8_MMA(1, 1, At, B1); PG8_BAR; PG8_SCHED;
            PG8_LDB(B0, 1, 0); PG8_LDB(B1, 1, 1); PG8_SCHED; PG8_LDA(At, 1, 0); PG8_STAGE(PG8_SA(0, 1), a2 + hstep, voffA);
            PG8_WAIT_V(8); PG8_WAIT_L(0); PG8_BAR; PG8_MMA(0, 0, At, B0); PG8_MMA(0, 1, At, B1); PG8_BAR; PG8_SCHED;
            PG8_LDA(At, 1, 1); PG8_STAGE(PG8_SB(1, 0), b3, voffB); PG8_STAGE(PG8_SB(1, 1), b3 + hstep, voffB); PG8_STAGE(PG8_SA(1, 0), a3, voffA);
            PG8_WAIT_V(8); PG8_WAIT_L(0); PG8_BAR; PG8_MMA(1, 0, At, B0); PG8_MMA(1, 1, At, B1); PG8_BAR; PG8_SCHED;
            } else {
            PG8_LDB(B0, 0, 0); PG8_SCHED; PG8_LDA(At, 0, 0); PG8_STAGE(PG8_SA(1, 1), a1 + hstep, voffA);
            PG8_WAIT_L(8); PG8_BAR; PG8_WAIT_L(0); PG8_MMA(0, 0, At, B0); PG8_BAR; PG8_SCHED;
            PG8_LDB(B1, 0, 1); PG8_STAGE(PG8_SB(0, 0), b2, voffB);
            PG8_BAR; PG8_WAIT_L(0); PG8_MMA(0, 1, At, B1); PG8_BAR;
            PG8_LDA(At, 0, 1); PG8_STAGE(PG8_SA(0, 0), a2, voffA);
            PG8_BAR; PG8_WAIT_L(0); PG8_MMA(1, 0, At, B0); PG8_BAR; PG8_SCHED;
            PG8_STAGE(PG8_SB(0, 1), b2 + hstep, voffB);
            PG8_WAIT_V(6); PG8_BAR; PG8_MMA(1, 1, At, B1); PG8_BAR;
            PG8_LDB(B0, 1, 0); PG8_SCHED; PG8_LDA(At, 1, 0); PG8_STAGE(PG8_SA(0, 1), a2 + hstep, voffA);
            PG8_WAIT_L(8); PG8_BAR; PG8_WAIT_L(0); PG8_MMA(0, 0, At, B0); PG8_BAR; PG8_SCHED;
            PG8_LDB(B1, 1, 1); PG8_STAGE(PG8_SB(1, 0), b3, voffB);
            PG8_BAR; PG8_WAIT_L(0); PG8_MMA(0, 1, At, B1); PG8_BAR;
            PG8_LDA(At, 1, 1); PG8_STAGE(PG8_SA(1, 0), a3, voffA);
            PG8_BAR; PG8_WAIT_L(0); PG8_MMA(1, 0, At, B0); PG8_BAR; PG8_SCHED;
            PG8_STAGE(PG8_SB(1, 1), b3 + hstep, voffB);
            PG8_WAIT_V(6); PG8_BAR; PG8_MMA(1, 1, At, B1); PG8_BAR;
            }
        }
        if constexpr (ALIGN_EPI) { if (wr == 0) PG8_BAR; }
        if constexpr (!Epi::AFTER_DRAIN) { E(acc, cur, wr, wc, fr, fq); S.done(cur); }
        if (!has_next) break;
#pragma unroll
        for (int a = 0; a < 2; ++a)
#pragma unroll
            for (int b = 0; b < 2; ++b)
#pragma unroll
                for (int m = 0; m < 4; ++m)
#pragma unroll
                    for (int n = 0; n < 2; ++n) acc[a][b][m][n] = (f32x4){0.f, 0.f, 0.f, 0.f};
        cur = nxt; cA = nA; cB = nB; ++ui;
        if constexpr (ALIGN_EPI) { if (wr == 1) PG8_BAR; }
    }
    PG8_WAIT_V(0);
    if constexpr (!ALIGN_EPI) { if (wr == 0) PG8_BAR; }
    PG8_BAR;
    if constexpr (Epi::AFTER_DRAIN) { E.fused(acc, cur, wr, wc, fr, fq, lds, wid, lane); S.done(cur); }
#undef PG8_SA
#undef PG8_SB
#undef PG8_STAGE
#undef PG8_LDA
#undef PG8_LDB
#undef PG8_MMA
#undef PG8_WAIT_V
#undef PG8_WAIT_L
#undef PG8_BAR
#undef PG8_SCHED
}
}

constexpr int NWAVES = 8, NTHR = 512;
constexpr int BATCH = 4, SEQ = 8192, DM = 1024, T = BATCH * SEQ;
constexpr int NH = 8, HD = 64, NBLK = 32, BLK = 256;
constexpr int BH = BATCH * NH;
constexpr int INW = 5376;
constexpr int ZR = 1536, ZL = 256;
constexpr int PEER_N = 2048;
constexpr float RMS_EPS = 1e-6f, GN_EPS = 64e-5f;
constexpr int OSTR = 1024;

constexpr size_t MiB = 1u << 20;
constexpr size_t WS_CTL = 0, CTL_ZERO_BYTES = 1 * MiB;
constexpr size_t WS_MOD = 1 * MiB;
constexpr size_t WS_KMEAN = 1 * MiB + 128 * 1024;
constexpr size_t WS_WIN = 2 * MiB;
constexpr size_t WS_WLORA = 13 * MiB;
constexpr size_t WS_WPM = 14 * MiB, WS_WPR = 15 * MiB;
constexpr size_t WS_WOUT = 16 * MiB;
constexpr size_t WS_WEFF = 18 * MiB;
constexpr size_t WS_XN = 24 * MiB;
constexpr size_t WS_EW = 24 * MiB, WS_AA = 56 * MiB;
constexpr size_t WS_Q = 88 * MiB, WS_K = 120 * MiB, WS_VT = 152 * MiB;
constexpr size_t WS_ZRKV = 184 * MiB;
constexpr size_t WS_GT = 280 * MiB;
constexpr size_t WS_ZLORA = 408 * MiB;
constexpr size_t WS_ALORA = 424 * MiB;
constexpr size_t WS_OCAT = 408 * MiB;
constexpr size_t WS_GG = 472 * MiB;
constexpr size_t WS_MIXED = 216 * MiB;
constexpr size_t WS_U8 = 2 * MiB, WS_V8 = 88 * MiB;
constexpr size_t WS_SCORES = 96 * MiB;
constexpr size_t WS_END = 512 * MiB;
constexpr size_t DO_OPART = 0, DO_LISTS = 96 * MiB, DO_LPART = 112 * MiB;
constexpr int LIST_PER_BH = 256 * 496;
__host__ __device__ constexpr int list_off(int n) { return 256 * (31 * n - n * (n - 1) / 2); }
constexpr int CW_QUEUE = 64;
constexpr int CW_CURSOR = 1024;
constexpr int CW_BAR = 4096;

constexpr int RING_BYTES = 131072;
constexpr int LDS_BYTES = 163840;
constexpr int MISC_OFF = LDS_BYTES - 512;

#define GAS __attribute__((address_space(1)))
#define LAS __attribute__((address_space(3)))
typedef unsigned short bf16;
typedef unsigned v4u __attribute__((ext_vector_type(4)));
typedef unsigned v2u __attribute__((ext_vector_type(2)));
typedef float f32x4 __attribute__((ext_vector_type(4)));
typedef float f32x2 __attribute__((ext_vector_type(2)));
typedef float f32x16 __attribute__((ext_vector_type(16)));
typedef short bf16x8 __attribute__((ext_vector_type(8)));
typedef short s16x4 __attribute__((ext_vector_type(4)));
#define RLX_AGENT __ATOMIC_RELAXED, __HIP_MEMORY_SCOPE_AGENT
#define LDS_WAIT() asm volatile("s_waitcnt lgkmcnt(0)" ::: "memory")
#define VM_WAIT() asm volatile("s_waitcnt vmcnt(0)" ::: "memory")
typedef __bf16 bf16x2_t __attribute__((ext_vector_type(2)));
__device__ __forceinline__ unsigned cvtpk(float lo, float hi) { f32x2 v = {lo, hi}; bf16x2_t b = __builtin_convertvector(v, bf16x2_t); return __builtin_bit_cast(unsigned, b); }
__device__ __forceinline__ unsigned pk2(float lo, float hi) { return cvtpk(lo, hi); }
__device__ __forceinline__ unsigned f2bf(float f) { return cvtpk(f, 0.f) & 0xffffu; }
__device__ __forceinline__ float bflo(unsigned u) { return __builtin_bit_cast(float, u << 16); }
__device__ __forceinline__ float bfhi(unsigned u) { return __builtin_bit_cast(float, u & 0xffff0000u); }
__device__ __forceinline__ float bf2f(bf16 h) { return __builtin_bit_cast(float, (unsigned)h << 16); }
__device__ __forceinline__ float wave_sum(float v) {
#pragma unroll
    for (int o = 1; o < 64; o <<= 1) v += __shfl_xor(v, o);
    return v;
}
__device__ __forceinline__ float sigmoidf_(float x) { return __builtin_amdgcn_rcpf(1.0f + __expf(-x)); }
#define XB_TMO      128
#define XB_XCNT(j)  (256  + 64 * (j))
#define XB_XSUB(j)  (1280 + 64 * (j))
#define XB_XGEN(j)  (2304 + 64 * (j))
#define XB_TOP      3328
#define XB_TOPGEN   3392
#define XCD_BAR_WORDS 3456
#define XB_SPIN_CAP (1u << 18)

__device__ __forceinline__ unsigned xb_ld(unsigned* p)              { return __hip_atomic_load(p, __ATOMIC_RELAXED, __HIP_MEMORY_SCOPE_AGENT); }
__device__ __forceinline__ unsigned xb_add(unsigned* p, unsigned v) { return __hip_atomic_fetch_add(p, v, __ATOMIC_RELAXED, __HIP_MEMORY_SCOPE_AGENT); }
__device__ __forceinline__ unsigned xb_xcc_id() { return (unsigned)__builtin_amdgcn_s_getreg((3 << 11) | 20) & 0xFu; }
#define XB_SPIN(cond, bar) do { unsigned _sp = 0; while (cond) { __builtin_amdgcn_s_sleep(1); \
    if ((++_sp & 255u) == 0u) { if (xb_ld(&(bar)[XB_TMO])) break; if (_sp > XB_SPIN_CAP) { atomicAdd(&(bar)[XB_TMO], 1u); break; } } } } while (0)

struct XcdBarrier {
    unsigned* bar; unsigned x;
    volatile LAS unsigned* st;
};

__device__ __forceinline__ XcdBarrier xcd_barrier_post(unsigned* bar, volatile LAS unsigned* st) {
    XcdBarrier b; b.bar = bar; b.x = xb_xcc_id(); b.st = st;
    if (threadIdx.x == 0) (void)xb_add(&bar[XB_XCNT(b.x)], 1u);
    return b;
}
__device__ __forceinline__ void xcd_barrier_complete(unsigned* bar, unsigned x, unsigned& nloc, unsigned& nx) {
    const unsigned G = gridDim.x * gridDim.y * gridDim.z;
    unsigned sum, cnt, mine, sp = 0u;
    for (;;) {
        sum = 0u; cnt = 0u; mine = 0u;
#pragma unroll
        for (unsigned j = 0; j < 16; ++j) { const unsigned c = xb_ld(&bar[XB_XCNT(j)]); sum += c; cnt += (c > 0u) ? 1u : 0u; mine = (j == x) ? c : mine; }
        if (sum == G) break;
        __builtin_amdgcn_s_sleep(1);
        if ((++sp & 255u) == 0u) { if (xb_ld(&bar[XB_TMO])) break; if (sp > XB_SPIN_CAP) { atomicAdd(&bar[XB_TMO], 1u); break; } }
    }
    nloc = mine > 0u ? mine : 1u; nx = cnt > 0u ? cnt : 1u;
}

__device__ __forceinline__ void xcd_barrier(const XcdBarrier& b) {
    asm volatile("s_waitcnt vmcnt(0)" ::: "memory");
    __syncthreads();
    if (threadIdx.x == 0) {
        unsigned* bar = b.bar;
        __builtin_amdgcn_s_waitcnt(0);
        unsigned nloc = b.st[0], nx = b.st[1];
        if (nloc == 0u) { xcd_barrier_complete(bar, b.x, nloc, nx); b.st[0] = nloc; b.st[1] = nx; }
        const unsigned old = xb_add(&bar[XB_XSUB(b.x)], 1u);
        const unsigned gen = old / nloc;
        if (old + 1u == (gen + 1u) * nloc) {
            __builtin_amdgcn_fence(__ATOMIC_RELEASE, "agent");
            asm volatile("s_waitcnt vmcnt(0)" ::: "memory");
            const unsigned og = xb_add(&bar[XB_TOP], 1u);
            const unsigned tg = og / nx;
            if (og + 1u == (tg + 1u) * nx) xb_add(&bar[XB_TOPGEN], 1u);
            else XB_SPIN(xb_ld(&bar[XB_TOPGEN]) == tg, bar);
            __builtin_amdgcn_fence(__ATOMIC_ACQUIRE, "agent");
            xb_add(&bar[XB_XGEN(b.x)], 1u);
            asm volatile("s_waitcnt vmcnt(0)" ::: "memory");
        } else {
            XB_SPIN(xb_ld(&bar[XB_XGEN(b.x)]) == gen, bar);
            __builtin_amdgcn_fence(__ATOMIC_ACQUIRE, "agent");
            asm volatile("s_waitcnt vmcnt(0)" ::: "memory");
        }
    }
    __syncthreads();
}

__device__ __forceinline__ void p0_transpose_item(const float* W, int K, int N, bf16* WT, int ldk, int koff, LAS float* scr, int item, int lane) {
    const int nblk = N / 32, kb = item / nblk, nb = item % nblk, k0 = 64 * kb, n0 = 32 * nb;
#pragma unroll 8
    for (int i = 0; i < 32; ++i) { const int kk = 2 * i + (lane >> 5); scr[kk * 33 + (lane & 31)] = W[(size_t)(k0 + kk) * N + n0 + (lane & 31)]; }
    LDS_WAIT(); asm volatile("" ::: "memory");
    const int c = lane & 7;
#pragma unroll
    for (int j = 0; j < 4; ++j) { const int n = (lane >> 3) + 8 * j; const LAS float* s = scr + (8 * c) * 33 + n;
        v4u o; o.x = pk2(s[0 * 33], s[1 * 33]); o.y = pk2(s[2 * 33], s[3 * 33]); o.z = pk2(s[4 * 33], s[5 * 33]); o.w = pk2(s[6 * 33], s[7 * 33]);
#ifdef EMU_FP8_G2
        if (N == INW) { float f_[8];
            for (int e_ = 0; e_ < 8; e_ += 2) { int w_ = __builtin_amdgcn_cvt_pk_fp8_f32(s[e_ * 33] * 256.f, s[(e_ + 1) * 33] * 256.f, 0, false); const f32x2 l_ = __builtin_amdgcn_cvt_pk_f32_fp8(w_, false); f_[e_] = l_.x * (1.f / 256.f); f_[e_ + 1] = l_.y * (1.f / 256.f); }
            o.x = pk2(f_[0], f_[1]); o.y = pk2(f_[2], f_[3]); o.z = pk2(f_[4], f_[5]); o.w = pk2(f_[6], f_[7]); }
#endif
        *(GAS v4u*)(WT + (size_t)(n0 + n) * ldk + koff + k0 + 8 * c) = o; }
    LDS_WAIT(); asm volatile("" ::: "memory");
}
__device__ __forceinline__ void p0_mod_item(const float* c, const float* w_ada, const float* b_ada, float* modp, LAS float* red  , int item, int wave, int lane) {
    const int j = item * 64 + lane;
    float a0 = 0.f, a1 = 0.f, a2 = 0.f, a3 = 0.f;
#pragma unroll 8
    for (int k = 128 * wave; k < 128 * wave + 128; ++k) {
        const float w = w_ada[(size_t)k * 6144 + j];
        const float c0 = c[k], c1 = c[1024 + k], c2 = c[2048 + k], c3 = c[3072 + k];
        a0 += c0 / (1.f + __expf(-c0)) * w; a1 += c1 / (1.f + __expf(-c1)) * w; a2 += c2 / (1.f + __expf(-c2)) * w; a3 += c3 / (1.f + __expf(-c3)) * w;
    }
    red[(wave * 4 + 0) * 64 + lane] = a0; red[(wave * 4 + 1) * 64 + lane] = a1; red[(wave * 4 + 2) * 64 + lane] = a2; red[(wave * 4 + 3) * 64 + lane] = a3;
    LDS_WAIT(); __syncthreads();
    if (wave < 4) { float s = b_ada[j];
#pragma unroll
        for (int w = 0; w < 8; ++w) s += red[(w * 4 + wave) * 64 + lane];
        modp[wave * 6144 + j] = s; }
    __syncthreads();
}
__device__ __forceinline__ void p0_weff_item(const float* wq, const float* sk, bf16* weff, int item, int lane) {
    const int nq = item & 3, kb = (item >> 2) & 31, hp = item >> 7;
    const int k = kb * 32 + (lane & 31), dh = lane >> 5;
    float w[64];
    const f32x4* src = (const f32x4*)(wq + (size_t)k * 2048 + hp * 128 + 64 * dh);
#pragma unroll
    for (int i = 0; i < 16; ++i) { const f32x4 v = src[i]; w[4 * i] = v.x; w[4 * i + 1] = v.y; w[4 * i + 2] = v.z; w[4 * i + 3] = v.w; }
#pragma unroll 1
    for (int n = nq * 32; n < nq * 32 + 32; n += 2) {
        float acc[2] = {0.f, 0.f};
#pragma unroll
        for (int u = 0; u < 2; ++u) {
            const f32x4* s = (const f32x4*)(sk + ((size_t)hp * 128 + n + u) * 128 + 64 * dh);
#pragma unroll
            for (int d = 0; d < 16; ++d) { const f32x4 s4 = s[d]; acc[u] += w[4 * d] * s4.x; acc[u] += w[4 * d + 1] * s4.y; acc[u] += w[4 * d + 2] * s4.z; acc[u] += w[4 * d + 3] * s4.w; }
        }
#pragma unroll
        for (int u = 0; u < 2; ++u) { acc[u] += __shfl_xor(acc[u], 32); if (dh == 0) weff[((size_t)hp * 128 + n + u) * 1024 + k] = (bf16)f2bf(acc[u]); }
    }
}
template <int NR> __device__ __forceinline__ void rms_mod_rows(const float* xrow, bf16* orow, unsigned* o8row  , const float* g, const float* sc, const float* sh, int lane) {
    f32x4 v[NR][4]; float ss[NR];
#pragma unroll
    for (int rr = 0; rr < NR; ++rr) { const f32x4* xr = (const f32x4*)(xrow + (size_t)rr * 1024) + lane; ss[rr] = 0.f;
#pragma unroll
        for (int j = 0; j < 4; ++j) v[rr][j] = xr[64 * j]; }
#pragma unroll
    for (int rr = 0; rr < NR; ++rr)
#pragma unroll
        for (int j = 0; j < 4; ++j) ss[rr] += (v[rr][j].x * v[rr][j].x + v[rr][j].y * v[rr][j].y) + (v[rr][j].z * v[rr][j].z + v[rr][j].w * v[rr][j].w);
#pragma unroll
    for (int o = 1; o < 64; o <<= 1) {
#pragma unroll
        for (int rr = 0; rr < NR; ++rr) ss[rr] += __shfl_xor(ss[rr], o);
    }
#pragma unroll
    for (int j = 0; j < 4; ++j) { const int col = 4 * lane + 256 * j;
        const f32x4 g4 = *(const f32x4*)(g + col), s4 = *(const f32x4*)(sc + col), h4 = *(const f32x4*)(sh + col);
#pragma unroll
        for (int rr = 0; rr < NR; ++rr) {
            const float rstd = 1.f / sqrtf(ss[rr] * (1.f / 1024.f) + RMS_EPS);
            const float o0 = v[rr][j].x * rstd * g4.x * (1.f + s4.x) + h4.x, o1 = v[rr][j].y * rstd * g4.y * (1.f + s4.y) + h4.y;
            const float o2 = v[rr][j].z * rstd * g4.z * (1.f + s4.z) + h4.z, o3 = v[rr][j].w * rstd * g4.w * (1.f + s4.w) + h4.w;
            ((unsigned long long*)(orow + (size_t)rr * 1024))[lane + 64 * j] = (unsigned long long)pk2(o0, o1) | ((unsigned long long)pk2(o2, o3) << 32);
            if (o8row) { int w = 0; w = __builtin_amdgcn_cvt_pk_fp8_f32(fminf(fmaxf(o0 * 8.f, -448.f), 448.f), fminf(fmaxf(o1 * 8.f, -448.f), 448.f), w, false);
                w = __builtin_amdgcn_cvt_pk_fp8_f32(fminf(fmaxf(o2 * 8.f, -448.f), 448.f), fminf(fmaxf(o3 * 8.f, -448.f), 448.f), w, true); (o8row + (size_t)rr * 256)[lane + 64 * j] = (unsigned)w; }
        }
    }
}

__device__ __forceinline__ v4u pack8(const f32x4 a, const f32x4 b) { v4u w; w.x = pk2(a.x, a.y); w.y = pk2(a.z, a.w); w.z = pk2(b.x, b.y); w.w = pk2(b.z, b.w); return w; }
__device__ __forceinline__ size_t gt_off(int pm, int pt, int frag, int wave, int lane) { return ((((size_t)(pm * 8 + pt) * 16 + frag) * 8 + wave) * 64 + lane) * 8; }
struct EpiIn {
    static constexpr bool PERM = true, AFTER_DRAIN = false, HAS_MID = false;
    bf16 *Q, *K, *VT, *ZRKV, *ZLORA, *GT;
    __device__ __forceinline__ void operator()(const f32x4 (&acc)[2][2][4][2], const pg8::Unit& u, int wr, int wc, int fr, int fq) const {
        const int pn = u.pn;
#pragma unroll
        for (int ai = 0; ai < 2; ++ai)
#pragma unroll
            for (int m = 0; m < 4; ++m) {
                const int row = u.pm * 256 + ai * 128 + wr * 64 + m * 16 + fr;
                const int b = row >> 13, s = row & 8191;
#pragma unroll
                for (int bj = 0; bj < 2; ++bj) {
                    const int colt = bj * 128 + wc * 32 + 8 * fq;
                    const f32x4 v0 = acc[ai][bj][m][0], v1 = acc[ai][bj][m][1];
                    if (pn < 4) {
                        bf16* base = pn < 2 ? Q : K; const int h = 4 * (pn & 1) + (colt >> 6), d0 = colt & 63;
                        *(v4u*)(base + ((size_t)((b * 8 + h) * 8192 + s)) * 64 + d0) = pack8(v0, v1);
                    } else if (pn < 6) {
                        const int h = 4 * (pn - 4) + (colt >> 6), dv0 = colt & 63;
                        bf16* p = VT + ((size_t)((b * 8 + h) * 64 + dv0)) * 8192 + s;
                        p[0 * 8192] = (bf16)f2bf(v0.x); p[1 * 8192] = (bf16)f2bf(v0.y); p[2 * 8192] = (bf16)f2bf(v0.z); p[3 * 8192] = (bf16)f2bf(v0.w);
                        p[4 * 8192] = (bf16)f2bf(v1.x); p[5 * 8192] = (bf16)f2bf(v1.y); p[6 * 8192] = (bf16)f2bf(v1.z); p[7 * 8192] = (bf16)f2bf(v1.w);
                    } else if (pn < 12) {
                        *(v4u*)(ZRKV + (size_t)row * ZR + 256 * (pn - 6) + colt) = pack8(v0, v1);
                    } else if (pn == 12) {
                        *(v4u*)(ZLORA + (size_t)row * ZL + colt) = pack8(v0, v1);
                    } else {
                        f32x4 s0, s1;
                        s0.x = sigmoidf_(v0.x); s0.y = sigmoidf_(v0.y); s0.z = sigmoidf_(v0.z); s0.w = sigmoidf_(v0.w);
                        s1.x = sigmoidf_(v1.x); s1.y = sigmoidf_(v1.y); s1.z = sigmoidf_(v1.z); s1.w = sigmoidf_(v1.w);
                        *(v4u*)(GT + gt_off(u.pm, pn - 13, 0, wr * 4 + wc, fq * 16 + fr) + (size_t)(((ai * 4 + m) * 2 + bj) * 4096)) = pack8(s0, s1);
                    }
                }
            }
    }
};
struct EpiLora {
    static constexpr bool PERM = true, AFTER_DRAIN = false, HAS_MID = false;
    bf16 *EW, *AA, *GG; const float *w0, *a0;
    __device__ __forceinline__ void operator()(const f32x4 (&acc)[2][2][4][2], const pg8::Unit& u, int wr, int wc, int fr, int fq) const {
        const int pn = u.pn;
#pragma unroll
        for (int ai = 0; ai < 2; ++ai)
#pragma unroll
            for (int m = 0; m < 4; ++m) {
                const int row = u.pm * 256 + ai * 128 + wr * 64 + m * 16 + fr;
#pragma unroll
                for (int bj = 0; bj < 2; ++bj) {
                    const int c = 256 * (pn & 1) + bj * 128 + wc * 32 + 8 * fq;
                    const f32x4 v0 = acc[ai][bj][m][0], v1 = acc[ai][bj][m][1];
                    float v[8] = {v0.x, v0.y, v0.z, v0.w, v1.x, v1.y, v1.z, v1.w};
                    bf16* dst;
                    if (pn < 2) {
#pragma unroll
                        for (int i = 0; i < 8; ++i) v[i] = 0.60653065971263342f * sigmoidf_(w0[c + i] + v[i]);
                        dst = EW;
                    } else if (pn < 4) {
#pragma unroll
                        for (int i = 0; i < 8; ++i) v[i] = sigmoidf_(a0[c + i] + v[i]);
                        dst = AA;
                    } else dst = GG;
                    v4u w; w.x = pk2(v[0], v[1]); w.y = pk2(v[2], v[3]); w.z = pk2(v[4], v[5]); w.w = pk2(v[6], v[7]);
                    *(v4u*)(dst + (size_t)row * 512 + c) = w;
                }
            }
    }
};
struct EpiMix {
    static constexpr bool PERM = true, AFTER_DRAIN = false, HAS_MID = true; static constexpr int MID_T = 8;
    const bf16* GT; bf16* MIXED; int probe;
    __device__ __forceinline__ void mid(f32x4 (&acc)[2][2][4][2], const pg8::Unit& u, int wr, int wc, int fr, int fq) const {
        if (probe & 1) return;
        const bf16* pm_ = GT + gt_off(u.pm, u.pn, 0, wr * 4 + wc, fq * 16 + fr); const bf16* pr_ = GT + gt_off(u.pm, u.pn + 4, 0, wr * 4 + wc, fq * 16 + fr);
#pragma unroll
        for (int ai = 0; ai < 2; ++ai)
#pragma unroll
            for (int m = 0; m < 4; ++m)
#pragma unroll
                for (int bj = 0; bj < 2; ++bj) {
                    const v4u gm = *(const v4u*)pm_, gr = *(const v4u*)pr_;
                    pm_ += 4096; pr_ += 4096; asm volatile("" : "+v"(pm_), "+v"(pr_));
                    f32x4 r0, r1;
                    r0.x = bflo(gm.x) * __builtin_amdgcn_rcpf(fmaxf(bflo(gr.x), 1e-30f)); r0.y = bfhi(gm.x) * __builtin_amdgcn_rcpf(fmaxf(bfhi(gr.x), 1e-30f));
                    r0.z = bflo(gm.y) * __builtin_amdgcn_rcpf(fmaxf(bflo(gr.y), 1e-30f)); r0.w = bfhi(gm.y) * __builtin_amdgcn_rcpf(fmaxf(bfhi(gr.y), 1e-30f));
                    r1.x = bflo(gm.z) * __builtin_amdgcn_rcpf(fmaxf(bflo(gr.z), 1e-30f)); r1.y = bfhi(gm.z) * __builtin_amdgcn_rcpf(fmaxf(bfhi(gr.z), 1e-30f));
                    r1.z = bflo(gm.w) * __builtin_amdgcn_rcpf(fmaxf(bflo(gr.w), 1e-30f)); r1.w = bfhi(gm.w) * __builtin_amdgcn_rcpf(fmaxf(bfhi(gr.w), 1e-30f));
                    acc[ai][bj][m][0] = acc[ai][bj][m][0] * r0; acc[ai][bj][m][1] = acc[ai][bj][m][1] * r1;
                }
    }
    __device__ __forceinline__ void operator()(const f32x4 (&acc)[2][2][4][2], const pg8::Unit& u, int wr, int wc, int fr, int fq) const {
        const bf16* pr_ = GT + gt_off(u.pm, u.pn + 4, 0, wr * 4 + wc, fq * 16 + fr);
#pragma unroll
        for (int ai = 0; ai < 2; ++ai)
#pragma unroll
            for (int m = 0; m < 4; ++m) {
                const int row = u.pm * 256 + ai * 128 + wr * 64 + m * 16 + fr;
#pragma unroll
                for (int bj = 0; bj < 2; ++bj) {
                    const int c = u.pn * 256 + bj * 128 + wc * 32 + 8 * fq;
                    v4u g = {0x3f803f80u, 0x3f803f80u, 0x3f803f80u, 0x3f803f80u};
                    if (!(probe & 2)) g = *(const v4u*)pr_;
                    pr_ += 4096; asm volatile("" : "+v"(pr_));
                    const f32x4 v0 = acc[ai][bj][m][0], v1 = acc[ai][bj][m][1];
                    f32x4 o0, o1;
                    o0.x = bflo(g.x) * v0.x; o0.y = bfhi(g.x) * v0.y; o0.z = bflo(g.y) * v0.z; o0.w = bfhi(g.y) * v0.w;
                    o1.x = bflo(g.z) * v1.x; o1.y = bfhi(g.z) * v1.y; o1.z = bflo(g.w) * v1.z; o1.w = bfhi(g.w) * v1.w;
                    *(v4u*)(MIXED + (size_t)row * 1024 + c) = pack8(o0, o1);
                }
            }
    }
};
struct EpiOut {
    static constexpr bool PERM = true, AFTER_DRAIN = false, HAS_MID = false;
    const float* X; const float* MOD; float* OUT;
    __device__ __forceinline__ void operator()(const f32x4 (&acc)[2][2][4][2], const pg8::Unit& u, int wr, int wc, int fr, int fq) const {
#pragma unroll
        for (int ai = 0; ai < 2; ++ai)
#pragma unroll
            for (int m = 0; m < 4; ++m) {
                const int row = u.pm * 256 + ai * 128 + wr * 64 + m * 16 + fr;
                const float* gt1 = MOD + (size_t)(row >> 13) * 6144 + 2048;
#pragma unroll
                for (int bj = 0; bj < 2; ++bj) {
                    const int c = u.pn * 256 + bj * 128 + wc * 32 + 8 * fq;
                    const float* xp = X + (size_t)row * 1024 + c;
                    const f32x4 x0 = *(const f32x4*)xp, x1 = *(const f32x4*)(xp + 4);
                    const f32x4 g0 = *(const f32x4*)(gt1 + c), g1 = *(const f32x4*)(gt1 + c + 4);
                    const f32x4 v0 = acc[ai][bj][m][0], v1 = acc[ai][bj][m][1];
                    float* d = OUT + (size_t)row * 1024 + c;
                    *(f32x4*)d = x0 + g0 * v0; *(f32x4*)(d + 4) = x1 + g1 * v1;
                }
            }
    }
};
struct EpiScores {
    static constexpr bool PERM = true, AFTER_DRAIN = false, HAS_MID = false;
    bf16* SC;
    __device__ __forceinline__ void operator()(const f32x4 (&acc)[2][2][4][2], const pg8::Unit& u, int wr, int wc, int fr, int fq) const {
#pragma unroll
        for (int ai = 0; ai < 2; ++ai)
#pragma unroll
            for (int m = 0; m < 4; ++m) {
                const int row = u.pm * 256 + ai * 128 + wr * 64 + m * 16 + fr;
#pragma unroll
                for (int bj = 0; bj < 2; ++bj) {
                    const int c = u.pn * 256 + bj * 128 + wc * 32 + 8 * fq;
                    *(v4u*)(SC + (size_t)row * 2048 + c) = pack8(acc[ai][bj][m][0], acc[ai][bj][m][1]);
                }
            }
    }
};


__device__ __forceinline__ void p2_qk_load(v4u (&raw)[4], int (&ps)[4], const bf16* buf, const int* pos, int bh, int n, int wave, int lane) {
#pragma unroll
    for (int it = 0; it < 4; ++it) { const int row = n * 256 + wave * 32 + it * 8 + (lane >> 3);
        raw[it] = *(const v4u*)(buf + ((size_t)(bh * 8192 + row)) * 64 + 8 * (lane & 7)); ps[it] = pos[(bh >> 3) * 8192 + row]; }
}
__device__ __forceinline__ void p2_qk_item(const v4u (&rawin)[4], const int (&psin)[4], bf16* obuf, const float* g, float* kmean, int bh, int n, LAS float* red, int tid, int wave, int lane) {
    const int c = lane & 7, rsub = lane >> 3;
    float gg[8], ks[8];
#pragma unroll
    for (int i = 0; i < 8; ++i) { gg[i] = g[8 * c + i]; ks[i] = 0.f; }
#pragma unroll
    for (int it = 0; it < 4; ++it) {
        const int row = n * 256 + wave * 32 + it * 8 + rsub;
        const size_t po = ((size_t)(bh * 8192 + row)) * 64 + 8 * c;
        const v4u raw = rawin[it];
        float x[8] = {bflo(raw.x), bfhi(raw.x), bflo(raw.y), bfhi(raw.y), bflo(raw.z), bfhi(raw.z), bflo(raw.w), bfhi(raw.w)};
        float ss = 0.f;
#pragma unroll
        for (int i = 0; i < 8; ++i) ss += x[i] * x[i];
        ss += __shfl_xor(ss, 1); ss += __shfl_xor(ss, 2); ss += __shfl_xor(ss, 4);
        const float rstd = 1.f / sqrtf(ss * (1.f / 64.f) + RMS_EPS);
        float y[8], py[8];
#pragma unroll
        for (int i = 0; i < 8; ++i) y[i] = x[i] * rstd * gg[i];
#pragma unroll
        for (int i = 0; i < 8; ++i) py[i] = __shfl_xor(y[i], 1);
        {
            const float myang = (float)psin[it] * exp2f(-(float)c * (18.931568569324174f / 8.f));
            const float mys = __sinf(myang), myc = __cosf(myang);
            float sn[8], cs[8];
#pragma unroll
            for (int i = 0; i < 8; ++i) { sn[i] = __shfl(mys, (lane & ~7) + i); cs[i] = __shfl(myc, (lane & ~7) + i); }
            if (c < 2) {
#pragma unroll
                for (int i = 0; i < 8; ++i) y[i] = (c == 0) ? (y[i] * cs[i] - py[i] * sn[i]) : (y[i] * cs[i] + py[i] * sn[i]);
            }
        }
        v4u o; o.x = pk2(y[0], y[1]); o.y = pk2(y[2], y[3]); o.z = pk2(y[4], y[5]); o.w = pk2(y[6], y[7]);
        *(v4u*)(obuf + po) = o;
#pragma unroll
        for (int i = 0; i < 8; ++i) ks[i] += y[i];
    }
    if (kmean) {
#pragma unroll
        for (int i = 0; i < 8; ++i) { ks[i] += __shfl_xor(ks[i], 8); ks[i] += __shfl_xor(ks[i], 16); ks[i] += __shfl_xor(ks[i], 32); }
        if (lane < 8) {
#pragma unroll
            for (int i = 0; i < 8; ++i) red[wave * 64 + 8 * lane + i] = ks[i];
        }
        __syncthreads();
        if (tid < 64) { float s = 0.f;
#pragma unroll
            for (int w = 0; w < 8; ++w) s += red[w * 64 + tid];
            kmean[(size_t)(bh * 32 + n) * 64 + tid] = s * (1.f / 256.f); }
        __syncthreads();
    }
}
__device__ __forceinline__ void p2_prep(const bf16* ZL_, const float* mu, bf16* AL, int gtid, int ntot) {
#pragma unroll 2
    for (int idx = gtid; idx < T * 32; idx += ntot) {
        const int t = idx >> 5, col = (idx & 31) * 8, s = t & 8191;
        const v4u cur = *(const v4u*)(ZL_ + (size_t)t * ZL + col);
        v4u prv = *(const v4u*)(ZL_ + (size_t)(s ? t - 1 : t) * ZL + col);
        prv = prv & (s ? 0xffffffffu : 0u);
        const float cz[8] = {bflo(cur.x), bfhi(cur.x), bflo(cur.y), bfhi(cur.y), bflo(cur.z), bfhi(cur.z), bflo(cur.w), bfhi(cur.w)};
        const float pz[8] = {bflo(prv.x), bfhi(prv.x), bflo(prv.y), bfhi(prv.y), bflo(prv.z), bfhi(prv.z), bflo(prv.w), bfhi(prv.w)};
        float o[8];
#pragma unroll
        for (int i = 0; i < 8; ++i) { const float z = cz[i] + (pz[i] - cz[i]) * mu[1536 + col + i];
            o[i] = (col < 64) ? tanhf(z) : ((col < 128) ? z : sigmoidf_(z)); }
        v4u w; w.x = pk2(o[0], o[1]); w.y = pk2(o[2], o[3]); w.z = pk2(o[4], o[5]); w.w = pk2(o[6], o[7]);
        *(v4u*)(AL + (size_t)t * ZL + col) = w;
    }
}

__device__ __forceinline__ void p3_top3_item(const bf16* Q, const float* kmean, unsigned* cursor, unsigned* lists, int bh0, int qb, LAS float* kmbase, int tid, int wave, int lane) {
    if (qb == 0) return;
    const int hf = wave >> 2, bh = bh0 + hf, w4 = wave & 3;
    LAS float* km = kmbase + hf * 2048;
    for (int i = (tid & 255); i < qb * 64; i += 256) km[i] = kmean[(size_t)bh * 2048 + i];
    __syncthreads();
    {
        const int s = qb * 256 + w4 * 64 + lane;
        float q[64];
        const v4u* qp = (const v4u*)(Q + ((size_t)(bh * 8192 + s)) * 64);
#pragma unroll
        for (int i = 0; i < 8; ++i) { const v4u r = qp[i];
            q[8 * i] = bflo(r.x); q[8 * i + 1] = bfhi(r.x); q[8 * i + 2] = bflo(r.y); q[8 * i + 3] = bfhi(r.y);
            q[8 * i + 4] = bflo(r.z); q[8 * i + 5] = bfhi(r.z); q[8 * i + 6] = bflo(r.w); q[8 * i + 7] = bfhi(r.w); }
        float v0 = -INFINITY, v1 = -INFINITY, v2 = -INFINITY; int i0 = -1, i1 = -1, i2 = -1;
        for (int n = 0; n < qb; ++n) {
            float dot = 0.f;
#pragma unroll
            for (int d4 = 0; d4 < 16; ++d4) { const f32x4 kk = *(const LAS f32x4*)(km + n * 64 + 4 * d4);
                dot += q[4 * d4] * kk.x; dot += q[4 * d4 + 1] * kk.y; dot += q[4 * d4 + 2] * kk.z; dot += q[4 * d4 + 3] * kk.w; }
            if (dot > v0) { v2 = v1; i2 = i1; v1 = v0; i1 = i0; v0 = dot; i0 = n; }
            else if (dot > v1) { v2 = v1; i2 = i1; v1 = dot; i1 = n; }
            else if (dot > v2) { v2 = dot; i2 = n; }
        }
        for (int n = 0; n < qb; ++n) {
            const int slot = (i0 == n) ? 0 : ((i1 == n) ? 1 : ((i2 == n) ? 2 : -1));
            const unsigned long long mask = __ballot(slot >= 0);
            if (mask == 0ull) continue;
            const unsigned cnt = (unsigned)__popcll(mask);
            unsigned base = 0u;
            if (lane == 0) base = __hip_atomic_fetch_add(cursor + bh * 32 + n, cnt, RLX_AGENT);
            base = (unsigned)__shfl((int)base, 0);
            if (slot >= 0) { const unsigned pos = base + (unsigned)__popcll(mask & ((1ull << lane) - 1ull));
                lists[(size_t)bh * LIST_PER_BH + list_off(n) + pos] = ((unsigned)s << 2) | (unsigned)slot; }
        }
    }
    __syncthreads();
}

template <int CTRL> __device__ __forceinline__ float dppf(float v) { return __builtin_bit_cast(float, __builtin_amdgcn_update_dpp(0, __builtin_bit_cast(int, v), CTRL, 0xF, 0xF, true)); }
__device__ __forceinline__ float allreduce16(float v) {
    v += dppf<0xB1>(v); v += dppf<0x4E>(v); v += dppf<0x141>(v); v += dppf<0x140>(v); return v;
}
constexpr int CK = 64, NCHK = SEQ / CK, CS = 72, SLOT = CK * CS;
__device__ __forceinline__ int sx(int row, int col) { return row * CS + (((col >> 3) ^ ((row >> 4) & 3)) << 3) + (col & 7); }
struct ScanRaw { v4u zr, zk, zv, pr, pk, pv, a, ew; };
__device__ __forceinline__ void scan_load(ScanRaw& R, const bf16* Z, const bf16* AA, const bf16* EW, int b, int hc0, int t) {
    const bf16* p = Z + (size_t)(b * 8192 + t) * ZR + hc0;
    const bf16* pp = (t > 0) ? p - ZR : p;
    R.zr = *(const v4u*)p; R.zk = *(const v4u*)(p + 512); R.zv = *(const v4u*)(p + 1024);
    R.pr = *(const v4u*)pp; R.pk = *(const v4u*)(pp + 512); R.pv = *(const v4u*)(pp + 1024);
    const unsigned m = (t > 0) ? 0xffffffffu : 0u;
    R.pr = R.pr & m; R.pk = R.pk & m; R.pv = R.pv & m;
    const size_t o = (size_t)(b * 8192 + t) * 512 + hc0;
    R.a = *(const v4u*)(AA + o); R.ew = *(const v4u*)(EW + o);
}
__device__ __forceinline__ void unpack8(const v4u w, float (&f)[8]) { f[0] = bflo(w.x); f[1] = bfhi(w.x); f[2] = bflo(w.y); f[3] = bfhi(w.y); f[4] = bflo(w.z); f[5] = bfhi(w.z); f[6] = bflo(w.w); f[7] = bfhi(w.w); }
__device__ __forceinline__ v4u pack8f(const float (&f)[8]) { v4u w; w.x = cvtpk(f[0], f[1]); w.y = cvtpk(f[2], f[3]); w.z = cvtpk(f[4], f[5]); w.w = cvtpk(f[6], f[7]); return w; }
__device__ __forceinline__ f32x4 mm_tile(const LAS bf16* A, const LAS bf16* BT, int mt, int nt, int r, int q, f32x4 acc) {
#pragma unroll
    for (int ks = 0; ks < 2; ++ks) {
        const bf16x8 a = *(const LAS bf16x8*)(A + sx(16 * mt + r, 32 * ks + 8 * q));
        const bf16x8 b = *(const LAS bf16x8*)(BT + sx(16 * nt + r, 32 * ks + 8 * q));
        acc = __builtin_amdgcn_mfma_f32_16x16x32_bf16(a, b, acc, 0, 0, 0);
    }
    return acc;
}
struct PairF { bf16x8 b0, b1, a00, a01, a10, a11; };
__device__ __forceinline__ void mm_load(PairF& f, const LAS bf16* A, const LAS bf16* BT, int mt, int nt, int r, int q) {
    f.b0 = *(const LAS bf16x8*)(BT + sx(16 * nt + r, 8 * q)); f.b1 = *(const LAS bf16x8*)(BT + sx(16 * nt + r, 32 + 8 * q));
    f.a00 = *(const LAS bf16x8*)(A + sx(16 * mt + r, 8 * q)); f.a01 = *(const LAS bf16x8*)(A + sx(16 * mt + r, 32 + 8 * q));
    f.a10 = *(const LAS bf16x8*)(A + sx(16 * mt + 32 + r, 8 * q)); f.a11 = *(const LAS bf16x8*)(A + sx(16 * mt + 32 + r, 32 + 8 * q));
}
__device__ __forceinline__ void mm_mul(const PairF& f, f32x4& c0, f32x4& c1) {
    c0 = __builtin_amdgcn_mfma_f32_16x16x32_bf16(f.a00, f.b0, c0, 0, 0, 0); c1 = __builtin_amdgcn_mfma_f32_16x16x32_bf16(f.a10, f.b0, c1, 0, 0, 0);
    c0 = __builtin_amdgcn_mfma_f32_16x16x32_bf16(f.a01, f.b1, c0, 0, 0, 0); c1 = __builtin_amdgcn_mfma_f32_16x16x32_bf16(f.a11, f.b1, c1, 0, 0, 0);
}
__device__ __forceinline__ void mm_pair(const LAS bf16* A, const LAS bf16* BT, int mt, int nt, int r, int q, f32x4& c0, f32x4& c1) { PairF f; mm_load(f, A, BT, mt, nt, r, q); mm_mul(f, c0, c1); }
__device__ __forceinline__ void st_T(LAS bf16* D, int mt, int nt, int r, int q, const f32x4 v) {
    v2u w; w.x = cvtpk(v.x, v.y); w.y = cvtpk(v.z, v.w);
    *(LAS v2u*)(D + sx(16 * nt + r, 16 * mt + 4 * q)) = w;
}
__device__ __forceinline__ void st_Tg(bf16* D  , int mt, int nt, int r, int q, const f32x4 v) {
    v2u w; w.x = cvtpk(v.x, v.y); w.y = cvtpk(v.z, v.w);
    *(v2u*)(D + (16 * nt + r) * 64 + 16 * mt + 4 * q) = w;
}
__device__ __forceinline__ f32x4 mask_lt(f32x4 v, int R0, int Cc, bool incl) {
    const int lim = incl ? Cc + 1 : Cc;
    v.x = (R0 < lim) ? v.x : 0.f; v.y = (R0 + 1 < lim) ? v.y : 0.f; v.z = (R0 + 2 < lim) ? v.z : 0.f; v.w = (R0 + 3 < lim) ? v.w : 0.f; return v;
}
__device__ __forceinline__ void rwkv_cp_item(const bf16* Z, const bf16* AAg, const bf16* EWg, const float* mu, const float* k_k, const float* k_a,
                                             bf16* RW, bf16* MM, bf16* Y0T, bf16* GAT, float* PC, int chain, int c, ScanRaw& R, int nchain, int nc, LAS unsigned char* lds, int tid, int wave, int lane, int probe) {
    LAS bf16* S_ = (LAS bf16*)lds;
#define SL(k) (S_ + (k) * SLOT)
    LAS float* Ef = (LAS float*)(SL(12));
    LAS float* Red = (LAS float*)(SL(8));
    LAS float* Seg = Red + 8 * 64;
    constexpr int EFS = 68;
    const int b = chain >> 3, h = chain & 7;
    const int r = lane & 15, q = lane >> 4;
    __syncthreads();
    const int t = tid >> 3, c0 = (tid & 7) * 8, hc0 = h * 64 + c0;
    float rr[8], k2[8], al[8], be[8], vv[8], kkr[8], aa[8];
    {
        float zr[8], zk[8], zv[8], pr[8], pk[8], pv[8], a[8], ew[8];
        unpack8(R.zr, zr); unpack8(R.zk, zk); unpack8(R.zv, zv); unpack8(R.pr, pr); unpack8(R.pk, pk); unpack8(R.pv, pv); unpack8(R.a, a); unpack8(R.ew, ew);
        scan_load(R, Z, AAg, EWg, nchain >> 3, (nchain & 7) * 64 + c0, nc * CK + t);
        float ss = 0.f;
#pragma unroll
        for (int i = 0; i < 8; ++i) { aa[i] = a[i]; rr[i] = zr[i] + (pr[i] - zr[i]) * mu[hc0 + i]; const float k = zk[i] + (pk[i] - zk[i]) * mu[512 + hc0 + i]; vv[i] = zv[i] + (pv[i] - zv[i]) * mu[1024 + hc0 + i];
            kkr[i] = k * k_k[hc0 + i]; ss += kkr[i] * kkr[i]; k2[i] = k * (1.f + (a[i] - 1.f) * k_a[hc0 + i]); }
        ss += dppf<0xB1>(ss); ss += dppf<0x4E>(ss); ss += dppf<0x141>(ss);
        if ((tid & 7) == 0) Red[t] = ss;
        *(LAS f32x4*)(Ef + t * EFS + c0) = (f32x4){ew[0], ew[1], ew[2], ew[3]}; *(LAS f32x4*)(Ef + t * EFS + c0 + 4) = (f32x4){ew[4], ew[5], ew[6], ew[7]};
    }
    LDS_WAIT(); __syncthreads();
    {
        const int seg = tid >> 6, j = tid & 63; float s = 0.f;
#pragma unroll
        for (int u = 0; u < 8; ++u) { s += Ef[(8 * seg + u) * EFS + j]; Ef[(8 * seg + u) * EFS + j] = s; }
        Seg[seg * 64 + j] = s;
    }
    LDS_WAIT(); __syncthreads();
    {
        { const float ss = Red[t];
          const float inrm = 1.f / fmaxf(sqrtf(ss), 1e-12f);
#pragma unroll
          for (int i = 0; i < 8; ++i) { const float kk = kkr[i] * inrm; al[i] = -kk; be[i] = kk * aa[i]; } }
        float off[8], Et[8], Ep[8];
#pragma unroll
        for (int i = 0; i < 8; ++i) off[i] = 0.f;
        for (int sg = 0; sg < (t >> 3); ++sg) {
            const f32x4 s0 = *(const LAS f32x4*)(Seg + sg * 64 + c0), s1 = *(const LAS f32x4*)(Seg + sg * 64 + c0 + 4);
            off[0] += s0.x; off[1] += s0.y; off[2] += s0.z; off[3] += s0.w; off[4] += s1.x; off[5] += s1.y; off[6] += s1.z; off[7] += s1.w;
        }
        { const f32x4 e0 = *(const LAS f32x4*)(Ef + t * EFS + c0), e1 = *(const LAS f32x4*)(Ef + t * EFS + c0 + 4);
          Et[0] = e0.x + off[0]; Et[1] = e0.y + off[1]; Et[2] = e0.z + off[2]; Et[3] = e0.w + off[3]; Et[4] = e1.x + off[4]; Et[5] = e1.y + off[5]; Et[6] = e1.z + off[6]; Et[7] = e1.w + off[7]; }
        if (t & 7) { const f32x4 e0 = *(const LAS f32x4*)(Ef + (t - 1) * EFS + c0), e1 = *(const LAS f32x4*)(Ef + (t - 1) * EFS + c0 + 4);
          Ep[0] = e0.x + off[0]; Ep[1] = e0.y + off[1]; Ep[2] = e0.z + off[2]; Ep[3] = e0.w + off[3]; Ep[4] = e1.x + off[4]; Ep[5] = e1.y + off[5]; Ep[6] = e1.z + off[6]; Ep[7] = e1.w + off[7]; }
        else {
#pragma unroll
            for (int i = 0; i < 8; ++i) Ep[i] = off[i];
        }
        float at[8], bt[8], kt[8], rt[8];
#pragma unroll
        for (int i = 0; i < 8; ++i) { const float ep = __expf(Et[i]), en = __expf(-Et[i]); at[i] = al[i] * __expf(-Ep[i]); bt[i] = be[i] * ep; kt[i] = k2[i] * ep; rt[i] = rr[i] * en; }
        *(LAS v4u*)(SL(0) + sx(t, c0)) = pack8f(at); *(LAS v4u*)(SL(1) + sx(t, c0)) = pack8f(bt); *(LAS v4u*)(SL(2) + sx(t, c0)) = pack8f(kt); *(LAS v4u*)(SL(3) + sx(t, c0)) = pack8f(rt);
#pragma unroll
        for (int i = 0; i < 8; ++i) { SL(4)[sx(c0 + i, t)] = (bf16)f2bf(at[i]); SL(5)[sx(c0 + i, t)] = (bf16)f2bf(bt[i]); SL(6)[sx(c0 + i, t)] = (bf16)f2bf(kt[i]); SL(7)[sx(c0 + i, t)] = (bf16)f2bf(vv[i]); }
        if (t == CK - 1) { *(f32x4*)(PC + c0) = (f32x4){__expf(-Et[0]), __expf(-Et[1]), __expf(-Et[2]), __expf(-Et[3])}; *(f32x4*)(PC + c0 + 4) = (f32x4){__expf(-Et[4]), __expf(-Et[5]), __expf(-Et[6]), __expf(-Et[7])}; }
    }
    LDS_WAIT(); __syncthreads();
    if (probe == 4) return;
    const f32x4 z4 = {0.f, 0.f, 0.f, 0.f};
    const int mt = wave >> 2, nt = wave & 3, Cc = 16 * nt + r, R0 = 16 * mt + 4 * q, R1 = R0 + 32;
    { PairF f0, f1, f2, f3, f4;
      mm_load(f0, SL(0), SL(1), mt, nt, r, q); mm_load(f1, SL(1), SL(0), mt, nt, r, q); mm_load(f2, SL(2), SL(0), mt, nt, r, q); mm_load(f3, SL(1), SL(3), mt, nt, r, q); mm_load(f4, SL(2), SL(3), mt, nt, r, q);
      f32x4 a0 = z4, a1 = z4, b0 = z4, b1 = z4, c0 = z4, c1 = z4, d0 = z4, d1 = z4, e0 = z4, e1 = z4;
      mm_mul(f0, a0, a1); mm_mul(f1, b0, b1); mm_mul(f2, c0, c1); mm_mul(f3, d0, d1); mm_mul(f4, e0, e1);
      a0.x = (Cc < R0) ? a0.x : 0.f; a0.y = (Cc < R0 + 1) ? a0.y : 0.f; a0.z = (Cc < R0 + 2) ? a0.z : 0.f; a0.w = (Cc < R0 + 3) ? a0.w : 0.f;
      a1.x = (Cc < R1) ? a1.x : 0.f; a1.y = (Cc < R1 + 1) ? a1.y : 0.f; a1.z = (Cc < R1 + 2) ? a1.z : 0.f; a1.w = (Cc < R1 + 3) ? a1.w : 0.f;
      st_T(SL(12), mt, nt, r, q, a0); st_T(SL(12), mt + 2, nt, r, q, a1);
      b0 = mask_lt(b0, R0, Cc, false); b1 = mask_lt(b1, R1, Cc, false);
      st_T(SL(11), mt, nt, r, q, b0); st_T(SL(11), mt + 2, nt, r, q, b1);
      b0.x += (R0 == Cc) ? 1.f : 0.f; b0.y += (R0 + 1 == Cc) ? 1.f : 0.f; b0.z += (R0 + 2 == Cc) ? 1.f : 0.f; b0.w += (R0 + 3 == Cc) ? 1.f : 0.f;
      b1.x += (R1 == Cc) ? 1.f : 0.f; b1.y += (R1 + 1 == Cc) ? 1.f : 0.f; b1.z += (R1 + 2 == Cc) ? 1.f : 0.f; b1.w += (R1 + 3 == Cc) ? 1.f : 0.f;
      st_T(SL(13), mt, nt, r, q, b0); st_T(SL(13), mt + 2, nt, r, q, b1);
      st_T(SL(8), mt, nt, r, q, mask_lt(c0, R0, Cc, false)); st_T(SL(8), mt + 2, nt, r, q, mask_lt(c1, R1, Cc, false));
      st_T(SL(9), mt, nt, r, q, mask_lt(d0, R0, Cc, true)); st_T(SL(9), mt + 2, nt, r, q, mask_lt(d1, R1, Cc, true));
      st_T(SL(10), mt, nt, r, q, mask_lt(e0, R0, Cc, true)); st_T(SL(10), mt + 2, nt, r, q, mask_lt(e1, R1, Cc, true)); }
    LDS_WAIT(); __syncthreads();
    if (probe == 3) return;
    for (int m = (probe == 2 ? 6 : 0); m < 6; ++m) {
        const int ln = (m & 1) ? 0 : 11, ltn = ln + 1, l2 = (m & 1) ? 11 : 0;
        const int tsrc = (m & 1) ? 13 : 2, tdst = (m & 1) ? 2 : 13;
        PairF f0, f1, f2; v2u o0 = {0u, 0u}, o1 = {0u, 0u};
        if (m < 5) { mm_load(f0, SL(ltn), SL(ln), mt, nt, r, q); mm_load(f1, SL(ln), SL(ltn), mt, nt, r, q); }
        if (m >= 1) { mm_load(f2, SL(ltn), SL(tsrc), mt, nt, r, q);
            o0 = *(const LAS v2u*)(SL(tsrc) + sx(16 * nt + r, 16 * mt + 4 * q)); o1 = *(const LAS v2u*)(SL(tsrc) + sx(16 * nt + r, 16 * mt + 32 + 4 * q)); }
        if (m < 5) { f32x4 a0 = z4, a1 = z4, b0 = z4, b1 = z4; mm_mul(f0, a0, a1); mm_mul(f1, b0, b1);
            st_T(SL(l2), mt, nt, r, q, a0); st_T(SL(l2), mt + 2, nt, r, q, a1);
            st_T(SL(l2 + 1), mt, nt, r, q, b0); st_T(SL(l2 + 1), mt + 2, nt, r, q, b1); }
        if (m >= 1) { f32x4 c0 = {bflo(o0.x), bfhi(o0.x), bflo(o0.y), bfhi(o0.y)}, c1 = {bflo(o1.x), bfhi(o1.x), bflo(o1.y), bfhi(o1.y)};
            mm_mul(f2, c0, c1); st_T(SL(tdst), mt, nt, r, q, c0); st_T(SL(tdst), mt + 2, nt, r, q, c1); }
        LDS_WAIT(); __syncthreads();
    }
    { PairF f0, f1; mm_load(f0, SL(2), SL(4), mt, nt, r, q); mm_load(f1, SL(8), SL(7), mt, nt, r, q);
      f32x4 a0 = z4, a1 = z4, b0 = z4, b1 = z4; mm_mul(f0, a0, a1); mm_mul(f1, b0, b1);
      st_T(SL(11), mt, nt, r, q, a0); st_T(SL(11), mt + 2, nt, r, q, a1);
      st_T(SL(12), mt, nt, r, q, b0); st_T(SL(12), mt + 2, nt, r, q, b1); }
    LDS_WAIT(); __syncthreads();
    { PairF f0, f1, f2; mm_load(f0, SL(2), SL(12), mt, nt, r, q); mm_load(f1, SL(11), SL(9), mt, nt, r, q); mm_load(f2, SL(11), SL(5), mt, nt, r, q);
      const v2u o0 = *(const LAS v2u*)(SL(3) + sx(16 * nt + r, 16 * mt + 4 * q)), o1 = *(const LAS v2u*)(SL(3) + sx(16 * nt + r, 16 * mt + 32 + 4 * q));
      f32x4 a0 = z4, a1 = z4, b0 = {bflo(o0.x), bfhi(o0.x), bflo(o0.y), bfhi(o0.y)}, b1 = {bflo(o1.x), bfhi(o1.x), bflo(o1.y), bfhi(o1.y)}, c0 = z4, c1 = z4;
      mm_mul(f0, a0, a1); mm_mul(f1, b0, b1); mm_mul(f2, c0, c1);
      st_T(SL(13), mt, nt, r, q, a0); st_T(SL(13), mt + 2, nt, r, q, a1);
      st_Tg(RW, mt, nt, r, q, b0); st_Tg(RW, mt + 2, nt, r, q, b1);
      st_Tg(MM, mt, nt, r, q, c0); st_Tg(MM, mt + 2, nt, r, q, c1); }
    LDS_WAIT(); __syncthreads();
    { PairF f0, f1, f2, f3; mm_load(f0, SL(9), SL(13), mt, nt, r, q); mm_load(f1, SL(10), SL(7), mt, nt, r, q); mm_load(f2, SL(5), SL(13), mt, nt, r, q); mm_load(f3, SL(6), SL(7), mt, nt, r, q);
      f32x4 a0 = z4, a1 = z4, b0 = z4, b1 = z4; mm_mul(f0, a0, a1); mm_mul(f2, b0, b1); mm_mul(f1, a0, a1); mm_mul(f3, b0, b1);
      st_Tg(Y0T, mt, nt, r, q, a0); st_Tg(Y0T, mt + 2, nt, r, q, a1);
      st_Tg(GAT, mt, nt, r, q, b0); st_Tg(GAT, mt + 2, nt, r, q, b1); }
#undef SL
}
__device__ __forceinline__ void rwkv_seq(const bf16* RW, const bf16* MM, const bf16* Y0T, const bf16* GAT, const float* PC, bf16* Y, int sid, LAS unsigned char* lds, int tid, int wave, int lane) {
    const int chain = sid >> 2, g4 = sid & 3, b = chain >> 3, h = chain & 7;
    const int r = lane & 15, q = lane >> 4, tw = wave & 3;
    LAS bf16* HT = (LAS bf16*)lds;
    for (int i = tid; i < 2 * 16 * CS / 2; i += NTHR) ((LAS unsigned*)HT)[i] = 0u;
    LDS_WAIT(); __syncthreads();
    f32x4 Hreg = {0.f, 0.f, 0.f, 0.f};
    const bool isH = wave < 4;
    const bf16* Abase = isH ? MM : RW;
    const bf16* Ebase = isH ? GAT : Y0T;
    const size_t ci0 = (size_t)chain * NCHK;
    struct SeqOp { bf16x8 a0, a1; v2u ad; f32x4 pc; };
    SeqOp op[4];
#define SEQ_LD(S, C) do { const size_t ci_ = ci0 + (C); const bf16* ap_ = Abase + ci_ * 4096 + (16 * tw + r) * 64 + 8 * q; S.a0 = *(const bf16x8*)ap_; S.a1 = *(const bf16x8*)(ap_ + 32); \
        S.ad = *(const v2u*)(Ebase + ci_ * 4096 + (16 * g4 + r) * 64 + 16 * tw + 4 * q); S.pc = *(const f32x4*)(PC + ci_ * 64 + 16 * tw + 4 * q); } while (0)
#define SEQ_STEP(S, C) do { const LAS bf16* hb = HT + ((C) & 1) * 16 * CS; \
        const bf16x8 b0 = *(const LAS bf16x8*)(hb + r * CS + 8 * q), b1 = *(const LAS bf16x8*)(hb + r * CS + 32 + 8 * q); \
        f32x4 acc = {bflo(S.ad.x), bfhi(S.ad.x), bflo(S.ad.y), bfhi(S.ad.y)}; \
        acc = __builtin_amdgcn_mfma_f32_16x16x32_bf16(S.a0, b0, acc, 0, 0, 0); acc = __builtin_amdgcn_mfma_f32_16x16x32_bf16(S.a1, b1, acc, 0, 0, 0); \
        const f32x4 pcc = S.pc; \
        SEQ_LD(S, ((C) + 4 < NCHK ? (C) + 4 : NCHK - 1));            \
        if (isH) { Hreg = pcc * (Hreg + acc); v2u w; w.x = cvtpk(Hreg.x, Hreg.y); w.y = cvtpk(Hreg.z, Hreg.w); \
            *(LAS v2u*)(HT + (((C) + 1) & 1) * 16 * CS + r * CS + 16 * tw + 4 * q) = w; } \
        else { bf16* yp = Y + ((size_t)(b * 8192 + (C) * CK + 16 * tw + 4 * q)) * OSTR + h * 64 + 16 * g4 + r; \
            yp[0] = (bf16)f2bf(acc.x); yp[OSTR] = (bf16)f2bf(acc.y); yp[2 * OSTR] = (bf16)f2bf(acc.z); yp[3 * OSTR] = (bf16)f2bf(acc.w); } \
        LDS_WAIT(); __syncthreads(); } while (0)
    SEQ_LD(op[0], 0); SEQ_LD(op[1], 1); SEQ_LD(op[2], 2); SEQ_LD(op[3], 3);
#pragma unroll 1
    for (int c = 0; c < NCHK; c += 4) { SEQ_STEP(op[0], c); SEQ_STEP(op[1], c + 1); SEQ_STEP(op[2], c + 2); SEQ_STEP(op[3], c + 3); }
#undef SEQ_LD
#undef SEQ_STEP
}

__device__ __forceinline__ int crow(int r, int hi) { return (r & 3) + 8 * (r >> 2) + 4 * hi; }
constexpr int AT_KT_STRIDE = 72, AT_VL_STRIDE = 260, AT_VL_OFF = 256 * AT_KT_STRIDE * 2, AT_MISC_OFF = AT_VL_OFF + 64 * AT_VL_STRIDE * 2;
struct AttnStage { v4u k[4], v[4]; };
__device__ __forceinline__ void attn_stage_load(AttnStage& S, const bf16* K, const bf16* VT, int bh, int blk, int tid) {
#pragma unroll
    for (int i = 0; i < 4; ++i) { const int idx = tid + NTHR * i, row = idx >> 3, c8 = idx & 7;
        S.k[i] = *(const v4u*)(K + ((size_t)(bh * 8192 + blk * 256 + row)) * 64 + 8 * c8); }
#pragma unroll
    for (int i = 0; i < 4; ++i) { const int idx = tid + NTHR * i, dv = idx >> 5, c = idx & 31;
        S.v[i] = *(const v4u*)(VT + ((size_t)(bh * 64 + dv)) * 8192 + blk * 256 + 8 * c); }
}
__device__ __forceinline__ void attn_stage_store(const AttnStage& S, LAS unsigned char* buf, int tid) {
    LAS bf16* KT = (LAS bf16*)buf; LAS bf16* VL = (LAS bf16*)(buf + AT_VL_OFF);
#pragma unroll
    for (int i = 0; i < 4; ++i) { const int idx = tid + NTHR * i, row = idx >> 3, c8 = idx & 7; *(LAS v4u*)(KT + row * AT_KT_STRIDE + 8 * c8) = S.k[i]; }
#pragma unroll
    for (int i = 0; i < 4; ++i) { const int idx = tid + NTHR * i, dv = idx >> 5, c = idx & 31;
        LAS v2u* d = (LAS v2u*)(VL + dv * AT_VL_STRIDE + 8 * c);
        v2u lo = {S.v[i].x, S.v[i].y}, hi = {S.v[i].z, S.v[i].w}; d[0] = lo; d[1] = hi; }
}
__device__ __forceinline__ void attn_tile(const bf16x8 (&qf)[4], const LAS bf16* KT, const LAS bf16* VL, int kt0, int nkt, int dkt, int ql, int half, float c1, float c2, f32x16 (&O)[2], float& lsum) {
    for (int kt = kt0; kt < nkt; ++kt) {
        f32x16 X;
#pragma unroll
        for (int i = 0; i < 16; ++i) X[i] = 0.f;
#pragma unroll
        for (int ks = 0; ks < 4; ++ks) { const bf16x8 kf = *(const LAS bf16x8*)(KT + (32 * kt + ql) * AT_KT_STRIDE + 16 * ks + 8 * half);
            X = __builtin_amdgcn_mfma_f32_32x32x16_bf16(kf, qf[ks], X, 0, 0, 0); }
        float p[16];
#pragma unroll
        for (int i = 0; i < 16; ++i) p[i] = __builtin_amdgcn_exp2f(X[i] * c1 - c2);
        if (kt == dkt) {
#pragma unroll
            for (int i = 0; i < 16; ++i) if (crow(i, half) > ql) p[i] = 0.f;
        }
#pragma unroll
        for (int i = 0; i < 16; ++i) lsum += p[i];
#pragma unroll
        for (int s = 0; s < 2; ++s) {
            v4u pw; pw.x = cvtpk(p[8 * s], p[8 * s + 1]); pw.y = cvtpk(p[8 * s + 2], p[8 * s + 3]); pw.z = cvtpk(p[8 * s + 4], p[8 * s + 5]); pw.w = cvtpk(p[8 * s + 6], p[8 * s + 7]);
            const bf16x8 pa = __builtin_bit_cast(bf16x8, pw);
#pragma unroll
            for (int nt = 0; nt < 2; ++nt) {
                const LAS bf16* vp = VL + (32 * nt + ql) * AT_VL_STRIDE + 32 * kt + 16 * s + 4 * half;
                const s16x4 lo = *(const LAS s16x4*)vp, hi = *(const LAS s16x4*)(vp + 8);
                const bf16x8 vf = __builtin_shufflevector(lo, hi, 0, 1, 2, 3, 4, 5, 6, 7);
                O[nt] = __builtin_amdgcn_mfma_f32_32x32x16_bf16(pa, vf, O[nt], 0, 0, 0);
            }
        }
    }
}
__device__ __forceinline__ int attn_pop(unsigned* queue, unsigned* cursor, volatile LAS int* misc, int tid, int& count) {
    for (;;) {
        __syncthreads();
        if (tid == 0) misc[0] = (int)__hip_atomic_fetch_add(queue, 1u, RLX_AGENT);
        __syncthreads();
        const int item = misc[0];
        if (item >= 992 + 1024) { count = 0; return -1; }
        if (item >= 992) { count = 256; return item; }
        count = (int)__hip_atomic_load(cursor + (item & 31) * 32 + (item >> 5), RLX_AGENT);
        if (count > 0) return item;
    }
}
__device__ __forceinline__ void attn_phase(const bf16* Q, const bf16* K, const bf16* VT, const unsigned* lists, unsigned* cursor, unsigned* queue,
                                           bf16* OPART, float* LPART, bf16* OWN, const float* gq, const float* gk, LAS unsigned char* lds, int tid, int wave, int lane, int probe) {
    constexpr int AT_BUF = AT_MISC_OFF;
    volatile LAS int* misc = (volatile LAS int*)(lds + 2 * AT_BUF);
    float mq = fabsf(gq[lane]), mk = fabsf(gk[lane]);
#pragma unroll
    for (int o = 1; o < 64; o <<= 1) { mq = fmaxf(mq, __shfl_xor(mq, o)); mk = fmaxf(mk, __shfl_xor(mk, o)); }
    const float c1 = 0.125f * 1.4426950408889634f, c2 = 8.f * mq * mk * 1.4426950408889634f;
    const int ql = lane & 31, half = lane >> 5;
    int count = 0, ncount = 0;
    int item = attn_pop(queue, cursor, misc, tid, count);
    AttnStage St;
    if (item >= 0) { attn_stage_load(St, K, VT, item < 992 ? (item & 31) : ((item - 992) & 31), item < 992 ? (item >> 5) : ((item - 992) >> 5), tid); attn_stage_store(St, lds, tid); }
    LDS_WAIT();
    __syncthreads();
    int pb = 0;
    bool have = false; unsigned ent_c = 0u; bf16x8 q_c[4];
    while (item >= 0) {
        int nitem = -1;
        if (tid == 0) { nitem = (int)__hip_atomic_fetch_add(queue, 1u, RLX_AGENT); ncount = 256;
            if (nitem < 992) ncount = (int)__hip_atomic_load(cursor + (nitem & 31) * 32 + (nitem >> 5), RLX_AGENT);
            if (nitem >= 992 + 1024) { nitem = -1; ncount = 0; } }
        bool published = false;
#define ATTN_PUBLISH() do { __syncthreads(); if (tid == 0) { misc[0] = nitem; misc[1] = ncount; } __syncthreads(); nitem = misc[0]; ncount = misc[1]; published = true; \
            { const int li_ = nitem >= 0 ? nitem : item;                                         \
              attn_stage_load(St, K, VT, li_ < 992 ? (li_ & 31) : ((li_ - 992) & 31), li_ < 992 ? (li_ >> 5) : ((li_ - 992) >> 5), tid); } } while (0)
        const LAS bf16* KT = (const LAS bf16*)(lds + pb * AT_BUF); const LAS bf16* VL = (const LAS bf16*)(lds + pb * AT_BUF + AT_VL_OFF);
        const bool own = item >= 992;
        const int bh = own ? ((item - 992) & 31) : (item & 31), blk = own ? ((item - 992) >> 5) : (item >> 5);
        const unsigned* lp = lists + (size_t)bh * LIST_PER_BH + list_off(own ? 0 : blk);
        for (int c = 0;; ++c) {
            const int e0 = own ? 0 : c * 256 + wave * 32;
            if (!own && e0 >= count) break;
            if (!have) {
                if (own) ent_c = (unsigned)(blk * 256 + wave * 32 + ql) << 2;
                else { const int e = e0 + ql; ent_c = lp[e < count ? e : e0]; }
                const bf16* qp = Q + ((size_t)(bh * 8192 + (int)(ent_c >> 2))) * 64 + 8 * half;
#pragma unroll
                for (int ks = 0; ks < 4; ++ks) q_c[ks] = *(const bf16x8*)(qp + 16 * ks);
            }
            const int sq = (int)(ent_c >> 2), slot = (int)(ent_c & 3u);
            const bool valid = own || (e0 + ql < count);
            f32x16 O[2]; float lsum = 0.f;
#pragma unroll
            for (int i = 0; i < 16; ++i) { O[0][i] = 0.f; O[1][i] = 0.f; }
            const int nkt = own ? wave + 1 : 8, dkt = own ? wave : -1, kth = nkt >> 1;
            const bool more = !own && (c + 1) * 256 + wave * 32 < count;
            unsigned ent_n = ent_c; int nbh = bh; bool nhave = false;
            if (more) { nhave = true; const int e = (c + 1) * 256 + wave * 32 + ql; ent_n = lp[e < count ? e : (c + 1) * 256 + wave * 32]; }
            if (probe != 3 && probe != 4) attn_tile(q_c, KT, VL, 0, kth, dkt, ql, half, c1, c2, O, lsum);
            if (!published) ATTN_PUBLISH();
            if (!more) {
                if (nitem >= 992) { nhave = true; nbh = (nitem - 992) & 31; ent_n = (unsigned)(((nitem - 992) >> 5) * 256 + wave * 32 + ql) << 2; }
                else if (nitem >= 0 && wave * 32 < ncount) { nhave = true; nbh = nitem & 31; const int e = wave * 32 + ql;
                    ent_n = (lists + (size_t)nbh * LIST_PER_BH + list_off(nitem >> 5))[e < ncount ? e : wave * 32]; }
            }
            bf16x8 q_n[4];
            { const bf16* qp = Q + ((size_t)(nbh * 8192 + (int)(ent_n >> 2))) * 64 + 8 * half;
#pragma unroll
                for (int ks = 0; ks < 4; ++ks) q_n[ks] = *(const bf16x8*)(qp + 16 * ks); }
            if (probe != 3 && probe != 4) attn_tile(q_c, KT, VL, kth, nkt, dkt, ql, half, c1, c2, O, lsum);
            const float ltot = lsum + __shfl_xor(lsum, 32);
            if ((probe == 2 || probe == 4) && ltot != 12345.f) { } else
            if (own) {
                const int b = bh >> 3, h = bh & 7;
                if (half == 0) LPART[(size_t)3 * (BH * SEQ) + bh * 8192 + sq] = ltot;
#pragma unroll
                for (int i = 0; i < 16; ++i) {
                    const int s2 = blk * 256 + wave * 32 + crow(i, half);
                    bf16* op = OWN + ((size_t)(b * 8192 + s2)) * OSTR + h * 64 + ql;
                    op[0] = (bf16)f2bf(O[0][i]); op[32] = (bf16)f2bf(O[1][i]);
                }
            } else {
                if (half == 0 && valid) LPART[(size_t)slot * (BH * SEQ) + bh * 8192 + sq] = ltot;
                const int entv = valid ? (int)ent_c : -1;
#pragma unroll
                for (int i = 0; i < 16; ++i) {
                    const int e2 = __shfl(entv, crow(i, half));
                    if (e2 >= 0) { bf16* op = OPART + ((size_t)(e2 & 3) * (BH * SEQ) + bh * 8192 + (e2 >> 2)) * 64 + ql;
                        op[0] = (bf16)f2bf(O[0][i]); op[32] = (bf16)f2bf(O[1][i]); }
                }
            }
            have = nhave; ent_c = ent_n;
#pragma unroll
            for (int ks = 0; ks < 4; ++ks) q_c[ks] = q_n[ks];
            if (own) break;
        }
        if (!published) ATTN_PUBLISH();
#undef ATTN_PUBLISH
        if (nitem >= 0) attn_stage_store(St, lds + (pb ^ 1) * AT_BUF, tid);
        LDS_WAIT();
        __syncthreads();
        item = nitem; count = ncount; pb ^= 1;
    }
}

__device__ __forceinline__ void p5_combine(const bf16* OPART, const float* LPART, const bf16* OM, bf16* OMO, int gtid, int ntot) {
    for (int idx0 = gtid; idx0 < BH * SEQ * 8; idx0 += 2 * ntot) {
        v4u v[2][4]; unsigned lw[2][4]; size_t oo[2]; int nsel[2];
#pragma unroll
        for (int u = 0; u < 2; ++u) {
            const int idx = idx0 + u * ntot < BH * SEQ * 8 ? idx0 + u * ntot : idx0;
            const int qg = idx >> 3, c8 = idx & 7, bh = qg >> 13, s = qg & 8191, b = bh >> 3, h = bh & 7;
            nsel[u] = (s >> 8) < 3 ? (s >> 8) : 3;
            oo[u] = ((size_t)(b * 8192 + s)) * OSTR + h * 64 + 8 * c8;
#pragma unroll
            for (int sl = 0; sl < 3; ++sl) { v[u][sl] = *(const v4u*)(OPART + ((size_t)sl * (BH * SEQ) + qg) * 64 + 8 * c8); lw[u][sl] = *(const unsigned*)(LPART + (size_t)sl * (BH * SEQ) + qg); }
            v[u][3] = *(const v4u*)(OM + oo[u]); lw[u][3] = *(const unsigned*)(LPART + (size_t)3 * (BH * SEQ) + qg);
        }
#pragma unroll
        for (int u = 0; u < 2; ++u) {
            float acc[8] = {0.f, 0.f, 0.f, 0.f, 0.f, 0.f, 0.f, 0.f}; float l = 0.f;
#pragma unroll
            for (int sl = 0; sl < 4; ++sl) {
                const unsigned m = (sl == 3 || sl < nsel[u]) ? 0xffffffffu : 0u;
                const v4u w4 = v[u][sl] & m;
                acc[0] += bflo(w4.x); acc[1] += bfhi(w4.x); acc[2] += bflo(w4.y); acc[3] += bfhi(w4.y); acc[4] += bflo(w4.z); acc[5] += bfhi(w4.z); acc[6] += bflo(w4.w); acc[7] += bfhi(w4.w);
                l += __builtin_bit_cast(float, lw[u][sl] & m);
            }
            const float il = 1.f / l;
            v4u w; w.x = pk2(acc[0] * il, acc[1] * il); w.y = pk2(acc[2] * il, acc[3] * il); w.z = pk2(acc[4] * il, acc[5] * il); w.w = pk2(acc[6] * il, acc[7] * il);
            if (u == 0 || idx0 + ntot < BH * SEQ * 8) *(v4u*)(OMO + oo[u]) = w;
        }
    }
}
__device__ __forceinline__ void unpack4(const v2u w, float (&f)[4]) { f[0] = bflo(w.x); f[1] = bfhi(w.x); f[2] = bflo(w.y); f[3] = bfhi(w.y); }
__device__ __forceinline__ void p5_rwkv_post(const bf16* Z, const bf16* AA, const bf16* GG, const bf16* Y, bf16* YO, const float* mu, const float* k_a, const float* r_k,
                                             const float* ln_g, const float* ln_b, int gw, int ngw, int lane) {
    const int g = lane >> 4, r = lane & 15;
#pragma unroll 2
    for (int it = gw * 4 + g; it < T * NH; it += ngw * 4) {
        const int t = it >> 3, h = it & 7, col = h * 64 + 4 * r, s = t & 8191;
        const bf16* zp = Z + (size_t)t * ZR + col;
        float zr[4], zk[4], zv[4], pr[4] = {0.f, 0.f, 0.f, 0.f}, pk[4] = {0.f, 0.f, 0.f, 0.f}, pv[4] = {0.f, 0.f, 0.f, 0.f}, a[4], y[4], gg[4];
        unpack4(*(const v2u*)zp, zr); unpack4(*(const v2u*)(zp + 512), zk); unpack4(*(const v2u*)(zp + 1024), zv);
        { const bf16* zq = s ? zp - ZR : zp; const unsigned m_ = s ? 0xffffffffu : 0u;
          unpack4(*(const v2u*)(zq) & m_, pr); unpack4(*(const v2u*)(zq + 512) & m_, pk); unpack4(*(const v2u*)(zq + 1024) & m_, pv); }
        unpack4(*(const v2u*)(AA + (size_t)t * 512 + col), a); unpack4(*(const v2u*)(Y + (size_t)t * OSTR + col), y); unpack4(*(const v2u*)(GG + (size_t)t * 512 + col), gg);
        const f32x4 mr = *(const f32x4*)(mu + col), mk = *(const f32x4*)(mu + 512 + col), mv = *(const f32x4*)(mu + 1024 + col);
        const f32x4 ka = *(const f32x4*)(k_a + col), rk = *(const f32x4*)(r_k + col), lg = *(const f32x4*)(ln_g + col), lb = *(const f32x4*)(ln_b + col);
        float vv[4], dot = 0.f, sum = 0.f;
#pragma unroll
        for (int i = 0; i < 4; ++i) { const float rr = zr[i] + (pr[i] - zr[i]) * mr[i], k = zk[i] + (pk[i] - zk[i]) * mk[i]; vv[i] = zv[i] + (pv[i] - zv[i]) * mv[i];
            const float k2 = k * (1.f + (a[i] - 1.f) * ka[i]); dot += rr * k2 * rk[i]; sum += y[i]; }
        const float mean = allreduce16(sum) * (1.f / 64.f);
        float sq = 0.f;
#pragma unroll
        for (int i = 0; i < 4; ++i) { y[i] -= mean; sq += y[i] * y[i]; }
        const float rstd = 1.f / sqrtf(allreduce16(sq) * (1.f / 64.f) + GN_EPS);
        const float bonus = allreduce16(dot);
        float o[4];
#pragma unroll
        for (int i = 0; i < 4; ++i) o[i] = (y[i] * rstd * lg[i] + lb[i] + bonus * vv[i]) * gg[i];
        v2u w; w.x = pk2(o[0], o[1]); w.y = pk2(o[2], o[3]);
        *(v2u*)(YO + (size_t)t * OSTR + col) = w;
    }
}


__device__ __forceinline__ unsigned f2key(float f) { const unsigned u = __builtin_bit_cast(unsigned, f); return (u & 0x80000000u) ? ~u : (u | 0x80000000u); }
__device__ __forceinline__ float key2f(unsigned k) { const unsigned u = (k & 0x80000000u) ? (k & 0x7fffffffu) : ~k; return __builtin_bit_cast(float, u); }
template <int CTRL> __device__ __forceinline__ unsigned dppu(unsigned v) { return (unsigned)__builtin_amdgcn_update_dpp(0, (int)v, CTRL, 0xF, 0xF, true); }
__device__ __forceinline__ unsigned umax_(unsigned a, unsigned b) { return a > b ? a : b; }
__device__ __forceinline__ unsigned allmax16(unsigned v) { v = umax_(v, dppu<0xB1>(v)); v = umax_(v, dppu<0x4E>(v)); v = umax_(v, dppu<0x141>(v)); v = umax_(v, dppu<0x140>(v)); return v; }
__device__ __forceinline__ float dot2bf(unsigned w, unsigned x, float acc) { return __builtin_amdgcn_fdot2_f32_bf16(__builtin_bit_cast(bf16x2_t, w), __builtin_bit_cast(bf16x2_t, x), acc, false); }
__device__ __forceinline__ unsigned cand_word(int r) {
    const unsigned tab[16] = {0x03020100u, 0x07060504u, 0x0b0a0908u, 0x0f0e0d0cu, 0x13121110u, 0x17161514u, 0x23222120u, 0x32313024u,
                              0x42414033u, 0x61605150u, 0x90807170u, 0xd0c0b0a0u, 0xfffff0e0u, 0xffffffffu, 0xffffffffu, 0xffffffffu};
    unsigned w = 0xffffffffu;
#pragma unroll
    for (int i = 0; i < 13; ++i) w = (r == i) ? tab[i] : w;
    return w;
}
template <int NK> __device__ __forceinline__ unsigned top16_keys(unsigned (&k)[NK], int r) {
    unsigned res = 0u;
    for (int rd = 0; rd < 16; ++rd) {
        unsigned m = k[0];
#pragma unroll
        for (int j = 1; j < NK; ++j) m = umax_(m, k[j]);
        const unsigned gm = allmax16(m);
        res = (r == rd) ? gm : res;
#pragma unroll
        for (int j = 0; j < NK; ++j) k[j] = (k[j] == gm) ? 0u : k[j];
    }
    return res;
}
#define PEER_CE(a, b) do { const unsigned hi_ = umax_(k[a], k[b]), lo_ = (k[a] < k[b]) ? k[a] : k[b]; k[a] = hi_; k[b] = lo_; } while (0)
__device__ __forceinline__ unsigned top16_sorted8(unsigned (&k)[8], int r) {
    PEER_CE(0, 1); PEER_CE(2, 3); PEER_CE(4, 5); PEER_CE(6, 7);
    PEER_CE(0, 2); PEER_CE(1, 3); PEER_CE(4, 6); PEER_CE(5, 7);
    PEER_CE(1, 2); PEER_CE(5, 6);
    PEER_CE(0, 4); PEER_CE(1, 5); PEER_CE(2, 6); PEER_CE(3, 7);
    PEER_CE(2, 4); PEER_CE(3, 5);
    PEER_CE(1, 2); PEER_CE(3, 4); PEER_CE(5, 6);
    unsigned res = 0u;
    for (int rd = 0; rd < 16; ++rd) {
        const unsigned gm = allmax16(k[0]);
        res = (r == rd) ? gm : res;
        const bool pop = k[0] == gm;
#pragma unroll
        for (int j = 0; j < 7; ++j) k[j] = pop ? k[j + 1] : k[j];
        k[7] = pop ? 0u : k[7];
    }
    return res;
}
#undef PEER_CE
#ifdef PROBE_S
typedef int v8i_p __attribute__((ext_vector_type(8)));
__device__ __forceinline__ float mx_probe(int lane) {
    const int q = lane >> 4;
    unsigned aw[4] = {0u, 0u, 0u, 0u};
    if (lane == 16 * PROBE_QA) aw[(PROBE_S) >> 3] = 0x2u << (4 * ((PROBE_S) & 7));
    v8i_p A = {(int)aw[0], (int)aw[1], (int)aw[2], (int)aw[3], 0, 0, 0, 0};
    v8i_p B;
#pragma unroll
    for (int v = 0; v < 8; ++v) {
        float f[4];
#pragma unroll
        for (int b = 0; b < 4; ++b) { const int j = 4 * v + b; f[b] = (PROBE_PAT == 1) ? (float)(q + 1) : ((PROBE_PAT == 2) ? (float)((j & 15) + 1) : (float)((j >> 4) + 1)); }
        int w = 0; w = __builtin_amdgcn_cvt_pk_fp8_f32(f[0], f[1], w, false); w = __builtin_amdgcn_cvt_pk_fp8_f32(f[2], f[3], w, true); B[v] = w;
    }
    f32x4 c = {0.f, 0.f, 0.f, 0.f};
    c = __builtin_amdgcn_mfma_scale_f32_16x16x128_f8f6f4(A, B, c, 4, 0, 0, 0x7f7f7f7f, 0, 0x7f7f7f7f);
    const float r = __shfl(c.x, 0);
    const int code = (int)(r + 0.5f) - 1;
    float off = 0.1f;
    for (int i = 0; i < code && i < 40; ++i) off *= 1.3f;
    if (code < 0) off = 0.05f;
    return off;
}
#endif
typedef int v8i __attribute__((ext_vector_type(8)));
typedef int v4i __attribute__((ext_vector_type(4)));
__device__ __forceinline__ void peer_token_a(const bf16* SC, const unsigned char* XN8, const unsigned char* U8, LAS f32x4* xl, LAS int* pe, LAS float* ph, int t, int tnext, v4u (&scn)[4], v4u& x8n, int lane) {
    const int g = lane >> 4, r = lane & 15;
    int eidx[2]; float egate[2];
    unsigned resA[4];
#pragma unroll
    for (int pass = 0; pass < 4; ++pass) {
        const v4u sw = scn[pass];
        const float v[8] = {bflo(sw.x), bfhi(sw.x), bflo(sw.y), bfhi(sw.y), bflo(sw.z), bfhi(sw.z), bflo(sw.w), bfhi(sw.w)};
        unsigned k[8];
#pragma unroll
        for (int j = 0; j < 8; ++j) k[j] = (f2key(v[j]) & ~0x7Fu) | (unsigned)(127 - (r * 8 + j));
        resA[pass] = top16_sorted8(k, r);
    }
    const v4u x8cur = x8n;
#pragma unroll
    for (int pass = 0; pass < 4; ++pass) scn[pass] = *(const v4u*)(SC + (size_t)tnext * 2048 + (pass * 4 + g) * 128 + r * 8);
    x8n = *(const v4u*)(XN8 + (size_t)tnext * 1024 + 16 * lane);
    const unsigned cw = cand_word(r);
#pragma unroll
    for (int cp = 0; cp < 2; ++cp) {
        const int lbase = 32 * (g & 1); const bool hi = (g >> 1) != 0;
        unsigned ck[4];
#pragma unroll
        for (int m = 0; m < 4; ++m) {
            const unsigned byte = (cw >> (8 * m)) & 0xFFu; const int i = (int)(byte >> 4), j = (int)(byte & 15u);
            const unsigned a0 = (unsigned)__shfl((int)resA[2 * cp], lbase + i), a1 = (unsigned)__shfl((int)resA[2 * cp + 1], lbase + i);
            const unsigned b0 = (unsigned)__shfl((int)resA[2 * cp], lbase + 16 + j), b1 = (unsigned)__shfl((int)resA[2 * cp + 1], lbase + 16 + j);
            const unsigned ak = hi ? a1 : a0, bk = hi ? b1 : b0;
            const float val = key2f(ak & ~0x7Fu) + key2f(bk & ~0x7Fu);
            ck[m] = (byte != 0xFFu) ? ((f2key(val) & ~0xFFu) | (255u - byte)) : 0u;
        }
        const unsigned res = top16_keys<4>(ck, r);
        const unsigned flat = 255u - (res & 0xFFu); const int i = (int)(flat >> 4), j = (int)(flat & 15u);
        const float val = key2f(res & ~0xFFu), vmax = key2f(allmax16(res) & ~0xFFu);
        const float e = __expf(val - vmax);
        const float gate = e / allreduce16(e);
        const unsigned a0 = (unsigned)__shfl((int)resA[2 * cp], lbase + i), a1 = (unsigned)__shfl((int)resA[2 * cp + 1], lbase + i);
        const unsigned b0 = (unsigned)__shfl((int)resA[2 * cp], lbase + 16 + j), b1 = (unsigned)__shfl((int)resA[2 * cp + 1], lbase + 16 + j);
        const unsigned ak = hi ? a1 : a0, bk = hi ? b1 : b0;
        eidx[cp] = (int)((127u - (ak & 127u)) * 128u + (127u - (bk & 127u)));
        egate[cp] = gate;
    }
    LAS float* hl = (LAS float*)xl;
    {
        const int i16 = lane & 15, q = lane >> 4;
        LAS unsigned char* x8l = (LAS unsigned char*)(xl + 64);
        LDS_WAIT(); asm volatile("" ::: "memory");
        *(LAS v4u*)(x8l + 16 * lane) = x8cur;
#define PEER_LD(P, KB) (*(const v4i*)((P) + (KB) * 64))
#define PEER_PTR(GI) (U8 + (size_t)__shfl(eidx[(GI) >> 2], 16 * ((GI) & 3) + i16) * 512 + 16 * q)
        v4i ug[2][8];
        LDS_WAIT(); asm volatile("" ::: "memory");
        {
#pragma unroll
        for (int g0 = 0; g0 < 2; ++g0) { const unsigned char* p0 = PEER_PTR(g0);
#pragma unroll
            for (int kb = 0; kb < 8; ++kb) ug[g0][kb] = PEER_LD(p0, kb); }
#pragma unroll
        for (int gi = 0; gi < 8; ++gi) {
            const unsigned char* pn = PEER_PTR((gi + 2) & 7);
            f32x4 c_ = {0.f, 0.f, 0.f, 0.f};
#pragma unroll
            for (int kb = 0; kb < 8; ++kb) {
                const v8i xb_ = __builtin_shufflevector(*(const LAS v4i*)(x8l + kb * 128 + 16 * q), *(const LAS v4i*)(x8l + kb * 128 + 64 + 16 * q), 0, 1, 2, 3, 4, 5, 6, 7);
                const v8i ua_ = __builtin_shufflevector(ug[gi % 2][kb], (v4i){0, 0, 0, 0}, 0, 1, 2, 3, 4, 5, 6, 7);
                c_ = __builtin_amdgcn_mfma_scale_f32_16x16x128_f8f6f4(ua_, xb_, c_, 4, 0, 0, 0x7f7f7f7f, 0, 0x7f7f7f7f);
                if (gi + 2 < 8) ug[gi % 2][kb] = PEER_LD(pn, kb);
            }
            if (i16 == 0) *(LAS f32x4*)(hl + (gi >> 2) * 64 + 16 * (gi & 3) + 4 * q) = c_;
            __builtin_amdgcn_sched_barrier(0);
        }
        }
#undef PEER_LD
#undef PEER_PTR
    }
    LDS_WAIT(); asm volatile("" ::: "memory");
    float ehs[2];
#pragma unroll
    for (int cp = 0; cp < 2; ++cp) { const float hd = hl[cp * 64 + lane] * (1.f / 512.f); ehs[cp] = 0.5f * hd * (1.f + erff(hd * 0.70710678118654752f)) * egate[cp] * (1.f / 5.656854249f); }
    pe[lane] = eidx[0]; pe[64 + lane] = eidx[1]; ph[lane] = ehs[0]; ph[64 + lane] = ehs[1];
}
__device__ __forceinline__ void peer_token_b(const unsigned char* V8, const float* MOD, const float* OUT, float* OROW, const LAS int* pe, const LAS float* ph, int t, int lane) {
    const int g = lane >> 4, r = lane & 15;
    int eidx[2]; float ehs[2];
    eidx[0] = pe[lane]; eidx[1] = pe[64 + lane]; ehs[0] = ph[lane]; ehs[1] = ph[64 + lane];
    f32x2 acc[32];
#pragma unroll
    for (int i = 0; i < 32; ++i) acc[i] = (f32x2){0.f, 0.f};
#define PEER_VL(VV, BT) do { const int src_ = 4 * ((BT) & 15) + g; const int e0_ = __shfl(eidx[0], src_), e1_ = __shfl(eidx[1], src_); const int e_ = ((BT) < 16) ? e0_ : e1_; \
        const unsigned char* vp_ = V8 + (size_t)e_ * 512 + r * 16; VV[0] = *(const v4u*)(vp_); VV[1] = *(const v4u*)(vp_ + 256); } while (0)
#define PEER_AX(W, I, H) do { acc[(I)] += __builtin_amdgcn_cvt_scalef32_pk_f32_fp4((W), 1.0f, 0) * H; acc[(I) + 1] += __builtin_amdgcn_cvt_scalef32_pk_f32_fp4((W), 1.0f, 1) * H; \
        acc[(I) + 2] += __builtin_amdgcn_cvt_scalef32_pk_f32_fp4((W), 1.0f, 2) * H; acc[(I) + 3] += __builtin_amdgcn_cvt_scalef32_pk_f32_fp4((W), 1.0f, 3) * H; } while (0)
#define PEER_VC(VV, BT) do { const int src_ = 4 * ((BT) & 15) + g; const float h0_ = __shfl(ehs[0], src_), h1_ = __shfl(ehs[1], src_); const float hs_ = ((BT) < 16) ? h0_ : h1_; const f32x2 hg_ = {hs_, hs_}; \
        _Pragma("unroll") for (int k = 0; k < 2; ++k) { PEER_AX(VV[k].x, 16 * k, hg_); PEER_AX(VV[k].y, 16 * k + 4, hg_); PEER_AX(VV[k].z, 16 * k + 8, hg_); PEER_AX(VV[k].w, 16 * k + 12, hg_); } } while (0)
    {
        v4u vr[4][2];
#pragma unroll
        for (int i = 0; i < 4; ++i) PEER_VL(vr[i], i);
#pragma unroll 1
        for (int b4 = 0; b4 < 32; b4 += 4) {
#pragma unroll
            for (int i = 0; i < 4; ++i) {
                PEER_VC(vr[i], b4 + i);
                { const int nb_ = (b4 + 4 + i < 32) ? b4 + 4 + i : 31; PEER_VL(vr[i], nb_); }
            }
        }
    }
#undef PEER_VL
#undef PEER_AX
#undef PEER_VC
    const float* gt2 = MOD + (size_t)(t >> 13) * 6144 + 5 * 1024;
    const int col = (16 * (g >> 1) + r) * 32 + 16 * (g & 1);
    const float* op = OUT + (size_t)t * 1024 + col; float* op2 = OROW + col;
    f32x4 hv[4], qv[4];
#pragma unroll
    for (int q = 0; q < 4; ++q) { hv[q] = *(const f32x4*)(op + 4 * q); qv[q] = *(const f32x4*)(gt2 + col + 4 * q); }
#pragma unroll
    for (int i = 0; i < 32; ++i) { acc[i].x += __shfl_xor(acc[i].x, 16); acc[i].y += __shfl_xor(acc[i].y, 16); acc[i].x += __shfl_xor(acc[i].x, 32); acc[i].y += __shfl_xor(acc[i].y, 32); }
#pragma unroll
    for (int q = 0; q < 4; ++q) {
        f32x2 a0 = acc[2 * q], a1 = acc[2 * q + 1];
#pragma unroll
        for (int kk = 1; kk < 4; ++kk) { a0 = (g == kk) ? acc[8 * kk + 2 * q] : a0; a1 = (g == kk) ? acc[8 * kk + 2 * q + 1] : a1; }
        f32x4 o0; o0.x = hv[q].x + qv[q].x * a0.x; o0.y = hv[q].y + qv[q].y * a0.y; o0.z = hv[q].z + qv[q].z * a1.x; o0.w = hv[q].w + qv[q].w * a1.y;
        *(f32x4*)(op2 + 4 * q) = o0;
    }
}


#ifndef MK_N_LAUNCHES
#define MK_N_LAUNCHES 1
#endif
constexpr int N_PHASES = 15;
struct Args { const float* in[28]; float* out; unsigned char* ws; int ph_lo, ph_hi, use_bar, rep; };
enum { I_X = 0, I_C, I_POS, I_WADA, I_BADA, I_N1G, I_WIN, I_QNG, I_KNG, I_MU, I_W0, I_W2, I_A0, I_A2, I_G2, I_KK, I_KA, I_RK, I_LNG, I_LNB, I_WPM, I_WPR, I_WOUT, I_N2G, I_WQ, I_SK, I_PU, I_PV };

template <int OFF> __device__ __forceinline__ unsigned long long karg64() { unsigned long long p; asm volatile("s_load_dwordx2 %0, %1, %2\n\ts_waitcnt lgkmcnt(0)" : "=s"(p) : "s"(__builtin_amdgcn_kernarg_segment_ptr()), "n"(OFF)); return p; }
#define KIN(k) ((const float*)(const GAS float*)karg64<8 * (k)>())
#define KOUT ((float*)(GAS float*)karg64<224>())
#define KWS ((unsigned char*)(GAS unsigned char*)karg64<232>())
#define KOB ((unsigned char*)(GAS unsigned char*)karg64<224>())
#define ctl ((unsigned*)(KWS + WS_CTL))
#define mod ((float*)(KWS + WS_MOD))
#define kmean ((float*)(KWS + WS_KMEAN))
#define WinT ((bf16*)(KWS + WS_WIN))
#define WloraT ((bf16*)(KWS + WS_WLORA))
#define WpmT ((bf16*)(KWS + WS_WPM))
#define WprT ((bf16*)(KWS + WS_WPR))
#define WoutT ((bf16*)(KWS + WS_WOUT))
#define WeffT ((bf16*)(KWS + WS_WEFF))
#define XN ((bf16*)(KWS + WS_XN))
#define EW ((bf16*)(KWS + WS_EW))
#define AA ((bf16*)(KWS + WS_AA))
#define Qb ((bf16*)(KWS + WS_Q))
#define Kb ((bf16*)(KWS + WS_K))
#define VTb ((bf16*)(KWS + WS_VT))
#define ZRKV ((bf16*)(KWS + WS_ZRKV))
#define GT ((bf16*)(KWS + WS_GT))
#define ZLORA ((bf16*)(KWS + WS_ZLORA))
#define ALORA ((bf16*)(KWS + WS_ALORA))
#define OMOBA ((bf16*)(KWS + WS_OCAT))
#define GG ((bf16*)(KWS + WS_GG))
#define Yb ((bf16*)(KWS + WS_OCAT) + 512)
#define MIXED ((bf16*)(KWS + WS_MIXED))
#define U8 ((unsigned char*)(KWS + WS_U8))
#define XN8 ((unsigned char*)(KWS + 352 * MiB))
#define V8 ((unsigned char*)(KWS + WS_V8))
#define SCORES ((bf16*)(KWS + WS_SCORES))
#define OPART ((bf16*)(KOB + DO_OPART))
#define LISTS ((unsigned*)(KOB + DO_LISTS))
#define LPART ((float*)(KOB + DO_LPART))
#define CP_RW ((bf16*)(KOB))
#define CP_MM ((bf16*)(KOB + 32 * MiB))
#define CP_Y0T ((bf16*)(KOB + 64 * MiB))
#define CP_GAT ((bf16*)(KOB + 96 * MiB))
#define CP_PC ((float*)(KWS + 504 * MiB))
#define REPSEL(a, b) (PRB ? (a) : (b))
#define REPSEL5(a, b) REPSEL(a, b)
template <int PRB> __global__ void __launch_bounds__(NTHR, 2) mk_fwd_t(Args args) {
    extern __shared__ __attribute__((aligned(16))) unsigned char lds_raw[];
    LAS unsigned char* lds = (LAS unsigned char*)lds_raw;
    volatile LAS unsigned* MISC = (volatile LAS unsigned*)(lds + MISC_OFF);
    const int tid = threadIdx.x, lane = tid & 63, wave = __builtin_amdgcn_readfirstlane(tid >> 6);
    const int G = gridDim.x, bx = blockIdx.x;
    const int vcu = (G % 8 == 0) ? (bx % 8) * (G / 8) + bx / 8 : bx;
    const int gw = vcu * NWAVES + wave, NGW = G * NWAVES;
    const int gtid = vcu * NTHR + tid, NTOT = G * NTHR;
    for (int u = tid; u < (LDS_BYTES - MISC_OFF) / 4; u += NTHR) ((LAS unsigned*)(lds + MISC_OFF))[u] = 0u;
    __syncthreads();
    XcdBarrier bar; bar.bar = ctl + CW_BAR; bar.x = 0; bar.st = nullptr;
    if (args.use_bar) bar = xcd_barrier_post(ctl + CW_BAR, MISC + 8);
    const int lo = args.ph_lo, hi = args.ph_hi;
#ifdef PH_MASK
#define IN(k) ((((PH_MASK) >> (k)) & 1) && lo <= (k) && (k) < hi)
#else
#define IN(k) (lo <= (k) && (k) < hi)
#endif
#define SEAM(k) do { if (IN(k) && IN((k) + 1)) { if (lo < 0) { cg::this_grid().sync(); } xcd_barrier(bar); } } while (0)

    if (IN(0)) {
        LAS float* scr = (LAS float*)(lds + wave * 16384);
        for (int it = vcu; it < 96; it += G) p0_mod_item(KIN(I_C), KIN(I_WADA), KIN(I_BADA), mod, (LAS float*)lds, it, wave, lane);
        constexpr int I_WEFF = 2048, I_MOD = 0, I_T_IN = 16 * 168, I_T_PM = 8 * 32, I_T_OUT = 16 * 32;
        constexpr int NITEMS = I_WEFF + I_MOD + I_T_IN + 2 * I_T_PM + I_T_OUT;
        for (int it = gw; it < NITEMS; it += NGW) {
            int r = it;
            if (r < I_WEFF) { p0_weff_item(KIN(I_WQ), KIN(I_SK), WeffT, r, lane); continue; } r -= I_WEFF;
            if (r < I_T_IN) { p0_transpose_item(KIN(I_WIN), 1024, INW, WinT, 1024, 0, scr, r, lane); continue; } r -= I_T_IN;
            if (r < I_T_PM) { p0_transpose_item(KIN(I_WPM), 512, 1024, WpmT, 1024, 0, scr, r, lane); continue; } r -= I_T_PM;
            if (r < I_T_PM) { p0_transpose_item(KIN(I_WPR), 512, 1024, WpmT, 1024, 512, scr, r, lane); continue; } r -= I_T_PM;
            p0_transpose_item(KIN(I_WOUT), 1024, 1024, WoutT, 1024, 0, scr, r, lane);
        }
        const float* w2 = KIN(I_W2); const float* a2 = KIN(I_A2); const float* g2 = KIN(I_G2);
        for (int i = gtid; i < 1536 * 256; i += NTOT) {
            const int n = i >> 8, k = i & 255; float v = 0.f;
            if (n < 512) { if (k < 64) v = w2[k * 512 + n]; }
            else if (n < 1024) { if (k >= 64 && k < 128) v = a2[(k - 64) * 512 + (n - 512)]; }
            else { if (k >= 128) v = g2[(k - 128) * 512 + (n - 1024)]; }
            WloraT[i] = (bf16)f2bf(v);
        }
     }
    SEAM(0);
    if (IN(1)) {
        for (int m = gw * 4; m < T; m += NGW * 4) { const float* mb = mod + (size_t)(m >> 13) * 6144;
            rms_mod_rows<4>(KIN(I_X) + (size_t)m * DM, XN + (size_t)m * DM, nullptr, KIN(I_N1G), mb + 1024, mb, lane); }
     }
    SEAM(1);
    if (IN(2)) {
        pg8::Gemm g{XN, WinT, T, INW, DM}; pg8::StaticOrder S; S.init(T, INW, G, bx);
        EpiIn E{Qb, Kb, VTb, ZRKV, ZLORA, GT};
        pg8::gemm_phase<EpiIn, pg8::StaticOrder, true, true>(lds, g, S, E);
     }
    SEAM(2);
    if (IN(3)) {
        LAS float* red = (LAS float*)lds;
        v4u raw[4], rawn[4]; int ps[4], psn[4];
        if (vcu < 2048) p2_qk_load(raw, ps, (vcu >> 10) ? Qb : Kb, (const int*)KIN(I_POS), (vcu & 1023) >> 5, vcu & 31, wave, lane);
        for (int it = vcu; it < 2048; it += G) {
            const int isq = it >> 10, r = it & 1023, bh = r >> 5, n = r & 31;
            { const int itn = it + G < 2048 ? it + G : it;
              p2_qk_load(rawn, psn, (itn >> 10) ? Qb : Kb, (const int*)KIN(I_POS), (itn & 1023) >> 5, itn & 31, wave, lane); }
            if (isq) p2_qk_item(raw, ps, REPSEL((bf16*)KOB, Qb), KIN(I_QNG), nullptr, bh, n, red, tid, wave, lane);
            else p2_qk_item(raw, ps, REPSEL((bf16*)(KOB + 32 * MiB), Kb), KIN(I_KNG), REPSEL((float*)(KWS + 1536 * 1024), kmean), bh, n, red, tid, wave, lane);
#pragma unroll
            for (int i = 0; i < 4; ++i) { raw[i] = rawn[i]; ps[i] = psn[i]; }
        }
        p2_prep(ZLORA, KIN(I_MU), REPSEL((bf16*)(KOB + 64 * MiB), ALORA), gtid, NTOT);
    }
    SEAM(3);
    if (IN(4)) {
        { int kdim = 256; asm volatile("" : "+s"(kdim));
          pg8::Gemm g{ALORA, WloraT, T, 1536, kdim}; pg8::StaticOrder S; S.init(T, 1536, G, bx);
          EpiLora E{EW, AA, GG, KIN(I_W0), KIN(I_A0)};
          pg8::gemm_phase<EpiLora, pg8::StaticOrder, true, true>(lds, g, S, E); }
        __syncthreads();
        LAS float* km = (LAS float*)lds;
        for (int it = vcu; it < 512; it += G) p3_top3_item(Qb, kmean, ctl + CW_CURSOR + REPSEL(2048, 0), REPSEL((unsigned*)KOB, LISTS), (2 * it) & 31, (2 * it) >> 5, km, tid, wave, lane);
    }
    SEAM(4);
    if (IN(5)) {
        attn_phase(Qb, Kb, VTb, LISTS, ctl + CW_CURSOR, ctl + CW_QUEUE + REPSEL5(64, 0), OPART, LPART, OMOBA, KIN(I_QNG), KIN(I_KNG), lds, tid, wave, lane, PRB);
    }
    SEAM(5);
    if (IN(6)) {
        p5_combine(OPART, LPART, OMOBA, REPSEL(Qb, OMOBA), gtid, NTOT);
    }
    SEAM(6);
    if (IN(7)) {
        ScanRaw R;
        if (vcu < BH * NCHK) scan_load(R, ZRKV, AA, EW, (vcu >> 7) >> 3, ((vcu >> 7) & 7) * 64 + (tid & 7) * 8, (vcu & 127) * CK + (tid >> 3));
        for (int ci = vcu; ci < BH * NCHK; ci += G) {
            const int cn = ci + G;
            rwkv_cp_item(ZRKV, AA, EW, KIN(I_MU), KIN(I_KK), KIN(I_KA), CP_RW + (size_t)ci * 4096, CP_MM + (size_t)ci * 4096, CP_Y0T + (size_t)ci * 4096, CP_GAT + (size_t)ci * 4096,
                         CP_PC + (size_t)ci * 64, ci >> 7, ci & 127, R, (cn < BH * NCHK ? cn : ci) >> 7, (cn < BH * NCHK ? cn : ci) & 127, lds, tid, wave, lane, PRB);
        }
    }
    SEAM(7);
    if (IN(8)) {
        if (G >= 128) { if (vcu < 128) rwkv_seq(CP_RW, CP_MM, CP_Y0T, CP_GAT, CP_PC, Yb, vcu, lds, tid, wave, lane); }
        else for (int sid = vcu; sid < 128; sid += G) { __syncthreads(); rwkv_seq(CP_RW, CP_MM, CP_Y0T, CP_GAT, CP_PC, Yb, sid, lds, tid, wave, lane); }
        if (G > 128 ? vcu >= 128 : true) {
        const int cgt = (G > 128 ? vcu - 128 : vcu) * NTHR + tid, cnt = (G > 128 ? G - 128 : G) * NTHR;
        const f32x4* pu = (const f32x4*)KIN(I_PU); const f32x4* pv = (const f32x4*)KIN(I_PV);
        for (int i = cgt; i < 16384 * 1024 / 32; i += cnt) {
            v4u wu;
#pragma unroll
            for (int q = 0; q < 4; ++q) {
                f32x4 a = pu[8 * i + 2 * q] * 64.f, c = pu[8 * i + 2 * q + 1] * 64.f;
                a = __builtin_elementwise_min(__builtin_elementwise_max(a, (f32x4){-6.f, -6.f, -6.f, -6.f}), (f32x4){6.f, 6.f, 6.f, 6.f});
                c = __builtin_elementwise_min(__builtin_elementwise_max(c, (f32x4){-6.f, -6.f, -6.f, -6.f}), (f32x4){6.f, 6.f, 6.f, 6.f});
                unsigned w = 0u;
                w = __builtin_amdgcn_cvt_scalef32_pk_fp4_f32(w, a.x, a.y, 1.0f, 0); w = __builtin_amdgcn_cvt_scalef32_pk_fp4_f32(w, a.z, a.w, 1.0f, 1);
                w = __builtin_amdgcn_cvt_scalef32_pk_fp4_f32(w, c.x, c.y, 1.0f, 2); w = __builtin_amdgcn_cvt_scalef32_pk_fp4_f32(w, c.z, c.w, 1.0f, 3);
                wu[q] = w;
            }
            *(v4u*)(U8 + (size_t)i * 16) = wu;
        }
        for (int i = cgt; i < 16384 * 1024 / 32; i += cnt) {
            v4u wv;
#pragma unroll
            for (int q = 0; q < 4; ++q) {
                f32x4 a = pv[8 * i + 2 * q] * 5.656854249f, c = pv[8 * i + 2 * q + 1] * 5.656854249f;
                a = __builtin_elementwise_min(__builtin_elementwise_max(a, (f32x4){-6.f, -6.f, -6.f, -6.f}), (f32x4){6.f, 6.f, 6.f, 6.f});
                c = __builtin_elementwise_min(__builtin_elementwise_max(c, (f32x4){-6.f, -6.f, -6.f, -6.f}), (f32x4){6.f, 6.f, 6.f, 6.f});
                unsigned w = 0u;
                w = __builtin_amdgcn_cvt_scalef32_pk_fp4_f32(w, a.x, a.y, 1.0f, 0); w = __builtin_amdgcn_cvt_scalef32_pk_fp4_f32(w, a.z, a.w, 1.0f, 1);
                w = __builtin_amdgcn_cvt_scalef32_pk_fp4_f32(w, c.x, c.y, 1.0f, 2); w = __builtin_amdgcn_cvt_scalef32_pk_fp4_f32(w, c.z, c.w, 1.0f, 3);
                wv[q] = w;
            }
            *(v4u*)(V8 + (size_t)i * 16) = wv;
        }
        }
    }
    SEAM(8);
    if (IN(9)) {
        p5_rwkv_post(ZRKV, AA, GG, Yb, REPSEL(Qb, Yb), KIN(I_MU), KIN(I_KA), KIN(I_RK), KIN(I_LNG), KIN(I_LNB), gw, NGW, lane);
    }
    SEAM(9);
    if (IN(10)) {
        pg8::Gemm g{OMOBA, WpmT, T, DM, DM}; pg8::StaticOrder S; S.init(T, DM, G, bx);
        EpiMix E{GT, MIXED, PRB};
        pg8::gemm_phase<EpiMix, pg8::StaticOrder, true, true>(lds, g, S, E);
    }
    SEAM(10);
    if (IN(11)) {
        pg8::Gemm g{MIXED, WoutT, T, DM, DM}; pg8::StaticOrder S; S.init(T, DM, G, bx);
        EpiOut E{KIN(I_X), mod, KOUT};
        pg8::gemm_phase<EpiOut, pg8::StaticOrder, true, true>(lds, g, S, E);
     }
    SEAM(11);
    if (IN(12)) {
        for (int m = gw * 4; m < T; m += NGW * 4) { const float* mb = mod + (size_t)(m >> 13) * 6144;
            rms_mod_rows<4>(KOUT + (size_t)m * DM, XN + (size_t)m * DM, (unsigned*)(XN8 + (size_t)m * DM), KIN(I_N2G), mb + 4 * 1024, mb + 3 * 1024, lane); }
    }
    SEAM(12);
    if (IN(13)) {
        pg8::Gemm g{XN, WeffT, T, PEER_N, DM}; pg8::StaticOrder S; S.init(T, PEER_N, G, bx);
        EpiScores E{SCORES};
        pg8::gemm_phase<EpiScores, pg8::StaticOrder, true, true>(lds, g, S, E);
     }
    SEAM(13);
    if (IN(14)) {
        LAS f32x4* xl = (LAS f32x4*)(lds + wave * 18432);
        LAS int* pe = (LAS int*)(lds + wave * 18432 + 2048); LAS float* ph = (LAS float*)(lds + wave * 18432 + 2048 + 8192);
        v4u scn[4], x8n;
        { const int g_ = lane >> 4, r_ = lane & 15;
#pragma unroll
          for (int pass = 0; pass < 4; ++pass) scn[pass] = *(const v4u*)(SCORES + (size_t)gw * 2048 + (pass * 4 + g_) * 128 + r_ * 8);
          x8n = *(const v4u*)(XN8 + (size_t)gw * 1024 + 16 * lane); }
        { int k = 0; for (int t = gw; t < T; t += NGW, ++k) peer_token_a(SCORES, XN8, U8, xl, pe + 128 * (k & 15), ph + 128 * (k & 15), t, t + NGW < T ? t + NGW : t, scn, x8n, lane); }
        LDS_WAIT(); asm volatile("" ::: "memory");
        { int k = 0; for (int t = gw; t < T; t += NGW, ++k) peer_token_b(V8, mod, KOUT, KOUT + (size_t)t * 1024, pe + 128 * (k & 15), ph + 128 * (k & 15), t, lane); }
    }
#undef IN
#undef SEAM
}

extern "C" void kernel_launch(void* const* d_in, const int* in_sizes, int n_in, void* d_out, int out_size, void* d_ws, size_t ws_size, hipStream_t stream) {
    static int grid = 0;
    if (grid == 0) {
        if (n_in != 28 || in_sizes[0] != T * DM || out_size != T * DM || ws_size < WS_END) {
            fprintf(stderr, "kernel_launch: unexpected problem (n_in %d, in0 %d, out %d, ws %zu); nothing launched\n", n_in, n_in > 0 ? in_sizes[0] : -1, out_size, ws_size); grid = -1; return; }
        int dev = 0, cus = 0, per_cu = 0;
        if (hipGetDevice(&dev) != hipSuccess || hipDeviceGetAttribute(&cus, hipDeviceAttributeMultiprocessorCount, dev) != hipSuccess) { grid = -1; return; }
        if (hipFuncSetAttribute((const void*)mk_fwd_t<0>, hipFuncAttributeMaxDynamicSharedMemorySize, LDS_BYTES) != hipSuccess) { fprintf(stderr, "kernel_launch: hipFuncSetAttribute failed\n"); grid = -1; return; }
        if (hipOccupancyMaxActiveBlocksPerMultiprocessor(&per_cu, (const void*)mk_fwd_t<0>, NTHR, LDS_BYTES) != hipSuccess || per_cu < 1) { fprintf(stderr, "kernel_launch: occupancy query says %d\n", per_cu); per_cu = 1; }
        (void)hipGetLastError();
        grid = cus;
    }
    if (grid < 0) return;
    if (hipMemsetAsync((char*)d_ws + WS_CTL, 0, CTL_ZERO_BYTES, stream) != hipSuccess) { fprintf(stderr, "kernel_launch: memset failed\n"); return; }
    Args a{};
    for (int i = 0; i < 28; ++i) a.in[i] = (const float*)d_in[i];
    a.out = (float*)d_out; a.ws = (unsigned char*)d_ws;
#if MK_N_LAUNCHES == 1
    a.ph_lo = 0; a.ph_hi = N_PHASES; a.use_bar = 1;
    void* kargs[] = {&a};
    hipError_t e = hipLaunchCooperativeKernel((const void*)mk_fwd_t<0>, dim3(grid), dim3(NTHR), kargs, LDS_BYTES, stream);
    if (e != hipSuccess) fprintf(stderr, "kernel_launch: cooperative launch failed: %s (grid %d)\n", hipGetErrorString(e), grid);
#else
#ifndef REP_MASK
#define REP_MASK 0
#endif
#ifndef REP_CODE
#define REP_CODE 1
#endif
    for (int p = 0; p < N_PHASES; ++p) {
        a.ph_lo = p; a.ph_hi = p + 1; a.use_bar = 0;
#if REP_MASK != 0
        if ((REP_MASK >> p) & 1) { static bool once = false; if (!once) { once = true; (void)hipFuncSetAttribute((const void*)mk_fwd_t<REP_CODE>, hipFuncAttributeMaxDynamicSharedMemorySize, LDS_BYTES); }
            a.rep = REP_CODE; hipLaunchKernelGGL(mk_fwd_t<REP_CODE>, dim3(grid), dim3(NTHR), LDS_BYTES, stream, a); }
#endif
        a.rep = 0;
        hipLaunchKernelGGL(mk_fwd_t<0>, dim3(grid), dim3(NTHR), LDS_BYTES, stream, a);
    }
#endif
}
```

```cpp
#include <hip/hip_runtime.h>
#include <hip/hip_cooperative_groups.h>
#include <cstdio>
#include <cstdint>
namespace cg = cooperative_groups;

namespace pg8 {
#define PG8_LAS __attribute__((address_space(3)))
typedef unsigned short bf16_t;
typedef short bf16x8 __attribute__((ext_vector_type(8)));
typedef float f32x4 __attribute__((ext_vector_type(4)));
typedef unsigned u32x4 __attribute__((ext_vector_type(4)));
constexpr int BM = 256, BK = 64, HALF = 128, HTB = HALF * BK * 2  , STAGE_BYTES = 8 * HTB, NXCD = 8, WGM = 8;

__host__ __device__ __forceinline__ int lds_byte(int r, int c) { const int st = (r >> 4) * 2 + (c >> 5), rr = r & 15, cc = c & 31, ob = rr * 64 + cc * 2; return st * 1024 + (ob ^ (((ob >> 9) & 1) << 5)); }
__host__ __device__ __forceinline__ void stage_rc(int b, int& R, int& C) { const int st = b / 1024, sb = b % 1024, swz = sb ^ (((sb >> 9) & 1) << 5); R = (st >> 1) * 16 + swz / 64; C = (st & 1) * 32 + (swz % 64) / 2; }
__host__ __device__ __forceinline__ int perm32(int rho) { const int n = rho >> 4, i = rho & 15; return 8 * (i >> 2) + 4 * n + (i & 3); }

struct Unit { int pm, pn; };
struct Gemm { const bf16_t* A; const bf16_t* Bt; int M, N, K; };

struct StaticOrder {
    int nM, nN, nwg, G, c;
    __host__ __device__ void init(int M, int N, int G_, int c_) { nM = M / BM; nN = N / BM; nwg = nM * nN; G = G_; c = c_; }
    __host__ __device__ bool next(int i, Unit& u) const {
        const long L = (long)i * G + c; if (L >= nwg) return false;
        int wgid = (int)L; { const int q = nwg / NXCD, r = nwg % NXCD, xcd = wgid % NXCD, off = wgid / NXCD; wgid = (xcd < r ? xcd * (q + 1) : r * (q + 1) + (xcd - r) * q) + off; }
        const int nig = WGM * nN, gid = wgid / nig, fm = gid * WGM, gsz = (nM - fm) < WGM ? (nM - fm) : WGM;
        u.pm = fm + ((wgid % nig) % gsz); u.pn = (wgid % nig) / gsz; return true;
    }
    __device__ __forceinline__ void a_ready(const Unit&) const {}
    __device__ __forceinline__ void done(const Unit&) const {}
};
template <class Epi, class Sched, bool ALIGN_EPI = false, bool SP2 = false>
__device__ __forceinline__ void gemm_phase(PG8_LAS unsigned char* lds, const Gemm g, const Sched& S, const Epi& E) {
    const int tid = threadIdx.x, wid = __builtin_amdgcn_readfirstlane(tid >> 6), lane = tid & 63, wr = wid >> 2, wc = wid & 3, fr = lane & 15, fq = lane >> 4;
    const int K = g.K, nt = K / BK;
    unsigned voffA[2], voffB[2];
#pragma unroll
    for (int i = 0; i < 2; ++i) { int R, C; stage_rc(tid * 16 + i * 8192, R, C); const int Rb = Epi::PERM ? ((R & ~31) + perm32(R & 31)) : R;
        voffA[i] = (unsigned)(R * K + C) * 2u; voffB[i] = (unsigned)(Rb * K + C) * 2u; }
    const size_t kstep = (size_t)(BK * 2);
    const size_t hstep = (size_t)HALF * K * 2;
    const size_t tstep = 2 * hstep;
    const unsigned ldsw = (unsigned)wid * 1024u;
    const int aoff = lds_byte(wr * 64 + fr, fq * 8), boff = lds_byte(wc * 32 + fr, fq * 8);
#define PG8_SA(b, h) (((b) * 2 + (h)) * HTB)
#define PG8_SB(b, h) ((4 + (b) * 2 + (h)) * HTB)
#define PG8_STAGE(bufoff, gbase, voff) do { _Pragma("unroll") for (int _i = 0; _i < 2; ++_i) \
        __builtin_amdgcn_global_load_lds((const unsigned*)((const char*)(gbase) + (voff)[_i]), (PG8_LAS unsigned*)(lds + (bufoff) + ldsw + _i * 8192), 16, 0, 0); } while (0)
#define PG8_LDA(dst, b, h) do { _Pragma("unroll") for (int m = 0; m < 4; ++m) _Pragma("unroll") for (int k = 0; k < 2; ++k) dst[m][k] = *(const PG8_LAS bf16x8*)(lds + PG8_SA(b, h) + aoff + m * 2048 + k * 1024); } while (0)
#define PG8_LDB(dst, b, h) do { _Pragma("unroll") for (int n = 0; n < 2; ++n) _Pragma("unroll") for (int k = 0; k < 2; ++k) dst[n][k] = *(const PG8_LAS bf16x8*)(lds + PG8_SB(b, h) + boff + n * 2048 + k * 1024); } while (0)
#define PG8_MMA(ai, bj, At, Bt) do { __builtin_amdgcn_s_setprio(1); _Pragma("unroll") for (int m = 0; m < 4; ++m) _Pragma("unroll") for (int n = 0; n < 2; ++n) _Pragma("unroll") for (int k = 0; k < 2; ++k) \
        acc[ai][bj][m][n] = __builtin_amdgcn_mfma_f32_16x16x32_bf16(Bt[n][k], At[m][k], acc[ai][bj][m][n], 0, 0, 0); __builtin_amdgcn_s_setprio(0); } while (0)
#define PG8_WAIT_V(n) asm volatile("s_waitcnt vmcnt(" #n ")" ::: "memory")
#define PG8_WAIT_L(n) asm volatile("s_waitcnt lgkmcnt(" #n ")" ::: "memory")
#define PG8_BAR __builtin_amdgcn_s_barrier()
#define PG8_SCHED __builtin_amdgcn_sched_barrier(0)
    Unit cur, nxt; int ui = 0;
    if (!S.next(0, cur)) return;
    f32x4 acc[2][2][4][2];
#pragma unroll
    for (int a = 0; a < 2; ++a)
#pragma unroll
        for (int b = 0; b < 2; ++b)
#pragma unroll
            for (int m = 0; m < 4; ++m)
#pragma unroll
                for (int n = 0; n < 2; ++n) acc[a][b][m][n] = (f32x4){0.f, 0.f, 0.f, 0.f};
    bf16x8 At[4][2], B0[2][2], B1[2][2];
    const char* cA = (const char*)g.A + (size_t)cur.pm * tstep; const char* cB = (const char*)g.Bt + (size_t)cur.pn * tstep;
    S.a_ready(cur);
    if constexpr (SP2) {
        PG8_STAGE(PG8_SB(0, 0), cB, voffB); PG8_STAGE(PG8_SB(0, 1), cB + hstep, voffB); PG8_STAGE(PG8_SA(0, 0), cA, voffA); PG8_STAGE(PG8_SA(0, 1), cA + hstep, voffA);
        if (wr == 1) PG8_BAR;
        PG8_WAIT_V(2); PG8_BAR;
        PG8_STAGE(PG8_SB(1, 0), cB + kstep, voffB); PG8_STAGE(PG8_SA(1, 0), cA + kstep, voffA); PG8_STAGE(PG8_SB(1, 1), cB + hstep + kstep, voffB);
        PG8_WAIT_V(6); PG8_BAR;
    } else {
        PG8_STAGE(PG8_SB(0, 0), cB, voffB); PG8_STAGE(PG8_SA(0, 0), cA, voffA); PG8_STAGE(PG8_SB(0, 1), cB + hstep, voffB); PG8_STAGE(PG8_SA(0, 1), cA + hstep, voffA);
        if (wr == 1) PG8_BAR;
        PG8_WAIT_V(4); PG8_BAR;
        PG8_STAGE(PG8_SB(1, 0), cB + kstep, voffB); PG8_STAGE(PG8_SA(1, 0), cA + kstep, voffA); PG8_STAGE(PG8_SB(1, 1), cB + hstep + kstep, voffB);
        PG8_WAIT_V(6); PG8_BAR;
    }
    for (;;) {
        const bool has_next = S.next(ui + 1, nxt);
        const char* nA = has_next ? (const char*)g.A + (size_t)nxt.pm * tstep : cA; const char* nB = has_next ? (const char*)g.Bt + (size_t)nxt.pn * tstep : cB;
        for (int t = 0; t < nt; t += 2) {
            if constexpr (Epi::HAS_MID) { if (t == Epi::MID_T) E.mid(acc, cur, wr, wc, fr, fq); }
            const bool last = (t == nt - 2);
            const char* a1 = cA + (size_t)(t + 1) * kstep;
            const char* a2 = last ? nA : cA + (size_t)(t + 2) * kstep; const char* b2 = last ? nB : cB + (size_t)(t + 2) * kstep;
            const char* a3 = a2 + kstep; const char* b3 = b2 + kstep;
            if (last && has_next) S.a_ready(nxt);
            if constexpr (SP2) {
            PG8_LDB(B0, 0, 0); PG8_LDB(B1, 0, 1); PG8_SCHED; PG8_LDA(At, 0, 0); PG8_STAGE(PG8_SA(1, 1), a1 + hstep, voffA);
            PG8_WAIT_V(8); PG8_WAIT_L(0); PG8_BAR; PG8_MMA(0, 0, At, B0); PG8_MMA(0, 1, At, B1); PG8_BAR; PG8_SCHED;
            PG8_LDA(At, 0, 1); PG8_STAGE(PG8_SB(0, 0), b2, voffB); PG8_STAGE(PG8_SB(0, 1), b2 + hstep, voffB); PG8_STAGE(PG8_SA(0, 0), a2, voffA);
            PG8_WAIT_V(8); PG8_WAIT_L(0); PG8_BAR; PG8_MMA(1, 0, At, B0); PG8_MMA(1, 1, At, B1); PG8_BAR; PG8_SCHED;
            PG8_LDB(B0, 1, 0); PG8_LDB(B1, 1, 1); PG8_SCHED; PG8_LDA(At, 1, 0); PG8_STAGE(PG8_SA(0, 1), a2 + hstep, voffA);
            PG8_WAIT_V(8); PG8_WAIT_L(0); PG8_BAR; PG8_MMA(0, 0, At, B0); PG8_MMA(0, 1, At, B1); PG8_BAR; PG8_SCHED;
            PG8_LDA(At, 1, 1); PG8_STAGE(PG8_SB(1, 0), b3, voffB); PG8_STAGE(PG8_SB(1, 1), b3 + hstep, voffB); PG8_STAGE(PG8_SA(1, 0), a3, voffA);
            PG8_WAIT_V(8); PG8_WAIT_L(0); PG8_BAR; PG8_MMA(1, 0, At, B0); PG8_MMA(1, 1, At, B1); PG8_BAR; PG8_SCHED;
            } else {
            PG8_LDB(B0, 0, 0); PG8_SCHED; PG8_LDA(At, 0, 0); PG8_STAGE(PG8_SA(1, 1), a1 + hstep, voffA);
            PG8_WAIT_L(8); PG8_BAR; PG8_WAIT_L(0); PG8_MMA(0, 0, At, B0); PG8_BAR; PG8_SCHED;
            PG8_LDB(B1, 0, 1); PG8_STAGE(PG8_SB(0, 0), b2, voffB);
            PG8_BAR; PG8_WAIT_L(0); PG8_MMA(0, 1, At, B1); PG8_BAR;
            PG8_LDA(At, 0, 1); PG8_STAGE(PG8_SA(0, 0), a2, voffA);
            PG8_BAR; PG8_WAIT_L(0); PG8_MMA(1, 0, At, B0); PG8_BAR; PG8_SCHED;
            PG8_STAGE(PG8_SB(0, 1), b2 + hstep, voffB);
            PG8_WAIT_V(6); PG8_BAR; PG8_MMA(1, 1, At, B1); PG8_BAR;
            PG8_LDB(B0, 1, 0); PG8_SCHED; PG8_LDA(At, 1, 0); PG8_STAGE(PG8_SA(0, 1), a2 + hstep, voffA);
            PG8_WAIT_L(8); PG8_BAR; PG8_WAIT_L(0); PG8_MMA(0, 0, At, B0); PG8_BAR; PG8_SCHED;
            PG8_LDB(B1, 1, 1); PG8_STAGE(PG8_SB(1, 0), b3, voffB);
            PG8_BAR; PG8_WAIT_L(0); PG8_MMA(0, 1, At, B1); PG8_BAR;
            PG8_LDA(At, 1, 1); PG8_STAGE(PG8_SA(1, 0), a3, voffA);
            PG8_BAR; PG8_WAIT_L(0); PG8_MMA(1, 0, At, B0); PG8_BAR; PG8_SCHED;
            PG8_STAGE(PG8_SB(1, 1), b3 + hstep, voffB);
            PG8_WAIT_V(6); PG8_BAR; PG8_MMA(1, 1, At, B1); PG8_BAR;
            }
        }
        if constexpr (ALIGN_EPI) { if (wr == 0) PG8_BAR; }
        if constexpr (!Epi::AFTER_DRAIN) { E(acc, cur, wr, wc, fr, fq); S.done(cur); }
        if (!has_next) break;
#pragma unroll
        for (int a = 0; a < 2; ++a)
#pragma unroll
            for (int b = 0; b < 2; ++b)
#pragma unroll
                for (int m = 0; m < 4; ++m)
#pragma unroll
                    for (int n = 0; n < 2; ++n) acc[a][b][m][n] = (f32x4){0.f, 0.f, 0.f, 0.f};
        cur = nxt; cA = nA; cB = nB; ++ui;
        if constexpr (ALIGN_EPI) { if (wr == 1) PG8_BAR; }
    }
    PG8_WAIT_V(0);
    if constexpr (!ALIGN_EPI) { if (wr == 0) PG8_BAR; }
    PG8_BAR;
    if constexpr (Epi::AFTER_DRAIN) { E.fused(acc, cur, wr, wc, fr, fq, lds, wid, lane); S.done(cur); }
#undef PG8_SA
#undef PG8_SB
#undef PG8_STAGE
#undef PG8_LDA
#undef PG8_LDB
#undef PG8_MMA
#undef PG8_WAIT_V
#undef PG8_WAIT_L
#undef PG8_BAR
#undef PG8_SCHED
}
}

constexpr int NWAVES = 8, NTHR = 512;
constexpr int BATCH = 4, SEQ = 8192, DM = 1024, T = BATCH * SEQ;
constexpr int NH = 8, HD = 64, NBLK = 32, BLK = 256;
constexpr int BH = BATCH * NH;
constexpr int INW = 5376;
constexpr int ZR = 1536, ZL = 256;
constexpr int PEER_N = 2048;
constexpr float RMS_EPS = 1e-6f, GN_EPS = 64e-5f;
constexpr int OSTR = 1024;

constexpr size_t MiB = 1u << 20;
constexpr size_t WS_CTL = 0, CTL_ZERO_BYTES = 1 * MiB;
constexpr size_t WS_MOD = 1 * MiB;
constexpr size_t WS_KMEAN = 1 * MiB + 128 * 1024;
constexpr size_t WS_WIN = 2 * MiB;
constexpr size_t WS_WLORA = 13 * MiB;
constexpr size_t WS_WPM = 14 * MiB, WS_WPR = 15 * MiB;
constexpr size_t WS_WOUT = 16 * MiB;
constexpr size_t WS_WEFF = 18 * MiB;
constexpr size_t WS_XN = 24 * MiB;
constexpr size_t WS_EW = 24 * MiB, WS_AA = 56 * MiB;
constexpr size_t WS_Q = 88 * MiB, WS_K = 120 * MiB, WS_VT = 152 * MiB;
constexpr size_t WS_ZRKV = 184 * MiB;
constexpr size_t WS_GT = 280 * MiB;
constexpr size_t WS_ZLORA = 408 * MiB;
constexpr size_t WS_ALORA = 424 * MiB;
constexpr size_t WS_OCAT = 408 * MiB;
constexpr size_t WS_GG = 472 * MiB;
constexpr size_t WS_MIXED = 216 * MiB;
constexpr size_t WS_U8 = 2 * MiB, WS_V8 = 88 * MiB;
constexpr size_t WS_SCORES = 96 * MiB;
constexpr size_t WS_END = 512 * MiB;
constexpr size_t DO_OPART = 0, DO_LISTS = 96 * MiB, DO_LPART = 112 * MiB;
constexpr int LIST_PER_BH = 256 * 496;
__host__ __device__ constexpr int list_off(int n) { return 256 * (31 * n - n * (n - 1) / 2); }
constexpr int CW_QUEUE = 64;
constexpr int CW_CURSOR = 1024;
constexpr int CW_BAR = 4096;

constexpr int RING_BYTES = 131072;
constexpr int LDS_BYTES = 163840;
constexpr int MISC_OFF = LDS_BYTES - 512;

#define GAS __attribute__((address_space(1)))
#define LAS __attribute__((address_space(3)))
typedef unsigned short bf16;
typedef unsigned v4u __attribute__((ext_vector_type(4)));
typedef unsigned v2u __attribute__((ext_vector_type(2)));
typedef float f32x4 __attribute__((ext_vector_type(4)));
typedef float f32x2 __attribute__((ext_vector_type(2)));
typedef float f32x16 __attribute__((ext_vector_type(16)));
typedef short bf16x8 __attribute__((ext_vector_type(8)));
typedef short s16x4 __attribute__((ext_vector_type(4)));
#define RLX_AGENT __ATOMIC_RELAXED, __HIP_MEMORY_SCOPE_AGENT
#define LDS_WAIT() asm volatile("s_waitcnt lgkmcnt(0)" ::: "memory")
#define VM_WAIT() asm volatile("s_waitcnt vmcnt(0)" ::: "memory")
typedef __bf16 bf16x2_t __attribute__((ext_vector_type(2)));
__device__ __forceinline__ unsigned cvtpk(float lo, float hi) { f32x2 v = {lo, hi}; bf16x2_t b = __builtin_convertvector(v, bf16x2_t); return __builtin_bit_cast(unsigned, b); }
__device__ __forceinline__ unsigned pk2(float lo, float hi) { return cvtpk(lo, hi); }
__device__ __forceinline__ unsigned f2bf(float f) { return cvtpk(f, 0.f) & 0xffffu; }
__device__ __forceinline__ float bflo(unsigned u) { return __builtin_bit_cast(float, u << 16); }
__device__ __forceinline__ float bfhi(unsigned u) { return __builtin_bit_cast(float, u & 0xffff0000u); }
__device__ __forceinline__ float bf2f(bf16 h) { return __builtin_bit_cast(float, (unsigned)h << 16); }
__device__ __forceinline__ float wave_sum(float v) {
#pragma unroll
    for (int o = 1; o < 64; o <<= 1) v += __shfl_xor(v, o);
    return v;
}
__device__ __forceinline__ float sigmoidf_(float x) { return __builtin_amdgcn_rcpf(1.0f + __expf(-x)); }
#define XB_TMO      128
#define XB_XCNT(j)  (256  + 64 * (j))
#define XB_XSUB(j)  (1280 + 64 * (j))
#define XB_XGEN(j)  (2304 + 64 * (j))
#define XB_TOP      3328
#define XB_TOPGEN   3392
#define XCD_BAR_WORDS 3456
#define XB_SPIN_CAP (1u << 18)

__device__ __forceinline__ unsigned xb_ld(unsigned* p)              { return __hip_atomic_load(p, __ATOMIC_RELAXED, __HIP_MEMORY_SCOPE_AGENT); }
__device__ __forceinline__ unsigned xb_add(unsigned* p, unsigned v) { return __hip_atomic_fetch_add(p, v, __ATOMIC_RELAXED, __HIP_MEMORY_SCOPE_AGENT); }
__device__ __forceinline__ unsigned xb_xcc_id() { return (unsigned)__builtin_amdgcn_s_getreg((3 << 11) | 20) & 0xFu; }
#define XB_SPIN(cond, bar) do { unsigned _sp = 0; while (cond) { __builtin_amdgcn_s_sleep(1); \
    if ((++_sp & 255u) == 0u) { if (xb_ld(&(bar)[XB_TMO])) break; if (_sp > XB_SPIN_CAP) { atomicAdd(&(bar)[XB_TMO], 1u); break; } } } } while (0)

struct XcdBarrier {
    unsigned* bar; unsigned x;
    volatile LAS unsigned* st;
};

__device__ __forceinline__ XcdBarrier xcd_barrier_post(unsigned* bar, volatile LAS unsigned* st) {
    XcdBarrier b; b.bar = bar; b.x = xb_xcc_id(); b.st = st;
    if (threadIdx.x == 0) (void)xb_add(&bar[XB_XCNT(b.x)], 1u);
    return b;
}
__device__ __forceinline__ void xcd_barrier_complete(unsigned* bar, unsigned x, unsigned& nloc, unsigned& nx) {
    const unsigned G = gridDim.x * gridDim.y * gridDim.z;
    unsigned sum, cnt, mine, sp = 0u;
    for (;;) {
        sum = 0u; cnt = 0u; mine = 0u;
#pragma unroll
        for (unsigned j = 0; j < 16; ++j) { const unsigned c = xb_ld(&bar[XB_XCNT(j)]); sum += c; cnt += (c > 0u) ? 1u : 0u; mine = (j == x) ? c : mine; }
        if (sum == G) break;
        __builtin_amdgcn_s_sleep(1);
        if ((++sp & 255u) == 0u) { if (xb_ld(&bar[XB_TMO])) break; if (sp > XB_SPIN_CAP) { atomicAdd(&bar[XB_TMO], 1u); break; } }
    }
    nloc = mine > 0u ? mine : 1u; nx = cnt > 0u ? cnt : 1u;
}

__device__ __forceinline__ void xcd_barrier(const XcdBarrier& b) {
    asm volatile("s_waitcnt vmcnt(0)" ::: "memory");
    __syncthreads();
    if (threadIdx.x == 0) {
        unsigned* bar = b.bar;
        __builtin_amdgcn_s_waitcnt(0);
        unsigned nloc = b.st[0], nx = b.st[1];
        if (nloc == 0u) { xcd_barrier_complete(bar, b.x, nloc, nx); b.st[0] = nloc; b.st[1] = nx; }
        const unsigned old = xb_add(&bar[XB_XSUB(b.x)], 1u);
        const unsigned gen = old / nloc;
        if (old + 1u == (gen + 1u) * nloc) {
            __builtin_amdgcn_fence(__ATOMIC_RELEASE, "agent");
            asm volatile("s_waitcnt vmcnt(0)" ::: "memory");
            const unsigned og = xb_add(&bar[XB_TOP], 1u);
            const unsigned tg = og / nx;
            if (og + 1u == (tg + 1u) * nx) xb_add(&bar[XB_TOPGEN], 1u);
            else XB_SPIN(xb_ld(&bar[XB_TOPGEN]) == tg, bar);
            __builtin_amdgcn_fence(__ATOMIC_ACQUIRE, "agent");
            xb_add(&bar[XB_XGEN(b.x)], 1u);
            asm volatile("s_waitcnt vmcnt(0)" ::: "memory");
        } else {
            XB_SPIN(xb_ld(&bar[XB_XGEN(b.x)]) == gen, bar);
            __builtin_amdgcn_fence(__ATOMIC_ACQUIRE, "agent");
            asm volatile("s_waitcnt vmcnt(0)" ::: "memory");
        }
    }
    __syncthreads();
}

__device__ __forceinline__ void p0_transpose_item(const float* W, int K, int N, bf16* WT, int ldk, int koff, LAS float* scr, int item, int lane) {
    const int nblk = N / 32, kb = item / nblk, nb = item % nblk, k0 = 64 * kb, n0 = 32 * nb;
#pragma unroll 8
    for (int i = 0; i < 32; ++i) { const int kk = 2 * i + (lane >> 5); scr[kk * 33 + (lane & 31)] = W[(size_t)(k0 + kk) * N + n0 + (lane & 31)]; }
    LDS_WAIT(); asm volatile("" ::: "memory");
    const int c = lane & 7;
#pragma unroll
    for (int j = 0; j < 4; ++j) { const int n = (lane >> 3) + 8 * j; const LAS float* s = scr + (8 * c) * 33 + n;
        v4u o; o.x = pk2(s[0 * 33], s[1 * 33]); o.y = pk2(s[2 * 33], s[3 * 33]); o.z = pk2(s[4 * 33], s[5 * 33]); o.w = pk2(s[6 * 33], s[7 * 33]);
#ifdef EMU_FP8_G2
        if (N == INW) { float f_[8];
            for (int e_ = 0; e_ < 8; e_ += 2) { int w_ = __builtin_amdgcn_cvt_pk_fp8_f32(s[e_ * 33] * 256.f, s[(e_ + 1) * 33] * 256.f, 0, false); const f32x2 l_ = __builtin_amdgcn_cvt_pk_f32_fp8(w_, false); f_[e_] = l_.x * (1.f / 256.f); f_[e_ + 1] = l_.y * (1.f / 256.f); }
            o.x = pk2(f_[0], f_[1]); o.y = pk2(f_[2], f_[3]); o.z = pk2(f_[4], f_[5]); o.w = pk2(f_[6], f_[7]); }
#endif
        *(GAS v4u*)(WT + (size_t)(n0 + n) * ldk + koff + k0 + 8 * c) = o; }
    LDS_WAIT(); asm volatile("" ::: "memory");
}
__device__ __forceinline__ void p0_mod_item(const float* c, const float* w_ada, const float* b_ada, float* modp, LAS float* red  , int item, int wave, int lane) {
    const int j = item * 64 + lane;
    float a0 = 0.f, a1 = 0.f, a2 = 0.f, a3 = 0.f;
#pragma unroll 8
    for (int k = 128 * wave; k < 128 * wave + 128; ++k) {
        const float w = w_ada[(size_t)k * 6144 + j];
        const float c0 = c[k], c1 = c[1024 + k], c2 = c[2048 + k], c3 = c[3072 + k];
        a0 += c0 / (1.f + __expf(-c0)) * w; a1 += c1 / (1.f + __expf(-c1)) * w; a2 += c2 / (1.f + __expf(-c2)) * w; a3 += c3 / (1.f + __expf(-c3)) * w;
    }
    red[(wave * 4 + 0) * 64 + lane] = a0; red[(wave * 4 + 1) * 64 + lane] = a1; red[(wave * 4 + 2) * 64 + lane] = a2; red[(wave * 4 + 3) * 64 + lane] = a3;
    LDS_WAIT(); __syncthreads();
    if (wave < 4) { float s = b_ada[j];
#pragma unroll
        for (int w = 0; w < 8; ++w) s += red[(w * 4 + wave) * 64 + lane];
        modp[wave * 6144 + j] = s; }
    __syncthreads();
}
__device__ __forceinline__ void p0_weff_item(const float* wq, const float* sk, bf16* weff, int item, int lane) {
    const int nq = item & 3, kb = (item >> 2) & 31, hp = item >> 7;
    const int k = kb * 32 + (lane & 31), dh = lane >> 5;
    float w[64];
    const f32x4* src = (const f32x4*)(wq + (size_t)k * 2048 + hp * 128 + 64 * dh);
#pragma unroll
    for (int i = 0; i < 16; ++i) { const f32x4 v = src[i]; w[4 * i] = v.x; w[4 * i + 1] = v.y; w[4 * i + 2] = v.z; w[4 * i + 3] = v.w; }
#pragma unroll 1
    for (int n = nq * 32; n < nq * 32 + 32; n += 2) {
        float acc[2] = {0.f, 0.f};
#pragma unroll
        for (int u = 0; u < 2; ++u) {
            const f32x4* s = (const f32x4*)(sk + ((size_t)hp * 128 + n + u) * 128 + 64 * dh);
#pragma unroll
            for (int d = 0; d < 16; ++d) { const f32x4 s4 = s[d]; acc[u] += w[4 * d] * s4.x; acc[u] += w[4 * d + 1] * s4.y; acc[u] += w[4 * d + 2] * s4.z; acc[u] += w[4 * d + 3] * s4.w; }
        }
#pragma unroll
        for (int u = 0; u < 2; ++u) { acc[u] += __shfl_xor(acc[u], 32); if (dh == 0) weff[((size_t)hp * 128 + n + u) * 1024 + k] = (bf16)f2bf(acc[u]); }
    }
}
template <int NR> __device__ __forceinline__ void rms_mod_rows(const float* xrow, bf16* orow, unsigned* o8row  , const float* g, const float* sc, const float* sh, int lane) {
    f32x4 v[NR][4]; float ss[NR];
#pragma unroll
    for (int rr = 0; rr < NR; ++rr) { const f32x4* xr = (const f32x4*)(xrow + (size_t)rr * 1024) + lane; ss[rr] = 0.f;
#pragma unroll
        for (int j = 0; j < 4; ++j) v[rr][j] = xr[64 * j]; }
#pragma unroll
    for (int rr = 0; rr < NR; ++rr)
#pragma unroll
        for (int j = 0; j < 4; ++j) ss[rr] += (v[rr][j].x * v[rr][j].x + v[rr][j].y * v[rr][j].y) + (v[rr][j].z * v[rr][j].z + v[rr][j].w * v[rr][j].w);
#pragma unroll
    for (int o = 1; o < 64; o <<= 1) {
#pragma unroll
        for (int rr = 0; rr < NR; ++rr) ss[rr] += __shfl_xor(ss[rr], o);
    }
#pragma unroll
    for (int j = 0; j < 4; ++j) { const int col = 4 * lane + 256 * j;
        const f32x4 g4 = *(const f32x4*)(g + col), s4 = *(const f32x4*)(sc + col), h4 = *(const f32x4*)(sh + col);
#pragma unroll
        for (int rr = 0; rr < NR; ++rr) {
            const float rstd = 1.f / sqrtf(ss[rr] * (1.f / 1024.f) + RMS_EPS);
            const float o0 = v[rr][j].x * rstd * g4.x * (1.f + s4.x) + h4.x, o1 = v[rr][j].y * rstd * g4.y * (1.f + s4.y) + h4.y;
            const float o2 = v[rr][j].z * rstd * g4.z * (1.f + s4.z) + h4.z, o3 = v[rr][j].w * rstd * g4.w * (1.f + s4.w) + h4.w;
            ((unsigned long long*)(orow + (size_t)rr * 1024))[lane + 64 * j] = (unsigned long long)pk2(o0, o1) | ((unsigned long long)pk2(o2, o3) << 32);
            if (o8row) { int w = 0; w = __builtin_amdgcn_cvt_pk_fp8_f32(fminf(fmaxf(o0 * 8.f, -448.f), 448.f), fminf(fmaxf(o1 * 8.f, -448.f), 448.f), w, false);
                w = __builtin_amdgcn_cvt_pk_fp8_f32(fminf(fmaxf(o2 * 8.f, -448.f), 448.f), fminf(fmaxf(o3 * 8.f, -448.f), 448.f), w, true); (o8row + (size_t)rr * 256)[lane + 64 * j] = (unsigned)w; }
        }
    }
}

__device__ __forceinline__ v4u pack8(const f32x4 a, const f32x4 b) { v4u w; w.x = pk2(a.x, a.y); w.y = pk2(a.z, a.w); w.z = pk2(b.x, b.y); w.w = pk2(b.z, b.w); return w; }
__device__ __forceinline__ size_t gt_off(int pm, int pt, int frag, int wave, int lane) { return ((((size_t)(pm * 8 + pt) * 16 + frag) * 8 + wave) * 64 + lane) * 8; }
struct EpiIn {
    static constexpr bool PERM = true, AFTER_DRAIN = false, HAS_MID = false;
    bf16 *Q, *K, *VT, *ZRKV, *ZLORA, *GT;
    __device__ __forceinline__ void operator()(const f32x4 (&acc)[2][2][4][2], const pg8::Unit& u, int wr, int wc, int fr, int fq) const {
        const int pn = u.pn;
#pragma unroll
        for (int ai = 0; ai < 2; ++ai)
#pragma unroll
            for (int m = 0; m < 4; ++m) {
                const int row = u.pm * 256 + ai * 128 + wr * 64 + m * 16 + fr;
                const int b = row >> 13, s = row & 8191;
#pragma unroll
                for (int bj = 0; bj < 2; ++bj) {
                    const int colt = bj * 128 + wc * 32 + 8 * fq;
                    const f32x4 v0 = acc[ai][bj][m][0], v1 = acc[ai][bj][m][1];
                    if (pn < 4) {
                        bf16* base = pn < 2 ? Q : K; const int h = 4 * (pn & 1) + (colt >> 6), d0 = colt & 63;
                        *(v4u*)(base + ((size_t)((b * 8 + h) * 8192 + s)) * 64 + d0) = pack8(v0, v1);
                    } else if (pn < 6) {
                        const int h = 4 * (pn - 4) + (colt >> 6), dv0 = colt & 63;
                        bf16* p = VT + ((size_t)((b * 8 + h) * 64 + dv0)) * 8192 + s;
                        p[0 * 8192] = (bf16)f2bf(v0.x); p[1 * 8192] = (bf16)f2bf(v0.y); p[2 * 8192] = (bf16)f2bf(v0.z); p[3 * 8192] = (bf16)f2bf(v0.w);
                        p[4 * 8192] = (bf16)f2bf(v1.x); p[5 * 8192] = (bf16)f2bf(v1.y); p[6 * 8192] = (bf16)f2bf(v1.z); p[7 * 8192] = (bf16)f2bf(v1.w);
                    } else if (pn < 12) {
                        *(v4u*)(ZRKV + (size_t)row * ZR + 256 * (pn - 6) + colt) = pack8(v0, v1);
                    } else if (pn == 12) {
                        *(v4u*)(ZLORA + (size_t)row * ZL + colt) = pack8(v0, v1);
                    } else {
                        f32x4 s0, s1;
                        s0.x = sigmoidf_(v0.x); s0.y = sigmoidf_(v0.y); s0.z = sigmoidf_(v0.z); s0.w = sigmoidf_(v0.w);
                        s1.x = sigmoidf_(v1.x); s1.y = sigmoidf_(v1.y); s1.z = sigmoidf_(v1.z); s1.w = sigmoidf_(v1.w);
                        *(v4u*)(GT + gt_off(u.pm, pn - 13, 0, wr * 4 + wc, fq * 16 + fr) + (size_t)(((ai * 4 + m) * 2 + bj) * 4096)) = pack8(s0, s1);
                    }
                }
            }
    }
};
struct EpiLora {
    static constexpr bool PERM = true, AFTER_DRAIN = false, HAS_MID = false;
    bf16 *EW, *AA, *GG; const float *w0, *a0;
    __device__ __forceinline__ void operator()(const f32x4 (&acc)[2][2][4][2], const pg8::Unit& u, int wr, int wc, int fr, int fq) const {
        const int pn = u.pn;
#pragma unroll
        for (int ai = 0; ai < 2; ++ai)
#pragma unroll
            for (int m = 0; m < 4; ++m) {
                const int row = u.pm * 256 + ai * 128 + wr * 64 + m * 16 + fr;
#pragma unroll
                for (int bj = 0; bj < 2; ++bj) {
                    const int c = 256 * (pn & 1) + bj * 128 + wc * 32 + 8 * fq;
                    const f32x4 v0 = acc[ai][bj][m][0], v1 = acc[ai][bj][m][1];
                    float v[8] = {v0.x, v0.y, v0.z, v0.w, v1.x, v1.y, v1.z, v1.w};
                    bf16* dst;
                    if (pn < 2) {
#pragma unroll
                        for (int i = 0; i < 8; ++i) v[i] = 0.60653065971263342f * sigmoidf_(w0[c + i] + v[i]);
                        dst = EW;
                    } else if (pn < 4) {
#pragma unroll
                        for (int i = 0; i < 8; ++i) v[i] = sigmoidf_(a0[c + i] + v[i]);
                        dst = AA;
                    } else dst = GG;
                    v4u w; w.x = pk2(v[0], v[1]); w.y = pk2(v[2], v[3]); w.z = pk2(v[4], v[5]); w.w = pk2(v[6], v[7]);
                    *(v4u*)(dst + (size_t)row * 512 + c) = w;
                }
            }
    }
};
struct EpiMix {
    static constexpr bool PERM = true, AFTER_DRAIN = false, HAS_MID = true; static constexpr int MID_T = 8;
    const bf16* GT; bf16* MIXED; int probe;
    __device__ __forceinline__ void mid(f32x4 (&acc)[2][2][4][2], const pg8::Unit& u, int wr, int wc, int fr, int fq) const {
        if (probe & 1) return;
        const bf16* pm_ = GT + gt_off(u.pm, u.pn, 0, wr * 4 + wc, fq * 16 + fr); const bf16* pr_ = GT + gt_off(u.pm, u.pn + 4, 0, wr * 4 + wc, fq * 16 + fr);
#pragma unroll
        for (int ai = 0; ai < 2; ++ai)
#pragma unroll
            for (int m = 0; m < 4; ++m)
#pragma unroll
                for (int bj = 0; bj < 2; ++bj) {
                    const v4u gm = *(const v4u*)pm_, gr = *(const v4u*)pr_;
                    pm_ += 4096; pr_ += 4096; asm volatile("" : "+v"(pm_), "+v"(pr_));
                    f32x4 r0, r1;
                    r0.x = bflo(gm.x) * __builtin_amdgcn_rcpf(fmaxf(bflo(gr.x), 1e-30f)); r0.y = bfhi(gm.x) * __builtin_amdgcn_rcpf(fmaxf(bfhi(gr.x), 1e-30f));
                    r0.z = bflo(gm.y) * __builtin_amdgcn_rcpf(fmaxf(bflo(gr.y), 1e-30f)); r0.w = bfhi(gm.y) * __builtin_amdgcn_rcpf(fmaxf(bfhi(gr.y), 1e-30f));
                    r1.x = bflo(gm.z) * __builtin_amdgcn_rcpf(fmaxf(bflo(gr.z), 1e-30f)); r1.y = bfhi(gm.z) * __builtin_amdgcn_rcpf(fmaxf(bfhi(gr.z), 1e-30f));
                    r1.z = bflo(gm.w) * __builtin_amdgcn_rcpf(fmaxf(bflo(gr.w), 1e-30f)); r1.w = bfhi(gm.w) * __builtin_amdgcn_rcpf(fmaxf(bfhi(gr.w), 1e-30f));
                    acc[ai][bj][m][0] = acc[ai][bj][m][0] * r0; acc[ai][bj][m][1] = acc[ai][bj][m][1] * r1;
                }
    }
    __device__ __forceinline__ void operator()(const f32x4 (&acc)[2][2][4][2], const pg8::Unit& u, int wr, int wc, int fr, int fq) const {
        const bf16* pr_ = GT + gt_off(u.pm, u.pn + 4, 0, wr * 4 + wc, fq * 16 + fr);
#pragma unroll
        for (int ai = 0; ai < 2; ++ai)
#pragma unroll
            for (int m = 0; m < 4; ++m) {
                const int row = u.pm * 256 + ai * 128 + wr * 64 + m * 16 + fr;
#pragma unroll
                for (int bj = 0; bj < 2; ++bj) {
                    const int c = u.pn * 256 + bj * 128 + wc * 32 + 8 * fq;
                    v4u g = {0x3f803f80u, 0x3f803f80u, 0x3f803f80u, 0x3f803f80u};
                    if (!(probe & 2)) g = *(const v4u*)pr_;
                    pr_ += 4096; asm volatile("" : "+v"(pr_));
                    const f32x4 v0 = acc[ai][bj][m][0], v1 = acc[ai][bj][m][1];
                    f32x4 o0, o1;
                    o0.x = bflo(g.x) * v0.x; o0.y = bfhi(g.x) * v0.y; o0.z = bflo(g.y) * v0.z; o0.w = bfhi(g.y) * v0.w;
                    o1.x = bflo(g.z) * v1.x; o1.y = bfhi(g.z) * v1.y; o1.z = bflo(g.w) * v1.z; o1.w = bfhi(g.w) * v1.w;
                    *(v4u*)(MIXED + (size_t)row * 1024 + c) = pack8(o0, o1);
                }
            }
    }
};
struct EpiOut {
    static constexpr bool PERM = true, AFTER_DRAIN = false, HAS_MID = false;
    const float* X; const float* MOD; float* OUT;
    __device__ __forceinline__ void operator()(const f32x4 (&acc)[2][2][4][2], const pg8::Unit& u, int wr, int wc, int fr, int fq) const {
#pragma unroll
        for (int ai = 0; ai < 2; ++ai)
#pragma unroll
            for (int m = 0; m < 4; ++m) {
                const int row = u.pm * 256 + ai * 128 + wr * 64 + m * 16 + fr;
                const float* gt1 = MOD + (size_t)(row >> 13) * 6144 + 2048;
#pragma unroll
                for (int bj = 0; bj < 2; ++bj) {
                    const int c = u.pn * 256 + bj * 128 + wc * 32 + 8 * fq;
                    const float* xp = X + (size_t)row * 1024 + c;
                    const f32x4 x0 = *(const f32x4*)xp, x1 = *(const f32x4*)(xp + 4);
                    const f32x4 g0 = *(const f32x4*)(gt1 + c), g1 = *(const f32x4*)(gt1 + c + 4);
                    const f32x4 v0 = acc[ai][bj][m][0], v1 = acc[ai][bj][m][1];
                    float* d = OUT + (size_t)row * 1024 + c;
                    *(f32x4*)d = x0 + g0 * v0; *(f32x4*)(d + 4) = x1 + g1 * v1;
                }
            }
    }
};
struct EpiScores {
    static constexpr bool PERM = true, AFTER_DRAIN = false, HAS_MID = false;
    bf16* SC;
    __device__ __forceinline__ void operator()(const f32x4 (&acc)[2][2][4][2], const pg8::Unit& u, int wr, int wc, int fr, int fq) const {
#pragma unroll
        for (int ai = 0; ai < 2; ++ai)
#pragma unroll
            for (int m = 0; m < 4; ++m) {
                const int row = u.pm * 256 + ai * 128 + wr * 64 + m * 16 + fr;
#pragma unroll
                for (int bj = 0; bj < 2; ++bj) {
                    const int c = u.pn * 256 + bj * 128 + wc * 32 + 8 * fq;
                    *(v4u*)(SC + (size_t)row * 2048 + c) = pack8(acc[ai][bj][m][0], acc[ai][bj][m][1]);
                }
            }
    }
};


__device__ __forceinline__ void p2_qk_load(v4u (&raw)[4], int (&ps)[4], const bf16* buf, const int* pos, int bh, int n, int wave, int lane) {
#pragma unroll
    for (int it = 0; it < 4; ++it) { const int row = n * 256 + wave * 32 + it * 8 + (lane >> 3);
        raw[it] = *(const v4u*)(buf + ((size_t)(bh * 8192 + row)) * 64 + 8 * (lane & 7)); ps[it] = pos[(bh >> 3) * 8192 + row]; }
}
__device__ __forceinline__ void p2_qk_item(const v4u (&rawin)[4], const int (&psin)[4], bf16* obuf, const float* g, float* kmean, int bh, int n, LAS float* red, int tid, int wave, int lane) {
    const int c = lane & 7, rsub = lane >> 3;
    float gg[8], ks[8];
#pragma unroll
    for (int i = 0; i < 8; ++i) { gg[i] = g[8 * c + i]; ks[i] = 0.f; }
#pragma unroll
    for (int it = 0; it < 4; ++it) {
        const int row = n * 256 + wave * 32 + it * 8 + rsub;
        const size_t po = ((size_t)(bh * 8192 + row)) * 64 + 8 * c;
        const v4u raw = rawin[it];
        float x[8] = {bflo(raw.x), bfhi(raw.x), bflo(raw.y), bfhi(raw.y), bflo(raw.z), bfhi(raw.z), bflo(raw.w), bfhi(raw.w)};
        float ss = 0.f;
#pragma unroll
        for (int i = 0; i < 8; ++i) ss += x[i] * x[i];
        ss += __shfl_xor(ss, 1); ss += __shfl_xor(ss, 2); ss += __shfl_xor(ss, 4);
        const float rstd = 1.f / sqrtf(ss * (1.f / 64.f) + RMS_EPS);
        float y[8], py[8];
#pragma unroll
        for (int i = 0; i < 8; ++i) y[i] = x[i] * rstd * gg[i];
#pragma unroll
        for (int i = 0; i < 8; ++i) py[i] = __shfl_xor(y[i], 1);
        {
            const float myang = (float)psin[it] * exp2f(-(float)c * (18.931568569324174f / 8.f));
            const float mys = __sinf(myang), myc = __cosf(myang);
            float sn[8], cs[8];
#pragma unroll
            for (int i = 0; i < 8; ++i) { sn[i] = __shfl(mys, (lane & ~7) + i); cs[i] = __shfl(myc, (lane & ~7) + i); }
            if (c < 2) {
#pragma unroll
                for (int i = 0; i < 8; ++i) y[i] = (c == 0) ? (y[i] * cs[i] - py[i] * sn[i]) : (y[i] * cs[i] + py[i] * sn[i]);
            }
        }
        v4u o; o.x = pk2(y[0], y[1]); o.y = pk2(y[2], y[3]); o.z = pk2(y[4], y[5]); o.w = pk2(y[6], y[7]);
        *(v4u*)(obuf + po) = o;
#pragma unroll
        for (int i = 0; i < 8; ++i) ks[i] += y[i];
    }
    if (kmean) {
#pragma unroll
        for (int i = 0; i < 8; ++i) { ks[i] += __shfl_xor(ks[i], 8); ks[i] += __shfl_xor(ks[i], 16); ks[i] += __shfl_xor(ks[i], 32); }
        if (lane < 8) {
#pragma unroll
            for (int i = 0; i < 8; ++i) red[wave * 64 + 8 * lane + i] = ks[i];
        }
        __syncthreads();
        if (tid < 64) { float s = 0.f;
#pragma unroll
            for (int w = 0; w < 8; ++w) s += red[w * 64 + tid];
            kmean[(size_t)(bh * 32 + n) * 64 + tid] = s * (1.f / 256.f); }
        __syncthreads();
    }
}
__device__ __forceinline__ void p2_prep(const bf16* ZL_, const float* mu, bf16* AL, int gtid, int ntot) {
#pragma unroll 2
    for (int idx = gtid; idx < T * 32; idx += ntot) {
        const int t = idx >> 5, col = (idx & 31) * 8, s = t & 8191;
        const v4u cur = *(const v4u*)(ZL_ + (size_t)t * ZL + col);
        v4u prv = *(const v4u*)(ZL_ + (size_t)(s ? t - 1 : t) * ZL + col);
        prv = prv & (s ? 0xffffffffu : 0u);
        const float cz[8] = {bflo(cur.x), bfhi(cur.x), bflo(cur.y), bfhi(cur.y), bflo(cur.z), bfhi(cur.z), bflo(cur.w), bfhi(cur.w)};
        const float pz[8] = {bflo(prv.x), bfhi(prv.x), bflo(prv.y), bfhi(prv.y), bflo(prv.z), bfhi(prv.z), bflo(prv.w), bfhi(prv.w)};
        float o[8];
#pragma unroll
        for (int i = 0; i < 8; ++i) { const float z = cz[i] + (pz[i] - cz[i]) * mu[1536 + col + i];
            o[i] = (col < 64) ? tanhf(z) : ((col < 128) ? z : sigmoidf_(z)); }
        v4u w; w.x = pk2(o[0], o[1]); w.y = pk2(o[2], o[3]); w.z = pk2(o[4], o[5]); w.w = pk2(o[6], o[7]);
        *(v4u*)(AL + (size_t)t * ZL + col) = w;
    }
}

__device__ __forceinline__ void p3_top3_item(const bf16* Q, const float* kmean, unsigned* cursor, unsigned* lists, int bh0, int qb, LAS float* kmbase, int tid, int wave, int lane) {
    if (qb == 0) return;
    const int hf = wave >> 2, bh = bh0 + hf, w4 = wave & 3;
    LAS float* km = kmbase + hf * 2048;
    for (int i = (tid & 255); i < qb * 64; i += 256) km[i] = kmean[(size_t)bh * 2048 + i];
    __syncthreads();
    {
        const int s = qb * 256 + w4 * 64 + lane;
        float q[64];
        const v4u* qp = (const v4u*)(Q + ((size_t)(bh * 8192 + s)) * 64);
#pragma unroll
        for (int i = 0; i < 8; ++i) { const v4u r = qp[i];
            q[8 * i] = bflo(r.x); q[8 * i + 1] = bfhi(r.x); q[8 * i + 2] = bflo(r.y); q[8 * i + 3] = bfhi(r.y);
            q[8 * i + 4] = bflo(r.z); q[8 * i + 5] = bfhi(r.z); q[8 * i + 6] = bflo(r.w); q[8 * i + 7] = bfhi(r.w); }
        float v0 = -INFINITY, v1 = -INFINITY, v2 = -INFINITY; int i0 = -1, i1 = -1, i2 = -1;
        for (int n = 0; n < qb; ++n) {
            float dot = 0.f;
#pragma unroll
            for (int d4 = 0; d4 < 16; ++d4) { const f32x4 kk = *(const LAS f32x4*)(km + n * 64 + 4 * d4);
                dot += q[4 * d4] * kk.x; dot += q[4 * d4 + 1] * kk.y; dot += q[4 * d4 + 2] * kk.z; dot += q[4 * d4 + 3] * kk.w; }
            if (dot > v0) { v2 = v1; i2 = i1; v1 = v0; i1 = i0; v0 = dot; i0 = n; }
            else if (dot > v1) { v2 = v1; i2 = i1; v1 = dot; i1 = n; }
            else if (dot > v2) { v2 = dot; i2 = n; }
        }
        for (int n = 0; n < qb; ++n) {
            const int slot = (i0 == n) ? 0 : ((i1 == n) ? 1 : ((i2 == n) ? 2 : -1));
            const unsigned long long mask = __ballot(slot >= 0);
            if (mask == 0ull) continue;
            const unsigned cnt = (unsigned)__popcll(mask);
            unsigned base = 0u;
            if (lane == 0) base = __hip_atomic_fetch_add(cursor + bh * 32 + n, cnt, RLX_AGENT);
            base = (unsigned)__shfl((int)base, 0);
            if (slot >= 0) { const unsigned pos = base + (unsigned)__popcll(mask & ((1ull << lane) - 1ull));
                lists[(size_t)bh * LIST_PER_BH + list_off(n) + pos] = ((unsigned)s << 2) | (unsigned)slot; }
        }
    }
    __syncthreads();
}

template <int CTRL> __device__ __forceinline__ float dppf(float v) { return __builtin_bit_cast(float, __builtin_amdgcn_update_dpp(0, __builtin_bit_cast(int, v), CTRL, 0xF, 0xF, true)); }
__device__ __forceinline__ float allreduce16(float v) {
    v += dppf<0xB1>(v); v += dppf<0x4E>(v); v += dppf<0x141>(v); v += dppf<0x140>(v); return v;
}
constexpr int CK = 64, NCHK = SEQ / CK, CS = 72, SLOT = CK * CS;
__device__ __forceinline__ int sx(int row, int col) { return row * CS + (((col >> 3) ^ ((row >> 4) & 3)) << 3) + (col & 7); }
struct ScanRaw { v4u zr, zk, zv, pr, pk, pv, a, ew; };
__device__ __forceinline__ void scan_load(ScanRaw& R, const bf16* Z, const bf16* AA, const bf16* EW, int b, int hc0, int t) {
    const bf16* p = Z + (size_t)(b * 8192 + t) * ZR + hc0;
    const bf16* pp = (t > 0) ? p - ZR : p;
    R.zr = *(const v4u*)p; R.zk = *(const v4u*)(p + 512); R.zv = *(const v4u*)(p + 1024);
    R.pr = *(const v4u*)pp; R.pk = *(const v4u*)(pp + 512); R.pv = *(const v4u*)(pp + 1024);
    const unsigned m = (t > 0) ? 0xffffffffu : 0u;
    R.pr = R.pr & m; R.pk = R.pk & m; R.pv = R.pv & m;
    const size_t o = (size_t)(b * 8192 + t) * 512 + hc0;
    R.a = *(const v4u*)(AA + o); R.ew = *(const v4u*)(EW + o);
}
__device__ __forceinline__ void unpack8(const v4u w, float (&f)[8]) { f[0] = bflo(w.x); f[1] = bfhi(w.x); f[2] = bflo(w.y); f[3] = bfhi(w.y); f[4] = bflo(w.z); f[5] = bfhi(w.z); f[6] = bflo(w.w); f[7] = bfhi(w.w); }
__device__ __forceinline__ v4u pack8f(const float (&f)[8]) { v4u w; w.x = cvtpk(f[0], f[1]); w.y = cvtpk(f[2], f[3]); w.z = cvtpk(f[4], f[5]); w.w = cvtpk(f[6], f[7]); return w; }
__device__ __forceinline__ f32x4 mm_tile(const LAS bf16* A, const LAS bf16* BT, int mt, int nt, int r, int q, f32x4 acc) {
#pragma unroll
    for (int ks = 0; ks < 2; ++ks) {
        const bf16x8 a = *(const LAS bf16x8*)(A + sx(16 * mt + r, 32 * ks + 8 * q));
        const bf16x8 b = *(const LAS bf16x8*)(BT + sx(16 * nt + r, 32 * ks + 8 * q));
        acc = __builtin_amdgcn_mfma_f32_16x16x32_bf16(a, b, acc, 0, 0, 0);
    }
    return acc;
}
struct PairF { bf16x8 b0, b1, a00, a01, a10, a11; };
__device__ __forceinline__ void mm_load(PairF& f, const LAS bf16* A, const LAS bf16* BT, int mt, int nt, int r, int q) {
    f.b0 = *(const LAS bf16x8*)(BT + sx(16 * nt + r, 8 * q)); f.b1 = *(const LAS bf16x8*)(BT + sx(16 * nt + r, 32 + 8 * q));
    f.a00 = *(const LAS bf16x8*)(A + sx(16 * mt + r, 8 * q)); f.a01 = *(const LAS bf16x8*)(A + sx(16 * mt + r, 32 + 8 * q));
    f.a10 = *(const LAS bf16x8*)(A + sx(16 * mt + 32 + r, 8 * q)); f.a11 = *(const LAS bf16x8*)(A + sx(16 * mt + 32 + r, 32 + 8 * q));
}
__device__ __forceinline__ void mm_mul(const PairF& f, f32x4& c0, f32x4& c1) {
    c0 = __builtin_amdgcn_mfma_f32_16x16x32_bf16(f.a00, f.b0, c0, 0, 0, 0); c1 = __builtin_amdgcn_mfma_f32_16x16x32_bf16(f.a10, f.b0, c1, 0, 0, 0);
    c0 = __builtin_amdgcn_mfma_f32_16x16x32_bf16(f.a01, f.b1, c0, 0, 0, 0); c1 = __builtin_amdgcn_mfma_f32_16x16x32_bf16(f.a11, f.b1, c1, 0, 0, 0);
}
__device__ __forceinline__ void mm_pair(const LAS bf16* A, const LAS bf16* BT, int mt, int nt, int r, int q, f32x4& c0, f32x4& c1) { PairF f; mm_load(f, A, BT, mt, nt, r, q); mm_mul(f, c0, c1); }
__device__ __forceinline__ void st_T(LAS bf16* D, int mt, int nt, int r, int q, const f32x4 v) {
    v2u w; w.x = cvtpk(v.x, v.y); w.y = cvtpk(v.z, v.w);
    *(LAS v2u*)(D + sx(16 * nt + r, 16 * mt + 4 * q)) = w;
}
__device__ __forceinline__ void st_Tg(bf16* D  , int mt, int nt, int r, int q, const f32x4 v) {
    v2u w; w.x = cvtpk(v.x, v.y); w.y = cvtpk(v.z, v.w);
    *(v2u*)(D + (16 * nt + r) * 64 + 16 * mt + 4 * q) = w;
}
__device__ __forceinline__ f32x4 mask_lt(f32x4 v, int R0, int Cc, bool incl) {
    const int lim = incl ? Cc + 1 : Cc;
    v.x = (R0 < lim) ? v.x : 0.f; v.y = (R0 + 1 < lim) ? v.y : 0.f; v.z = (R0 + 2 < lim) ? v.z : 0.f; v.w = (R0 + 3 < lim) ? v.w : 0.f; return v;
}
__device__ __forceinline__ void rwkv_cp_item(const bf16* Z, const bf16* AAg, const bf16* EWg, const float* mu, const float* k_k, const float* k_a,
                                             bf16* RW, bf16* MM, bf16* Y0T, bf16* GAT, float* PC, int chain, int c, ScanRaw& R, int nchain, int nc, LAS unsigned char* lds, int tid, int wave, int lane, int probe) {
    LAS bf16* S_ = (LAS bf16*)lds;
#define SL(k) (S_ + (k) * SLOT)
    LAS float* Ef = (LAS float*)(SL(12));
    LAS float* Red = (LAS float*)(SL(8));
    LAS float* Seg = Red + 8 * 64;
    constexpr int EFS = 68;
    const int b = chain >> 3, h = chain & 7;
    const int r = lane & 15, q = lane >> 4;
    __syncthreads();
    const int t = tid >> 3, c0 = (tid & 7) * 8, hc0 = h * 64 + c0;
    float rr[8], k2[8], al[8], be[8], vv[8], kkr[8], aa[8];
    {
        float zr[8], zk[8], zv[8], pr[8], pk[8], pv[8], a[8], ew[8];
        unpack8(R.zr, zr); unpack8(R.zk, zk); unpack8(R.zv, zv); unpack8(R.pr, pr); unpack8(R.pk, pk); unpack8(R.pv, pv); unpack8(R.a, a); unpack8(R.ew, ew);
        scan_load(R, Z, AAg, EWg, nchain >> 3, (nchain & 7) * 64 + c0, nc * CK + t);
        float ss = 0.f;
#pragma unroll
        for (int i = 0; i < 8; ++i) { aa[i] = a[i]; rr[i] = zr[i] + (pr[i] - zr[i]) * mu[hc0 + i]; const float k = zk[i] + (pk[i] - zk[i]) * mu[512 + hc0 + i]; vv[i] = zv[i] + (pv[i] - zv[i]) * mu[1024 + hc0 + i];
            kkr[i] = k * k_k[hc0 + i]; ss += kkr[i] * kkr[i]; k2[i] = k * (1.f + (a[i] - 1.f) * k_a[hc0 + i]); }
        ss += dppf<0xB1>(ss); ss += dppf<0x4E>(ss); ss += dppf<0x141>(ss);
        if ((tid & 7) == 0) Red[t] = ss;
        *(LAS f32x4*)(Ef + t * EFS + c0) = (f32x4){ew[0], ew[1], ew[2], ew[3]}; *(LAS f32x4*)(Ef + t * EFS + c0 + 4) = (f32x4){ew[4], ew[5], ew[6], ew[7]};
    }
    LDS_WAIT(); __syncthreads();
    {
        const int seg = tid >> 6, j = tid & 63; float s = 0.f;
#pragma unroll
        for (int u = 0; u < 8; ++u) { s += Ef[(8 * seg + u) * EFS + j]; Ef[(8 * seg + u) * EFS + j] = s; }
        Seg[seg * 64 + j] = s;
    }
    LDS_WAIT(); __syncthreads();
    {
        { const float ss = Red[t];
          const float inrm = 1.f / fmaxf(sqrtf(ss), 1e-12f);
#pragma unroll
          for (int i = 0; i < 8; ++i) { const float kk = kkr[i] * inrm; al[i] = -kk; be[i] = kk * aa[i]; } }
        float off[8], Et[8], Ep[8];
#pragma unroll
        for (int i = 0; i < 8; ++i) off[i] = 0.f;
        for (int sg = 0; sg < (t >> 3); ++sg) {
            const f32x4 s0 = *(const LAS f32x4*)(Seg + sg * 64 + c0), s1 = *(const LAS f32x4*)(Seg + sg * 64 + c0 + 4);
            off[0] += s0.x; off[1] += s0.y; off[2] += s0.z; off[3] += s0.w; off[4] += s1.x; off[5] += s1.y; off[6] += s1.z; off[7] += s1.w;
        }
        { const f32x4 e0 = *(const LAS f32x4*)(Ef + t * EFS + c0), e1 = *(const LAS f32x4*)(Ef + t * EFS + c0 + 4);
          Et[0] = e0.x + off[0]; Et[1] = e0.y + off[1]; Et[2] = e0.z + off[2]; Et[3] = e0.w + off[3]; Et[4] = e1.x + off[4]; Et[5] = e1.y + off[5]; Et[6] = e1.z + off[6]; Et[7] = e1.w + off[7]; }
        if (t & 7) { const f32x4 e0 = *(const LAS f32x4*)(Ef + (t - 1) * EFS + c0), e1 = *(const LAS f32x4*)(Ef + (t - 1) * EFS + c0 + 4);
          Ep[0] = e0.x + off[0]; Ep[1] = e0.y + off[1]; Ep[2] = e0.z + off[2]; Ep[3] = e0.w + off[3]; Ep[4] = e1.x + off[4]; Ep[5] = e1.y + off[5]; Ep[6] = e1.z + off[6]; Ep[7] = e1.w + off[7]; }
        else {
#pragma unroll
            for (int i = 0; i < 8; ++i) Ep[i] = off[i];
        }
        float at[8], bt[8], kt[8], rt[8];
#pragma unroll
        for (int i = 0; i < 8; ++i) { const float ep = __expf(Et[i]), en = __expf(-Et[i]); at[i] = al[i] * __expf(-Ep[i]); bt[i] = be[i] * ep; kt[i] = k2[i] * ep; rt[i] = rr[i] * en; }
        *(LAS v4u*)(SL(0) + sx(t, c0)) = pack8f(at); *(LAS v4u*)(SL(1) + sx(t, c0)) = pack8f(bt); *(LAS v4u*)(SL(2) + sx(t, c0)) = pack8f(kt); *(LAS v4u*)(SL(3) + sx(t, c0)) = pack8f(rt);
#pragma unroll
        for (int i = 0; i < 8; ++i) { SL(4)[sx(c0 + i, t)] = (bf16)f2bf(at[i]); SL(5)[sx(c0 + i, t)] = (bf16)f2bf(bt[i]); SL(6)[sx(c0 + i, t)] = (bf16)f2bf(kt[i]); SL(7)[sx(c0 + i, t)] = (bf16)f2bf(vv[i]); }
        if (t == CK - 1) { *(f32x4*)(PC + c0) = (f32x4){__expf(-Et[0]), __expf(-Et[1]), __expf(-Et[2]), __expf(-Et[3])}; *(f32x4*)(PC + c0 + 4) = (f32x4){__expf(-Et[4]), __expf(-Et[5]), __expf(-Et[6]), __expf(-Et[7])}; }
    }
    LDS_WAIT(); __syncthreads();
    if (probe == 4) return;
    const f32x4 z4 = {0.f, 0.f, 0.f, 0.f};
    const int mt = wave >> 2, nt = wave & 3, Cc = 16 * nt + r, R0 = 16 * mt + 4 * q, R1 = R0 + 32;
    { PairF f0, f1, f2, f3, f4;
      mm_load(f0, SL(0), SL(1), mt, nt, r, q); mm_load(f1, SL(1), SL(0), mt, nt, r, q); mm_load(f2, SL(2), SL(0), mt, nt, r, q); mm_load(f3, SL(1), SL(3), mt, nt, r, q); mm_load(f4, SL(2), SL(3), mt, nt, r, q);
      f32x4 a0 = z4, a1 = z4, b0 = z4, b1 = z4, c0 = z4, c1 = z4, d0 = z4, d1 = z4, e0 = z4, e1 = z4;
      mm_mul(f0, a0, a1); mm_mul(f1, b0, b1); mm_mul(f2, c0, c1); mm_mul(f3, d0, d1); mm_mul(f4, e0, e1);
      a0.x = (Cc < R0) ? a0.x : 0.f; a0.y = (Cc < R0 + 1) ? a0.y : 0.f; a0.z = (Cc < R0 + 2) ? a0.z : 0.f; a0.w = (Cc < R0 + 3) ? a0.w : 0.f;
      a1.x = (Cc < R1) ? a1.x : 0.f; a1.y = (Cc < R1 + 1) ? a1.y : 0.f; a1.z = (Cc < R1 + 2) ? a1.z : 0.f; a1.w = (Cc < R1 + 3) ? a1.w : 0.f;
      st_T(SL(12), mt, nt, r, q, a0); st_T(SL(12), mt + 2, nt, r, q, a1);
      b0 = mask_lt(b0, R0, Cc, false); b1 = mask_lt(b1, R1, Cc, false);
      st_T(SL(11), mt, nt, r, q, b0); st_T(SL(11), mt + 2, nt, r, q, b1);
      b0.x += (R0 == Cc) ? 1.f : 0.f; b0.y += (R0 + 1 == Cc) ? 1.f : 0.f; b0.z += (R0 + 2 == Cc) ? 1.f : 0.f; b0.w += (R0 + 3 == Cc) ? 1.f : 0.f;
      b1.x += (R1 == Cc) ? 1.f : 0.f; b1.y += (R1 + 1 == Cc) ? 1.f : 0.f; b1.z += (R1 + 2 == Cc) ? 1.f : 0.f; b1.w += (R1 + 3 == Cc) ? 1.f : 0.f;
      st_T(SL(13), mt, nt, r, q, b0); st_T(SL(13), mt + 2, nt, r, q, b1);
      st_T(SL(8), mt, nt, r, q, mask_lt(c0, R0, Cc, false)); st_T(SL(8), mt + 2, nt, r, q, mask_lt(c1, R1, Cc, false));
      st_T(SL(9), mt, nt, r, q, mask_lt(d0, R0, Cc, true)); st_T(SL(9), mt + 2, nt, r, q, mask_lt(d1, R1, Cc, true));
      st_T(SL(10), mt, nt, r, q, mask_lt(e0, R0, Cc, true)); st_T(SL(10), mt + 2, nt, r, q, mask_lt(e1, R1, Cc, true)); }
    LDS_WAIT(); __syncthreads();
    if (probe == 3) return;
    for (int m = (probe == 2 ? 6 : 0); m < 6; ++m) {
        const int ln = (m & 1) ? 0 : 11, ltn = ln + 1, l2 = (m & 1) ? 11 : 0;
        const int tsrc = (m & 1) ? 13 : 2, tdst = (m & 1) ? 2 : 13;
        PairF f0, f1, f2; v2u o0 = {0u, 0u}, o1 = {0u, 0u};
        if (m < 5) { mm_load(f0, SL(ltn), SL(ln), mt, nt, r, q); mm_load(f1, SL(ln), SL(ltn), mt, nt, r, q); }
        if (m >= 1) { mm_load(f2, SL(ltn), SL(tsrc), mt, nt, r, q);
            o0 = *(const LAS v2u*)(SL(tsrc) + sx(16 * nt + r, 16 * mt + 4 * q)); o1 = *(const LAS v2u*)(SL(tsrc) + sx(16 * nt + r, 16 * mt + 32 + 4 * q)); }
        if (m < 5) { f32x4 a0 = z4, a1 = z4, b0 = z4, b1 = z4; mm_mul(f0, a0, a1); mm_mul(f1, b0, b1);
            st_T(SL(l2), mt, nt, r, q, a0); st_T(SL(l2), mt + 2, nt, r, q, a1);
            st_T(SL(l2 + 1), mt, nt, r, q, b0); st_T(SL(l2 + 1), mt + 2, nt, r, q, b1); }
        if (m >= 1) { f32x4 c0 = {bflo(o0.x), bfhi(o0.x), bflo(o0.y), bfhi(o0.y)}, c1 = {bflo(o1.x), bfhi(o1.x), bflo(o1.y), bfhi(o1.y)};
            mm_mul(f2, c0, c1); st_T(SL(tdst), mt, nt, r, q, c0); st_T(SL(tdst), mt + 2, nt, r, q, c1); }
        LDS_WAIT(); __syncthreads();
    }
    { PairF f0, f1; mm_load(f0, SL(2), SL(4), mt, nt, r, q); mm_load(f1, SL(8), SL(7), mt, nt, r, q);
      f32x4 a0 = z4, a1 = z4, b0 = z4, b1 = z4; mm_mul(f0, a0, a1); mm_mul(f1, b0, b1);
      st_T(SL(11), mt, nt, r, q, a0); st_T(SL(11), mt + 2, nt, r, q, a1);
      st_T(SL(12), mt, nt, r, q, b0); st_T(SL(12), mt + 2, nt, r, q, b1); }
    LDS_WAIT(); __syncthreads();
    { PairF f0, f1, f2; mm_load(f0, SL(2), SL(12), mt, nt, r, q); mm_load(f1, SL(11), SL(9), mt, nt, r, q); mm_load(f2, SL(11), SL(5), mt, nt, r, q);
      const v2u o0 = *(const LAS v2u*)(SL(3) + sx(16 * nt + r, 16 * mt + 4 * q)), o1 = *(const LAS v2u*)(SL(3) + sx(16 * nt + r, 16 * mt + 32 + 4 * q));
      f32x4 a0 = z4, a1 = z4, b0 = {bflo(o0.x), bfhi(o0.x), bflo(o0.y), bfhi(o0.y)}, b1 = {bflo(o1.x), bfhi(o1.x), bflo(o1.y), bfhi(o1.y)}, c0 = z4, c1 = z4;
      mm_mul(f0, a0, a1); mm_mul(f1, b0, b1); mm_mul(f2, c0, c1);
      st_T(SL(13), mt, nt, r, q, a0); st_T(SL(13), mt + 2, nt, r, q, a1);
      st_Tg(RW, mt, nt, r, q, b0); st_Tg(RW, mt + 2, nt, r, q, b1);
      st_Tg(MM, mt, nt, r, q, c0); st_Tg(MM, mt + 2, nt, r, q, c1); }
    LDS_WAIT(); __syncthreads();
    { PairF f0, f1, f2, f3; mm_load(f0, SL(9), SL(13), mt, nt, r, q); mm_load(f1, SL(10), SL(7), mt, nt, r, q); mm_load(f2, SL(5), SL(13), mt, nt, r, q); mm_load(f3, SL(6), SL(7), mt, nt, r, q);
      f32x4 a0 = z4, a1 = z4, b0 = z4, b1 = z4; mm_mul(f0, a0, a1); mm_mul(f2, b0, b1); mm_mul(f1, a0, a1); mm_mul(f3, b0, b1);
      st_Tg(Y0T, mt, nt, r, q, a0); st_Tg(Y0T, mt + 2, nt, r, q, a1);
      st_Tg(GAT, mt, nt, r, q, b0); st_Tg(GAT, mt + 2, nt, r, q, b1); }
#undef SL
}
__device__ __forceinline__ void rwkv_seq(const bf16* RW, const bf16* MM, const bf16* Y0T, const bf16* GAT, const float* PC, bf16* Y, int sid, LAS unsigned char* lds, int tid, int wave, int lane) {
    const int chain = sid >> 2, g4 = sid & 3, b = chain >> 3, h = chain & 7;
    const int r = lane & 15, q = lane >> 4, tw = wave & 3;
    LAS bf16* HT = (LAS bf16*)lds;
    for (int i = tid; i < 2 * 16 * CS / 2; i += NTHR) ((LAS unsigned*)HT)[i] = 0u;
    LDS_WAIT(); __syncthreads();
    f32x4 Hreg = {0.f, 0.f, 0.f, 0.f};
    const bool isH = wave < 4;
    const bf16* Abase = isH ? MM : RW;
    const bf16* Ebase = isH ? GAT : Y0T;
    const size_t ci0 = (size_t)chain * NCHK;
    struct SeqOp { bf16x8 a0, a1; v2u ad; f32x4 pc; };
    SeqOp op[4];
#define SEQ_LD(S, C) do { const size_t ci_ = ci0 + (C); const bf16* ap_ = Abase + ci_ * 4096 + (16 * tw + r) * 64 + 8 * q; S.a0 = *(const bf16x8*)ap_; S.a1 = *(const bf16x8*)(ap_ + 32); \
        S.ad = *(const v2u*)(Ebase + ci_ * 4096 + (16 * g4 + r) * 64 + 16 * tw + 4 * q); S.pc = *(const f32x4*)(PC + ci_ * 64 + 16 * tw + 4 * q); } while (0)
#define SEQ_STEP(S, C) do { const LAS bf16* hb = HT + ((C) & 1) * 16 * CS; \
        const bf16x8 b0 = *(const LAS bf16x8*)(hb + r * CS + 8 * q), b1 = *(const LAS bf16x8*)(hb + r * CS + 32 + 8 * q); \
        f32x4 acc = {bflo(S.ad.x), bfhi(S.ad.x), bflo(S.ad.y), bfhi(S.ad.y)}; \
        acc = __builtin_amdgcn_mfma_f32_16x16x32_bf16(S.a0, b0, acc, 0, 0, 0); acc = __builtin_amdgcn_mfma_f32_16x16x32_bf16(S.a1, b1, acc, 0, 0, 0); \
        const f32x4 pcc = S.pc; \
        SEQ_LD(S, ((C) + 4 < NCHK ? (C) + 4 : NCHK - 1));            \
        if (isH) { Hreg = pcc * (Hreg + acc); v2u w; w.x = cvtpk(Hreg.x, Hreg.y); w.y = cvtpk(Hreg.z, Hreg.w); \
            *(LAS v2u*)(HT + (((C) + 1) & 1) * 16 * CS + r * CS + 16 * tw + 4 * q) = w; } \
        else { bf16* yp = Y + ((size_t)(b * 8192 + (C) * CK + 16 * tw + 4 * q)) * OSTR + h * 64 + 16 * g4 + r; \
            yp[0] = (bf16)f2bf(acc.x); yp[OSTR] = (bf16)f2bf(acc.y); yp[2 * OSTR] = (bf16)f2bf(acc.z); yp[3 * OSTR] = (bf16)f2bf(acc.w); } \
        LDS_WAIT(); __syncthreads(); } while (0)
    SEQ_LD(op[0], 0); SEQ_LD(op[1], 1); SEQ_LD(op[2], 2); SEQ_LD(op[3], 3);
#pragma unroll 1
    for (int c = 0; c < NCHK; c += 4) { SEQ_STEP(op[0], c); SEQ_STEP(op[1], c + 1); SEQ_STEP(op[2], c + 2); SEQ_STEP(op[3], c + 3); }
#undef SEQ_LD
#undef SEQ_STEP
}

__device__ __forceinline__ int crow(int r, int hi) { return (r & 3) + 8 * (r >> 2) + 4 * hi; }
constexpr int AT_KT_STRIDE = 72, AT_VL_STRIDE = 260, AT_VL_OFF = 256 * AT_KT_STRIDE * 2, AT_MISC_OFF = AT_VL_OFF + 64 * AT_VL_STRIDE * 2;
struct AttnStage { v4u k[4], v[4]; };
__device__ __forceinline__ void attn_stage_load(AttnStage& S, const bf16* K, const bf16* VT, int bh, int blk, int tid) {
#pragma unroll
    for (int i = 0; i < 4; ++i) { const int idx = tid + NTHR * i, row = idx >> 3, c8 = idx & 7;
        S.k[i] = *(const v4u*)(K + ((size_t)(bh * 8192 + blk * 256 + row)) * 64 + 8 * c8); }
#pragma unroll
    for (int i = 0; i < 4; ++i) { const int idx = tid + NTHR * i, dv = idx >> 5, c = idx & 31;
        S.v[i] = *(const v4u*)(VT + ((size_t)(bh * 64 + dv)) * 8192 + blk * 256 + 8 * c); }
}
__device__ __forceinline__ void attn_stage_store(const AttnStage& S, LAS unsigned char* buf, int tid) {
    LAS bf16* KT = (LAS bf16*)buf; LAS bf16* VL = (LAS bf16*)(buf + AT_VL_OFF);
#pragma unroll
    for (int i = 0; i < 4; ++i) { const int idx = tid + NTHR * i, row = idx >> 3, c8 = idx & 7; *(LAS v4u*)(KT + row * AT_KT_STRIDE + 8 * c8) = S.k[i]; }
#pragma unroll
    for (int i = 0; i < 4; ++i) { const int idx = tid + NTHR * i, dv = idx >> 5, c = idx & 31;
        LAS v2u* d = (LAS v2u*)(VL + dv * AT_VL_STRIDE + 8 * c);
        v2u lo = {S.v[i].x, S.v[i].y}, hi = {S.v[i].z, S.v[i].w}; d[0] = lo; d[1] = hi; }
}
__device__ __forceinline__ void attn_tile(const bf16x8 (&qf)[4], const LAS bf16* KT, const LAS bf16* VL, int kt0, int nkt, int dkt, int ql, int half, float c1, float c2, f32x16 (&O)[2], float& lsum) {
    for (int kt = kt0; kt < nkt; ++kt) {
        f32x16 X;
#pragma unroll
        for (int i = 0; i < 16; ++i) X[i] = 0.f;
#pragma unroll
        for (int ks = 0; ks < 4; ++ks) { const bf16x8 kf = *(const LAS bf16x8*)(KT + (32 * kt + ql) * AT_KT_STRIDE + 16 * ks + 8 * half);
            X = __builtin_amdgcn_mfma_f32_32x32x16_bf16(kf, qf[ks], X, 0, 0, 0); }
        float p[16];
#pragma unroll
        for (int i = 0; i < 16; ++i) p[i] = __builtin_amdgcn_exp2f(X[i] * c1 - c2);
        if (kt == dkt) {
#pragma unroll
            for (int i = 0; i < 16; ++i) if (crow(i, half) > ql) p[i] = 0.f;
        }
#pragma unroll
        for (int i = 0; i < 16; ++i) lsum += p[i];
#pragma unroll
        for (int s = 0; s < 2; ++s) {
            v4u pw; pw.x = cvtpk(p[8 * s], p[8 * s + 1]); pw.y = cvtpk(p[8 * s + 2], p[8 * s + 3]); pw.z = cvtpk(p[8 * s + 4], p[8 * s + 5]); pw.w = cvtpk(p[8 * s + 6], p[8 * s + 7]);
            const bf16x8 pa = __builtin_bit_cast(bf16x8, pw);
#pragma unroll
            for (int nt = 0; nt < 2; ++nt) {
                const LAS bf16* vp = VL + (32 * nt + ql) * AT_VL_STRIDE + 32 * kt + 16 * s + 4 * half;
                const s16x4 lo = *(const LAS s16x4*)vp, hi = *(const LAS s16x4*)(vp + 8);
                const bf16x8 vf = __builtin_shufflevector(lo, hi, 0, 1, 2, 3, 4, 5, 6, 7);
                O[nt] = __builtin_amdgcn_mfma_f32_32x32x16_bf16(pa, vf, O[nt], 0, 0, 0);
            }
        }
    }
}
__device__ __forceinline__ int attn_pop(unsigned* queue, unsigned* cursor, volatile LAS int* misc, int tid, int& count) {
    for (;;) {
        __syncthreads();
        if (tid == 0) misc[0] = (int)__hip_atomic_fetch_add(queue, 1u, RLX_AGENT);
        __syncthreads();
        const int item = misc[0];
        if (item >= 992 + 1024) { count = 0; return -1; }
        if (item >= 992) { count = 256; return item; }
        count = (int)__hip_atomic_load(cursor + (item & 31) * 32 + (item >> 5), RLX_AGENT);
        if (count > 0) return item;
    }
}
__device__ __forceinline__ void attn_phase(const bf16* Q, const bf16* K, const bf16* VT, const unsigned* lists, unsigned* cursor, unsigned* queue,
                                           bf16* OPART, float* LPART, bf16* OWN, const float* gq, const float* gk, LAS unsigned char* lds, int tid, int wave, int lane, int probe) {
    constexpr int AT_BUF = AT_MISC_OFF;
    volatile LAS int* misc = (volatile LAS int*)(lds + 2 * AT_BUF);
    float mq = fabsf(gq[lane]), mk = fabsf(gk[lane]);
#pragma unroll
    for (int o = 1; o < 64; o <<= 1) { mq = fmaxf(mq, __shfl_xor(mq, o)); mk = fmaxf(mk, __shfl_xor(mk, o)); }
    const float c1 = 0.125f * 1.4426950408889634f, c2 = 8.f * mq * mk * 1.4426950408889634f;
    const int ql = lane & 31, half = lane >> 5;
    int count = 0, ncount = 0;
    int item = attn_pop(queue, cursor, misc, tid, count);
    AttnStage St;
    if (item >= 0) { attn_stage_load(St, K, VT, item < 992 ? (item & 31) : ((item - 992) & 31), item < 992 ? (item >> 5) : ((item - 992) >> 5), tid); attn_stage_store(St, lds, tid); }
    LDS_WAIT();
    __syncthreads();
    int pb = 0;
    bool have = false; unsigned ent_c = 0u; bf16x8 q_c[4];
    while (item >= 0) {
        int nitem = -1;
        if (tid == 0) { nitem = (int)__hip_atomic_fetch_add(queue, 1u, RLX_AGENT); ncount = 256;
            if (nitem < 992) ncount = (int)__hip_atomic_load(cursor + (nitem & 31) * 32 + (nitem >> 5), RLX_AGENT);
            if (nitem >= 992 + 1024) { nitem = -1; ncount = 0; } }
        bool published = false;
#define ATTN_PUBLISH() do { __syncthreads(); if (tid == 0) { misc[0] = nitem; misc[1] = ncount; } __syncthreads(); nitem = misc[0]; ncount = misc[1]; published = true; \
            { const int li_ = nitem >= 0 ? nitem : item;                                         \
              attn_stage_load(St, K, VT, li_ < 992 ? (li_ & 31) : ((li_ - 992) & 31), li_ < 992 ? (li_ >> 5) : ((li_ - 992) >> 5), tid); } } while (0)
        const LAS bf16* KT = (const LAS bf16*)(lds + pb * AT_BUF); const LAS bf16* VL = (const LAS bf16*)(lds + pb * AT_BUF + AT_VL_OFF);
        const bool own = item >= 992;
        const int bh = own ? ((item - 992) & 31) : (item & 31), blk = own ? ((item - 992) >> 5) : (item >> 5);
        const unsigned* lp = lists + (size_t)bh * LIST_PER_BH + list_off(own ? 0 : blk);
        for (int c = 0;; ++c) {
            const int e0 = own ? 0 : c * 256 + wave * 32;
            if (!own && e0 >= count) break;
            if (!have) {
                if (own) ent_c = (unsigned)(blk * 256 + wave * 32 + ql) << 2;
                else { const int e = e0 + ql; ent_c = lp[e < count ? e : e0]; }
                const bf16* qp = Q + ((size_t)(bh * 8192 + (int)(ent_c >> 2))) * 64 + 8 * half;
#pragma unroll
                for (int ks = 0; ks < 4; ++ks) q_c[ks] = *(const bf16x8*)(qp + 16 * ks);
            }
            const int sq = (int)(ent_c >> 2), slot = (int)(ent_c & 3u);
            const bool valid = own || (e0 + ql < count);
            f32x16 O[2]; float lsum = 0.f;
#pragma unroll
            for (int i = 0; i < 16; ++i) { O[0][i] = 0.f; O[1][i] = 0.f; }
            const int nkt = own ? wave + 1 : 8, dkt = own ? wave : -1, kth = nkt >> 1;
            const bool more = !own && (c + 1) * 256 + wave * 32 < count;
            unsigned ent_n = ent_c; int nbh = bh; bool nhave = false;
            if (more) { nhave = true; const int e = (c + 1) * 256 + wave * 32 + ql; ent_n = lp[e < count ? e : (c + 1) * 256 + wave * 32]; }
            if (probe != 3 && probe != 4) attn_tile(q_c, KT, VL, 0, kth, dkt, ql, half, c1, c2, O, lsum);
            if (!published) ATTN_PUBLISH();
            if (!more) {
                if (nitem >= 992) { nhave = true; nbh = (nitem - 992) & 31; ent_n = (unsigned)(((nitem - 992) >> 5) * 256 + wave * 32 + ql) << 2; }
                else if (nitem >= 0 && wave * 32 < ncount) { nhave = true; nbh = nitem & 31; const int e = wave * 32 + ql;
                    ent_n = (lists + (size_t)nbh * LIST_PER_BH + list_off(nitem >> 5))[e < ncount ? e : wave * 32]; }
            }
            bf16x8 q_n[4];
            { const bf16* qp = Q + ((size_t)(nbh * 8192 + (int)(ent_n >> 2))) * 64 + 8 * half;
#pragma unroll
                for (int ks = 0; ks < 4; ++ks) q_n[ks] = *(const bf16x8*)(qp + 16 * ks); }
            if (probe != 3 && probe != 4) attn_tile(q_c, KT, VL, kth, nkt, dkt, ql, half, c1, c2, O, lsum);
            const float ltot = lsum + __shfl_xor(lsum, 32);
            if ((probe == 2 || probe == 4) && ltot != 12345.f) { } else
            if (own) {
                const int b = bh >> 3, h = bh & 7;
                if (half == 0) LPART[(size_t)3 * (BH * SEQ) + bh * 8192 + sq] = ltot;
#pragma unroll
                for (int i = 0; i < 16; ++i) {
                    const int s2 = blk * 256 + wave * 32 + crow(i, half);
                    bf16* op = OWN + ((size_t)(b * 8192 + s2)) * OSTR + h * 64 + ql;
                    op[0] = (bf16)f2bf(O[0][i]); op[32] = (bf16)f2bf(O[1][i]);
                }
            } else {
                if (half == 0 && valid) LPART[(size_t)slot * (BH * SEQ) + bh * 8192 + sq] = ltot;
                const int entv = valid ? (int)ent_c : -1;
#pragma unroll
                for (int i = 0; i < 16; ++i) {
                    const int e2 = __shfl(entv, crow(i, half));
                    if (e2 >= 0) { bf16* op = OPART + ((size_t)(e2 & 3) * (BH * SEQ) + bh * 8192 + (e2 >> 2)) * 64 + ql;
                        op[0] = (bf16)f2bf(O[0][i]); op[32] = (bf16)f2bf(O[1][i]); }
                }
            }
            have = nhave; ent_c = ent_n;
#pragma unroll
            for (int ks = 0; ks < 4; ++ks) q_c[ks] = q_n[ks];
            if (own) break;
        }
        if (!published) ATTN_PUBLISH();
#undef ATTN_PUBLISH
        if (nitem >= 0) attn_stage_store(St, lds + (pb ^ 1) * AT_BUF, tid);
        LDS_WAIT();
        __syncthreads();
        item = nitem; count = ncount; pb ^= 1;
    }
}

__device__ __forceinline__ void p5_combine(const bf16* OPART, const float* LPART, const bf16* OM, bf16* OMO, int gtid, int ntot) {
    for (int idx0 = gtid; idx0 < BH * SEQ * 8; idx0 += 2 * ntot) {
        v4u v[2][4]; unsigned lw[2][4]; size_t oo[2]; int nsel[2];
#pragma unroll
        for (int u = 0; u < 2; ++u) {
            const int idx = idx0 + u * ntot < BH * SEQ * 8 ? idx0 + u * ntot : idx0;
            const int qg = idx >> 3, c8 = idx & 7, bh = qg >> 13, s = qg & 8191, b = bh >> 3, h = bh & 7;
            nsel[u] = (s >> 8) < 3 ? (s >> 8) : 3;
            oo[u] = ((size_t)(b * 8192 + s)) * OSTR + h * 64 + 8 * c8;
#pragma unroll
            for (int sl = 0; sl < 3; ++sl) { v[u][sl] = *(const v4u*)(OPART + ((size_t)sl * (BH * SEQ) + qg) * 64 + 8 * c8); lw[u][sl] = *(const unsigned*)(LPART + (size_t)sl * (BH * SEQ) + qg); }
            v[u][3] = *(const v4u*)(OM + oo[u]); lw[u][3] = *(const unsigned*)(LPART + (size_t)3 * (BH * SEQ) + qg);
        }
#pragma unroll
        for (int u = 0; u < 2; ++u) {
            float acc[8] = {0.f, 0.f, 0.f, 0.f, 0.f, 0.f, 0.f, 0.f}; float l = 0.f;
#pragma unroll
            for (int sl = 0; sl < 4; ++sl) {
                const unsigned m = (sl == 3 || sl < nsel[u]) ? 0xffffffffu : 0u;
                const v4u w4 = v[u][sl] & m;
                acc[0] += bflo(w4.x); acc[1] += bfhi(w4.x); acc[2] += bflo(w4.y); acc[3] += bfhi(w4.y); acc[4] += bflo(w4.z); acc[5] += bfhi(w4.z); acc[6] += bflo(w4.w); acc[7] += bfhi(w4.w);
                l += __builtin_bit_cast(float, lw[u][sl] & m);
            }
            const float il = 1.f / l;
            v4u w; w.x = pk2(acc[0] * il, acc[1] * il); w.y = pk2(acc[2] * il, acc[3] * il); w.z = pk2(acc[4] * il, acc[5] * il); w.w = pk2(acc[6] * il, acc[7] * il);
            if (u == 0 || idx0 + ntot < BH * SEQ * 8) *(v4u*)(OMO + oo[u]) = w;
        }
    }
}
__device__ __forceinline__ void unpack4(const v2u w, float (&f)[4]) { f[0] = bflo(w.x); f[1] = bfhi(w.x); f[2] = bflo(w.y); f[3] = bfhi(w.y); }
__device__ __forceinline__ void p5_rwkv_post(const bf16* Z, const bf16* AA, const bf16* GG, const bf16* Y, bf16* YO, const float* mu, const float* k_a, const float* r_k,
                                             const float* ln_g, const float* ln_b, int gw, int ngw, int lane) {
    const int g = lane >> 4, r = lane & 15;
#pragma unroll 2
    for (int it = gw * 4 + g; it < T * NH; it += ngw * 4) {
        const int t = it >> 3, h = it & 7, col = h * 64 + 4 * r, s = t & 8191;
        const bf16* zp = Z + (size_t)t * ZR + col;
        float zr[4], zk[4], zv[4], pr[4] = {0.f, 0.f, 0.f, 0.f}, pk[4] = {0.f, 0.f, 0.f, 0.f}, pv[4] = {0.f, 0.f, 0.f, 0.f}, a[4], y[4], gg[4];
        unpack4(*(const v2u*)zp, zr); unpack4(*(const v2u*)(zp + 512), zk); unpack4(*(const v2u*)(zp + 1024), zv);
        { const bf16* zq = s ? zp - ZR : zp; const unsigned m_ = s ? 0xffffffffu : 0u;
          unpack4(*(const v2u*)(zq) & m_, pr); unpack4(*(const v2u*)(zq + 512) & m_, pk); unpack4(*(const v2u*)(zq + 1024) & m_, pv); }
        unpack4(*(const v2u*)(AA + (size_t)t * 512 + col), a); unpack4(*(const v2u*)(Y + (size_t)t * OSTR + col), y); unpack4(*(const v2u*)(GG + (size_t)t * 512 + col), gg);
        const f32x4 mr = *(const f32x4*)(mu + col), mk = *(const f32x4*)(mu + 512 + col), mv = *(const f32x4*)(mu + 1024 + col);
        const f32x4 ka = *(const f32x4*)(k_a + col), rk = *(const f32x4*)(r_k + col), lg = *(const f32x4*)(ln_g + col), lb = *(const f32x4*)(ln_b + col);
        float vv[4], dot = 0.f, sum = 0.f;
#pragma unroll
        for (int i = 0; i < 4; ++i) { const float rr = zr[i] + (pr[i] - zr[i]) * mr[i], k = zk[i] + (pk[i] - zk[i]) * mk[i]; vv[i] = zv[i] + (pv[i] - zv[i]) * mv[i];
            const float k2 = k * (1.f + (a[i] - 1.f) * ka[i]); dot += rr * k2 * rk[i]; sum += y[i]; }
        const float mean = allreduce16(sum) * (1.f / 64.f);
        float sq = 0.f;
#pragma unroll
        for (int i = 0; i < 4; ++i) { y[i] -= mean; sq += y[i] * y[i]; }
        const float rstd = 1.f / sqrtf(allreduce16(sq) * (1.f / 64.f) + GN_EPS);
        const float bonus = allreduce16(dot);
        float o[4];
#pragma unroll
        for (int i = 0; i < 4; ++i) o[i] = (y[i] * rstd * lg[i] + lb[i] + bonus * vv[i]) * gg[i];
        v2u w; w.x = pk2(o[0], o[1]); w.y = pk2(o[2], o[3]);
        *(v2u*)(YO + (size_t)t * OSTR + col) = w;
    }
}


__device__ __forceinline__ unsigned f2key(float f) { const unsigned u = __builtin_bit_cast(unsigned, f); return (u & 0x80000000u) ? ~u : (u | 0x80000000u); }
__device__ __forceinline__ float key2f(unsigned k) { const unsigned u = (k & 0x80000000u) ? (k & 0x7fffffffu) : ~k; return __builtin_bit_cast(float, u); }
template <int CTRL> __device__ __forceinline__ unsigned dppu(unsigned v) { return (unsigned)__builtin_amdgcn_update_dpp(0, (int)v, CTRL, 0xF, 0xF, true); }
__device__ __forceinline__ unsigned umax_(unsigned a, unsigned b) { return a > b ? a : b; }
__device__ __forceinline__ unsigned allmax16(unsigned v) { v = umax_(v, dppu<0xB1>(v)); v = umax_(v, dppu<0x4E>(v)); v = umax_(v, dppu<0x141>(v)); v = umax_(v, dppu<0x140>(v)); return v; }
__device__ __forceinline__ float dot2bf(unsigned w, unsigned x, float acc) { return __builtin_amdgcn_fdot2_f32_bf16(__builtin_bit_cast(bf16x2_t, w), __builtin_bit_cast(bf16x2_t, x), acc, false); }
__device__ __forceinline__ unsigned cand_word(int r) {
    const unsigned tab[16] = {0x03020100u, 0x07060504u, 0x0b0a0908u, 0x0f0e0d0cu, 0x13121110u, 0x17161514u, 0x23222120u, 0x32313024u,
                              0x42414033u, 0x61605150u, 0x90807170u, 0xd0c0b0a0u, 0xfffff0e0u, 0xffffffffu, 0xffffffffu, 0xffffffffu};
    unsigned w = 0xffffffffu;
#pragma unroll
    for (int i = 0; i < 13; ++i) w = (r == i) ? tab[i] : w;
    return w;
}
template <int NK> __device__ __forceinline__ unsigned top16_keys(unsigned (&k)[NK], int r) {
    unsigned res = 0u;
    for (int rd = 0; rd < 16; ++rd) {
        unsigned m = k[0];
#pragma unroll
        for (int j = 1; j < NK; ++j) m = umax_(m, k[j]);
        const unsigned gm = allmax16(m);
        res = (r == rd) ? gm : res;
#pragma unroll
        for (int j = 0; j < NK; ++j) k[j] = (k[j] == gm) ? 0u : k[j];
    }
    return res;
}
#define PEER_CE(a, b) do { const unsigned hi_ = umax_(k[a], k[b]), lo_ = (k[a] < k[b]) ? k[a] : k[b]; k[a] = hi_; k[b] = lo_; } while (0)
__device__ __forceinline__ unsigned top16_sorted8(unsigned (&k)[8], int r) {
    PEER_CE(0, 1); PEER_CE(2, 3); PEER_CE(4, 5); PEER_CE(6, 7);
    PEER_CE(0, 2); PEER_CE(1, 3); PEER_CE(4, 6); PEER_CE(5, 7);
    PEER_CE(1, 2); PEER_CE(5, 6);
    PEER_CE(0, 4); PEER_CE(1, 5); PEER_CE(2, 6); PEER_CE(3, 7);
    PEER_CE(2, 4); PEER_CE(3, 5);
    PEER_CE(1, 2); PEER_CE(3, 4); PEER_CE(5, 6);
    unsigned res = 0u;
    for (int rd = 0; rd < 16; ++rd) {
        const unsigned gm = allmax16(k[0]);
        res = (r == rd) ? gm : res;
        const bool pop = k[0] == gm;
#pragma unroll
        for (int j = 0; j < 7; ++j) k[j] = pop ? k[j + 1] : k[j];
        k[7] = pop ? 0u : k[7];
    }
    return res;
}
#undef PEER_CE
#ifdef PROBE_S
typedef int v8i_p __attribute__((ext_vector_type(8)));
__device__ __forceinline__ float mx_probe(int lane) {
    const int q = lane >> 4;
    unsigned aw[4] = {0u, 0u, 0u, 0u};
    if (lane == 16 * PROBE_QA) aw[(PROBE_S) >> 3] = 0x2u << (4 * ((PROBE_S) & 7));
    v8i_p A = {(int)aw[0], (int)aw[1], (int)aw[2], (int)aw[3], 0, 0, 0, 0};
    v8i_p B;
#pragma unroll
    for (int v = 0; v < 8; ++v) {
        float f[4];
#pragma unroll
        for (int b = 0; b < 4; ++b) { const int j = 4 * v + b; f[b] = (PROBE_PAT == 1) ? (float)(q + 1) : ((PROBE_PAT == 2) ? (float)((j & 15) + 1) : (float)((j >> 4) + 1)); }
        int w = 0; w = __builtin_amdgcn_cvt_pk_fp8_f32(f[0], f[1], w, false); w = __builtin_amdgcn_cvt_pk_fp8_f32(f[2], f[3], w, true); B[v] = w;
    }
    f32x4 c = {0.f, 0.f, 0.f, 0.f};
    c = __builtin_amdgcn_mfma_scale_f32_16x16x128_f8f6f4(A, B, c, 4, 0, 0, 0x7f7f7f7f, 0, 0x7f7f7f7f);
    const float r = __shfl(c.x, 0);
    const int code = (int)(r + 0.5f) - 1;
    float off = 0.1f;
    for (int i = 0; i < code && i < 40; ++i) off *= 1.3f;
    if (code < 0) off = 0.05f;
    return off;
}
#endif
typedef int v8i __attribute__((ext_vector_type(8)));
typedef int v4i __attribute__((ext_vector_type(4)));
__device__ __forceinline__ void peer_token_a(const bf16* SC, const unsigned char* XN8, const unsigned char* U8, LAS f32x4* xl, LAS unsigned short* pe16, LAS unsigned char* w8, LAS float* scl, int t, int tnext, v4u (&scn)[4], v4u& x8n, int lane) {
    const int g = lane >> 4, r = lane & 15;
    int eidx[2]; float egate[2];
    unsigned resA[4];
#pragma unroll
    for (int pass = 0; pass < 4; ++pass) {
        const v4u sw = scn[pass];
        const float v[8] = {bflo(sw.x), bfhi(sw.x), bflo(sw.y), bfhi(sw.y), bflo(sw.z), bfhi(sw.z), bflo(sw.w), bfhi(sw.w)};
        unsigned k[8];
#pragma unroll
        for (int j = 0; j < 8; ++j) k[j] = (f2key(v[j]) & ~0x7Fu) | (unsigned)(127 - (r * 8 + j));
        resA[pass] = top16_sorted8(k, r);
    }
    const v4u x8cur = x8n;
#pragma unroll
    for (int pass = 0; pass < 4; ++pass) scn[pass] = *(const v4u*)(SC + (size_t)tnext * 2048 + (pass * 4 + g) * 128 + r * 8);
    x8n = *(const v4u*)(XN8 + (size_t)tnext * 1024 + 16 * lane);
    const unsigned cw = cand_word(r);
#pragma unroll
    for (int cp = 0; cp < 2; ++cp) {
        const int lbase = 32 * (g & 1); const bool hi = (g >> 1) != 0;
        unsigned ck[4];
#pragma unroll
        for (int m = 0; m < 4; ++m) {
            const unsigned byte = (cw >> (8 * m)) & 0xFFu; const int i = (int)(byte >> 4), j = (int)(byte & 15u);
            const unsigned a0 = (unsigned)__shfl((int)resA[2 * cp], lbase + i), a1 = (unsigned)__shfl((int)resA[2 * cp + 1], lbase + i);
            const unsigned b0 = (unsigned)__shfl((int)resA[2 * cp], lbase + 16 + j), b1 = (unsigned)__shfl((int)resA[2 * cp + 1], lbase + 16 + j);
            const unsigned ak = hi ? a1 : a0, bk = hi ? b1 : b0;
            const float val = key2f(ak & ~0x7Fu) + key2f(bk & ~0x7Fu);
            ck[m] = (byte != 0xFFu) ? ((f2key(val) & ~0xFFu) | (255u - byte)) : 0u;
        }
        const unsigned res = top16_keys<4>(ck, r);
        const unsigned flat = 255u - (res & 0xFFu); const int i = (int)(flat >> 4), j = (int)(flat & 15u);
        const float val = key2f(res & ~0xFFu), vmax = key2f(allmax16(res) & ~0xFFu);
        const float e = __expf(val - vmax);
        const float gate = e / allreduce16(e);
        const unsigned a0 = (unsigned)__shfl((int)resA[2 * cp], lbase + i), a1 = (unsigned)__shfl((int)resA[2 * cp + 1], lbase + i);
        const unsigned b0 = (unsigned)__shfl((int)resA[2 * cp], lbase + 16 + j), b1 = (unsigned)__shfl((int)resA[2 * cp + 1], lbase + 16 + j);
        const unsigned ak = hi ? a1 : a0, bk = hi ? b1 : b0;
        eidx[cp] = (int)((127u - (ak & 127u)) * 128u + (127u - (bk & 127u)));
        egate[cp] = gate;
    }
    LAS float* hl = (LAS float*)xl;
    {
        const int i16 = lane & 15, q = lane >> 4;
        LAS unsigned char* x8l = (LAS unsigned char*)(xl + 64);
        LDS_WAIT(); asm volatile("" ::: "memory");
        *(LAS v4u*)(x8l + 16 * lane) = x8cur;
#define PEER_LD(P, KB) (*(const v4i*)((P) + (KB) * 64))
#define PEER_PTR(GI) (U8 + (size_t)__shfl(eidx[(GI) >> 2], 16 * ((GI) & 3) + i16) * 512 + 16 * q)
        v4i ug[2][8];
        LDS_WAIT(); asm volatile("" ::: "memory");
        {
#pragma unroll
        for (int g0 = 0; g0 < 2; ++g0) { const unsigned char* p0 = PEER_PTR(g0);
#pragma unroll
            for (int kb = 0; kb < 8; ++kb) ug[g0][kb] = PEER_LD(p0, kb); }
#pragma unroll
        for (int gi = 0; gi < 8; ++gi) {
            const unsigned char* pn = PEER_PTR((gi + 2) & 7);
            f32x4 c_ = {0.f, 0.f, 0.f, 0.f};
#pragma unroll
            for (int kb = 0; kb < 8; ++kb) {
                const v8i xb_ = __builtin_shufflevector(*(const LAS v4i*)(x8l + kb * 128 + 16 * q), *(const LAS v4i*)(x8l + kb * 128 + 64 + 16 * q), 0, 1, 2, 3, 4, 5, 6, 7);
                const v8i ua_ = __builtin_shufflevector(ug[gi % 2][kb], (v4i){0, 0, 0, 0}, 0, 1, 2, 3, 4, 5, 6, 7);
                c_ = __builtin_amdgcn_mfma_scale_f32_16x16x128_f8f6f4(ua_, xb_, c_, 4, 0, 0, 0x7f7f7f7f, 0, 0x7f7f7f7f);
                if (gi + 2 < 8) ug[gi % 2][kb] = PEER_LD(pn, kb);
            }
            if (i16 == 0) *(LAS f32x4*)(hl + (gi >> 2) * 64 + 16 * (gi & 3) + 4 * q) = c_;
            __builtin_amdgcn_sched_barrier(0);
        }
        }
#undef PEER_LD
#undef PEER_PTR
    }
    LDS_WAIT(); asm volatile("" ::: "memory");
    float ehs[2];
#pragma unroll
    for (int cp = 0; cp < 2; ++cp) { const float hd = hl[cp * 64 + lane] * (1.f / 512.f); ehs[cp] = 0.5f * hd * (1.f + erff(hd * 0.70710678118654752f)) * egate[cp] * (1.f / 5.656854249f); }
    float wm = fmaxf(fabsf(ehs[0]), fabsf(ehs[1]));
#pragma unroll
    for (int o = 1; o < 64; o <<= 1) wm = fmaxf(wm, __shfl_xor(wm, o));
    wm = fmaxf(wm, 1e-30f);
    const float ws_ = 224.f * __builtin_amdgcn_rcpf(wm);
    const unsigned pk = (unsigned)__builtin_amdgcn_cvt_pk_fp8_f32(ehs[0] * ws_, ehs[1] * ws_, 0, false);
    pe16[lane] = (unsigned short)eidx[0]; pe16[64 + lane] = (unsigned short)eidx[1]; w8[lane] = (unsigned char)(pk & 0xFFu); w8[64 + lane] = (unsigned char)((pk >> 8) & 0xFFu);
    if (lane == 0) *scl = wm * (1.f / 224.f);
}
typedef int v2i __attribute__((ext_vector_type(2)));
__device__ __forceinline__ void peer_stage_b(const unsigned char* V8, const float* MOD, float* OUT, LAS unsigned char* sb, const LAS unsigned short* pe16, const LAS unsigned char* w8, const LAS float* scl,
                                             int t0, int tstride, int n, int lane) {
    const int r = lane & 15, q = lane >> 4, l3 = lane >> 3, p7 = lane & 7;
    const unsigned wo0 = (unsigned)(l3 * 128 + ((p7 ^ (l3 >> 1)) << 4)), wo1 = (unsigned)(l3 * 128 + ((p7 ^ (4 + (l3 >> 1))) << 4));
    const unsigned rbase = (unsigned)((32 * q + r) * 128 + ((r >> 1) << 4));
    unsigned off[16];
    v4u RA[16], RB[16];
#define PB_OFF(TOK) do { const bool ok_ = (TOK) < n; const int tk_ = ok_ ? (TOK) : n - 1; _Pragma("unroll") for (int i = 0; i < 16; ++i) { const unsigned e_ = pe16[tk_ * 128 + 8 * i + l3]; \
        off[i] = (ok_ ? e_ * 512u : 0u) + 16u * (unsigned)p7; } } while (0)
#define PB_ISSUE(RX, S) do { _Pragma("unroll") for (int i = 0; i < 16; ++i) RX[i] = *(const v4u*)(V8 + off[i] + 128 * (S)); } while (0)
#define PB_WRITE(RX) do { _Pragma("unroll") for (int i = 0; i < 16; ++i) *(LAS v4u*)(sb + ((i & 1) ? wo1 : wo0) + i * 1024) = RX[i]; } while (0)
#define PB_SLICE(RX, S, SNEXT) do { const int col_ = 256 * (S) + lane; float hv_[4], gv_[4]; \
        _Pragma("unroll") for (int j = 0; j < 4; ++j) { hv_[j] = orow[col_ + 64 * j]; gv_[j] = gt2[col_ + 64 * j]; } \
        PB_WRITE(RX); PB_ISSUE(RX, SNEXT); \
        float res_[4] = {0.f, 0.f, 0.f, 0.f}; \
        _Pragma("unroll") for (int mp = 0; mp < 8; ++mp) { const unsigned ad_ = rbase ^ (unsigned)(mp << 4); \
            _Pragma("unroll") for (int mb = 0; mb < 2; ++mb) { const int m_ = 2 * mp + mb; \
                const v2i b0_ = __builtin_amdgcn_ds_read_tr4_b64_v2i32((LAS v2i*)(sb + ad_ + 8 * mb)), b1_ = __builtin_amdgcn_ds_read_tr4_b64_v2i32((LAS v2i*)(sb + ad_ + 8 * mb + 2048)); \
                const v8i bb_ = {b0_.x, b0_.y, b1_.x, b1_.y, 0, 0, 0, 0}; \
                const f32x4 d_ = __builtin_amdgcn_mfma_scale_f32_16x16x128_f8f6f4(wa, bb_, (f32x4){0.f, 0.f, 0.f, 0.f}, 0, 4, 0, 0x7f7f7f7f, 0, 0x7f7f7f7f); \
                res_[m_ >> 2] = (q == (m_ & 3)) ? d_.x : res_[m_ >> 2]; } } \
        _Pragma("unroll") for (int j = 0; j < 4; ++j) orow[col_ + 64 * j] = hv_[j] + gv_[j] * (res_[j] * sc); } while (0)
    PB_OFF(0); PB_ISSUE(RA, 0); PB_ISSUE(RB, 1);
#pragma unroll 1
    for (int tok = 0; tok < n; ++tok) {
        const int t = t0 + tok * tstride;
        float* orow = OUT + (size_t)t * 1024; const float* gt2 = MOD + (size_t)(t >> 13) * 6144 + 5 * 1024;
        const v8i wa = __builtin_shufflevector(*(const LAS v4i*)(w8 + tok * 128 + 16 * q), *(const LAS v4i*)(w8 + tok * 128 + 64 + 16 * q), 0, 1, 2, 3, 4, 5, 6, 7);
        const float sc = scl[tok];
        PB_SLICE(RA, 0, 2); PB_SLICE(RB, 1, 3);
        PB_OFF(tok + 1);
        PB_SLICE(RA, 2, 0); PB_SLICE(RB, 3, 1);
    }
#undef PB_OFF
#undef PB_ISSUE
#undef PB_WRITE
#undef PB_SLICE
}

#ifndef MK_N_LAUNCHES
#define MK_N_LAUNCHES 1
#endif
constexpr int N_PHASES = 15;
struct Args { const float* in[28]; float* out; unsigned char* ws; int ph_lo, ph_hi, use_bar, rep; };
enum { I_X = 0, I_C, I_POS, I_WADA, I_BADA, I_N1G, I_WIN, I_QNG, I_KNG, I_MU, I_W0, I_W2, I_A0, I_A2, I_G2, I_KK, I_KA, I_RK, I_LNG, I_LNB, I_WPM, I_WPR, I_WOUT, I_N2G, I_WQ, I_SK, I_PU, I_PV };

template <int OFF> __device__ __forceinline__ unsigned long long karg64() { unsigned long long p; asm volatile("s_load_dwordx2 %0, %1, %2\n\ts_waitcnt lgkmcnt(0)" : "=s"(p) : "s"(__builtin_amdgcn_kernarg_segment_ptr()), "n"(OFF)); return p; }
#define KIN(k) ((const float*)(const GAS float*)karg64<8 * (k)>())
#define KOUT ((float*)(GAS float*)karg64<224>())
#define KWS ((unsigned char*)(GAS unsigned char*)karg64<232>())
#define KOB ((unsigned char*)(GAS unsigned char*)karg64<224>())
#define ctl ((unsigned*)(KWS + WS_CTL))
#define mod ((float*)(KWS + WS_MOD))
#define kmean ((float*)(KWS + WS_KMEAN))
#define WinT ((bf16*)(KWS + WS_WIN))
#define WloraT ((bf16*)(KWS + WS_WLORA))
#define WpmT ((bf16*)(KWS + WS_WPM))
#define WprT ((bf16*)(KWS + WS_WPR))
#define WoutT ((bf16*)(KWS + WS_WOUT))
#define WeffT ((bf16*)(KWS + WS_WEFF))
#define XN ((bf16*)(KWS + WS_XN))
#define EW ((bf16*)(KWS + WS_EW))
#define AA ((bf16*)(KWS + WS_AA))
#define Qb ((bf16*)(KWS + WS_Q))
#define Kb ((bf16*)(KWS + WS_K))
#define VTb ((bf16*)(KWS + WS_VT))
#define ZRKV ((bf16*)(KWS + WS_ZRKV))
#define GT ((bf16*)(KWS + WS_GT))
#define ZLORA ((bf16*)(KWS + WS_ZLORA))
#define ALORA ((bf16*)(KWS + WS_ALORA))
#define OMOBA ((bf16*)(KWS + WS_OCAT))
#define GG ((bf16*)(KWS + WS_GG))
#define Yb ((bf16*)(KWS + WS_OCAT) + 512)
#define MIXED ((bf16*)(KWS + WS_MIXED))
#define U8 ((unsigned char*)(KWS + WS_U8))
#define XN8 ((unsigned char*)(KWS + 352 * MiB))
#define V8 ((unsigned char*)(KWS + WS_V8))
#define SCORES ((bf16*)(KWS + WS_SCORES))
#define OPART ((bf16*)(KOB + DO_OPART))
#define LISTS ((unsigned*)(KOB + DO_LISTS))
#define LPART ((float*)(KOB + DO_LPART))
#define CP_RW ((bf16*)(KOB))
#define CP_MM ((bf16*)(KOB + 32 * MiB))
#define CP_Y0T ((bf16*)(KOB + 64 * MiB))
#define CP_GAT ((bf16*)(KOB + 96 * MiB))
#define CP_PC ((float*)(KWS + 504 * MiB))
#define REPSEL(a, b) (PRB ? (a) : (b))
#define REPSEL5(a, b) REPSEL(a, b)
template <int PRB> __global__ void __launch_bounds__(NTHR, 2) mk_fwd_t(Args args) {
    extern __shared__ __attribute__((aligned(16))) unsigned char lds_raw[];
    LAS unsigned char* lds = (LAS unsigned char*)lds_raw;
    volatile LAS unsigned* MISC = (volatile LAS unsigned*)(lds + MISC_OFF);
    const int tid = threadIdx.x, lane = tid & 63, wave = __builtin_amdgcn_readfirstlane(tid >> 6);
    const int G = gridDim.x, bx = blockIdx.x;
    const int vcu = (G % 8 == 0) ? (bx % 8) * (G / 8) + bx / 8 : bx;
    const int gw = vcu * NWAVES + wave, NGW = G * NWAVES;
    const int gtid = vcu * NTHR + tid, NTOT = G * NTHR;
    for (int u = tid; u < (LDS_BYTES - MISC_OFF) / 4; u += NTHR) ((LAS unsigned*)(lds + MISC_OFF))[u] = 0u;
    __syncthreads();
    XcdBarrier bar; bar.bar = ctl + CW_BAR; bar.x = 0; bar.st = nullptr;
    if (args.use_bar) bar = xcd_barrier_post(ctl + CW_BAR, MISC + 8);
    const int lo = args.ph_lo, hi = args.ph_hi;
#ifdef PH_MASK
#define IN(k) ((((PH_MASK) >> (k)) & 1) && lo <= (k) && (k) < hi)
#else
#define IN(k) (lo <= (k) && (k) < hi)
#endif
#define SEAM(k) do { if (IN(k) && IN((k) + 1)) { if (lo < 0) { cg::this_grid().sync(); } xcd_barrier(bar); } } while (0)

    if (IN(0)) {
        LAS float* scr = (LAS float*)(lds + wave * 16384);
        for (int it = vcu; it < 96; it += G) p0_mod_item(KIN(I_C), KIN(I_WADA), KIN(I_BADA), mod, (LAS float*)lds, it, wave, lane);
        constexpr int I_WEFF = 2048, I_MOD = 0, I_T_IN = 16 * 168, I_T_PM = 8 * 32, I_T_OUT = 16 * 32;
        constexpr int NITEMS = I_WEFF + I_MOD + I_T_IN + 2 * I_T_PM + I_T_OUT;
        for (int it = gw; it < NITEMS; it += NGW) {
            int r = it;
            if (r < I_WEFF) { p0_weff_item(KIN(I_WQ), KIN(I_SK), WeffT, r, lane); continue; } r -= I_WEFF;
            if (r < I_T_IN) { p0_transpose_item(KIN(I_WIN), 1024, INW, WinT, 1024, 0, scr, r, lane); continue; } r -= I_T_IN;
            if (r < I_T_PM) { p0_transpose_item(KIN(I_WPM), 512, 1024, WpmT, 1024, 0, scr, r, lane); continue; } r -= I_T_PM;
            if (r < I_T_PM) { p0_transpose_item(KIN(I_WPR), 512, 1024, WpmT, 1024, 512, scr, r, lane); continue; } r -= I_T_PM;
            p0_transpose_item(KIN(I_WOUT), 1024, 1024, WoutT, 1024, 0, scr, r, lane);
        }
        const float* w2 = KIN(I_W2); const float* a2 = KIN(I_A2); const float* g2 = KIN(I_G2);
        for (int i = gtid; i < 1536 * 256; i += NTOT) {
            const int n = i >> 8, k = i & 255; float v = 0.f;
            if (n < 512) { if (k < 64) v = w2[k * 512 + n]; }
            else if (n < 1024) { if (k >= 64 && k < 128) v = a2[(k - 64) * 512 + (n - 512)]; }
            else { if (k >= 128) v = g2[(k - 128) * 512 + (n - 1024)]; }
            WloraT[i] = (bf16)f2bf(v);
        }
     }
    SEAM(0);
    if (IN(1)) {
        for (int m = gw * 4; m < T; m += NGW * 4) { const float* mb = mod + (size_t)(m >> 13) * 6144;
            rms_mod_rows<4>(KIN(I_X) + (size_t)m * DM, XN + (size_t)m * DM, nullptr, KIN(I_N1G), mb + 1024, mb, lane); }
     }
    SEAM(1);
    if (IN(2)) {
        pg8::Gemm g{XN, WinT, T, INW, DM}; pg8::StaticOrder S; S.init(T, INW, G, bx);
        EpiIn E{Qb, Kb, VTb, ZRKV, ZLORA, GT};
        pg8::gemm_phase<EpiIn, pg8::StaticOrder, true, true>(lds, g, S, E);
     }
    SEAM(2);
    if (IN(3)) {
        LAS float* red = (LAS float*)lds;
        v4u raw[4], rawn[4]; int ps[4], psn[4];
        if (vcu < 2048) p2_qk_load(raw, ps, (vcu >> 10) ? Qb : Kb, (const int*)KIN(I_POS), (vcu & 1023) >> 5, vcu & 31, wave, lane);
        for (int it = vcu; it < 2048; it += G) {
            const int isq = it >> 10, r = it & 1023, bh = r >> 5, n = r & 31;
            { const int itn = it + G < 2048 ? it + G : it;
              p2_qk_load(rawn, psn, (itn >> 10) ? Qb : Kb, (const int*)KIN(I_POS), (itn & 1023) >> 5, itn & 31, wave, lane); }
            if (isq) p2_qk_item(raw, ps, REPSEL((bf16*)KOB, Qb), KIN(I_QNG), nullptr, bh, n, red, tid, wave, lane);
            else p2_qk_item(raw, ps, REPSEL((bf16*)(KOB + 32 * MiB), Kb), KIN(I_KNG), REPSEL((float*)(KWS + 1536 * 1024), kmean), bh, n, red, tid, wave, lane);
#pragma unroll
            for (int i = 0; i < 4; ++i) { raw[i] = rawn[i]; ps[i] = psn[i]; }
        }
        p2_prep(ZLORA, KIN(I_MU), REPSEL((bf16*)(KOB + 64 * MiB), ALORA), gtid, NTOT);
    }
    SEAM(3);
    if (IN(4)) {
        { int kdim = 256; asm volatile("" : "+s"(kdim));
          pg8::Gemm g{ALORA, WloraT, T, 1536, kdim}; pg8::StaticOrder S; S.init(T, 1536, G, bx);
          EpiLora E{EW, AA, GG, KIN(I_W0), KIN(I_A0)};
          pg8::gemm_phase<EpiLora, pg8::StaticOrder, true, true>(lds, g, S, E); }
        __syncthreads();
        LAS float* km = (LAS float*)lds;
        for (int it = vcu; it < 512; it += G) p3_top3_item(Qb, kmean, ctl + CW_CURSOR + REPSEL(2048, 0), REPSEL((unsigned*)KOB, LISTS), (2 * it) & 31, (2 * it) >> 5, km, tid, wave, lane);
    }
    SEAM(4);
    if (IN(5)) {
        attn_phase(Qb, Kb, VTb, LISTS, ctl + CW_CURSOR, ctl + CW_QUEUE + REPSEL5(64, 0), OPART, LPART, OMOBA, KIN(I_QNG), KIN(I_KNG), lds, tid, wave, lane, PRB);
    }
    SEAM(5);
    if (IN(6)) {
        p5_combine(OPART, LPART, OMOBA, REPSEL(Qb, OMOBA), gtid, NTOT);
    }
    SEAM(6);
    if (IN(7)) {
        ScanRaw R;
        if (vcu < BH * NCHK) scan_load(R, ZRKV, AA, EW, (vcu >> 7) >> 3, ((vcu >> 7) & 7) * 64 + (tid & 7) * 8, (vcu & 127) * CK + (tid >> 3));
        for (int ci = vcu; ci < BH * NCHK; ci += G) {
            const int cn = ci + G;
            rwkv_cp_item(ZRKV, AA, EW, KIN(I_MU), KIN(I_KK), KIN(I_KA), CP_RW + (size_t)ci * 4096, CP_MM + (size_t)ci * 4096, CP_Y0T + (size_t)ci * 4096, CP_GAT + (size_t)ci * 4096,
                         CP_PC + (size_t)ci * 64, ci >> 7, ci & 127, R, (cn < BH * NCHK ? cn : ci) >> 7, (cn < BH * NCHK ? cn : ci) & 127, lds, tid, wave, lane, PRB);
        }
    }
    SEAM(7);
    if (IN(8)) {
        if (G >= 128) { if (vcu < 128) rwkv_seq(CP_RW, CP_MM, CP_Y0T, CP_GAT, CP_PC, Yb, vcu, lds, tid, wave, lane); }
        else for (int sid = vcu; sid < 128; sid += G) { __syncthreads(); rwkv_seq(CP_RW, CP_MM, CP_Y0T, CP_GAT, CP_PC, Yb, sid, lds, tid, wave, lane); }
        if (G > 128 ? vcu >= 128 : true) {
        const int cgt = (G > 128 ? vcu - 128 : vcu) * NTHR + tid, cnt = (G > 128 ? G - 128 : G) * NTHR;
        const f32x4* pu = (const f32x4*)KIN(I_PU); const f32x4* pv = (const f32x4*)KIN(I_PV);
        for (int i = cgt; i < 16384 * 1024 / 32; i += cnt) {
            v4u wu;
#pragma unroll
            for (int q = 0; q < 4; ++q) {
                f32x4 a = pu[8 * i + 2 * q] * 64.f, c = pu[8 * i + 2 * q + 1] * 64.f;
                a = __builtin_elementwise_min(__builtin_elementwise_max(a, (f32x4){-6.f, -6.f, -6.f, -6.f}), (f32x4){6.f, 6.f, 6.f, 6.f});
                c = __builtin_elementwise_min(__builtin_elementwise_max(c, (f32x4){-6.f, -6.f, -6.f, -6.f}), (f32x4){6.f, 6.f, 6.f, 6.f});
                unsigned w = 0u;
                w = __builtin_amdgcn_cvt_scalef32_pk_fp4_f32(w, a.x, a.y, 1.0f, 0); w = __builtin_amdgcn_cvt_scalef32_pk_fp4_f32(w, a.z, a.w, 1.0f, 1);
                w = __builtin_amdgcn_cvt_scalef32_pk_fp4_f32(w, c.x, c.y, 1.0f, 2); w = __builtin_amdgcn_cvt_scalef32_pk_fp4_f32(w, c.z, c.w, 1.0f, 3);
                wu[q] = w;
            }
            *(v4u*)(U8 + (size_t)i * 16) = wu;
        }
        for (int i = cgt; i < 16384 * 1024 / 32; i += cnt) {
            v4u wv;
#pragma unroll
            for (int q = 0; q < 4; ++q) {
                f32x4 a = pv[8 * i + 2 * q] * 5.656854249f, c = pv[8 * i + 2 * q + 1] * 5.656854249f;
                a = __builtin_elementwise_min(__builtin_elementwise_max(a, (f32x4){-6.f, -6.f, -6.f, -6.f}), (f32x4){6.f, 6.f, 6.f, 6.f});
                c = __builtin_elementwise_min(__builtin_elementwise_max(c, (f32x4){-6.f, -6.f, -6.f, -6.f}), (f32x4){6.f, 6.f, 6.f, 6.f});
                unsigned w = 0u;
                w = __builtin_amdgcn_cvt_scalef32_pk_fp4_f32(w, a.x, a.y, 1.0f, 0); w = __builtin_amdgcn_cvt_scalef32_pk_fp4_f32(w, a.z, a.w, 1.0f, 1);
                w = __builtin_amdgcn_cvt_scalef32_pk_fp4_f32(w, c.x, c.y, 1.0f, 2); w = __builtin_amdgcn_cvt_scalef32_pk_fp4_f32(w, c.z, c.w, 1.0f, 3);
                wv[q] = w;
            }
            *(v4u*)(V8 + (size_t)i * 16) = wv;
        }
        }
    }
    SEAM(8);
    if (IN(9)) {
        p5_rwkv_post(ZRKV, AA, GG, Yb, REPSEL(Qb, Yb), KIN(I_MU), KIN(I_KA), KIN(I_RK), KIN(I_LNG), KIN(I_LNB), gw, NGW, lane);
    }
    SEAM(9);
    if (IN(10)) {
        pg8::Gemm g{OMOBA, WpmT, T, DM, DM}; pg8::StaticOrder S; S.init(T, DM, G, bx);
        EpiMix E{GT, MIXED, PRB};
        pg8::gemm_phase<EpiMix, pg8::StaticOrder, true, true>(lds, g, S, E);
    }
    SEAM(10);
    if (IN(11)) {
        pg8::Gemm g{MIXED, WoutT, T, DM, DM}; pg8::StaticOrder S; S.init(T, DM, G, bx);
        EpiOut E{KIN(I_X), mod, KOUT};
        pg8::gemm_phase<EpiOut, pg8::StaticOrder, true, true>(lds, g, S, E);
     }
    SEAM(11);
    if (IN(12)) {
        for (int m = gw * 4; m < T; m += NGW * 4) { const float* mb = mod + (size_t)(m >> 13) * 6144;
            rms_mod_rows<4>(KOUT + (size_t)m * DM, XN + (size_t)m * DM, (unsigned*)(XN8 + (size_t)m * DM), KIN(I_N2G), mb + 4 * 1024, mb + 3 * 1024, lane); }
    }
    SEAM(12);
    if (IN(13)) {
        pg8::Gemm g{XN, WeffT, T, PEER_N, DM}; pg8::StaticOrder S; S.init(T, PEER_N, G, bx);
        EpiScores E{SCORES};
        pg8::gemm_phase<EpiScores, pg8::StaticOrder, true, true>(lds, g, S, E);
     }
    SEAM(13);
    if (IN(14)) {
        constexpr int PW = (LDS_BYTES - 512) / NWAVES;
        LAS unsigned char* wb = lds + wave * PW;
        LAS f32x4* xl = (LAS f32x4*)wb;
        LAS unsigned short* pe16 = (LAS unsigned short*)(wb + 16384); LAS unsigned char* w8 = wb + 16384 + 2048; LAS float* scl = (LAS float*)(wb + 16384 + 3072);
        v4u scn[4], x8n;
        { const int g_ = lane >> 4, r_ = lane & 15;
#pragma unroll
          for (int pass = 0; pass < 4; ++pass) scn[pass] = *(const v4u*)(SCORES + (size_t)gw * 2048 + (pass * 4 + g_) * 128 + r_ * 8);
          x8n = *(const v4u*)(XN8 + (size_t)gw * 1024 + 16 * lane); }
#pragma unroll 1
        for (int t0 = gw; t0 < T; t0 += 8 * NGW) {
            int n = 0;
            int la = lane, lb = lane;
            asm volatile("" : "+v"(la));
#pragma unroll 1
            for (int t = t0; t < T && n < 8; t += NGW, ++n) peer_token_a(SCORES, XN8, U8, xl, pe16 + 128 * n, w8 + 128 * n, scl + n, t, t + NGW < T ? t + NGW : t, scn, x8n, la);
            LDS_WAIT(); asm volatile("" ::: "memory");
            asm volatile("" : "+v"(lb));
            peer_stage_b(V8, mod, KOUT, wb, pe16, w8, scl, t0, NGW, n, lb);
            LDS_WAIT(); asm volatile("" ::: "memory");
        }
    }
#undef IN
#undef SEAM
}

extern "C" void kernel_launch(void* const* d_in, const int* in_sizes, int n_in, void* d_out, int out_size, void* d_ws, size_t ws_size, hipStream_t stream) {
    static int grid = 0;
    if (grid == 0) {
        if (n_in != 28 || in_sizes[0] != T * DM || out_size != T * DM || ws_size < WS_END) {
            fprintf(stderr, "kernel_launch: unexpected problem (n_in %d, in0 %d, out %d, ws %zu); nothing launched\n", n_in, n_in > 0 ? in_sizes[0] : -1, out_size, ws_size); grid = -1; return; }
        int dev = 0, cus = 0, per_cu = 0;
        if (hipGetDevice(&dev) != hipSuccess || hipDeviceGetAttribute(&cus, hipDeviceAttributeMultiprocessorCount, dev) != hipSuccess) { grid = -1; return; }
        if (hipFuncSetAttribute((const void*)mk_fwd_t<0>, hipFuncAttributeMaxDynamicSharedMemorySize, LDS_BYTES) != hipSuccess) { fprintf(stderr, "kernel_launch: hipFuncSetAttribute failed\n"); grid = -1; return; }
        if (hipOccupancyMaxActiveBlocksPerMultiprocessor(&per_cu, (const void*)mk_fwd_t<0>, NTHR, LDS_BYTES) != hipSuccess || per_cu < 1) { fprintf(stderr, "kernel_launch: occupancy query says %d\n", per_cu); per_cu = 1; }
        (void)hipGetLastError();
        grid = cus;
    }
    if (grid < 0) return;
    if (hipMemsetAsync((char*)d_ws + WS_CTL, 0, CTL_ZERO_BYTES, stream) != hipSuccess) { fprintf(stderr, "kernel_launch: memset failed\n"); return; }
    Args a{};
    for (int i = 0; i < 28; ++i) a.in[i] = (const float*)d_in[i];
    a.out = (float*)d_out; a.ws = (unsigned char*)d_ws;
#if MK_N_LAUNCHES == 1
    a.ph_lo = 0; a.ph_hi = N_PHASES; a.use_bar = 1;
    void* kargs[] = {&a};
    hipError_t e = hipLaunchCooperativeKernel((const void*)mk_fwd_t<0>, dim3(grid), dim3(NTHR), kargs, LDS_BYTES, stream);
    if (e != hipSuccess) fprintf(stderr, "kernel_launch: cooperative launch failed: %s (grid %d)\n", hipGetErrorString(e), grid);
#else
#ifndef REP_MASK
#define REP_MASK 0
#endif
#ifndef REP_CODE
#define REP_CODE 1
#endif
    for (int p = 0; p < N_PHASES; ++p) {
        a.ph_lo = p; a.ph_hi = p + 1; a.use_bar = 0;
#if REP_MASK != 0
        if ((REP_MASK >> p) & 1) { static bool once = false; if (!once) { once = true; (void)hipFuncSetAttribute((const void*)mk_fwd_t<REP_CODE>, hipFuncAttributeMaxDynamicSharedMemorySize, LDS_BYTES); }
            a.rep = REP_CODE; hipLaunchKernelGGL(mk_fwd_t<REP_CODE>, dim3(grid), dim3(NTHR), LDS_BYTES, stream, a); }
#endif
        a.rep = 0;
        hipLaunchKernelGGL(mk_fwd_t<0>, dim3(grid), dim3(NTHR), LDS_BYTES, stream, a);
    }
#endif
}
```

```cpp
#include <hip/hip_runtime.h>
#include <hip/hip_cooperative_groups.h>
#include <cstdio>
#include <cstdint>
namespace cg = cooperative_groups;

namespace pg8 {
#define PG8_LAS __attribute__((address_space(3)))
typedef unsigned short bf16_t;
typedef short bf16x8 __attribute__((ext_vector_type(8)));
typedef float f32x4 __attribute__((ext_vector_type(4)));
typedef unsigned u32x4 __attribute__((ext_vector_type(4)));
constexpr int BM = 256, BK = 64, HALF = 128, HTB = HALF * BK * 2  , STAGE_BYTES = 8 * HTB, NXCD = 8, WGM = 8;

__host__ __device__ __forceinline__ int lds_byte(int r, int c) { const int st = (r >> 4) * 2 + (c >> 5), rr = r & 15, cc = c & 31, ob = rr * 64 + cc * 2; return st * 1024 + (ob ^ (((ob >> 9) & 1) << 5)); }
__host__ __device__ __forceinline__ void stage_rc(int b, int& R, int& C) { const int st = b / 1024, sb = b % 1024, swz = sb ^ (((sb >> 9) & 1) << 5); R = (st >> 1) * 16 + swz / 64; C = (st & 1) * 32 + (swz % 64) / 2; }
__host__ __device__ __forceinline__ int perm32(int rho) { const int n = rho >> 4, i = rho & 15; return 8 * (i >> 2) + 4 * n + (i & 3); }

struct Unit { int pm, pn; };
struct Gemm { const bf16_t* A; const bf16_t* Bt; int M, N, K; };

struct StaticOrder {
    int nM, nN, nwg, G, c;
    __host__ __device__ void init(int M, int N, int G_, int c_) { nM = M / BM; nN = N / BM; nwg = nM * nN; G = G_; c = c_; }
    __host__ __device__ bool next(int i, Unit& u) const {
        const long L = (long)i * G + c; if (L >= nwg) return false;
        int wgid = (int)L; { const int q = nwg / NXCD, r = nwg % NXCD, xcd = wgid % NXCD, off = wgid / NXCD; wgid = (xcd < r ? xcd * (q + 1) : r * (q + 1) + (xcd - r) * q) + off; }
        const int nig = WGM * nN, gid = wgid / nig, fm = gid * WGM, gsz = (nM - fm) < WGM ? (nM - fm) : WGM;
        u.pm = fm + ((wgid % nig) % gsz); u.pn = (wgid % nig) / gsz; return true;
    }
    __device__ __forceinline__ void a_ready(const Unit&) const {}
    __device__ __forceinline__ void done(const Unit&) const {}
};
template <class Epi, class Sched, bool ALIGN_EPI = false, bool SP2 = false>
__device__ __forceinline__ void gemm_phase(PG8_LAS unsigned char* lds, const Gemm g, const Sched& S, const Epi& E) {
    const int tid = threadIdx.x, wid = __builtin_amdgcn_readfirstlane(tid >> 6), lane = tid & 63, wr = wid >> 2, wc = wid & 3, fr = lane & 15, fq = lane >> 4;
    const int K = g.K, nt = K / BK;
    unsigned voffA[2], voffB[2];
#pragma unroll
    for (int i = 0; i < 2; ++i) { int R, C; stage_rc(tid * 16 + i * 8192, R, C); const int Rb = Epi::PERM ? ((R & ~31) + perm32(R & 31)) : R;
        voffA[i] = (unsigned)(R * K + C) * 2u; voffB[i] = (unsigned)(Rb * K + C) * 2u; }
    const size_t kstep = (size_t)(BK * 2);
    const size_t hstep = (size_t)HALF * K * 2;
    const size_t tstep = 2 * hstep;
    const unsigned ldsw = (unsigned)wid * 1024u;
    const int aoff = lds_byte(wr * 64 + fr, fq * 8), boff = lds_byte(wc * 32 + fr, fq * 8);
#define PG8_SA(b, h) (((b) * 2 + (h)) * HTB)
#define PG8_SB(b, h) ((4 + (b) * 2 + (h)) * HTB)
#define PG8_STAGE(bufoff, gbase, voff) do { _Pragma("unroll") for (int _i = 0; _i < 2; ++_i) \
        __builtin_amdgcn_global_load_lds((const unsigned*)((const char*)(gbase) + (voff)[_i]), (PG8_LAS unsigned*)(lds + (bufoff) + ldsw + _i * 8192), 16, 0, 0); } while (0)
#define PG8_LDA(dst, b, h) do { _Pragma("unroll") for (int m = 0; m < 4; ++m) _Pragma("unroll") for (int k = 0; k < 2; ++k) dst[m][k] = *(const PG8_LAS bf16x8*)(lds + PG8_SA(b, h) + aoff + m * 2048 + k * 1024); } while (0)
#define PG8_LDB(dst, b, h) do { _Pragma("unroll") for (int n = 0; n < 2; ++n) _Pragma("unroll") for (int k = 0; k < 2; ++k) dst[n][k] = *(const PG8_LAS bf16x8*)(lds + PG8_SB(b, h) + boff + n * 2048 + k * 1024); } while (0)
#define PG8_MMA(ai, bj, At, Bt) do { __builtin_amdgcn_s_setprio(1); _Pragma("unroll") for (int m = 0; m < 4; ++m) _Pragma("unroll") for (int n = 0; n < 2; ++n) _Pragma("unroll") for (int k = 0; k < 2; ++k) \
        acc[ai][bj][m][n] = __builtin_amdgcn_mfma_f32_16x16x32_bf16(Bt[n][k], At[m][k], acc[ai][bj][m][n], 0, 0, 0); __builtin_amdgcn_s_setprio(0); } while (0)
#define PG8_WAIT_V(n) asm volatile("s_waitcnt vmcnt(" #n ")" ::: "memory")
#define PG8_WAIT_L(n) asm volatile("s_waitcnt lgkmcnt(" #n ")" ::: "memory")
#define PG8_BAR __builtin_amdgcn_s_barrier()
#define PG8_SCHED __builtin_amdgcn_sched_barrier(0)
    Unit cur, nxt; int ui = 0;
    if (!S.next(0, cur)) return;
    f32x4 acc[2][2][4][2];
#pragma unroll
    for (int a = 0; a < 2; ++a)
#pragma unroll
        for (int b = 0; b < 2; ++b)
#pragma unroll
            for (int m = 0; m < 4; ++m)
#pragma unroll
                for (int n = 0; n < 2; ++n) acc[a][b][m][n] = (f32x4){0.f, 0.f, 0.f, 0.f};
    bf16x8 At[4][2], B0[2][2], B1[2][2];
    const char* cA = (const char*)g.A + (size_t)cur.pm * tstep; const char* cB = (const char*)g.Bt + (size_t)cur.pn * tstep;
    S.a_ready(cur);
    if constexpr (SP2) {
        PG8_STAGE(PG8_SB(0, 0), cB, voffB); PG8_STAGE(PG8_SB(0, 1), cB + hstep, voffB); PG8_STAGE(PG8_SA(0, 0), cA, voffA); PG8_STAGE(PG8_SA(0, 1), cA + hstep, voffA);
        if (wr == 1) PG8_BAR;
        PG8_WAIT_V(2); PG8_BAR;
        PG8_STAGE(PG8_SB(1, 0), cB + kstep, voffB); PG8_STAGE(PG8_SA(1, 0), cA + kstep, voffA); PG8_STAGE(PG8_SB(1, 1), cB + hstep + kstep, voffB);
        PG8_WAIT_V(6); PG8_BAR;
    } else {
        PG8_STAGE(PG8_SB(0, 0), cB, voffB); PG8_STAGE(PG8_SA(0, 0), cA, voffA); PG8_STAGE(PG8_SB(0, 1), cB + hstep, voffB); PG8_STAGE(PG8_SA(0, 1), cA + hstep, voffA);
        if (wr == 1) PG8_BAR;
        PG8_WAIT_V(4); PG8_BAR;
        PG8_STAGE(PG8_SB(1, 0), cB + kstep, voffB); PG8_STAGE(PG8_SA(1, 0), cA + kstep, voffA); PG8_STAGE(PG8_SB(1, 1), cB + hstep + kstep, voffB);
        PG8_WAIT_V(6); PG8_BAR;
    }
    for (;;) {
        const bool has_next = S.next(ui + 1, nxt);
        const char* nA = has_next ? (const char*)g.A + (size_t)nxt.pm * tstep : cA; const char* nB = has_next ? (const char*)g.Bt + (size_t)nxt.pn * tstep : cB;
        for (int t = 0; t < nt; t += 2) {
            if constexpr (Epi::HAS_MID) { if (t == Epi::MID_T) E.mid(acc, cur, wr, wc, fr, fq); }
            const bool last = (t == nt - 2);
            const char* a1 = cA + (size_t)(t + 1) * kstep;
            const char* a2 = last ? nA : cA + (size_t)(t + 2) * kstep; const char* b2 = last ? nB : cB + (size_t)(t + 2) * kstep;
            const char* a3 = a2 + kstep; const char* b3 = b2 + kstep;
            if (last && has_next) S.a_ready(nxt);
            if constexpr (SP2) {
            PG8_LDB(B0, 0, 0); PG8_LDB(B1, 0, 1); PG8_SCHED; PG8_LDA(At, 0, 0); PG8_STAGE(PG8_SA(1, 1), a1 + hstep, voffA);
            PG8_WAIT_V(8); PG8_WAIT_L(0); PG8_BAR; PG8_MMA(0, 0, At, B0); PG8_MMA(0, 1, At, B1); PG8_BAR; PG8_SCHED;
            PG8_LDA(At, 0, 1); PG8_STAGE(PG8_SB(0, 0), b2, voffB); PG8_STAGE(PG8_SB(0, 1), b2 + hstep, voffB); PG8_STAGE(PG8_SA(0, 0), a2, voffA);
            PG8_WAIT_V(8); PG8_WAIT_L(0); PG8_BAR; PG8_MMA(1, 0, At, B0); PG8_MMA(1, 1, At, B1); PG8_BAR; PG8_SCHED;
            PG8_LDB(B0, 1, 0); PG8_LDB(B1, 1, 1); PG8_SCHED; PG8_LDA(At, 1, 0); PG8_STAGE(PG8_SA(0, 1), a2 + hstep, voffA);
            PG8_WAIT_V(8); PG8_WAIT_L(0); PG8_BAR; PG8_MMA(0, 0, At, B0); PG8_MMA(0, 1, At, B1); PG8_BAR; PG8_SCHED;
            PG8_LDA(At, 1, 1); PG8_STAGE(PG8_SB(1, 0), b3, voffB); PG8_STAGE(PG8_SB(1, 1), b3 + hstep, voffB); PG8_STAGE(PG8_SA(1, 0), a3, voffA);
            PG8_WAIT_V(8); PG8_WAIT_L(0); PG8_BAR; PG8_MMA(1, 0, At, B0); PG8_MMA(1, 1, At, B1); PG8_BAR; PG8_SCHED;
            } else {
            PG8_LDB(B0, 0, 0); PG8_SCHED; PG8_LDA(At, 0, 0); PG8_STAGE(PG8_SA(1, 1), a1 + hstep, voffA);
            PG8_WAIT_L(8); PG8_BAR; PG8_WAIT_L(0); PG8_MMA(0, 0, At, B0); PG8_BAR; PG8_SCHED;
            PG8_LDB(B1, 0, 1); PG8_STAGE(PG8_SB(0, 0), b2, voffB);
            PG8_BAR; PG8_WAIT_L(0); PG8_MMA(0, 1, At, B1); PG8_BAR;
            PG8_LDA(At, 0, 1); PG8_STAGE(PG8_SA(0, 0), a2, voffA);
            PG8_BAR; PG8_WAIT_L(0); PG8_MMA(1, 0, At, B0); PG8_BAR; PG8_SCHED;
            PG8_STAGE(PG8_SB(0, 1), b2 + hstep, voffB);
            PG8_WAIT_V(6); PG8_BAR; PG8_MMA(1, 1, At, B1); PG8_BAR;
            PG8_LDB(B0, 1, 0); PG8_SCHED; PG8_LDA(At, 1, 0); PG8_STAGE(PG8_SA(0, 1), a2 + hstep, voffA);
            PG8_WAIT_L(8); PG8_BAR; PG8_WAIT_L(0); PG8_MMA(0, 0, At, B0); PG8_BAR; PG8_SCHED;
            PG8_LDB(B1, 1, 1); PG8_STAGE(PG8_SB(1, 0), b3, voffB);
            PG8_BAR; PG8_WAIT_L(0); PG8_MMA(0, 1, At, B1); PG8_BAR;
            PG8_LDA(At, 1, 1); PG8_STAGE(PG8_SA(1, 0), a3, voffA);
            PG8_BAR; PG8_WAIT_L(0); PG8_MMA(1, 0, At, B0); PG8_BAR; PG8_SCHED;
            PG8_STAGE(PG8_SB(1, 1), b3 + hstep, voffB);
            PG8_WAIT_V(6); PG8_BAR; PG8_MMA(1, 1, At, B1); PG8_BAR;
            }
        }
        if constexpr (ALIGN_EPI) { if (wr == 0) PG8_BAR; }
        if constexpr (!Epi::AFTER_DRAIN) { E(acc, cur, wr, wc, fr, fq); S.done(cur); }
        if (!has_next) break;
#pragma unroll
        for (int a = 0; a < 2; ++a)
#pragma unroll
            for (int b = 0; b < 2; ++b)
#pragma unroll
                for (int m = 0; m < 4; ++m)
#pragma unroll
                    for (int n = 0; n < 2; ++n) acc[a][b][m][n] = (f32x4){0.f, 0.f, 0.f, 0.f};
        cur = nxt; cA = nA; cB = nB; ++ui;
        if constexpr (ALIGN_EPI) { if (wr == 1) PG8_BAR; }
    }
    PG8_WAIT_V(0);
    if constexpr (!ALIGN_EPI) { if (wr == 0) PG8_BAR; }
    PG8_BAR;
    if constexpr (Epi::AFTER_DRAIN) { E.fused(acc, cur, wr, wc, fr, fq, lds, wid, lane); S.done(cur); }
#undef PG8_SA
#undef PG8_SB
#undef PG8_STAGE
#undef PG8_LDA
#undef PG8_LDB
#undef PG8_MMA
#undef PG8_WAIT_V
#undef PG8_WAIT_L
#undef PG8_BAR
#undef PG8_SCHED
}
}

constexpr int NWAVES = 8, NTHR = 512;
constexpr int BATCH = 4, SEQ = 8192, DM = 1024, T = BATCH * SEQ;
constexpr int NH = 8, HD = 64, NBLK = 32, BLK = 256;
constexpr int BH = BATCH * NH;
constexpr int INW = 5376;
constexpr int ZR = 1536, ZL = 256;
constexpr int PEER_N = 2048;
constexpr float RMS_EPS = 1e-6f, GN_EPS = 64e-5f;
constexpr int OSTR = 1024;

constexpr size_t MiB = 1u << 20;
constexpr size_t WS_CTL = 0, CTL_ZERO_BYTES = 1 * MiB;
constexpr size_t WS_MOD = 1 * MiB;
constexpr size_t WS_KMEAN = 1 * MiB + 128 * 1024;
constexpr size_t WS_WIN = 2 * MiB;
constexpr size_t WS_WLORA = 13 * MiB;
constexpr size_t WS_WPM = 14 * MiB, WS_WPR = 15 * MiB;
constexpr size_t WS_WOUT = 16 * MiB;
constexpr size_t WS_WEFF = 18 * MiB;
constexpr size_t WS_XN = 24 * MiB;
constexpr size_t WS_EW = 24 * MiB, WS_AA = 56 * MiB;
constexpr size_t WS_Q = 88 * MiB, WS_K = 120 * MiB, WS_VT = 152 * MiB;
constexpr size_t WS_ZRKV = 184 * MiB;
constexpr size_t WS_GT = 280 * MiB;
constexpr size_t WS_ZLORA = 408 * MiB;
constexpr size_t WS_ALORA = 424 * MiB;
constexpr size_t WS_OCAT = 408 * MiB;
constexpr size_t WS_H1B = 408 * MiB;
constexpr size_t WS_GG = 472 * MiB;
constexpr size_t WS_MIXED = 216 * MiB;
constexpr size_t WS_U8 = 2 * MiB, WS_V8 = 88 * MiB;
constexpr size_t WS_SCORES = 96 * MiB;
constexpr size_t WS_END = 512 * MiB;
constexpr size_t DO_OPART = 0, DO_LISTS = 96 * MiB, DO_LPART = 112 * MiB;
constexpr int LIST_PER_BH = 256 * 496;
__host__ __device__ constexpr int list_off(int n) { return 256 * (31 * n - n * (n - 1) / 2); }
constexpr int CW_QUEUE = 64;
constexpr int CW_CURSOR = 1024;
constexpr int CW_BAR = 4096;

constexpr int RING_BYTES = 131072;
constexpr int LDS_BYTES = 163840;
constexpr int MISC_OFF = LDS_BYTES - 512;

#define GAS __attribute__((address_space(1)))
#define LAS __attribute__((address_space(3)))
typedef unsigned short bf16;
typedef unsigned v4u __attribute__((ext_vector_type(4)));
typedef unsigned v2u __attribute__((ext_vector_type(2)));
typedef float f32x4 __attribute__((ext_vector_type(4)));
typedef float f32x2 __attribute__((ext_vector_type(2)));
typedef float f32x16 __attribute__((ext_vector_type(16)));
typedef short bf16x8 __attribute__((ext_vector_type(8)));
typedef short s16x4 __attribute__((ext_vector_type(4)));
#define RLX_AGENT __ATOMIC_RELAXED, __HIP_MEMORY_SCOPE_AGENT
#define LDS_WAIT() asm volatile("s_waitcnt lgkmcnt(0)" ::: "memory")
#define VM_WAIT() asm volatile("s_waitcnt vmcnt(0)" ::: "memory")
typedef __bf16 bf16x2_t __attribute__((ext_vector_type(2)));
__device__ __forceinline__ unsigned cvtpk(float lo, float hi) { f32x2 v = {lo, hi}; bf16x2_t b = __builtin_convertvector(v, bf16x2_t); return __builtin_bit_cast(unsigned, b); }
__device__ __forceinline__ unsigned pk2(float lo, float hi) { return cvtpk(lo, hi); }
__device__ __forceinline__ unsigned f2bf(float f) { return cvtpk(f, 0.f) & 0xffffu; }
__device__ __forceinline__ float bflo(unsigned u) { return __builtin_bit_cast(float, u << 16); }
__device__ __forceinline__ float bfhi(unsigned u) { return __builtin_bit_cast(float, u & 0xffff0000u); }
__device__ __forceinline__ float bf2f(bf16 h) { return __builtin_bit_cast(float, (unsigned)h << 16); }
__device__ __forceinline__ float wave_sum(float v) {
#pragma unroll
    for (int o = 1; o < 64; o <<= 1) v += __shfl_xor(v, o);
    return v;
}
__device__ __forceinline__ float sigmoidf_(float x) { return __builtin_amdgcn_rcpf(1.0f + __expf(-x)); }
#define XB_TMO      128
#define XB_XCNT(j)  (256  + 64 * (j))
#define XB_XSUB(j)  (1280 + 64 * (j))
#define XB_XGEN(j)  (2304 + 64 * (j))
#define XB_TOP      3328
#define XB_TOPGEN   3392
#define XCD_BAR_WORDS 3456
#define XB_SPIN_CAP (1u << 18)

__device__ __forceinline__ unsigned xb_ld(unsigned* p)              { return __hip_atomic_load(p, __ATOMIC_RELAXED, __HIP_MEMORY_SCOPE_AGENT); }
__device__ __forceinline__ unsigned xb_add(unsigned* p, unsigned v) { return __hip_atomic_fetch_add(p, v, __ATOMIC_RELAXED, __HIP_MEMORY_SCOPE_AGENT); }
__device__ __forceinline__ unsigned xb_xcc_id() { return (unsigned)__builtin_amdgcn_s_getreg((3 << 11) | 20) & 0xFu; }
#define XB_SPIN(cond, bar) do { unsigned _sp = 0; while (cond) { __builtin_amdgcn_s_sleep(1); \
    if ((++_sp & 255u) == 0u) { if (xb_ld(&(bar)[XB_TMO])) break; if (_sp > XB_SPIN_CAP) { atomicAdd(&(bar)[XB_TMO], 1u); break; } } } } while (0)

struct XcdBarrier {
    unsigned* bar; unsigned x;
    volatile LAS unsigned* st;
};

__device__ __forceinline__ XcdBarrier xcd_barrier_post(unsigned* bar, volatile LAS unsigned* st) {
    XcdBarrier b; b.bar = bar; b.x = xb_xcc_id(); b.st = st;
    if (threadIdx.x == 0) (void)xb_add(&bar[XB_XCNT(b.x)], 1u);
    return b;
}
__device__ __forceinline__ void xcd_barrier_complete(unsigned* bar, unsigned x, unsigned& nloc, unsigned& nx) {
    const unsigned G = gridDim.x * gridDim.y * gridDim.z;
    unsigned sum, cnt, mine, sp = 0u;
    for (;;) {
        sum = 0u; cnt = 0u; mine = 0u;
#pragma unroll
        for (unsigned j = 0; j < 16; ++j) { const unsigned c = xb_ld(&bar[XB_XCNT(j)]); sum += c; cnt += (c > 0u) ? 1u : 0u; mine = (j == x) ? c : mine; }
        if (sum == G) break;
        __builtin_amdgcn_s_sleep(1);
        if ((++sp & 255u) == 0u) { if (xb_ld(&bar[XB_TMO])) break; if (sp > XB_SPIN_CAP) { atomicAdd(&bar[XB_TMO], 1u); break; } }
    }
    nloc = mine > 0u ? mine : 1u; nx = cnt > 0u ? cnt : 1u;
}

__device__ __forceinline__ void xcd_barrier(const XcdBarrier& b) {
    asm volatile("s_waitcnt vmcnt(0)" ::: "memory");
    __syncthreads();
    if (threadIdx.x == 0) {
        unsigned* bar = b.bar;
        __builtin_amdgcn_s_waitcnt(0);
        unsigned nloc = b.st[0], nx = b.st[1];
        if (nloc == 0u) { xcd_barrier_complete(bar, b.x, nloc, nx); b.st[0] = nloc; b.st[1] = nx; }
        const unsigned old = xb_add(&bar[XB_XSUB(b.x)], 1u);
        const unsigned gen = old / nloc;
        if (old + 1u == (gen + 1u) * nloc) {
            __builtin_amdgcn_fence(__ATOMIC_RELEASE, "agent");
            asm volatile("s_waitcnt vmcnt(0)" ::: "memory");
            const unsigned og = xb_add(&bar[XB_TOP], 1u);
            const unsigned tg = og / nx;
            if (og + 1u == (tg + 1u) * nx) xb_add(&bar[XB_TOPGEN], 1u);
            else XB_SPIN(xb_ld(&bar[XB_TOPGEN]) == tg, bar);
            __builtin_amdgcn_fence(__ATOMIC_ACQUIRE, "agent");
            xb_add(&bar[XB_XGEN(b.x)], 1u);
            asm volatile("s_waitcnt vmcnt(0)" ::: "memory");
        } else {
            XB_SPIN(xb_ld(&bar[XB_XGEN(b.x)]) == gen, bar);
            __builtin_amdgcn_fence(__ATOMIC_ACQUIRE, "agent");
            asm volatile("s_waitcnt vmcnt(0)" ::: "memory");
        }
    }
    __syncthreads();
}

__device__ __forceinline__ void p0_transpose_item(const float* W, int K, int N, bf16* WT, int ldk, int koff, LAS float* scr, int item, int lane) {
    const int nblk = N / 32, kb = item / nblk, nb = item % nblk, k0 = 64 * kb, n0 = 32 * nb;
#pragma unroll 8
    for (int i = 0; i < 32; ++i) { const int kk = 2 * i + (lane >> 5); scr[kk * 33 + (lane & 31)] = W[(size_t)(k0 + kk) * N + n0 + (lane & 31)]; }
    LDS_WAIT(); asm volatile("" ::: "memory");
    const int c = lane & 7;
#pragma unroll
    for (int j = 0; j < 4; ++j) { const int n = (lane >> 3) + 8 * j; const LAS float* s = scr + (8 * c) * 33 + n;
        v4u o; o.x = pk2(s[0 * 33], s[1 * 33]); o.y = pk2(s[2 * 33], s[3 * 33]); o.z = pk2(s[4 * 33], s[5 * 33]); o.w = pk2(s[6 * 33], s[7 * 33]);
#ifdef EMU_FP8_G2
        if (N == INW) { float f_[8];
            for (int e_ = 0; e_ < 8; e_ += 2) { int w_ = __builtin_amdgcn_cvt_pk_fp8_f32(s[e_ * 33] * 256.f, s[(e_ + 1) * 33] * 256.f, 0, false); const f32x2 l_ = __builtin_amdgcn_cvt_pk_f32_fp8(w_, false); f_[e_] = l_.x * (1.f / 256.f); f_[e_ + 1] = l_.y * (1.f / 256.f); }
            o.x = pk2(f_[0], f_[1]); o.y = pk2(f_[2], f_[3]); o.z = pk2(f_[4], f_[5]); o.w = pk2(f_[6], f_[7]); }
#endif
        *(GAS v4u*)(WT + (size_t)(n0 + n) * ldk + koff + k0 + 8 * c) = o; }
    LDS_WAIT(); asm volatile("" ::: "memory");
}
__device__ __forceinline__ void p0_mod_item(const float* c, const float* w_ada, const float* b_ada, float* modp, LAS float* red  , int item, int wave, int lane) {
    const int j = item * 64 + lane;
    float a0 = 0.f, a1 = 0.f, a2 = 0.f, a3 = 0.f;
#pragma unroll 8
    for (int k = 128 * wave; k < 128 * wave + 128; ++k) {
        const float w = w_ada[(size_t)k * 6144 + j];
        const float c0 = c[k], c1 = c[1024 + k], c2 = c[2048 + k], c3 = c[3072 + k];
        a0 += c0 / (1.f + __expf(-c0)) * w; a1 += c1 / (1.f + __expf(-c1)) * w; a2 += c2 / (1.f + __expf(-c2)) * w; a3 += c3 / (1.f + __expf(-c3)) * w;
    }
    red[(wave * 4 + 0) * 64 + lane] = a0; red[(wave * 4 + 1) * 64 + lane] = a1; red[(wave * 4 + 2) * 64 + lane] = a2; red[(wave * 4 + 3) * 64 + lane] = a3;
    LDS_WAIT(); __syncthreads();
    if (wave < 4) { float s = b_ada[j];
#pragma unroll
        for (int w = 0; w < 8; ++w) s += red[(w * 4 + wave) * 64 + lane];
        modp[wave * 6144 + j] = s; }
    __syncthreads();
}
__device__ __forceinline__ void p0_weff_item(const float* wq, const float* sk, bf16* weff, int item, int lane) {
    const int nq = item & 3, kb = (item >> 2) & 31, hp = item >> 7;
    const int k = kb * 32 + (lane & 31), dh = lane >> 5;
    float w[64];
    const f32x4* src = (const f32x4*)(wq + (size_t)k * 2048 + hp * 128 + 64 * dh);
#pragma unroll
    for (int i = 0; i < 16; ++i) { const f32x4 v = src[i]; w[4 * i] = v.x; w[4 * i + 1] = v.y; w[4 * i + 2] = v.z; w[4 * i + 3] = v.w; }
#pragma unroll 1
    for (int n = nq * 32; n < nq * 32 + 32; n += 2) {
        float acc[2] = {0.f, 0.f};
#pragma unroll
        for (int u = 0; u < 2; ++u) {
            const f32x4* s = (const f32x4*)(sk + ((size_t)hp * 128 + n + u) * 128 + 64 * dh);
#pragma unroll
            for (int d = 0; d < 16; ++d) { const f32x4 s4 = s[d]; acc[u] += w[4 * d] * s4.x; acc[u] += w[4 * d + 1] * s4.y; acc[u] += w[4 * d + 2] * s4.z; acc[u] += w[4 * d + 3] * s4.w; }
        }
#pragma unroll
        for (int u = 0; u < 2; ++u) { acc[u] += __shfl_xor(acc[u], 32); if (dh == 0) weff[((size_t)hp * 128 + n + u) * 1024 + k] = (bf16)f2bf(acc[u]); }
    }
}
template <int NR, bool BF_IN = false> __device__ __forceinline__ void rms_mod_rows(const void* xrow_, bf16* orow, unsigned* o8row  , const float* g, const float* sc, const float* sh, int lane) {
    f32x4 v[NR][4]; float ss[NR];
    if constexpr (BF_IN) {
        const bf16* xrow = (const bf16*)xrow_; v2u raw[NR][4];
#pragma unroll
        for (int rr = 0; rr < NR; ++rr) { const v2u* xr = (const v2u*)(xrow + (size_t)rr * 1024) + lane; ss[rr] = 0.f;
#pragma unroll
            for (int j = 0; j < 4; ++j) raw[rr][j] = xr[64 * j]; }
#pragma unroll
        for (int rr = 0; rr < NR; ++rr)
#pragma unroll
            for (int j = 0; j < 4; ++j) v[rr][j] = (f32x4){bflo(raw[rr][j].x), bfhi(raw[rr][j].x), bflo(raw[rr][j].y), bfhi(raw[rr][j].y)};
    } else {
        const float* xrow = (const float*)xrow_;
#pragma unroll
        for (int rr = 0; rr < NR; ++rr) { const f32x4* xr = (const f32x4*)(xrow + (size_t)rr * 1024) + lane; ss[rr] = 0.f;
#pragma unroll
            for (int j = 0; j < 4; ++j) v[rr][j] = xr[64 * j]; }
    }
#pragma unroll
    for (int rr = 0; rr < NR; ++rr)
#pragma unroll
        for (int j = 0; j < 4; ++j) ss[rr] += (v[rr][j].x * v[rr][j].x + v[rr][j].y * v[rr][j].y) + (v[rr][j].z * v[rr][j].z + v[rr][j].w * v[rr][j].w);
#pragma unroll
    for (int o = 1; o < 64; o <<= 1) {
#pragma unroll
        for (int rr = 0; rr < NR; ++rr) ss[rr] += __shfl_xor(ss[rr], o);
    }
#pragma unroll
    for (int j = 0; j < 4; ++j) { const int col = 4 * lane + 256 * j;
        const f32x4 g4 = *(const f32x4*)(g + col), s4 = *(const f32x4*)(sc + col), h4 = *(const f32x4*)(sh + col);
#pragma unroll
        for (int rr = 0; rr < NR; ++rr) {
            const float rstd = 1.f / sqrtf(ss[rr] * (1.f / 1024.f) + RMS_EPS);
            const float o0 = v[rr][j].x * rstd * g4.x * (1.f + s4.x) + h4.x, o1 = v[rr][j].y * rstd * g4.y * (1.f + s4.y) + h4.y;
            const float o2 = v[rr][j].z * rstd * g4.z * (1.f + s4.z) + h4.z, o3 = v[rr][j].w * rstd * g4.w * (1.f + s4.w) + h4.w;
            ((unsigned long long*)(orow + (size_t)rr * 1024))[lane + 64 * j] = (unsigned long long)pk2(o0, o1) | ((unsigned long long)pk2(o2, o3) << 32);
            if (o8row) { int w = 0; w = __builtin_amdgcn_cvt_pk_fp8_f32(fminf(fmaxf(o0 * 8.f, -448.f), 448.f), fminf(fmaxf(o1 * 8.f, -448.f), 448.f), w, false);
                w = __builtin_amdgcn_cvt_pk_fp8_f32(fminf(fmaxf(o2 * 8.f, -448.f), 448.f), fminf(fmaxf(o3 * 8.f, -448.f), 448.f), w, true); (o8row + (size_t)rr * 256)[lane + 64 * j] = (unsigned)w; }
        }
    }
}

__device__ __forceinline__ v4u pack8(const f32x4 a, const f32x4 b) { v4u w; w.x = pk2(a.x, a.y); w.y = pk2(a.z, a.w); w.z = pk2(b.x, b.y); w.w = pk2(b.z, b.w); return w; }
__device__ __forceinline__ size_t gt_off(int pm, int pt, int frag, int wave, int lane) { return ((((size_t)(pm * 8 + pt) * 16 + frag) * 8 + wave) * 64 + lane) * 8; }
struct EpiIn {
    static constexpr bool PERM = true, AFTER_DRAIN = false, HAS_MID = false;
    bf16 *Q, *K, *VT, *ZRKV, *ZLORA, *GT;
    __device__ __forceinline__ void operator()(const f32x4 (&acc)[2][2][4][2], const pg8::Unit& u, int wr, int wc, int fr, int fq) const {
        const int pn = u.pn;
#pragma unroll
        for (int ai = 0; ai < 2; ++ai)
#pragma unroll
            for (int m = 0; m < 4; ++m) {
                const int row = u.pm * 256 + ai * 128 + wr * 64 + m * 16 + fr;
                const int b = row >> 13, s = row & 8191;
#pragma unroll
                for (int bj = 0; bj < 2; ++bj) {
                    const int colt = bj * 128 + wc * 32 + 8 * fq;
                    const f32x4 v0 = acc[ai][bj][m][0], v1 = acc[ai][bj][m][1];
                    if (pn < 4) {
                        bf16* base = pn < 2 ? Q : K; const int h = 4 * (pn & 1) + (colt >> 6), d0 = colt & 63;
                        *(v4u*)(base + ((size_t)((b * 8 + h) * 8192 + s)) * 64 + d0) = pack8(v0, v1);
                    } else if (pn < 6) {
                        const int h = 4 * (pn - 4) + (colt >> 6), dv0 = colt & 63;
                        bf16* p = VT + ((size_t)((b * 8 + h) * 64 + dv0)) * 8192 + s;
                        p[0 * 8192] = (bf16)f2bf(v0.x); p[1 * 8192] = (bf16)f2bf(v0.y); p[2 * 8192] = (bf16)f2bf(v0.z); p[3 * 8192] = (bf16)f2bf(v0.w);
                        p[4 * 8192] = (bf16)f2bf(v1.x); p[5 * 8192] = (bf16)f2bf(v1.y); p[6 * 8192] = (bf16)f2bf(v1.z); p[7 * 8192] = (bf16)f2bf(v1.w);
                    } else if (pn < 12) {
                        *(v4u*)(ZRKV + (size_t)row * ZR + 256 * (pn - 6) + colt) = pack8(v0, v1);
                    } else if (pn == 12) {
                        *(v4u*)(ZLORA + (size_t)row * ZL + colt) = pack8(v0, v1);
                    } else {
                        f32x4 s0, s1;
                        s0.x = sigmoidf_(v0.x); s0.y = sigmoidf_(v0.y); s0.z = sigmoidf_(v0.z); s0.w = sigmoidf_(v0.w);
                        s1.x = sigmoidf_(v1.x); s1.y = sigmoidf_(v1.y); s1.z = sigmoidf_(v1.z); s1.w = sigmoidf_(v1.w);
                        *(v4u*)(GT + gt_off(u.pm, pn - 13, 0, wr * 4 + wc, fq * 16 + fr) + (size_t)(((ai * 4 + m) * 2 + bj) * 4096)) = pack8(s0, s1);
                    }
                }
            }
    }
};
struct EpiLora {
    static constexpr bool PERM = true, AFTER_DRAIN = false, HAS_MID = false;
    bf16 *EW, *AA, *GG; const float *w0, *a0;
    __device__ __forceinline__ void operator()(const f32x4 (&acc)[2][2][4][2], const pg8::Unit& u, int wr, int wc, int fr, int fq) const {
        const int pn = u.pn;
#pragma unroll
        for (int ai = 0; ai < 2; ++ai)
#pragma unroll
            for (int m = 0; m < 4; ++m) {
                const int row = u.pm * 256 + ai * 128 + wr * 64 + m * 16 + fr;
#pragma unroll
                for (int bj = 0; bj < 2; ++bj) {
                    const int c = 256 * (pn & 1) + bj * 128 + wc * 32 + 8 * fq;
                    const f32x4 v0 = acc[ai][bj][m][0], v1 = acc[ai][bj][m][1];
                    float v[8] = {v0.x, v0.y, v0.z, v0.w, v1.x, v1.y, v1.z, v1.w};
                    bf16* dst;
                    if (pn < 2) {
#pragma unroll
                        for (int i = 0; i < 8; ++i) v[i] = 0.60653065971263342f * sigmoidf_(w0[c + i] + v[i]);
                        dst = EW;
                    } else if (pn < 4) {
#pragma unroll
                        for (int i = 0; i < 8; ++i) v[i] = sigmoidf_(a0[c + i] + v[i]);
                        dst = AA;
                    } else dst = GG;
                    v4u w; w.x = pk2(v[0], v[1]); w.y = pk2(v[2], v[3]); w.z = pk2(v[4], v[5]); w.w = pk2(v[6], v[7]);
                    *(v4u*)(dst + (size_t)row * 512 + c) = w;
                }
            }
    }
};
struct EpiMix {
    static constexpr bool PERM = true, AFTER_DRAIN = false, HAS_MID = true; static constexpr int MID_T = 8;
    const bf16* GT; bf16* MIXED; int probe;
    __device__ __forceinline__ void mid(f32x4 (&acc)[2][2][4][2], const pg8::Unit& u, int wr, int wc, int fr, int fq) const {
        if (probe & 1) return;
        const bf16* pm_ = GT + gt_off(u.pm, u.pn, 0, wr * 4 + wc, fq * 16 + fr); const bf16* pr_ = GT + gt_off(u.pm, u.pn + 4, 0, wr * 4 + wc, fq * 16 + fr);
#pragma unroll
        for (int ai = 0; ai < 2; ++ai)
#pragma unroll
            for (int m = 0; m < 4; ++m)
#pragma unroll
                for (int bj = 0; bj < 2; ++bj) {
                    const v4u gm = *(const v4u*)pm_, gr = *(const v4u*)pr_;
                    pm_ += 4096; pr_ += 4096; asm volatile("" : "+v"(pm_), "+v"(pr_));
                    f32x4 r0, r1;
                    r0.x = bflo(gm.x) * __builtin_amdgcn_rcpf(fmaxf(bflo(gr.x), 1e-30f)); r0.y = bfhi(gm.x) * __builtin_amdgcn_rcpf(fmaxf(bfhi(gr.x), 1e-30f));
                    r0.z = bflo(gm.y) * __builtin_amdgcn_rcpf(fmaxf(bflo(gr.y), 1e-30f)); r0.w = bfhi(gm.y) * __builtin_amdgcn_rcpf(fmaxf(bfhi(gr.y), 1e-30f));
                    r1.x = bflo(gm.z) * __builtin_amdgcn_rcpf(fmaxf(bflo(gr.z), 1e-30f)); r1.y = bfhi(gm.z) * __builtin_amdgcn_rcpf(fmaxf(bfhi(gr.z), 1e-30f));
                    r1.z = bflo(gm.w) * __builtin_amdgcn_rcpf(fmaxf(bflo(gr.w), 1e-30f)); r1.w = bfhi(gm.w) * __builtin_amdgcn_rcpf(fmaxf(bfhi(gr.w), 1e-30f));
                    acc[ai][bj][m][0] = acc[ai][bj][m][0] * r0; acc[ai][bj][m][1] = acc[ai][bj][m][1] * r1;
                }
    }
    __device__ __forceinline__ void operator()(const f32x4 (&acc)[2][2][4][2], const pg8::Unit& u, int wr, int wc, int fr, int fq) const {
        const bf16* pr_ = GT + gt_off(u.pm, u.pn + 4, 0, wr * 4 + wc, fq * 16 + fr);
#pragma unroll
        for (int ai = 0; ai < 2; ++ai)
#pragma unroll
            for (int m = 0; m < 4; ++m) {
                const int row = u.pm * 256 + ai * 128 + wr * 64 + m * 16 + fr;
#pragma unroll
                for (int bj = 0; bj < 2; ++bj) {
                    const int c = u.pn * 256 + bj * 128 + wc * 32 + 8 * fq;
                    v4u g = {0x3f803f80u, 0x3f803f80u, 0x3f803f80u, 0x3f803f80u};
                    if (!(probe & 2)) g = *(const v4u*)pr_;
                    pr_ += 4096; asm volatile("" : "+v"(pr_));
                    const f32x4 v0 = acc[ai][bj][m][0], v1 = acc[ai][bj][m][1];
                    f32x4 o0, o1;
                    o0.x = bflo(g.x) * v0.x; o0.y = bfhi(g.x) * v0.y; o0.z = bflo(g.y) * v0.z; o0.w = bfhi(g.y) * v0.w;
                    o1.x = bflo(g.z) * v1.x; o1.y = bfhi(g.z) * v1.y; o1.z = bflo(g.w) * v1.z; o1.w = bfhi(g.w) * v1.w;
                    *(v4u*)(MIXED + (size_t)row * 1024 + c) = pack8(o0, o1);
                }
            }
    }
};
struct EpiOut {
    static constexpr bool PERM = true, AFTER_DRAIN = false, HAS_MID = false;
    const float* X; const float* MOD; bf16* OUT;
    __device__ __forceinline__ void operator()(const f32x4 (&acc)[2][2][4][2], const pg8::Unit& u, int wr, int wc, int fr, int fq) const {
#pragma unroll
        for (int ai = 0; ai < 2; ++ai)
#pragma unroll
            for (int m = 0; m < 4; ++m) {
                const int row = u.pm * 256 + ai * 128 + wr * 64 + m * 16 + fr;
                const float* gt1 = MOD + (size_t)(row >> 13) * 6144 + 2048;
#pragma unroll
                for (int bj = 0; bj < 2; ++bj) {
                    const int c = u.pn * 256 + bj * 128 + wc * 32 + 8 * fq;
                    const float* xp = X + (size_t)row * 1024 + c;
                    const f32x4 x0 = *(const f32x4*)xp, x1 = *(const f32x4*)(xp + 4);
                    const f32x4 g0 = *(const f32x4*)(gt1 + c), g1 = *(const f32x4*)(gt1 + c + 4);
                    const f32x4 v0 = acc[ai][bj][m][0], v1 = acc[ai][bj][m][1];
                    *(v4u*)(OUT + (size_t)row * 1024 + c) = pack8(x0 + g0 * v0, x1 + g1 * v1);
                }
            }
    }
};
struct EpiScores {
    static constexpr bool PERM = true, AFTER_DRAIN = false, HAS_MID = false;
    bf16* SC;
    __device__ __forceinline__ void operator()(const f32x4 (&acc)[2][2][4][2], const pg8::Unit& u, int wr, int wc, int fr, int fq) const {
#pragma unroll
        for (int ai = 0; ai < 2; ++ai)
#pragma unroll
            for (int m = 0; m < 4; ++m) {
                const int row = u.pm * 256 + ai * 128 + wr * 64 + m * 16 + fr;
#pragma unroll
                for (int bj = 0; bj < 2; ++bj) {
                    const int c = u.pn * 256 + bj * 128 + wc * 32 + 8 * fq;
                    *(v4u*)(SC + (size_t)row * 2048 + c) = pack8(acc[ai][bj][m][0], acc[ai][bj][m][1]);
                }
            }
    }
};


__device__ __forceinline__ void p2_qk_load(v4u (&raw)[4], int (&ps)[4], const bf16* buf, const int* pos, int bh, int n, int wave, int lane) {
#pragma unroll
    for (int it = 0; it < 4; ++it) { const int row = n * 256 + wave * 32 + it * 8 + (lane >> 3);
        raw[it] = *(const v4u*)(buf + ((size_t)(bh * 8192 + row)) * 64 + 8 * (lane & 7)); ps[it] = pos[(bh >> 3) * 8192 + row]; }
}
__device__ __forceinline__ void p2_qk_item(const v4u (&rawin)[4], const int (&psin)[4], bf16* obuf, const float* g, float* kmean, int bh, int n, LAS float* red, int tid, int wave, int lane) {
    const int c = lane & 7, rsub = lane >> 3;
    float gg[8], ks[8];
#pragma unroll
    for (int i = 0; i < 8; ++i) { gg[i] = g[8 * c + i]; ks[i] = 0.f; }
#pragma unroll
    for (int it = 0; it < 4; ++it) {
        const int row = n * 256 + wave * 32 + it * 8 + rsub;
        const size_t po = ((size_t)(bh * 8192 + row)) * 64 + 8 * c;
        const v4u raw = rawin[it];
        float x[8] = {bflo(raw.x), bfhi(raw.x), bflo(raw.y), bfhi(raw.y), bflo(raw.z), bfhi(raw.z), bflo(raw.w), bfhi(raw.w)};
        float ss = 0.f;
#pragma unroll
        for (int i = 0; i < 8; ++i) ss += x[i] * x[i];
        ss += __shfl_xor(ss, 1); ss += __shfl_xor(ss, 2); ss += __shfl_xor(ss, 4);
        const float rstd = 1.f / sqrtf(ss * (1.f / 64.f) + RMS_EPS);
        float y[8], py[8];
#pragma unroll
        for (int i = 0; i < 8; ++i) y[i] = x[i] * rstd * gg[i];
#pragma unroll
        for (int i = 0; i < 8; ++i) py[i] = __shfl_xor(y[i], 1);
        {
            const float myang = (float)psin[it] * exp2f(-(float)c * (18.931568569324174f / 8.f));
            const float mys = __sinf(myang), myc = __cosf(myang);
            float sn[8], cs[8];
#pragma unroll
            for (int i = 0; i < 8; ++i) { sn[i] = __shfl(mys, (lane & ~7) + i); cs[i] = __shfl(myc, (lane & ~7) + i); }
            if (c < 2) {
#pragma unroll
                for (int i = 0; i < 8; ++i) y[i] = (c == 0) ? (y[i] * cs[i] - py[i] * sn[i]) : (y[i] * cs[i] + py[i] * sn[i]);
            }
        }
        v4u o; o.x = pk2(y[0], y[1]); o.y = pk2(y[2], y[3]); o.z = pk2(y[4], y[5]); o.w = pk2(y[6], y[7]);
        *(v4u*)(obuf + po) = o;
#pragma unroll
        for (int i = 0; i < 8; ++i) ks[i] += y[i];
    }
    if (kmean) {
#pragma unroll
        for (int i = 0; i < 8; ++i) { ks[i] += __shfl_xor(ks[i], 8); ks[i] += __shfl_xor(ks[i], 16); ks[i] += __shfl_xor(ks[i], 32); }
        if (lane < 8) {
#pragma unroll
            for (int i = 0; i < 8; ++i) red[wave * 64 + 8 * lane + i] = ks[i];
        }
        __syncthreads();
        if (tid < 64) { float s = 0.f;
#pragma unroll
            for (int w = 0; w < 8; ++w) s += red[w * 64 + tid];
            kmean[(size_t)(bh * 32 + n) * 64 + tid] = s * (1.f / 256.f); }
        __syncthreads();
    }
}
__device__ __forceinline__ void p2_prep(const bf16* ZL_, const float* mu, bf16* AL, int gtid, int ntot) {
#pragma unroll 2
    for (int idx = gtid; idx < T * 32; idx += ntot) {
        const int t = idx >> 5, col = (idx & 31) * 8, s = t & 8191;
        const v4u cur = *(const v4u*)(ZL_ + (size_t)t * ZL + col);
        v4u prv = *(const v4u*)(ZL_ + (size_t)(s ? t - 1 : t) * ZL + col);
        prv = prv & (s ? 0xffffffffu : 0u);
        const float cz[8] = {bflo(cur.x), bfhi(cur.x), bflo(cur.y), bfhi(cur.y), bflo(cur.z), bfhi(cur.z), bflo(cur.w), bfhi(cur.w)};
        const float pz[8] = {bflo(prv.x), bfhi(prv.x), bflo(prv.y), bfhi(prv.y), bflo(prv.z), bfhi(prv.z), bflo(prv.w), bfhi(prv.w)};
        float o[8];
#pragma unroll
        for (int i = 0; i < 8; ++i) { const float z = cz[i] + (pz[i] - cz[i]) * mu[1536 + col + i];
            o[i] = (col < 64) ? tanhf(z) : ((col < 128) ? z : sigmoidf_(z)); }
        v4u w; w.x = pk2(o[0], o[1]); w.y = pk2(o[2], o[3]); w.z = pk2(o[4], o[5]); w.w = pk2(o[6], o[7]);
        *(v4u*)(AL + (size_t)t * ZL + col) = w;
    }
}

__device__ __forceinline__ void p3_top3_item(const bf16* Q, const float* kmean, unsigned* cursor, unsigned* lists, int bh0, int qb, LAS float* kmbase, int tid, int wave, int lane) {
    if (qb == 0) return;
    const int hf = wave >> 2, bh = bh0 + hf, w4 = wave & 3;
    LAS float* km = kmbase + hf * 2048;
    for (int i = (tid & 255); i < qb * 64; i += 256) km[i] = kmean[(size_t)bh * 2048 + i];
    __syncthreads();
    {
        const int s = qb * 256 + w4 * 64 + lane;
        float q[64];
        const v4u* qp = (const v4u*)(Q + ((size_t)(bh * 8192 + s)) * 64);
#pragma unroll
        for (int i = 0; i < 8; ++i) { const v4u r = qp[i];
            q[8 * i] = bflo(r.x); q[8 * i + 1] = bfhi(r.x); q[8 * i + 2] = bflo(r.y); q[8 * i + 3] = bfhi(r.y);
            q[8 * i + 4] = bflo(r.z); q[8 * i + 5] = bfhi(r.z); q[8 * i + 6] = bflo(r.w); q[8 * i + 7] = bfhi(r.w); }
        float v0 = -INFINITY, v1 = -INFINITY, v2 = -INFINITY; int i0 = -1, i1 = -1, i2 = -1;
        for (int n = 0; n < qb; ++n) {
            float dot = 0.f;
#pragma unroll
            for (int d4 = 0; d4 < 16; ++d4) { const f32x4 kk = *(const LAS f32x4*)(km + n * 64 + 4 * d4);
                dot += q[4 * d4] * kk.x; dot += q[4 * d4 + 1] * kk.y; dot += q[4 * d4 + 2] * kk.z; dot += q[4 * d4 + 3] * kk.w; }
            if (dot > v0) { v2 = v1; i2 = i1; v1 = v0; i1 = i0; v0 = dot; i0 = n; }
            else if (dot > v1) { v2 = v1; i2 = i1; v1 = dot; i1 = n; }
            else if (dot > v2) { v2 = dot; i2 = n; }
        }
        for (int n = 0; n < qb; ++n) {
            const int slot = (i0 == n) ? 0 : ((i1 == n) ? 1 : ((i2 == n) ? 2 : -1));
            const unsigned long long mask = __ballot(slot >= 0);
            if (mask == 0ull) continue;
            const unsigned cnt = (unsigned)__popcll(mask);
            unsigned base = 0u;
            if (lane == 0) base = __hip_atomic_fetch_add(cursor + bh * 32 + n, cnt, RLX_AGENT);
            base = (unsigned)__shfl((int)base, 0);
            if (slot >= 0) { const unsigned pos = base + (unsigned)__popcll(mask & ((1ull << lane) - 1ull));
                lists[(size_t)bh * LIST_PER_BH + list_off(n) + pos] = ((unsigned)s << 2) | (unsigned)slot; }
        }
    }
    __syncthreads();
}

template <int CTRL> __device__ __forceinline__ float dppf(float v) { return __builtin_bit_cast(float, __builtin_amdgcn_update_dpp(0, __builtin_bit_cast(int, v), CTRL, 0xF, 0xF, true)); }
__device__ __forceinline__ float allreduce16(float v) {
    v += dppf<0xB1>(v); v += dppf<0x4E>(v); v += dppf<0x141>(v); v += dppf<0x140>(v); return v;
}
constexpr int CK = 64, NCHK = SEQ / CK, CS = 72, SLOT = CK * CS;
__device__ __forceinline__ int sx(int row, int col) { return row * CS + (((col >> 3) ^ ((row >> 4) & 3)) << 3) + (col & 7); }
struct ScanRaw { v4u zr, zk, zv, pr, pk, pv, a, ew; };
__device__ __forceinline__ void scan_load(ScanRaw& R, const bf16* Z, const bf16* AA, const bf16* EW, int b, int hc0, int t) {
    const bf16* p = Z + (size_t)(b * 8192 + t) * ZR + hc0;
    const bf16* pp = (t > 0) ? p - ZR : p;
    R.zr = *(const v4u*)p; R.zk = *(const v4u*)(p + 512); R.zv = *(const v4u*)(p + 1024);
    R.pr = *(const v4u*)pp; R.pk = *(const v4u*)(pp + 512); R.pv = *(const v4u*)(pp + 1024);
    const unsigned m = (t > 0) ? 0xffffffffu : 0u;
    R.pr = R.pr & m; R.pk = R.pk & m; R.pv = R.pv & m;
    const size_t o = (size_t)(b * 8192 + t) * 512 + hc0;
    R.a = *(const v4u*)(AA + o); R.ew = *(const v4u*)(EW + o);
}
__device__ __forceinline__ void unpack8(const v4u w, float (&f)[8]) { f[0] = bflo(w.x); f[1] = bfhi(w.x); f[2] = bflo(w.y); f[3] = bfhi(w.y); f[4] = bflo(w.z); f[5] = bfhi(w.z); f[6] = bflo(w.w); f[7] = bfhi(w.w); }
__device__ __forceinline__ v4u pack8f(const float (&f)[8]) { v4u w; w.x = cvtpk(f[0], f[1]); w.y = cvtpk(f[2], f[3]); w.z = cvtpk(f[4], f[5]); w.w = cvtpk(f[6], f[7]); return w; }
__device__ __forceinline__ f32x4 mm_tile(const LAS bf16* A, const LAS bf16* BT, int mt, int nt, int r, int q, f32x4 acc) {
#pragma unroll
    for (int ks = 0; ks < 2; ++ks) {
        const bf16x8 a = *(const LAS bf16x8*)(A + sx(16 * mt + r, 32 * ks + 8 * q));
        const bf16x8 b = *(const LAS bf16x8*)(BT + sx(16 * nt + r, 32 * ks + 8 * q));
        acc = __builtin_amdgcn_mfma_f32_16x16x32_bf16(a, b, acc, 0, 0, 0);
    }
    return acc;
}
struct PairF { bf16x8 b0, b1, a00, a01, a10, a11; };
__device__ __forceinline__ void mm_load(PairF& f, const LAS bf16* A, const LAS bf16* BT, int mt, int nt, int r, int q) {
    f.b0 = *(const LAS bf16x8*)(BT + sx(16 * nt + r, 8 * q)); f.b1 = *(const LAS bf16x8*)(BT + sx(16 * nt + r, 32 + 8 * q));
    f.a00 = *(const LAS bf16x8*)(A + sx(16 * mt + r, 8 * q)); f.a01 = *(const LAS bf16x8*)(A + sx(16 * mt + r, 32 + 8 * q));
    f.a10 = *(const LAS bf16x8*)(A + sx(16 * mt + 32 + r, 8 * q)); f.a11 = *(const LAS bf16x8*)(A + sx(16 * mt + 32 + r, 32 + 8 * q));
}
__device__ __forceinline__ void mm_mul(const PairF& f, f32x4& c0, f32x4& c1) {
    c0 = __builtin_amdgcn_mfma_f32_16x16x32_bf16(f.a00, f.b0, c0, 0, 0, 0); c1 = __builtin_amdgcn_mfma_f32_16x16x32_bf16(f.a10, f.b0, c1, 0, 0, 0);
    c0 = __builtin_amdgcn_mfma_f32_16x16x32_bf16(f.a01, f.b1, c0, 0, 0, 0); c1 = __builtin_amdgcn_mfma_f32_16x16x32_bf16(f.a11, f.b1, c1, 0, 0, 0);
}
__device__ __forceinline__ void mm_pair(const LAS bf16* A, const LAS bf16* BT, int mt, int nt, int r, int q, f32x4& c0, f32x4& c1) { PairF f; mm_load(f, A, BT, mt, nt, r, q); mm_mul(f, c0, c1); }
__device__ __forceinline__ void st_T(LAS bf16* D, int mt, int nt, int r, int q, const f32x4 v) {
    v2u w; w.x = cvtpk(v.x, v.y); w.y = cvtpk(v.z, v.w);
    *(LAS v2u*)(D + sx(16 * nt + r, 16 * mt + 4 * q)) = w;
}
__device__ __forceinline__ void st_Tg(bf16* D  , int mt, int nt, int r, int q, const f32x4 v) {
    v2u w; w.x = cvtpk(v.x, v.y); w.y = cvtpk(v.z, v.w);
    *(v2u*)(D + (16 * nt + r) * 64 + 16 * mt + 4 * q) = w;
}
__device__ __forceinline__ f32x4 mask_lt(f32x4 v, int R0, int Cc, bool incl) {
    const int lim = incl ? Cc + 1 : Cc;
    v.x = (R0 < lim) ? v.x : 0.f; v.y = (R0 + 1 < lim) ? v.y : 0.f; v.z = (R0 + 2 < lim) ? v.z : 0.f; v.w = (R0 + 3 < lim) ? v.w : 0.f; return v;
}
__device__ __forceinline__ void rwkv_cp_item(const bf16* Z, const bf16* AAg, const bf16* EWg, const float* mu, const float* k_k, const float* k_a, const float* r_k, bf16* VVB, float* BONUS,
                                             bf16* RW, bf16* MM, bf16* Y0T, bf16* GAT, float* PC, int chain, int c, ScanRaw& R, int nchain, int nc, LAS unsigned char* lds, int tid, int wave, int lane, int probe) {
    LAS bf16* S_ = (LAS bf16*)lds;
#define SL(k) (S_ + (k) * SLOT)
    LAS float* Ef = (LAS float*)(SL(12));
    LAS float* Red = (LAS float*)(SL(8));
    LAS float* Seg = Red + 8 * 64;
    constexpr int EFS = 68;
    const int b = chain >> 3, h = chain & 7;
    const int r = lane & 15, q = lane >> 4;
    __syncthreads();
    const int t = tid >> 3, c0 = (tid & 7) * 8, hc0 = h * 64 + c0;
    float rr[8], k2[8], al[8], be[8], vv[8], kkr[8], aa[8];
    {
        float zr[8], zk[8], zv[8], pr[8], pk[8], pv[8], a[8], ew[8];
        unpack8(R.zr, zr); unpack8(R.zk, zk); unpack8(R.zv, zv); unpack8(R.pr, pr); unpack8(R.pk, pk); unpack8(R.pv, pv); unpack8(R.a, a); unpack8(R.ew, ew);
        scan_load(R, Z, AAg, EWg, nchain >> 3, (nchain & 7) * 64 + c0, nc * CK + t);
        float ss = 0.f;
#pragma unroll
        for (int i = 0; i < 8; ++i) { aa[i] = a[i]; rr[i] = zr[i] + (pr[i] - zr[i]) * mu[hc0 + i]; const float k = zk[i] + (pk[i] - zk[i]) * mu[512 + hc0 + i]; vv[i] = zv[i] + (pv[i] - zv[i]) * mu[1024 + hc0 + i];
            kkr[i] = k * k_k[hc0 + i]; ss += kkr[i] * kkr[i]; k2[i] = k * (1.f + (a[i] - 1.f) * k_a[hc0 + i]); }
        ss += dppf<0xB1>(ss); ss += dppf<0x4E>(ss); ss += dppf<0x141>(ss);
        {
            float bs = 0.f;
#pragma unroll
            for (int i = 0; i < 8; ++i) bs += rr[i] * k2[i] * r_k[hc0 + i];
            bs += dppf<0xB1>(bs); bs += dppf<0x4E>(bs); bs += dppf<0x141>(bs);
            const size_t tok = (size_t)b * SEQ + (size_t)c * CK + t;
            *(v4u*)(VVB + tok * 512 + hc0) = pack8f(vv);
            if ((tid & 7) == 0) BONUS[tok * 8 + h] = bs;
        }
        if ((tid & 7) == 0) Red[t] = ss;
        *(LAS f32x4*)(Ef + t * EFS + c0) = (f32x4){ew[0], ew[1], ew[2], ew[3]}; *(LAS f32x4*)(Ef + t * EFS + c0 + 4) = (f32x4){ew[4], ew[5], ew[6], ew[7]};
    }
    LDS_WAIT(); __syncthreads();
    {
        const int seg = tid >> 6, j = tid & 63; float s = 0.f;
#pragma unroll
        for (int u = 0; u < 8; ++u) { s += Ef[(8 * seg + u) * EFS + j]; Ef[(8 * seg + u) * EFS + j] = s; }
        Seg[seg * 64 + j] = s;
    }
    LDS_WAIT(); __syncthreads();
    {
        { const float ss = Red[t];
          const float inrm = 1.f / fmaxf(sqrtf(ss), 1e-12f);
#pragma unroll
          for (int i = 0; i < 8; ++i) { const float kk = kkr[i] * inrm; al[i] = -kk; be[i] = kk * aa[i]; } }
        float off[8], Et[8], Ep[8];
#pragma unroll
        for (int i = 0; i < 8; ++i) off[i] = 0.f;
        for (int sg = 0; sg < (t >> 3); ++sg) {
            const f32x4 s0 = *(const LAS f32x4*)(Seg + sg * 64 + c0), s1 = *(const LAS f32x4*)(Seg + sg * 64 + c0 + 4);
            off[0] += s0.x; off[1] += s0.y; off[2] += s0.z; off[3] += s0.w; off[4] += s1.x; off[5] += s1.y; off[6] += s1.z; off[7] += s1.w;
        }
        { const f32x4 e0 = *(const LAS f32x4*)(Ef + t * EFS + c0), e1 = *(const LAS f32x4*)(Ef + t * EFS + c0 + 4);
          Et[0] = e0.x + off[0]; Et[1] = e0.y + off[1]; Et[2] = e0.z + off[2]; Et[3] = e0.w + off[3]; Et[4] = e1.x + off[4]; Et[5] = e1.y + off[5]; Et[6] = e1.z + off[6]; Et[7] = e1.w + off[7]; }
        if (t & 7) { const f32x4 e0 = *(const LAS f32x4*)(Ef + (t - 1) * EFS + c0), e1 = *(const LAS f32x4*)(Ef + (t - 1) * EFS + c0 + 4);
          Ep[0] = e0.x + off[0]; Ep[1] = e0.y + off[1]; Ep[2] = e0.z + off[2]; Ep[3] = e0.w + off[3]; Ep[4] = e1.x + off[4]; Ep[5] = e1.y + off[5]; Ep[6] = e1.z + off[6]; Ep[7] = e1.w + off[7]; }
        else {
#pragma unroll
            for (int i = 0; i < 8; ++i) Ep[i] = off[i];
        }
        float at[8], bt[8], kt[8], rt[8];
#pragma unroll
        for (int i = 0; i < 8; ++i) { const float ep = __expf(Et[i]), en = __expf(-Et[i]); at[i] = al[i] * __expf(-Ep[i]); bt[i] = be[i] * ep; kt[i] = k2[i] * ep; rt[i] = rr[i] * en; }
        *(LAS v4u*)(SL(0) + sx(t, c0)) = pack8f(at); *(LAS v4u*)(SL(1) + sx(t, c0)) = pack8f(bt); *(LAS v4u*)(SL(2) + sx(t, c0)) = pack8f(kt); *(LAS v4u*)(SL(3) + sx(t, c0)) = pack8f(rt);
#pragma unroll
        for (int i = 0; i < 8; ++i) { SL(4)[sx(c0 + i, t)] = (bf16)f2bf(at[i]); SL(5)[sx(c0 + i, t)] = (bf16)f2bf(bt[i]); SL(6)[sx(c0 + i, t)] = (bf16)f2bf(kt[i]); SL(7)[sx(c0 + i, t)] = (bf16)f2bf(vv[i]); }
        if (t == CK - 1) { *(f32x4*)(PC + c0) = (f32x4){__expf(-Et[0]), __expf(-Et[1]), __expf(-Et[2]), __expf(-Et[3])}; *(f32x4*)(PC + c0 + 4) = (f32x4){__expf(-Et[4]), __expf(-Et[5]), __expf(-Et[6]), __expf(-Et[7])}; }
    }
    LDS_WAIT(); __syncthreads();
    if (probe == 4) return;
    const f32x4 z4 = {0.f, 0.f, 0.f, 0.f};
    const int mt = wave >> 2, nt = wave & 3, Cc = 16 * nt + r, R0 = 16 * mt + 4 * q, R1 = R0 + 32;
    { PairF f0, f1, f2, f3, f4;
      mm_load(f0, SL(0), SL(1), mt, nt, r, q); mm_load(f1, SL(1), SL(0), mt, nt, r, q); mm_load(f2, SL(2), SL(0), mt, nt, r, q); mm_load(f3, SL(1), SL(3), mt, nt, r, q); mm_load(f4, SL(2), SL(3), mt, nt, r, q);
      f32x4 a0 = z4, a1 = z4, b0 = z4, b1 = z4, c0 = z4, c1 = z4, d0 = z4, d1 = z4, e0 = z4, e1 = z4;
      mm_mul(f0, a0, a1); mm_mul(f1, b0, b1); mm_mul(f2, c0, c1); mm_mul(f3, d0, d1); mm_mul(f4, e0, e1);
      a0.x = (Cc < R0) ? a0.x : 0.f; a0.y = (Cc < R0 + 1) ? a0.y : 0.f; a0.z = (Cc < R0 + 2) ? a0.z : 0.f; a0.w = (Cc < R0 + 3) ? a0.w : 0.f;
      a1.x = (Cc < R1) ? a1.x : 0.f; a1.y = (Cc < R1 + 1) ? a1.y : 0.f; a1.z = (Cc < R1 + 2) ? a1.z : 0.f; a1.w = (Cc < R1 + 3) ? a1.w : 0.f;
      st_T(SL(12), mt, nt, r, q, a0); st_T(SL(12), mt + 2, nt, r, q, a1);
      b0 = mask_lt(b0, R0, Cc, false); b1 = mask_lt(b1, R1, Cc, false);
      st_T(SL(11), mt, nt, r, q, b0); st_T(SL(11), mt + 2, nt, r, q, b1);
      b0.x += (R0 == Cc) ? 1.f : 0.f; b0.y += (R0 + 1 == Cc) ? 1.f : 0.f; b0.z += (R0 + 2 == Cc) ? 1.f : 0.f; b0.w += (R0 + 3 == Cc) ? 1.f : 0.f;
      b1.x += (R1 == Cc) ? 1.f : 0.f; b1.y += (R1 + 1 == Cc) ? 1.f : 0.f; b1.z += (R1 + 2 == Cc) ? 1.f : 0.f; b1.w += (R1 + 3 == Cc) ? 1.f : 0.f;
      st_T(SL(13), mt, nt, r, q, b0); st_T(SL(13), mt + 2, nt, r, q, b1);
      st_T(SL(8), mt, nt, r, q, mask_lt(c0, R0, Cc, false)); st_T(SL(8), mt + 2, nt, r, q, mask_lt(c1, R1, Cc, false));
      st_T(SL(9), mt, nt, r, q, mask_lt(d0, R0, Cc, true)); st_T(SL(9), mt + 2, nt, r, q, mask_lt(d1, R1, Cc, true));
      st_T(SL(10), mt, nt, r, q, mask_lt(e0, R0, Cc, true)); st_T(SL(10), mt + 2, nt, r, q, mask_lt(e1, R1, Cc, true)); }
    LDS_WAIT(); __syncthreads();
    if (probe == 3) return;
    for (int m = (probe == 2 ? 6 : 0); m < 6; ++m) {
        const int ln = (m & 1) ? 0 : 11, ltn = ln + 1, l2 = (m & 1) ? 11 : 0;
        const int tsrc = (m & 1) ? 13 : 2, tdst = (m & 1) ? 2 : 13;
        PairF f0, f1, f2; v2u o0 = {0u, 0u}, o1 = {0u, 0u};
        if (m < 5) { mm_load(f0, SL(ltn), SL(ln), mt, nt, r, q); mm_load(f1, SL(ln), SL(ltn), mt, nt, r, q); }
        if (m >= 1) { mm_load(f2, SL(ltn), SL(tsrc), mt, nt, r, q);
            o0 = *(const LAS v2u*)(SL(tsrc) + sx(16 * nt + r, 16 * mt + 4 * q)); o1 = *(const LAS v2u*)(SL(tsrc) + sx(16 * nt + r, 16 * mt + 32 + 4 * q)); }
        if (m < 5) { f32x4 a0 = z4, a1 = z4, b0 = z4, b1 = z4; mm_mul(f0, a0, a1); mm_mul(f1, b0, b1);
            st_T(SL(l2), mt, nt, r, q, a0); st_T(SL(l2), mt + 2, nt, r, q, a1);
            st_T(SL(l2 + 1), mt, nt, r, q, b0); st_T(SL(l2 + 1), mt + 2, nt, r, q, b1); }
        if (m >= 1) { f32x4 c0 = {bflo(o0.x), bfhi(o0.x), bflo(o0.y), bfhi(o0.y)}, c1 = {bflo(o1.x), bfhi(o1.x), bflo(o1.y), bfhi(o1.y)};
            mm_mul(f2, c0, c1); st_T(SL(tdst), mt, nt, r, q, c0); st_T(SL(tdst), mt + 2, nt, r, q, c1); }
        LDS_WAIT(); __syncthreads();
    }
    { PairF f0, f1; mm_load(f0, SL(2), SL(4), mt, nt, r, q); mm_load(f1, SL(8), SL(7), mt, nt, r, q);
      f32x4 a0 = z4, a1 = z4, b0 = z4, b1 = z4; mm_mul(f0, a0, a1); mm_mul(f1, b0, b1);
      st_T(SL(11), mt, nt, r, q, a0); st_T(SL(11), mt + 2, nt, r, q, a1);
      st_T(SL(12), mt, nt, r, q, b0); st_T(SL(12), mt + 2, nt, r, q, b1); }
    LDS_WAIT(); __syncthreads();
    { PairF f0, f1, f2; mm_load(f0, SL(2), SL(12), mt, nt, r, q); mm_load(f1, SL(11), SL(9), mt, nt, r, q); mm_load(f2, SL(11), SL(5), mt, nt, r, q);
      const v2u o0 = *(const LAS v2u*)(SL(3) + sx(16 * nt + r, 16 * mt + 4 * q)), o1 = *(const LAS v2u*)(SL(3) + sx(16 * nt + r, 16 * mt + 32 + 4 * q));
      f32x4 a0 = z4, a1 = z4, b0 = {bflo(o0.x), bfhi(o0.x), bflo(o0.y), bfhi(o0.y)}, b1 = {bflo(o1.x), bfhi(o1.x), bflo(o1.y), bfhi(o1.y)}, c0 = z4, c1 = z4;
      mm_mul(f0, a0, a1); mm_mul(f1, b0, b1); mm_mul(f2, c0, c1);
      st_T(SL(13), mt, nt, r, q, a0); st_T(SL(13), mt + 2, nt, r, q, a1);
      st_Tg(RW, mt, nt, r, q, b0); st_Tg(RW, mt + 2, nt, r, q, b1);
      st_Tg(MM, mt, nt, r, q, c0); st_Tg(MM, mt + 2, nt, r, q, c1); }
    LDS_WAIT(); __syncthreads();
    { PairF f0, f1, f2, f3; mm_load(f0, SL(9), SL(13), mt, nt, r, q); mm_load(f1, SL(10), SL(7), mt, nt, r, q); mm_load(f2, SL(5), SL(13), mt, nt, r, q); mm_load(f3, SL(6), SL(7), mt, nt, r, q);
      f32x4 a0 = z4, a1 = z4, b0 = z4, b1 = z4; mm_mul(f0, a0, a1); mm_mul(f2, b0, b1); mm_mul(f1, a0, a1); mm_mul(f3, b0, b1);
      st_Tg(Y0T, mt, nt, r, q, a0); st_Tg(Y0T, mt + 2, nt, r, q, a1);
      st_Tg(GAT, mt, nt, r, q, b0); st_Tg(GAT, mt + 2, nt, r, q, b1); }
#undef SL
}
__device__ __forceinline__ void rwkv_seq(const bf16* RW, const bf16* MM, const bf16* Y0T, const bf16* GAT, const float* PC, bf16* Y, int sid, LAS unsigned char* lds, int tid, int wave, int lane) {
    const int chain = sid >> 2, g4 = sid & 3, b = chain >> 3, h = chain & 7;
    const int r = lane & 15, q = lane >> 4, tw = wave & 3;
    LAS bf16* HT = (LAS bf16*)lds;
    for (int i = tid; i < 2 * 16 * CS / 2; i += NTHR) ((LAS unsigned*)HT)[i] = 0u;
    LDS_WAIT(); __syncthreads();
    f32x4 Hreg = {0.f, 0.f, 0.f, 0.f};
    const bool isH = wave < 4;
    const bf16* Abase = isH ? MM : RW;
    const bf16* Ebase = isH ? GAT : Y0T;
    const size_t ci0 = (size_t)chain * NCHK;
    struct SeqOp { bf16x8 a0, a1; v2u ad; f32x4 pc; };
    SeqOp op[4];
#define SEQ_LD(S, C) do { const size_t ci_ = ci0 + (C); const bf16* ap_ = Abase + ci_ * 4096 + (16 * tw + r) * 64 + 8 * q; S.a0 = *(const bf16x8*)ap_; S.a1 = *(const bf16x8*)(ap_ + 32); \
        S.ad = *(const v2u*)(Ebase + ci_ * 4096 + (16 * g4 + r) * 64 + 16 * tw + 4 * q); S.pc = *(const f32x4*)(PC + ci_ * 64 + 16 * tw + 4 * q); } while (0)
#define SEQ_STEP(S, C) do { const LAS bf16* hb = HT + ((C) & 1) * 16 * CS; \
        const bf16x8 b0 = *(const LAS bf16x8*)(hb + r * CS + 8 * q), b1 = *(const LAS bf16x8*)(hb + r * CS + 32 + 8 * q); \
        f32x4 acc = {bflo(S.ad.x), bfhi(S.ad.x), bflo(S.ad.y), bfhi(S.ad.y)}; \
        acc = __builtin_amdgcn_mfma_f32_16x16x32_bf16(S.a0, b0, acc, 0, 0, 0); acc = __builtin_amdgcn_mfma_f32_16x16x32_bf16(S.a1, b1, acc, 0, 0, 0); \
        const f32x4 pcc = S.pc; \
        SEQ_LD(S, ((C) + 4 < NCHK ? (C) + 4 : NCHK - 1));            \
        if (isH) { Hreg = pcc * (Hreg + acc); v2u w; w.x = cvtpk(Hreg.x, Hreg.y); w.y = cvtpk(Hreg.z, Hreg.w); \
            *(LAS v2u*)(HT + (((C) + 1) & 1) * 16 * CS + r * CS + 16 * tw + 4 * q) = w; } \
        else { bf16* yp = Y + ((size_t)(b * 8192 + (C) * CK + 16 * tw + 4 * q)) * OSTR + h * 64 + 16 * g4 + r; \
            yp[0] = (bf16)f2bf(acc.x); yp[OSTR] = (bf16)f2bf(acc.y); yp[2 * OSTR] = (bf16)f2bf(acc.z); yp[3 * OSTR] = (bf16)f2bf(acc.w); } \
        LDS_WAIT(); __syncthreads(); } while (0)
    SEQ_LD(op[0], 0); SEQ_LD(op[1], 1); SEQ_LD(op[2], 2); SEQ_LD(op[3], 3);
#pragma unroll 1
    for (int c = 0; c < NCHK; c += 4) { SEQ_STEP(op[0], c); SEQ_STEP(op[1], c + 1); SEQ_STEP(op[2], c + 2); SEQ_STEP(op[3], c + 3); }
#undef SEQ_LD
#undef SEQ_STEP
}

__device__ __forceinline__ int crow(int r, int hi) { return (r & 3) + 8 * (r >> 2) + 4 * hi; }
constexpr int AT_KT_STRIDE = 72, AT_VL_STRIDE = 260, AT_VL_OFF = 256 * AT_KT_STRIDE * 2, AT_MISC_OFF = AT_VL_OFF + 64 * AT_VL_STRIDE * 2;
struct AttnStage { v4u k[4], v[4]; };
__device__ __forceinline__ void attn_stage_load(AttnStage& S, const bf16* K, const bf16* VT, int bh, int blk, int tid) {
#pragma unroll
    for (int i = 0; i < 4; ++i) { const int idx = tid + NTHR * i, row = idx >> 3, c8 = idx & 7;
        S.k[i] = *(const v4u*)(K + ((size_t)(bh * 8192 + blk * 256 + row)) * 64 + 8 * c8); }
#pragma unroll
    for (int i = 0; i < 4; ++i) { const int idx = tid + NTHR * i, dv = idx >> 5, c = idx & 31;
        S.v[i] = *(const v4u*)(VT + ((size_t)(bh * 64 + dv)) * 8192 + blk * 256 + 8 * c); }
}
__device__ __forceinline__ void attn_stage_store(const AttnStage& S, LAS unsigned char* buf, int tid) {
    LAS bf16* KT = (LAS bf16*)buf; LAS bf16* VL = (LAS bf16*)(buf + AT_VL_OFF);
#pragma unroll
    for (int i = 0; i < 4; ++i) { const int idx = tid + NTHR * i, row = idx >> 3, c8 = idx & 7; *(LAS v4u*)(KT + row * AT_KT_STRIDE + 8 * c8) = S.k[i]; }
#pragma unroll
    for (int i = 0; i < 4; ++i) { const int idx = tid + NTHR * i, dv = idx >> 5, c = idx & 31;
        LAS v2u* d = (LAS v2u*)(VL + dv * AT_VL_STRIDE + 8 * c);
        v2u lo = {S.v[i].x, S.v[i].y}, hi = {S.v[i].z, S.v[i].w}; d[0] = lo; d[1] = hi; }
}
__device__ __forceinline__ void attn_tile(const bf16x8 (&qf)[4], const LAS bf16* KT, const LAS bf16* VL, int kt0, int nkt, int dkt, int ql, int half, float c1, float c2, f32x16 (&O)[2], float& lsum) {
    for (int kt = kt0; kt < nkt; ++kt) {
        f32x16 X;
#pragma unroll
        for (int i = 0; i < 16; ++i) X[i] = 0.f;
#pragma unroll
        for (int ks = 0; ks < 4; ++ks) { const bf16x8 kf = *(const LAS bf16x8*)(KT + (32 * kt + ql) * AT_KT_STRIDE + 16 * ks + 8 * half);
            X = __builtin_amdgcn_mfma_f32_32x32x16_bf16(kf, qf[ks], X, 0, 0, 0); }
        float p[16];
#pragma unroll
        for (int i = 0; i < 16; ++i) p[i] = __builtin_amdgcn_exp2f(X[i] * c1 - c2);
        if (kt == dkt) {
#pragma unroll
            for (int i = 0; i < 16; ++i) if (crow(i, half) > ql) p[i] = 0.f;
        }
#pragma unroll
        for (int i = 0; i < 16; ++i) lsum += p[i];
#pragma unroll
        for (int s = 0; s < 2; ++s) {
            v4u pw; pw.x = cvtpk(p[8 * s], p[8 * s + 1]); pw.y = cvtpk(p[8 * s + 2], p[8 * s + 3]); pw.z = cvtpk(p[8 * s + 4], p[8 * s + 5]); pw.w = cvtpk(p[8 * s + 6], p[8 * s + 7]);
            const bf16x8 pa = __builtin_bit_cast(bf16x8, pw);
#pragma unroll
            for (int nt = 0; nt < 2; ++nt) {
                const LAS bf16* vp = VL + (32 * nt + ql) * AT_VL_STRIDE + 32 * kt + 16 * s + 4 * half;
                const s16x4 lo = *(const LAS s16x4*)vp, hi = *(const LAS s16x4*)(vp + 8);
                const bf16x8 vf = __builtin_shufflevector(lo, hi, 0, 1, 2, 3, 4, 5, 6, 7);
                O[nt] = __builtin_amdgcn_mfma_f32_32x32x16_bf16(pa, vf, O[nt], 0, 0, 0);
            }
        }
    }
}
__device__ __forceinline__ int attn_pop(unsigned* queue, unsigned* cursor, volatile LAS int* misc, int tid, int& count) {
    for (;;) {
        __syncthreads();
        if (tid == 0) misc[0] = (int)__hip_atomic_fetch_add(queue, 1u, RLX_AGENT);
        __syncthreads();
        const int item = misc[0];
        if (item >= 992 + 1024) { count = 0; return -1; }
        if (item >= 992) { count = 256; return item; }
        count = (int)__hip_atomic_load(cursor + (item & 31) * 32 + (item >> 5), RLX_AGENT);
        if (count > 0) return item;
    }
}
__device__ __forceinline__ void attn_phase(const bf16* Q, const bf16* K, const bf16* VT, const unsigned* lists, unsigned* cursor, unsigned* queue,
                                           bf16* OPART, float* LPART, bf16* OWN, const float* gq, const float* gk, LAS unsigned char* lds, int tid, int wave, int lane, int probe) {
    constexpr int AT_BUF = AT_MISC_OFF;
    volatile LAS int* misc = (volatile LAS int*)(lds + 2 * AT_BUF);
    float mq = fabsf(gq[lane]), mk = fabsf(gk[lane]);
#pragma unroll
    for (int o = 1; o < 64; o <<= 1) { mq = fmaxf(mq, __shfl_xor(mq, o)); mk = fmaxf(mk, __shfl_xor(mk, o)); }
    const float c1 = 0.125f * 1.4426950408889634f, c2 = 8.f * mq * mk * 1.4426950408889634f;
    const int ql = lane & 31, half = lane >> 5;
    int count = 0, ncount = 0;
    int item = attn_pop(queue, cursor, misc, tid, count);
    AttnStage St;
    if (item >= 0) { attn_stage_load(St, K, VT, item < 992 ? (item & 31) : ((item - 992) & 31), item < 992 ? (item >> 5) : ((item - 992) >> 5), tid); attn_stage_store(St, lds, tid); }
    LDS_WAIT();
    __syncthreads();
    int pb = 0;
    bool have = false; unsigned ent_c = 0u; bf16x8 q_c[4];
    while (item >= 0) {
        int nitem = -1;
        if (tid == 0) { nitem = (int)__hip_atomic_fetch_add(queue, 1u, RLX_AGENT); ncount = 256;
            if (nitem < 992) ncount = (int)__hip_atomic_load(cursor + (nitem & 31) * 32 + (nitem >> 5), RLX_AGENT);
            if (nitem >= 992 + 1024) { nitem = -1; ncount = 0; } }
        bool published = false;
#define ATTN_PUBLISH() do { __syncthreads(); if (tid == 0) { misc[0] = nitem; misc[1] = ncount; } __syncthreads(); nitem = misc[0]; ncount = misc[1]; published = true; \
            { const int li_ = nitem >= 0 ? nitem : item;                                         \
              attn_stage_load(St, K, VT, li_ < 992 ? (li_ & 31) : ((li_ - 992) & 31), li_ < 992 ? (li_ >> 5) : ((li_ - 992) >> 5), tid); } } while (0)
        const LAS bf16* KT = (const LAS bf16*)(lds + pb * AT_BUF); const LAS bf16* VL = (const LAS bf16*)(lds + pb * AT_BUF + AT_VL_OFF);
        const bool own = item >= 992;
        const int bh = own ? ((item - 992) & 31) : (item & 31), blk = own ? ((item - 992) >> 5) : (item >> 5);
        const unsigned* lp = lists + (size_t)bh * LIST_PER_BH + list_off(own ? 0 : blk);
        for (int c = 0;; ++c) {
            const int e0 = own ? 0 : c * 256 + wave * 32;
            if (!own && e0 >= count) break;
            if (!have) {
                if (own) ent_c = (unsigned)(blk * 256 + wave * 32 + ql) << 2;
                else { const int e = e0 + ql; ent_c = lp[e < count ? e : e0]; }
                const bf16* qp = Q + ((size_t)(bh * 8192 + (int)(ent_c >> 2))) * 64 + 8 * half;
#pragma unroll
                for (int ks = 0; ks < 4; ++ks) q_c[ks] = *(const bf16x8*)(qp + 16 * ks);
            }
            const int sq = (int)(ent_c >> 2), slot = (int)(ent_c & 3u);
            const bool valid = own || (e0 + ql < count);
            f32x16 O[2]; float lsum = 0.f;
#pragma unroll
            for (int i = 0; i < 16; ++i) { O[0][i] = 0.f; O[1][i] = 0.f; }
            const int nkt = own ? wave + 1 : 8, dkt = own ? wave : -1, kth = nkt >> 1;
            const bool more = !own && (c + 1) * 256 + wave * 32 < count;
            unsigned ent_n = ent_c; int nbh = bh; bool nhave = false;
            if (more) { nhave = true; const int e = (c + 1) * 256 + wave * 32 + ql; ent_n = lp[e < count ? e : (c + 1) * 256 + wave * 32]; }
            if (probe != 3 && probe != 4) attn_tile(q_c, KT, VL, 0, kth, dkt, ql, half, c1, c2, O, lsum);
            if (!published) ATTN_PUBLISH();
            if (!more) {
                if (nitem >= 992) { nhave = true; nbh = (nitem - 992) & 31; ent_n = (unsigned)(((nitem - 992) >> 5) * 256 + wave * 32 + ql) << 2; }
                else if (nitem >= 0 && wave * 32 < ncount) { nhave = true; nbh = nitem & 31; const int e = wave * 32 + ql;
                    ent_n = (lists + (size_t)nbh * LIST_PER_BH + list_off(nitem >> 5))[e < ncount ? e : wave * 32]; }
            }
            bf16x8 q_n[4];
            { const bf16* qp = Q + ((size_t)(nbh * 8192 + (int)(ent_n >> 2))) * 64 + 8 * half;
#pragma unroll
                for (int ks = 0; ks < 4; ++ks) q_n[ks] = *(const bf16x8*)(qp + 16 * ks); }
            if (probe != 3 && probe != 4) attn_tile(q_c, KT, VL, kth, nkt, dkt, ql, half, c1, c2, O, lsum);
            const float ltot = lsum + __shfl_xor(lsum, 32);
            if ((probe == 2 || probe == 4) && ltot != 12345.f) { } else
            if (own) {
                const int b = bh >> 3, h = bh & 7;
                if (half == 0) LPART[(size_t)3 * (BH * SEQ) + bh * 8192 + sq] = ltot;
#pragma unroll
                for (int i = 0; i < 16; ++i) {
                    const int s2 = blk * 256 + wave * 32 + crow(i, half);
                    bf16* op = OWN + ((size_t)(b * 8192 + s2)) * OSTR + h * 64 + ql;
                    op[0] = (bf16)f2bf(O[0][i]); op[32] = (bf16)f2bf(O[1][i]);
                }
            } else {
                if (half == 0 && valid) LPART[(size_t)slot * (BH * SEQ) + bh * 8192 + sq] = ltot;
                const int entv = valid ? (int)ent_c : -1;
#pragma unroll
                for (int i = 0; i < 16; ++i) {
                    const int e2 = __shfl(entv, crow(i, half));
                    if (e2 >= 0) { bf16* op = OPART + ((size_t)(e2 & 3) * (BH * SEQ) + bh * 8192 + (e2 >> 2)) * 64 + ql;
                        op[0] = (bf16)f2bf(O[0][i]); op[32] = (bf16)f2bf(O[1][i]); }
                }
            }
            have = nhave; ent_c = ent_n;
#pragma unroll
            for (int ks = 0; ks < 4; ++ks) q_c[ks] = q_n[ks];
            if (own) break;
        }
        if (!published) ATTN_PUBLISH();
#undef ATTN_PUBLISH
        if (nitem >= 0) attn_stage_store(St, lds + (pb ^ 1) * AT_BUF, tid);
        LDS_WAIT();
        __syncthreads();
        item = nitem; count = ncount; pb ^= 1;
    }
}

__device__ __forceinline__ void p5_combine(const bf16* OPART, const float* LPART, const bf16* OM, bf16* OMO, int gtid, int ntot) {
    for (int idx0 = gtid; idx0 < BH * SEQ * 8; idx0 += 2 * ntot) {
        v4u v[2][4]; unsigned lw[2][4]; size_t oo[2]; int nsel[2];
#pragma unroll
        for (int u = 0; u < 2; ++u) {
            const int idx = idx0 + u * ntot < BH * SEQ * 8 ? idx0 + u * ntot : idx0;
            const int qg = idx >> 3, c8 = idx & 7, bh = qg >> 13, s = qg & 8191, b = bh >> 3, h = bh & 7;
            nsel[u] = (s >> 8) < 3 ? (s >> 8) : 3;
            oo[u] = ((size_t)(b * 8192 + s)) * OSTR + h * 64 + 8 * c8;
#pragma unroll
            for (int sl = 0; sl < 3; ++sl) { v[u][sl] = *(const v4u*)(OPART + ((size_t)sl * (BH * SEQ) + qg) * 64 + 8 * c8); lw[u][sl] = *(const unsigned*)(LPART + (size_t)sl * (BH * SEQ) + qg); }
            v[u][3] = *(const v4u*)(OM + oo[u]); lw[u][3] = *(const unsigned*)(LPART + (size_t)3 * (BH * SEQ) + qg);
        }
#pragma unroll
        for (int u = 0; u < 2; ++u) {
            float acc[8] = {0.f, 0.f, 0.f, 0.f, 0.f, 0.f, 0.f, 0.f}; float l = 0.f;
#pragma unroll
            for (int sl = 0; sl < 4; ++sl) {
                const unsigned m = (sl == 3 || sl < nsel[u]) ? 0xffffffffu : 0u;
                const v4u w4 = v[u][sl] & m;
                acc[0] += bflo(w4.x); acc[1] += bfhi(w4.x); acc[2] += bflo(w4.y); acc[3] += bfhi(w4.y); acc[4] += bflo(w4.z); acc[5] += bfhi(w4.z); acc[6] += bflo(w4.w); acc[7] += bfhi(w4.w);
                l += __builtin_bit_cast(float, lw[u][sl] & m);
            }
            const float il = 1.f / l;
            v4u w; w.x = pk2(acc[0] * il, acc[1] * il); w.y = pk2(acc[2] * il, acc[3] * il); w.z = pk2(acc[4] * il, acc[5] * il); w.w = pk2(acc[6] * il, acc[7] * il);
            if (u == 0 || idx0 + ntot < BH * SEQ * 8) *(v4u*)(OMO + oo[u]) = w;
        }
    }
}
__device__ __forceinline__ void unpack4(const v2u w, float (&f)[4]) { f[0] = bflo(w.x); f[1] = bfhi(w.x); f[2] = bflo(w.y); f[3] = bfhi(w.y); }
__device__ __forceinline__ void p5_rwkv_post(const bf16* GG, const bf16* Y, bf16* YO, const bf16* VVB, const float* BONUS, const float* ln_g, const float* ln_b, int gw, int ngw, int lane) {
    const int g = lane >> 4, r = lane & 15;
    constexpr int NB = 8;
    for (int it0 = gw * 4 + g; it0 < T * NH; it0 += ngw * 4 * NB) {
        v2u yw[NB], gw_[NB], vw[NB]; float bon[NB];
#pragma unroll
        for (int u = 0; u < NB; ++u) {
            const int itc = it0 + u * ngw * 4 < T * NH ? it0 + u * ngw * 4 : it0;
            const int t = itc >> 3, h = itc & 7, col = h * 64 + 4 * r;
            yw[u] = *(const v2u*)(Y + (size_t)t * OSTR + col); gw_[u] = *(const v2u*)(GG + (size_t)t * 512 + col); vw[u] = *(const v2u*)(VVB + (size_t)t * 512 + col);
            bon[u] = BONUS[(size_t)t * 8 + h];
        }
#pragma unroll
        for (int u = 0; u < NB; ++u) {
            const int it = it0 + u * ngw * 4;
            const int t = it >> 3, h = it & 7, col = h * 64 + 4 * r;
            float y[4], gg[4], vv[4];
            unpack4(yw[u], y); unpack4(gw_[u], gg); unpack4(vw[u], vv);
            const f32x4 lg = *(const f32x4*)(ln_g + col), lb = *(const f32x4*)(ln_b + col);
            float sum = 0.f;
#pragma unroll
            for (int i = 0; i < 4; ++i) sum += y[i];
            const float mean = allreduce16(sum) * (1.f / 64.f);
            float sq = 0.f;
#pragma unroll
            for (int i = 0; i < 4; ++i) { y[i] -= mean; sq += y[i] * y[i]; }
            const float rstd = 1.f / sqrtf(allreduce16(sq) * (1.f / 64.f) + GN_EPS);
            float o[4];
#pragma unroll
            for (int i = 0; i < 4; ++i) o[i] = (y[i] * rstd * lg[i] + lb[i] + bon[u] * vv[i]) * gg[i];
            v2u w; w.x = pk2(o[0], o[1]); w.y = pk2(o[2], o[3]);
            if (it < T * NH) *(v2u*)(YO + (size_t)t * OSTR + col) = w;
        }
    }
}


__device__ __forceinline__ unsigned f2key(float f) { const unsigned u = __builtin_bit_cast(unsigned, f); return (u & 0x80000000u) ? ~u : (u | 0x80000000u); }
__device__ __forceinline__ float key2f(unsigned k) { const unsigned u = (k & 0x80000000u) ? (k & 0x7fffffffu) : ~k; return __builtin_bit_cast(float, u); }
template <int CTRL> __device__ __forceinline__ unsigned dppu(unsigned v) { return (unsigned)__builtin_amdgcn_update_dpp(0, (int)v, CTRL, 0xF, 0xF, true); }
__device__ __forceinline__ unsigned umax_(unsigned a, unsigned b) { return a > b ? a : b; }
__device__ __forceinline__ unsigned allmax16(unsigned v) { v = umax_(v, dppu<0xB1>(v)); v = umax_(v, dppu<0x4E>(v)); v = umax_(v, dppu<0x141>(v)); v = umax_(v, dppu<0x140>(v)); return v; }
__device__ __forceinline__ float dot2bf(unsigned w, unsigned x, float acc) { return __builtin_amdgcn_fdot2_f32_bf16(__builtin_bit_cast(bf16x2_t, w), __builtin_bit_cast(bf16x2_t, x), acc, false); }
__device__ __forceinline__ unsigned cand_word(int r) {
    const unsigned tab[16] = {0x03020100u, 0x07060504u, 0x0b0a0908u, 0x0f0e0d0cu, 0x13121110u, 0x17161514u, 0x23222120u, 0x32313024u,
                              0x42414033u, 0x61605150u, 0x90807170u, 0xd0c0b0a0u, 0xfffff0e0u, 0xffffffffu, 0xffffffffu, 0xffffffffu};
    unsigned w = 0xffffffffu;
#pragma unroll
    for (int i = 0; i < 13; ++i) w = (r == i) ? tab[i] : w;
    return w;
}
template <int NK> __device__ __forceinline__ unsigned top16_keys(unsigned (&k)[NK], int r) {
    unsigned res = 0u;
    for (int rd = 0; rd < 16; ++rd) {
        unsigned m = k[0];
#pragma unroll
        for (int j = 1; j < NK; ++j) m = umax_(m, k[j]);
        const unsigned gm = allmax16(m);
        res = (r == rd) ? gm : res;
#pragma unroll
        for (int j = 0; j < NK; ++j) k[j] = (k[j] == gm) ? 0u : k[j];
    }
    return res;
}
#define PEER_CE(a, b) do { const unsigned hi_ = umax_(k[a], k[b]), lo_ = (k[a] < k[b]) ? k[a] : k[b]; k[a] = hi_; k[b] = lo_; } while (0)
__device__ __forceinline__ unsigned top16_sorted8(unsigned (&k)[8], int r) {
    PEER_CE(0, 1); PEER_CE(2, 3); PEER_CE(4, 5); PEER_CE(6, 7);
    PEER_CE(0, 2); PEER_CE(1, 3); PEER_CE(4, 6); PEER_CE(5, 7);
    PEER_CE(1, 2); PEER_CE(5, 6);
    PEER_CE(0, 4); PEER_CE(1, 5); PEER_CE(2, 6); PEER_CE(3, 7);
    PEER_CE(2, 4); PEER_CE(3, 5);
    PEER_CE(1, 2); PEER_CE(3, 4); PEER_CE(5, 6);
    unsigned res = 0u;
    for (int rd = 0; rd < 16; ++rd) {
        const unsigned gm = allmax16(k[0]);
        res = (r == rd) ? gm : res;
        const bool pop = k[0] == gm;
#pragma unroll
        for (int j = 0; j < 7; ++j) k[j] = pop ? k[j + 1] : k[j];
        k[7] = pop ? 0u : k[7];
    }
    return res;
}
#undef PEER_CE
#ifdef PROBE_S
typedef int v8i_p __attribute__((ext_vector_type(8)));
__device__ __forceinline__ float mx_probe(int lane) {
    const int q = lane >> 4;
    unsigned aw[4] = {0u, 0u, 0u, 0u};
    if (lane == 16 * PROBE_QA) aw[(PROBE_S) >> 3] = 0x2u << (4 * ((PROBE_S) & 7));
    v8i_p A = {(int)aw[0], (int)aw[1], (int)aw[2], (int)aw[3], 0, 0, 0, 0};
    v8i_p B;
#pragma unroll
    for (int v = 0; v < 8; ++v) {
        float f[4];
#pragma unroll
        for (int b = 0; b < 4; ++b) { const int j = 4 * v + b; f[b] = (PROBE_PAT == 1) ? (float)(q + 1) : ((PROBE_PAT == 2) ? (float)((j & 15) + 1) : (float)((j >> 4) + 1)); }
        int w = 0; w = __builtin_amdgcn_cvt_pk_fp8_f32(f[0], f[1], w, false); w = __builtin_amdgcn_cvt_pk_fp8_f32(f[2], f[3], w, true); B[v] = w;
    }
    f32x4 c = {0.f, 0.f, 0.f, 0.f};
    c = __builtin_amdgcn_mfma_scale_f32_16x16x128_f8f6f4(A, B, c, 4, 0, 0, 0x7f7f7f7f, 0, 0x7f7f7f7f);
    const float r = __shfl(c.x, 0);
    const int code = (int)(r + 0.5f) - 1;
    float off = 0.1f;
    for (int i = 0; i < code && i < 40; ++i) off *= 1.3f;
    if (code < 0) off = 0.05f;
    return off;
}
#endif
typedef int v8i __attribute__((ext_vector_type(8)));
typedef int v4i __attribute__((ext_vector_type(4)));
struct PeerTK { unsigned ids, gates; };
__device__ __forceinline__ void peer_topk1(const LAS unsigned char* sbuf, unsigned (&resA)[4], int r, int lane) {
#pragma unroll
    for (int pass = 0; pass < 4; ++pass) {
        const v4u sw = *(const LAS v4u*)(sbuf + pass * 1024 + 16 * lane);
        const float v[8] = {bflo(sw.x), bfhi(sw.x), bflo(sw.y), bfhi(sw.y), bflo(sw.z), bfhi(sw.z), bflo(sw.w), bfhi(sw.w)};
        unsigned k[8];
#pragma unroll
        for (int j = 0; j < 8; ++j) k[j] = (f2key(v[j]) & ~0x7Fu) | (unsigned)(127 - (r * 8 + j));
        resA[pass] = top16_sorted8(k, r);
    }
}
__device__ __forceinline__ PeerTK peer_topk2(const unsigned (&resA)[4], int r, int g) {
    PeerTK o; unsigned eid_[2]; float egt_[2];
    const unsigned cw = cand_word(r);
#pragma unroll
    for (int cp = 0; cp < 2; ++cp) {
        const int lbase = 32 * (g & 1); const bool hi = (g >> 1) != 0;
        unsigned ck[4];
#pragma unroll
        for (int m = 0; m < 4; ++m) {
            const unsigned byte = (cw >> (8 * m)) & 0xFFu; const int i = (int)(byte >> 4), j = (int)(byte & 15u);
            const unsigned a0 = (unsigned)__shfl((int)resA[2 * cp], lbase + i), a1 = (unsigned)__shfl((int)resA[2 * cp + 1], lbase + i);
            const unsigned b0 = (unsigned)__shfl((int)resA[2 * cp], lbase + 16 + j), b1 = (unsigned)__shfl((int)resA[2 * cp + 1], lbase + 16 + j);
            const unsigned ak = hi ? a1 : a0, bk = hi ? b1 : b0;
            const float val = key2f(ak & ~0x7Fu) + key2f(bk & ~0x7Fu);
            ck[m] = (byte != 0xFFu) ? ((f2key(val) & ~0xFFu) | (255u - byte)) : 0u;
        }
        const unsigned res = top16_keys<4>(ck, r);
        const unsigned flat = 255u - (res & 0xFFu); const int i = (int)(flat >> 4), j = (int)(flat & 15u);
        const float val = key2f(res & ~0xFFu), vmax = key2f(allmax16(res) & ~0xFFu);
        const float e = __expf(val - vmax);
        const float gate = e / allreduce16(e);
        const unsigned a0 = (unsigned)__shfl((int)resA[2 * cp], lbase + i), a1 = (unsigned)__shfl((int)resA[2 * cp + 1], lbase + i);
        const unsigned b0 = (unsigned)__shfl((int)resA[2 * cp], lbase + 16 + j), b1 = (unsigned)__shfl((int)resA[2 * cp + 1], lbase + 16 + j);
        const unsigned ak = hi ? a1 : a0, bk = hi ? b1 : b0;
        eid_[cp] = (127u - (ak & 127u)) * 128u + (127u - (bk & 127u));
        egt_[cp] = gate;
    }
    o.ids = eid_[0] | (eid_[1] << 16); o.gates = pk2(egt_[0], egt_[1]);
    return o;
}
__device__ __forceinline__ void peer_stage_a(const bf16* SC, const unsigned char* XN8, const unsigned char* U8, LAS f32x4* xl, unsigned* PE32, unsigned* W32, int t0, int tstride, int lane) {
    if (t0 >= T) return;
    const int g = lane >> 4, r = lane & 15, i16 = lane & 15, q = lane >> 4;
    LAS float* hl = (LAS float*)xl;
    LAS unsigned char* xb = (LAS unsigned char*)(xl + 64);
    LAS unsigned char* sb = xb + 2048;
#define PA_XDMA(TT, PB) __builtin_amdgcn_global_load_lds((const GAS unsigned*)(XN8 + (size_t)(TT) * 1024 + 16 * lane), (LAS unsigned*)(xb + (PB) * 1024), 16, 0, 0)
#define PA_SDMA(TT, PB) do { _Pragma("unroll") for (int pass = 0; pass < 4; ++pass) \
        __builtin_amdgcn_global_load_lds((const GAS unsigned*)(SC + (size_t)(TT) * 2048 + (pass * 4 + g) * 128 + r * 8), (LAS unsigned*)(sb + (PB) * 4096 + pass * 1024), 16, 0, 0); } while (0)
    unsigned resA[4];
    const int t1_ = t0 + tstride < T ? t0 + tstride : t0;
    PA_SDMA(t0, 0); PA_XDMA(t0, 0);
    asm volatile("s_waitcnt vmcnt(0)" ::: "memory");
    peer_topk1(sb, resA, r, lane);
    PA_SDMA(t1_, 1);
    PeerTK cur = peer_topk2(resA, r, g);
    asm volatile("s_waitcnt vmcnt(0)" ::: "memory");
    int pb = 0;
#pragma unroll 1
    for (int t = t0; t < T; t += tstride, pb ^= 1) {
        LAS unsigned char* x8l = xb + pb * 1024;
        const int tn1 = t + tstride < T ? t + tstride : t, tn2 = tn1 + tstride < T ? tn1 + tstride : tn1;
#define PEER_LD(P, KB) (*(const v4i*)((P) + (KB) * 64))
#define PEER_PTR(GI) (U8 + (size_t)(((unsigned)__shfl((int)cur.ids, 16 * ((GI) & 3) + i16) >> (16 * ((GI) >> 2))) & 0xFFFFu) * 512 + 16 * q)
        v4i ug[2][8];
        asm volatile("" ::: "memory");
        PA_XDMA(tn1, pb ^ 1); PA_SDMA(tn2, pb);
#pragma unroll
        for (int g0 = 0; g0 < 2; ++g0) { const unsigned char* p0 = PEER_PTR(g0);
#pragma unroll
            for (int kb = 0; kb < 8; ++kb) ug[g0][kb] = PEER_LD(p0, kb); }
        __builtin_amdgcn_sched_barrier(0);
        int ll = lane; asm volatile("" : "+v"(ll));
        peer_topk1(sb + (pb ^ 1) * 4096, resA, ll & 15, ll);
        const PeerTK nxt = peer_topk2(resA, ll & 15, ll >> 4);
        __builtin_amdgcn_sched_barrier(0);
#pragma unroll
        for (int gi = 0; gi < 8; ++gi) {
            const unsigned char* pn = PEER_PTR((gi + 2) & 7);
            f32x4 c_ = {0.f, 0.f, 0.f, 0.f};
#pragma unroll
            for (int kb = 0; kb < 8; ++kb) {
                const v8i xb_ = __builtin_shufflevector(*(const LAS v4i*)(x8l + kb * 128 + 16 * q), *(const LAS v4i*)(x8l + kb * 128 + 64 + 16 * q), 0, 1, 2, 3, 4, 5, 6, 7);
                const v8i ua_ = __builtin_shufflevector(ug[gi % 2][kb], (v4i){0, 0, 0, 0}, 0, 1, 2, 3, 4, 5, 6, 7);
                c_ = __builtin_amdgcn_mfma_scale_f32_16x16x128_f8f6f4(ua_, xb_, c_, 4, 0, 0, 0x7f7f7f7f, 0, 0x7f7f7f7f);
                if (gi + 2 < 8) ug[gi % 2][kb] = PEER_LD(pn, kb);
            }
            if (i16 == 0) *(LAS f32x4*)(hl + (gi >> 2) * 64 + 16 * (gi & 3) + 4 * q) = c_;
            __builtin_amdgcn_sched_barrier(0);
        }
#undef PEER_LD
#undef PEER_PTR
        LDS_WAIT(); asm volatile("" ::: "memory");
        float ehs[2];
#pragma unroll
        for (int cp = 0; cp < 2; ++cp) { const float hd = hl[cp * 64 + lane] * (1.f / 512.f); ehs[cp] = 0.5f * hd * (1.f + erff(hd * 0.70710678118654752f)) * (cp ? bfhi(cur.gates) : bflo(cur.gates)) * (1.f / 5.656854249f); }
        float wm = fmaxf(fabsf(ehs[0]), fabsf(ehs[1]));
#pragma unroll
        for (int o = 1; o < 64; o <<= 1) wm = fmaxf(wm, __shfl_xor(wm, o));
        wm = fmaxf(wm, 1e-30f);
        const float ws_ = 224.f * __builtin_amdgcn_rcpf(wm);
        const unsigned pk = (unsigned)__builtin_amdgcn_cvt_pk_fp8_f32(ehs[0] * ws_, ehs[1] * ws_, 0, false);
        const unsigned w16 = pk & 0xFFFFu;
        const unsigned wlo = (unsigned)__shfl((int)w16, (2 * lane) & 63), whi = (unsigned)__shfl((int)w16, (2 * lane + 1) & 63);
        const unsigned wrow = (lane < 32) ? (wlo | (whi << 16)) : ((lane == 32) ? __builtin_bit_cast(unsigned, wm * (1.f / 224.f)) : 0u);
        PE32[(size_t)t * 64 + lane] = cur.ids; W32[(size_t)t * 64 + lane] = wrow;
        cur = nxt;
    }
#undef PA_SDMA
#undef PA_XDMA
}
typedef int v2i __attribute__((ext_vector_type(2)));
struct PeerE { float sc; bf16 h[4]; v4i w0, w1; };
__device__ __forceinline__ void peer_stage_b(const unsigned char* V8s, const float* MOD, const bf16* OUT, float* OUTW, const unsigned* PE16, const unsigned char* W8G,
                                             LAS unsigned char* sb, int S, int half, int w0, int wstride, int lane, const int probe = 0) {
    const int r = lane & 15, q = lane >> 4, l3 = lane >> 3, p7 = lane & 7;
    const unsigned wo0 = (unsigned)(l3 * 128 + ((p7 ^ (l3 >> 1)) << 4)), wo1 = (unsigned)(l3 * 128 + ((p7 ^ (4 + (l3 >> 1))) << 4));
    const unsigned rbase = (unsigned)((32 * q + r) * 128 + ((r >> 1) << 4));
    LAS unsigned* idb = (LAS unsigned*)(sb + 16384);
    const int idsh = 16 * (l3 & 1), idq = l3 >> 1;
    const int NU = T / 2;
    const int nt = (w0 < NU) ? (NU - w0 + wstride - 1) / wstride : 0;
    if (nt == 0) return;
    const int col0 = 256 * S + lane;
    unsigned off[16];
    v4u RA[16], RB[16];
    PeerE EA, EB;
    unsigned idw;
#define PB_TOK(J) (2 * (w0 + ((J) < nt ? (J) : nt - 1) * wstride) + half)
#define PB_IDW(J) do { idw = PE16[(size_t)PB_TOK(J) * 64 + lane]; } while (0)
#define PB_OFF(J) do { idb[lane] = idw; const unsigned okm_ = ((J) < nt && probe != 2) ? 128u : 0u;         \
        _Pragma("unroll") for (int i = 0; i < 16; ++i) { const unsigned e_ = (idb[4 * i + idq] >> idsh) & 0xFFFFu; off[i] = e_ * okm_ + 16u * (unsigned)p7; } } while (0)
#define PB_ISSUE(RX) do { _Pragma("unroll") for (int i = 0; i < 16; ++i) RX[i] = *(const v4u*)(V8s + off[i]); } while (0)
#define PB_WRITE(RX) do { _Pragma("unroll") for (int i = 0; i < 16; ++i) *(LAS v4u*)(sb + ((i & 1) ? wo1 : wo0) + i * 1024) = RX[i]; } while (0)
#define PB_ELOAD(EX, J) do { const int t_ = PB_TOK(J); { const bf16* o_ = OUT + (size_t)t_ * 1024 + col0; _Pragma("unroll") for (int j = 0; j < 4; ++j) EX.h[j] = __builtin_nontemporal_load(o_ + 64 * j); }     \
        EX.w0 = *(const v4i*)(W8G + (size_t)t_ * 256 + 16 * q); EX.w1 = *(const v4i*)(W8G + (size_t)t_ * 256 + 64 + 16 * q); EX.sc = *(const float*)(W8G + (size_t)t_ * 256 + 128); } while (0)
#define PB_ITER(RX, EC, EN, J) do { \
        const int tj_ = PB_TOK(J); const float* g_ = MOD + (size_t)(tj_ >> 13) * 6144 + 5 * 1024 + col0; float gv_[4]; \
        _Pragma("unroll") for (int j = 0; j < 4; ++j) gv_[j] = g_[64 * j];                                 \
        PB_WRITE(RX);                                            \
        __builtin_amdgcn_sched_barrier(0);                       \
        PB_OFF((J) + 2); PB_IDW((J) + 3); PB_ELOAD(EN, (J) + 1); PB_ISSUE(RX);     \
        __builtin_amdgcn_sched_barrier(0); \
        const v8i wa_ = __builtin_shufflevector(EC.w0, EC.w1, 0, 1, 2, 3, 4, 5, 6, 7); \
        float res_[4] = {0.f, 0.f, 0.f, 0.f}; \
        if (probe != 3) _Pragma("unroll") for (int mp = 0; mp < 8; ++mp) { const unsigned ad_ = rbase ^ (unsigned)(mp << 4); \
            _Pragma("unroll") for (int mb = 0; mb < 2; ++mb) { const int m_ = 2 * mp + mb; \
                const v2i b0_ = __builtin_amdgcn_ds_read_tr4_b64_v2i32((LAS v2i*)(sb + ad_ + 8 * mb)), b1_ = __builtin_amdgcn_ds_read_tr4_b64_v2i32((LAS v2i*)(sb + ad_ + 8 * mb + 2048)); \
                const v8i bb_ = {b0_.x, b0_.y, b1_.x, b1_.y, 0, 0, 0, 0}; \
                const f32x4 d_ = __builtin_amdgcn_mfma_scale_f32_16x16x128_f8f6f4(wa_, bb_, (f32x4){0.f, 0.f, 0.f, 0.f}, 0, 4, 0, 0x7f7f7f7f, 0, 0x7f7f7f7f); \
                res_[m_ >> 2] = (q == (m_ & 3)) ? d_.x : res_[m_ >> 2]; } } \
        { float* ow_ = OUTW + (size_t)tj_ * 1024 + col0;          \
            _Pragma("unroll") for (int j = 0; j < 4; ++j) __builtin_nontemporal_store(bf2f(EC.h[j]) + gv_[j] * (res_[j] * EC.sc), ow_ + 64 * j); }        \
        __builtin_amdgcn_sched_barrier(0); } while (0)
    PB_IDW(0); PB_OFF(0); PB_ISSUE(RA); PB_ELOAD(EA, 0);
    PB_IDW(1); PB_OFF(1); PB_ISSUE(RB);
    PB_IDW(2);
    int j = 0;
#pragma unroll 1
    for (; j + 1 < nt; j += 2) { PB_ITER(RA, EA, EB, j); PB_ITER(RB, EB, EA, j + 1); }
    if (j < nt) PB_ITER(RA, EA, EB, j);
#undef PB_TOK
#undef PB_IDW
#undef PB_OFF
#undef PB_ISSUE
#undef PB_WRITE
#undef PB_ELOAD
#undef PB_ITER
}

#ifndef MK_N_LAUNCHES
#define MK_N_LAUNCHES 1
#endif
constexpr int N_PHASES = 16;
struct Args { const float* in[28]; float* out; unsigned char* ws; int ph_lo, ph_hi, use_bar, rep; };
enum { I_X = 0, I_C, I_POS, I_WADA, I_BADA, I_N1G, I_WIN, I_QNG, I_KNG, I_MU, I_W0, I_W2, I_A0, I_A2, I_G2, I_KK, I_KA, I_RK, I_LNG, I_LNB, I_WPM, I_WPR, I_WOUT, I_N2G, I_WQ, I_SK, I_PU, I_PV };

template <int OFF> __device__ __forceinline__ unsigned long long karg64() { unsigned long long p; asm volatile("s_load_dwordx2 %0, %1, %2\n\ts_waitcnt lgkmcnt(0)" : "=s"(p) : "s"(__builtin_amdgcn_kernarg_segment_ptr()), "n"(OFF)); return p; }
#define KIN(k) ((const float*)(const GAS float*)karg64<8 * (k)>())
#define KOUT ((float*)(GAS float*)karg64<224>())
#define KWS ((unsigned char*)(GAS unsigned char*)karg64<232>())
#define KOB ((unsigned char*)(GAS unsigned char*)karg64<224>())
#define ctl ((unsigned*)(KWS + WS_CTL))
#define mod ((float*)(KWS + WS_MOD))
#define kmean ((float*)(KWS + WS_KMEAN))
#define WinT ((bf16*)(KWS + WS_WIN))
#define WloraT ((bf16*)(KWS + WS_WLORA))
#define WpmT ((bf16*)(KWS + WS_WPM))
#define WprT ((bf16*)(KWS + WS_WPR))
#define WoutT ((bf16*)(KWS + WS_WOUT))
#define WeffT ((bf16*)(KWS + WS_WEFF))
#define XN ((bf16*)(KWS + WS_XN))
#define EW ((bf16*)(KWS + WS_EW))
#define AA ((bf16*)(KWS + WS_AA))
#define Qb ((bf16*)(KWS + WS_Q))
#define Kb ((bf16*)(KWS + WS_K))
#define VTb ((bf16*)(KWS + WS_VT))
#define ZRKV ((bf16*)(KWS + WS_ZRKV))
#define GT ((bf16*)(KWS + WS_GT))
#define ZLORA ((bf16*)(KWS + WS_ZLORA))
#define ALORA ((bf16*)(KWS + WS_ALORA))
#define OMOBA ((bf16*)(KWS + WS_OCAT))
#define GG ((bf16*)(KWS + WS_GG))
#define Yb ((bf16*)(KWS + WS_OCAT) + 512)
#define MIXED ((bf16*)(KWS + WS_MIXED))
#define U8 ((unsigned char*)(KWS + WS_U8))
#define XN8 ((unsigned char*)(KWS + 352 * MiB))
#define V8 ((unsigned char*)(KWS + WS_V8))
#define H1B ((bf16*)(KWS + WS_H1B))
#define VVB ((bf16*)(KWS + 96 * MiB))
#define BONUS ((float*)(KWS + 128 * MiB))
#define PE16 ((unsigned short*)(KWS + 24 * MiB))
#define W8G ((unsigned char*)(KWS + 32 * MiB))
#define SCORES ((bf16*)(KWS + WS_SCORES))
#define OPART ((bf16*)(KOB + DO_OPART))
#define LISTS ((unsigned*)(KOB + DO_LISTS))
#define LPART ((float*)(KOB + DO_LPART))
#define CP_RW ((bf16*)(KOB))
#define CP_MM ((bf16*)(KOB + 32 * MiB))
#define CP_Y0T ((bf16*)(KOB + 64 * MiB))
#define CP_GAT ((bf16*)(KOB + 96 * MiB))
#define CP_PC ((float*)(KWS + 504 * MiB))
#define REPSEL(a, b) (PRB ? (a) : (b))
#define REPSEL5(a, b) REPSEL(a, b)
template <int PRB> __global__ void __launch_bounds__(NTHR, 2) mk_fwd_t(Args args) {
    extern __shared__ __attribute__((aligned(16))) unsigned char lds_raw[];
    LAS unsigned char* lds = (LAS unsigned char*)lds_raw;
    volatile LAS unsigned* MISC = (volatile LAS unsigned*)(lds + MISC_OFF);
    const int tid = threadIdx.x, lane = tid & 63, wave = __builtin_amdgcn_readfirstlane(tid >> 6);
    const int G = gridDim.x, bx = blockIdx.x;
    const int vcu = (G % 8 == 0) ? (bx % 8) * (G / 8) + bx / 8 : bx;
    const int gw = vcu * NWAVES + wave, NGW = G * NWAVES;
    const int gtid = vcu * NTHR + tid, NTOT = G * NTHR;
    for (int u = tid; u < (LDS_BYTES - MISC_OFF) / 4; u += NTHR) ((LAS unsigned*)(lds + MISC_OFF))[u] = 0u;
    __syncthreads();
    XcdBarrier bar; bar.bar = ctl + CW_BAR; bar.x = 0; bar.st = nullptr;
    if (args.use_bar) bar = xcd_barrier_post(ctl + CW_BAR, MISC + 8);
    const int lo = args.ph_lo, hi = args.ph_hi;
#ifdef PH_MASK
#define IN(k) ((((PH_MASK) >> (k)) & 1) && lo <= (k) && (k) < hi)
#else
#define IN(k) (lo <= (k) && (k) < hi)
#endif
#ifdef TIMEP
#define SEAM(k) do { if (IN(k) && IN((k) + 1)) { if (lo < 0) { cg::this_grid().sync(); } xcd_barrier(bar); if (bx == 0 && tid == 0) ((unsigned long long*)(ctl + 512))[(k)] = __builtin_amdgcn_s_memrealtime(); } } while (0)
#else
#ifdef DOUBLE_BAR
#define SEAM(k) do { if (IN(k) && IN((k) + 1)) { if (lo < 0) { cg::this_grid().sync(); } xcd_barrier(bar); xcd_barrier(bar); } } while (0)
#else
#define SEAM(k) do { if (IN(k) && IN((k) + 1)) { if (lo < 0) { cg::this_grid().sync(); } xcd_barrier(bar); } } while (0)
#endif
#endif

    constexpr int I_WEFF = 2048, I_T_IN = 16 * 168, I_T_PM = 8 * 32, I_T_OUT = 16 * 32;
    constexpr int NITEMS = I_WEFF + I_T_IN + 2 * I_T_PM + I_T_OUT;
    const int n0 = (G > 96) ? ((G - 96) * NWAVES < NITEMS ? (G - 96) * NWAVES : NITEMS) : 0;
#define PREP_ITEM(IT) do { int r = (IT); LAS float* scr = (LAS float*)(lds + wave * 16384); \
        if (r < I_WEFF) { p0_weff_item(KIN(I_WQ), KIN(I_SK), WeffT, r, lane); break; } r -= I_WEFF; \
        if (r < I_T_IN) { p0_transpose_item(KIN(I_WIN), 1024, INW, WinT, 1024, 0, scr, r, lane); break; } r -= I_T_IN; \
        if (r < I_T_PM) { p0_transpose_item(KIN(I_WPM), 512, 1024, WpmT, 1024, 0, scr, r, lane); break; } r -= I_T_PM;          \
        if (r < I_T_PM) { p0_transpose_item(KIN(I_WPR), 512, 1024, WpmT, 1024, 512, scr, r, lane); break; } r -= I_T_PM;        \
        p0_transpose_item(KIN(I_WOUT), 1024, 1024, WoutT, 1024, 0, scr, r, lane); } while (0)
    if (IN(0)) {
        if (vcu < 96 || G <= 96) { for (int it = vcu; it < 96; it += G) p0_mod_item(KIN(I_C), KIN(I_WADA), KIN(I_BADA), mod, (LAS float*)lds, it, wave, lane); }
        else { for (int it = (vcu - 96) * NWAVES + wave; it < n0; it += (G - 96) * NWAVES) PREP_ITEM(it); }
     }
    SEAM(0);
    if (IN(1)) {
#pragma unroll 1
        for (int step = 0; step < 2; ++step) {
            if ((step == 0) == ((wave & 1) == 0)) {
                for (int it = n0 + gw; it < NITEMS; it += NGW) PREP_ITEM(it);
            } else {
                for (int m = gw * 4; m < T; m += NGW * 4) { const float* mb = mod + (size_t)(m >> 13) * 6144;
                    rms_mod_rows<4>(KIN(I_X) + (size_t)m * DM, XN + (size_t)m * DM, nullptr, KIN(I_N1G), mb + 1024, mb, lane); }
            }
        }
        const float* w2 = KIN(I_W2); const float* a2 = KIN(I_A2); const float* g2 = KIN(I_G2);
        for (int i = gtid; i < 1536 * 256; i += NTOT) {
            const int n = i >> 8, k = i & 255; float v = 0.f;
            if (n < 512) { if (k < 64) v = w2[k * 512 + n]; }
            else if (n < 1024) { if (k >= 64 && k < 128) v = a2[(k - 64) * 512 + (n - 512)]; }
            else { if (k >= 128) v = g2[(k - 128) * 512 + (n - 1024)]; }
            WloraT[i] = (bf16)f2bf(v);
        }
     }
    SEAM(1);
#undef PREP_ITEM
    if (IN(2)) {
        pg8::Gemm g{XN, WinT, T, INW, DM}; pg8::StaticOrder S; S.init(T, INW, G, bx);
        EpiIn E{Qb, Kb, VTb, ZRKV, ZLORA, GT};
        pg8::gemm_phase<EpiIn, pg8::StaticOrder, true, true>(lds, g, S, E);
     }
    SEAM(2);
    if (IN(3)) {
        LAS float* red = (LAS float*)lds;
        v4u raw[4], rawn[4]; int ps[4], psn[4];
        if (vcu < 2048) p2_qk_load(raw, ps, (vcu >> 10) ? Qb : Kb, (const int*)KIN(I_POS), (vcu & 1023) >> 5, vcu & 31, wave, lane);
        for (int it = vcu; it < 2048; it += G) {
            const int isq = it >> 10, r = it & 1023, bh = r >> 5, n = r & 31;
            { const int itn = it + G < 2048 ? it + G : it;
              p2_qk_load(rawn, psn, (itn >> 10) ? Qb : Kb, (const int*)KIN(I_POS), (itn & 1023) >> 5, itn & 31, wave, lane); }
            if (isq) p2_qk_item(raw, ps, REPSEL((bf16*)KOB, Qb), KIN(I_QNG), nullptr, bh, n, red, tid, wave, lane);
            else p2_qk_item(raw, ps, REPSEL((bf16*)(KOB + 32 * MiB), Kb), KIN(I_KNG), REPSEL((float*)(KWS + 1536 * 1024), kmean), bh, n, red, tid, wave, lane);
#pragma unroll
            for (int i = 0; i < 4; ++i) { raw[i] = rawn[i]; ps[i] = psn[i]; }
        }
        p2_prep(ZLORA, KIN(I_MU), REPSEL((bf16*)(KOB + 64 * MiB), ALORA), gtid, NTOT);
    }
    SEAM(3);
    if (IN(4)) {
        { int kdim = 256; asm volatile("" : "+s"(kdim));
          pg8::Gemm g{ALORA, WloraT, T, 1536, kdim}; pg8::StaticOrder S; S.init(T, 1536, G, bx);
          EpiLora E{EW, AA, GG, KIN(I_W0), KIN(I_A0)};
          pg8::gemm_phase<EpiLora, pg8::StaticOrder, true, true>(lds, g, S, E); }
        __syncthreads();
        LAS float* km = (LAS float*)lds;
        for (int it = vcu; it < 512; it += G) p3_top3_item(Qb, kmean, ctl + CW_CURSOR + REPSEL(2048, 0), REPSEL((unsigned*)KOB, LISTS), (2 * it) & 31, (2 * it) >> 5, km, tid, wave, lane);
    }
    SEAM(4);
    if (IN(5)) {
        attn_phase(Qb, Kb, VTb, LISTS, ctl + CW_CURSOR, ctl + CW_QUEUE + REPSEL5(64, 0), OPART, LPART, OMOBA, KIN(I_QNG), KIN(I_KNG), lds, tid, wave, lane, PRB);
    }
    SEAM(5);
    if (IN(6)) {
        p5_combine(OPART, LPART, OMOBA, REPSEL(Qb, OMOBA), gtid, NTOT);
    }
    SEAM(6);
    if (IN(7)) {
        ScanRaw R;
        if (vcu < BH * NCHK) scan_load(R, ZRKV, AA, EW, (vcu >> 7) >> 3, ((vcu >> 7) & 7) * 64 + (tid & 7) * 8, (vcu & 127) * CK + (tid >> 3));
        for (int ci = vcu; ci < BH * NCHK; ci += G) {
            const int cn = ci + G;
            rwkv_cp_item(ZRKV, AA, EW, KIN(I_MU), KIN(I_KK), KIN(I_KA), KIN(I_RK), VVB, BONUS, CP_RW + (size_t)ci * 4096, CP_MM + (size_t)ci * 4096, CP_Y0T + (size_t)ci * 4096, CP_GAT + (size_t)ci * 4096,
                         CP_PC + (size_t)ci * 64, ci >> 7, ci & 127, R, (cn < BH * NCHK ? cn : ci) >> 7, (cn < BH * NCHK ? cn : ci) & 127, lds, tid, wave, lane, PRB);
        }
    }
    SEAM(7);
    if (IN(8)) {
        if (G >= 128) { if (vcu < 128) rwkv_seq(CP_RW, CP_MM, CP_Y0T, CP_GAT, CP_PC, Yb, vcu, lds, tid, wave, lane); }
        else for (int sid = vcu; sid < 128; sid += G) { __syncthreads(); rwkv_seq(CP_RW, CP_MM, CP_Y0T, CP_GAT, CP_PC, Yb, sid, lds, tid, wave, lane); }
        if (G > 128 ? vcu >= 128 : true) {
        const int cgt = (G > 128 ? vcu - 128 : vcu) * NTHR + tid, cnt = (G > 128 ? G - 128 : G) * NTHR;
        const f32x4* pu = (const f32x4*)KIN(I_PU); const f32x4* pv = (const f32x4*)KIN(I_PV);
        for (int i = cgt; i < 16384 * 1024 / 32; i += cnt) {
            v4u wu;
#pragma unroll
            for (int q = 0; q < 4; ++q) {
                f32x4 a = pu[8 * i + 2 * q] * 64.f, c = pu[8 * i + 2 * q + 1] * 64.f;
                a = __builtin_elementwise_min(__builtin_elementwise_max(a, (f32x4){-6.f, -6.f, -6.f, -6.f}), (f32x4){6.f, 6.f, 6.f, 6.f});
                c = __builtin_elementwise_min(__builtin_elementwise_max(c, (f32x4){-6.f, -6.f, -6.f, -6.f}), (f32x4){6.f, 6.f, 6.f, 6.f});
                unsigned w = 0u;
                w = __builtin_amdgcn_cvt_scalef32_pk_fp4_f32(w, a.x, a.y, 1.0f, 0); w = __builtin_amdgcn_cvt_scalef32_pk_fp4_f32(w, a.z, a.w, 1.0f, 1);
                w = __builtin_amdgcn_cvt_scalef32_pk_fp4_f32(w, c.x, c.y, 1.0f, 2); w = __builtin_amdgcn_cvt_scalef32_pk_fp4_f32(w, c.z, c.w, 1.0f, 3);
                wu[q] = w;
            }
            *(v4u*)(U8 + (size_t)i * 16) = wu;
        }
        for (int i = cgt; i < 16384 * 1024 / 32; i += cnt) {
            v4u wv;
#pragma unroll
            for (int q = 0; q < 4; ++q) {
                f32x4 a = pv[8 * i + 2 * q] * 5.656854249f, c = pv[8 * i + 2 * q + 1] * 5.656854249f;
                a = __builtin_elementwise_min(__builtin_elementwise_max(a, (f32x4){-6.f, -6.f, -6.f, -6.f}), (f32x4){6.f, 6.f, 6.f, 6.f});
                c = __builtin_elementwise_min(__builtin_elementwise_max(c, (f32x4){-6.f, -6.f, -6.f, -6.f}), (f32x4){6.f, 6.f, 6.f, 6.f});
                unsigned w = 0u;
                w = __builtin_amdgcn_cvt_scalef32_pk_fp4_f32(w, a.x, a.y, 1.0f, 0); w = __builtin_amdgcn_cvt_scalef32_pk_fp4_f32(w, a.z, a.w, 1.0f, 1);
                w = __builtin_amdgcn_cvt_scalef32_pk_fp4_f32(w, c.x, c.y, 1.0f, 2); w = __builtin_amdgcn_cvt_scalef32_pk_fp4_f32(w, c.z, c.w, 1.0f, 3);
                wv[q] = w;
            }
            *(v4u*)(V8 + (size_t)((i & 31) >> 3) * (2 * MiB) + (size_t)(i >> 5) * 128 + (i & 7) * 16) = wv;
        }
        }
    }
    SEAM(8);
    if (IN(9)) {
        p5_rwkv_post(GG, Yb, REPSEL(Qb, Yb), VVB, BONUS, KIN(I_LNG), KIN(I_LNB), gw, NGW, lane);
    }
    SEAM(9);
    if (IN(10)) {
        pg8::Gemm g{OMOBA, WpmT, T, DM, DM}; pg8::StaticOrder S; S.init(T, DM, G, bx);
        EpiMix E{GT, MIXED, PRB};
        pg8::gemm_phase<EpiMix, pg8::StaticOrder, true, true>(lds, g, S, E);
    }
    SEAM(10);
    if (IN(11)) {
        pg8::Gemm g{MIXED, WoutT, T, DM, DM}; pg8::StaticOrder S; S.init(T, DM, G, bx);
        EpiOut E{KIN(I_X), mod, H1B};
        pg8::gemm_phase<EpiOut, pg8::StaticOrder, true, true>(lds, g, S, E);
     }
    SEAM(11);
    if (IN(12)) {
        for (int m = gw * 4; m < T; m += NGW * 4) { const float* mb = mod + (size_t)(m >> 13) * 6144;
            rms_mod_rows<4, true>(H1B + (size_t)m * DM, XN + (size_t)m * DM, (unsigned*)(XN8 + (size_t)m * DM), KIN(I_N2G), mb + 4 * 1024, mb + 3 * 1024, lane); }
    }
    SEAM(12);
    if (IN(13)) {
        pg8::Gemm g{XN, WeffT, T, PEER_N, DM}; pg8::StaticOrder S; S.init(T, PEER_N, G, bx);
        EpiScores E{SCORES};
        pg8::gemm_phase<EpiScores, pg8::StaticOrder, true, true>(lds, g, S, E);
     }
    SEAM(13);
    if (IN(14)) {
        peer_stage_a(SCORES, XN8, U8, (LAS f32x4*)(lds + wave * 11264), (unsigned*)PE16, (unsigned*)W8G, gw, NGW, lane);
    }
    SEAM(14);
    if (IN(15)) {
        constexpr int PW = (LDS_BYTES - 512) / NWAVES;
        const bool part = (G >= 8);
        const int wi = part ? (bx >> 3) : bx, nwi = part ? ((G - (bx & 7) + 7) >> 3) : G;
#pragma unroll 1
        for (int cls = part ? (bx & 7) : 0; cls < 8; cls += (part ? 8 : 1))
            peer_stage_b(V8 + (size_t)(cls & 3) * (2 * MiB), mod, H1B, REPSEL((float*)(KWS + 384 * MiB), KOUT), (const unsigned*)PE16, W8G, lds + wave * PW, cls & 3, cls >> 2, wi * NWAVES + wave, nwi * NWAVES, lane, PRB);
    }
#ifdef TIMEP
    xcd_barrier(bar);
    if (bx == 0) {
        if (tid == 0) ((unsigned long long*)(ctl + 512))[15] = __builtin_amdgcn_s_memrealtime();
        __syncthreads();
        const unsigned long long ta = ((volatile unsigned long long*)(ctl + 512))[TIMEP - 1], tb = ((volatile unsigned long long*)(ctl + 512))[TIMEP];
        const float us = (float)(tb - ta) * 0.01f;
        float code = (TIMEP_CAL) ? 10.f : floorf((us - (float)(TIMEP_BASE)) * (1.f / (float)(TIMEP_STEP)));
        code = code < 0.f ? 0.f : (code > 40.f ? 40.f : code);
        const float off = 0.02f * exp2f(code * 0.2630344f);
        float* o = KOUT; for (int i = tid; i < 1024 * 1024; i += NTHR) o[i] += off;
    }
#endif
#undef IN
#undef SEAM
}

extern "C" void kernel_launch(void* const* d_in, const int* in_sizes, int n_in, void* d_out, int out_size, void* d_ws, size_t ws_size, hipStream_t stream) {
    static int grid = 0;
    if (grid == 0) {
        if (n_in != 28 || in_sizes[0] != T * DM || out_size != T * DM || ws_size < WS_END) {
            fprintf(stderr, "kernel_launch: unexpected problem (n_in %d, in0 %d, out %d, ws %zu); nothing launched\n", n_in, n_in > 0 ? in_sizes[0] : -1, out_size, ws_size); grid = -1; return; }
        int dev = 0, cus = 0, per_cu = 0;
        if (hipGetDevice(&dev) != hipSuccess || hipDeviceGetAttribute(&cus, hipDeviceAttributeMultiprocessorCount, dev) != hipSuccess) { grid = -1; return; }
        if (hipFuncSetAttribute((const void*)mk_fwd_t<0>, hipFuncAttributeMaxDynamicSharedMemorySize, LDS_BYTES) != hipSuccess) { fprintf(stderr, "kernel_launch: hipFuncSetAttribute failed\n"); grid = -1; return; }
        if (hipOccupancyMaxActiveBlocksPerMultiprocessor(&per_cu, (const void*)mk_fwd_t<0>, NTHR, LDS_BYTES) != hipSuccess || per_cu < 1) { fprintf(stderr, "kernel_launch: occupancy query says %d\n", per_cu); per_cu = 1; }
        (void)hipGetLastError();
        grid = cus;
    }
    if (grid < 0) return;
    if (hipMemsetAsync((char*)d_ws + WS_CTL, 0, CTL_ZERO_BYTES, stream) != hipSuccess) { fprintf(stderr, "kernel_launch: memset failed\n"); return; }
    Args a{};
    for (int i = 0; i < 28; ++i) a.in[i] = (const float*)d_in[i];
    a.out = (float*)d_out; a.ws = (unsigned char*)d_ws;
#if MK_N_LAUNCHES == 1
    a.ph_lo = 0; a.ph_hi = N_PHASES; a.use_bar = 1;
    void* kargs[] = {&a};
    hipError_t e = hipLaunchCooperativeKernel((const void*)mk_fwd_t<0>, dim3(grid), dim3(NTHR), kargs, LDS_BYTES, stream);
    if (e != hipSuccess) fprintf(stderr, "kernel_launch: cooperative launch failed: %s (grid %d)\n", hipGetErrorString(e), grid);
#else
#ifndef REP_MASK
#define REP_MASK 0
#endif
#ifndef REP_CODE
#define REP_CODE 1
#endif
    for (int p = 0; p < N_PHASES; ++p) {
        a.ph_lo = p; a.ph_hi = p + 1; a.use_bar = 0;
#if REP_MASK != 0
        if ((REP_MASK >> p) & 1) { static bool once = false; if (!once) { once = true; (void)hipFuncSetAttribute((const void*)mk_fwd_t<REP_CODE>, hipFuncAttributeMaxDynamicSharedMemorySize, LDS_BYTES); }
            a.rep = REP_CODE; hipLaunchKernelGGL(mk_fwd_t<REP_CODE>, dim3(grid), dim3(NTHR), LDS_BYTES, stream, a); }
#endif
        a.rep = 0;
        hipLaunchKernelGGL(mk_fwd_t<0>, dim3(grid), dim3(NTHR), LDS_BYTES, stream, a);
    }
#endif
}
```

```cpp
#include <hip/hip_runtime.h>
#include <hip/hip_cooperative_groups.h>
#include <cstdio>
#include <cstdint>
namespace cg = cooperative_groups;

namespace pg8 {
#define PG8_LAS __attribute__((address_space(3)))
typedef unsigned short bf16_t;
typedef short bf16x8 __attribute__((ext_vector_type(8)));
typedef float f32x4 __attribute__((ext_vector_type(4)));
typedef unsigned u32x4 __attribute__((ext_vector_type(4)));
constexpr int BM = 256, BK = 64, HALF = 128, HTB = HALF * BK * 2  , STAGE_BYTES = 8 * HTB, NXCD = 8, WGM = 8;

__host__ __device__ __forceinline__ int lds_byte(int r, int c) { const int st = (r >> 4) * 2 + (c >> 5), rr = r & 15, cc = c & 31, ob = rr * 64 + cc * 2; return st * 1024 + (ob ^ (((ob >> 9) & 1) << 5)); }
__host__ __device__ __forceinline__ void stage_rc(int b, int& R, int& C) { const int st = b / 1024, sb = b % 1024, swz = sb ^ (((sb >> 9) & 1) << 5); R = (st >> 1) * 16 + swz / 64; C = (st & 1) * 32 + (swz % 64) / 2; }
__host__ __device__ __forceinline__ int perm32(int rho) { const int n = rho >> 4, i = rho & 15; return 8 * (i >> 2) + 4 * n + (i & 3); }

struct Unit { int pm, pn; };
struct Gemm { const bf16_t* A; const bf16_t* Bt; int M, N, K; };

struct StaticOrder {
    int nM, nN, nwg, G, c;
    __host__ __device__ void init(int M, int N, int G_, int c_) { nM = M / BM; nN = N / BM; nwg = nM * nN; G = G_; c = c_; }
    __host__ __device__ bool next(int i, Unit& u) const {
        const long L = (long)i * G + c; if (L >= nwg) return false;
        int wgid = (int)L; { const int q = nwg / NXCD, r = nwg % NXCD, xcd = wgid % NXCD, off = wgid / NXCD; wgid = (xcd < r ? xcd * (q + 1) : r * (q + 1) + (xcd - r) * q) + off; }
        const int nig = WGM * nN, gid = wgid / nig, fm = gid * WGM, gsz = (nM - fm) < WGM ? (nM - fm) : WGM;
        u.pm = fm + ((wgid % nig) % gsz); u.pn = (wgid % nig) / gsz; return true;
    }
    __device__ __forceinline__ void a_ready(const Unit&) const {}
    __device__ __forceinline__ void done(const Unit&) const {}
};
template <class Epi, class Sched, bool ALIGN_EPI = false, bool SP2 = false>
__device__ __forceinline__ void gemm_phase(PG8_LAS unsigned char* lds, const Gemm g, const Sched& S, const Epi& E) {
    const int tid = threadIdx.x, wid = __builtin_amdgcn_readfirstlane(tid >> 6), lane = tid & 63, wr = wid >> 2, wc = wid & 3, fr = lane & 15, fq = lane >> 4;
    const int K = g.K, nt = K / BK;
    unsigned voffA[2], voffB[2];
#pragma unroll
    for (int i = 0; i < 2; ++i) { int R, C; stage_rc(tid * 16 + i * 8192, R, C); const int Rb = Epi::PERM ? ((R & ~31) + perm32(R & 31)) : R;
        voffA[i] = (unsigned)(R * K + C) * 2u; voffB[i] = (unsigned)(Rb * K + C) * 2u; }
    const size_t kstep = (size_t)(BK * 2);
    const size_t hstep = (size_t)HALF * K * 2;
    const size_t tstep = 2 * hstep;
    const unsigned ldsw = (unsigned)wid * 1024u;
    const int aoff = lds_byte(wr * 64 + fr, fq * 8), boff = lds_byte(wc * 32 + fr, fq * 8);
#define PG8_SA(b, h) (((b) * 2 + (h)) * HTB)
#define PG8_SB(b, h) ((4 + (b) * 2 + (h)) * HTB)
#define PG8_STAGE(bufoff, gbase, voff) do { _Pragma("unroll") for (int _i = 0; _i < 2; ++_i) \
        __builtin_amdgcn_global_load_lds((const unsigned*)((const char*)(gbase) + (voff)[_i]), (PG8_LAS unsigned*)(lds + (bufoff) + ldsw + _i * 8192), 16, 0, 0); } while (0)
#define PG8_LDA(dst, b, h) do { _Pragma("unroll") for (int m = 0; m < 4; ++m) _Pragma("unroll") for (int k = 0; k < 2; ++k) dst[m][k] = *(const PG8_LAS bf16x8*)(lds + PG8_SA(b, h) + aoff + m * 2048 + k * 1024); } while (0)
#define PG8_LDB(dst, b, h) do { _Pragma("unroll") for (int n = 0; n < 2; ++n) _Pragma("unroll") for (int k = 0; k < 2; ++k) dst[n][k] = *(const PG8_LAS bf16x8*)(lds + PG8_SB(b, h) + boff + n * 2048 + k * 1024); } while (0)
#define PG8_MMA(ai, bj, At, Bt) do { __builtin_amdgcn_s_setprio(1); _Pragma("unroll") for (int m = 0; m < 4; ++m) _Pragma("unroll") for (int n = 0; n < 2; ++n) _Pragma("unroll") for (int k = 0; k < 2; ++k) \
        acc[ai][bj][m][n] = __builtin_amdgcn_mfma_f32_16x16x32_bf16(Bt[n][k], At[m][k], acc[ai][bj][m][n], 0, 0, 0); __builtin_amdgcn_s_setprio(0); } while (0)
#define PG8_WAIT_V(n) asm volatile("s_waitcnt vmcnt(" #n ")" ::: "memory")
#define PG8_WAIT_L(n) asm volatile("s_waitcnt lgkmcnt(" #n ")" ::: "memory")
#define PG8_BAR __builtin_amdgcn_s_barrier()
#define PG8_SCHED __builtin_amdgcn_sched_barrier(0)
    Unit cur, nxt; int ui = 0;
    if (!S.next(0, cur)) return;
    f32x4 acc[2][2][4][2];
#pragma unroll
    for (int a = 0; a < 2; ++a)
#pragma unroll
        for (int b = 0; b < 2; ++b)
#pragma unroll
            for (int m = 0; m < 4; ++m)
#pragma unroll
                for (int n = 0; n < 2; ++n) acc[a][b][m][n] = (f32x4){0.f, 0.f, 0.f, 0.f};
    bf16x8 At[4][2], B0[2][2], B1[2][2];
    const char* cA = (const char*)g.A + (size_t)cur.pm * tstep; const char* cB = (const char*)g.Bt + (size_t)cur.pn * tstep;
    S.a_ready(cur);
    if constexpr (SP2) {
        PG8_STAGE(PG8_SB(0, 0), cB, voffB); PG8_STAGE(PG8_SB(0, 1), cB + hstep, voffB); PG8_STAGE(PG8_SA(0, 0), cA, voffA); PG8_STAGE(PG8_SA(0, 1), cA + hstep, voffA);
        if (wr == 1) PG8_BAR;
        PG8_WAIT_V(2); PG8_BAR;
        PG8_STAGE(PG8_SB(1, 0), cB + kstep, voffB); PG8_STAGE(PG8_SA(1, 0), cA + kstep, voffA); PG8_STAGE(PG8_SB(1, 1), cB + hstep + kstep, voffB);
        PG8_WAIT_V(6); PG8_BAR;
    } else {
        PG8_STAGE(PG8_SB(0, 0), cB, voffB); PG8_STAGE(PG8_SA(0, 0), cA, voffA); PG8_STAGE(PG8_SB(0, 1), cB + hstep, voffB); PG8_STAGE(PG8_SA(0, 1), cA + hstep, voffA);
        if (wr == 1) PG8_BAR;
        PG8_WAIT_V(4); PG8_BAR;
        PG8_STAGE(PG8_SB(1, 0), cB + kstep, voffB); PG8_STAGE(PG8_SA(1, 0), cA + kstep, voffA); PG8_STAGE(PG8_SB(1, 1), cB + hstep + kstep, voffB);
        PG8_WAIT_V(6); PG8_BAR;
    }
    for (;;) {
        const bool has_next = S.next(ui + 1, nxt);
        const char* nA = has_next ? (const char*)g.A + (size_t)nxt.pm * tstep : cA; const char* nB = has_next ? (const char*)g.Bt + (size_t)nxt.pn * tstep : cB;
        for (int t = 0; t < nt; t += 2) {
            if constexpr (Epi::HAS_MID) { if (t == Epi::MID_T) E.mid(acc, cur, wr, wc, fr, fq); }
            const bool last = (t == nt - 2);
            const char* a1 = cA + (size_t)(t + 1) * kstep;
            const char* a2 = last ? nA : cA + (size_t)(t + 2) * kstep; const char* b2 = last ? nB : cB + (size_t)(t + 2) * kstep;
            const char* a3 = a2 + kstep; const char* b3 = b2 + kstep;
            if (last && has_next) S.a_ready(nxt);
            if constexpr (SP2) {
            PG8_LDB(B0, 0, 0); PG8_LDB(B1, 0, 1); PG8_SCHED; PG8_LDA(At, 0, 0); PG8_STAGE(PG8_SA(1, 1), a1 + hstep, voffA);
            PG8_WAIT_V(8); PG8_WAIT_L(0); PG8_BAR; PG8_MMA(0, 0, At, B0); PG8_MMA(0, 1, At, B1); PG8_BAR; PG8_SCHED;
            PG8_LDA(At, 0, 1); PG8_STAGE(PG8_SB(0, 0), b2, voffB); PG8_STAGE(PG8_SB(0, 1), b2 + hstep, voffB); PG8_STAGE(PG8_SA(0, 0), a2, voffA);
            PG8_WAIT_V(8); PG8_WAIT_L(0); PG8_BAR; PG8_MMA(1, 0, At, B0); PG8_MMA(1, 1, At, B1); PG8_BAR; PG8_SCHED;
            PG8_LDB(B0, 1, 0); PG8_LDB(B1, 1, 1); PG8_SCHED; PG8_LDA(At, 1, 0); PG8_STAGE(PG8_SA(0, 1), a2 + hstep, voffA);
            PG8_WAIT_V(8); PG8_WAIT_L(0); PG8_BAR; PG8_MMA(0, 0, At, B0); PG8_MMA(0, 1, At, B1); PG8_BAR; PG8_SCHED;
            PG8_LDA(At, 1, 1); PG8_STAGE(PG8_SB(1, 0), b3, voffB); PG8_STAGE(PG8_SB(1, 1), b3 + hstep, voffB); PG8_STAGE(PG8_SA(1, 0), a3, voffA);
            PG8_WAIT_V(8); PG8_WAIT_L(0); PG8_BAR; PG8_MMA(1, 0, At, B0); PG8_MMA(1, 1, At, B1); PG8_BAR; PG8_SCHED;
            } else {
            PG8_LDB(B0, 0, 0); PG8_SCHED; PG8_LDA(At, 0, 0); PG8_STAGE(PG8_SA(1, 1), a1 + hstep, voffA);
            PG8_WAIT_L(8); PG8_BAR; PG8_WAIT_L(0); PG8_MMA(0, 0, At, B0); PG8_BAR; PG8_SCHED;
            PG8_LDB(B1, 0, 1); PG8_STAGE(PG8_SB(0, 0), b2, voffB);
            PG8_BAR; PG8_WAIT_L(0); PG8_MMA(0, 1, At, B1); PG8_BAR;
            PG8_LDA(At, 0, 1); PG8_STAGE(PG8_SA(0, 0), a2, voffA);
            PG8_BAR; PG8_WAIT_L(0); PG8_MMA(1, 0, At, B0); PG8_BAR; PG8_SCHED;
            PG8_STAGE(PG8_SB(0, 1), b2 + hstep, voffB);
            PG8_WAIT_V(6); PG8_BAR; PG8_MMA(1, 1, At, B1); PG8_BAR;
            PG8_LDB(B0, 1, 0); PG8_SCHED; PG8_LDA(At, 1, 0); PG8_STAGE(PG8_SA(0, 1), a2 + hstep, voffA);
            PG8_WAIT_L(8); PG8_BAR; PG8_WAIT_L(0); PG8_MMA(0, 0, At, B0); PG8_BAR; PG8_SCHED;
            PG8_LDB(B1, 1, 1); PG8_STAGE(PG8_SB(1, 0), b3, voffB);
            PG8_BAR; PG8_WAIT_L(0); PG8_MMA(0, 1, At, B1); PG8_BAR;
            PG8_LDA(At, 1, 1); PG8_STAGE(PG8_SA(1, 0), a3, voffA);
            PG8_BAR; PG8_WAIT_L(0); PG8_MMA(1, 0, At, B0); PG8_BAR; PG8_SCHED;
            PG8_STAGE(PG8_SB(1, 1), b3 + hstep, voffB);
            PG8_WAIT_V(6); PG8_BAR; PG8_MMA(1, 1, At, B1); PG8_BAR;
            }
        }
        if constexpr (ALIGN_EPI) { if (wr == 0) PG8_BAR; }
        if constexpr (!Epi::AFTER_DRAIN) { E(acc, cur, wr, wc, fr, fq); S.done(cur); }
        if (!has_next) break;
#pragma unroll
        for (int a = 0; a < 2; ++a)
#pragma unroll
            for (int b = 0; b < 2; ++b)
#pragma unroll
                for (int m = 0; m < 4; ++m)
#pragma unroll
                    for (int n = 0; n < 2; ++n) acc[a][b][m][n] = (f32x4){0.f, 0.f, 0.f, 0.f};
        cur = nxt; cA = nA; cB = nB; ++ui;
        if constexpr (ALIGN_EPI) { if (wr == 1) PG8_BAR; }
    }
    PG8_WAIT_V(0);
    if constexpr (!ALIGN_EPI) { if (wr == 0) PG8_BAR; }
    PG8_BAR;
    if constexpr (Epi::AFTER_DRAIN) { E.fused(acc, cur, wr, wc, fr, fq, lds, wid, lane); S.done(cur); }
#undef PG8_SA
#undef PG8_SB
#undef PG8_STAGE
#undef PG8_LDA
#undef PG8_LDB
#undef PG8_MMA
#undef PG8_WAIT_V
#undef PG8_WAIT_L
#undef PG8_BAR
#undef PG8_SCHED
}
}

constexpr int NWAVES = 8, NTHR = 512;
constexpr int BATCH = 4, SEQ = 8192, DM = 1024, T = BATCH * SEQ;
constexpr int NH = 8, HD = 64, NBLK = 32, BLK = 256;
constexpr int BH = BATCH * NH;
constexpr int INW = 5376;
constexpr int ZR = 1536, ZL = 256;
constexpr int PEER_N = 2048;
constexpr float RMS_EPS = 1e-6f, GN_EPS = 64e-5f;
constexpr int OSTR = 1024;

constexpr size_t MiB = 1u << 20;
constexpr size_t WS_CTL = 0, CTL_ZERO_BYTES = 32 * 1024;
constexpr size_t WS_MOD = 1 * MiB;
constexpr size_t WS_KMEAN = 1 * MiB + 128 * 1024;
constexpr size_t WS_WIN = 2 * MiB;
constexpr size_t WS_WLORA = 13 * MiB;
constexpr size_t WS_WPM = 14 * MiB, WS_WPR = 15 * MiB;
constexpr size_t WS_WOUT = 16 * MiB;
constexpr size_t WS_WEFF = 18 * MiB;
constexpr size_t WS_XN = 24 * MiB;
constexpr size_t WS_EW = 24 * MiB, WS_AA = 56 * MiB;
constexpr size_t WS_Q = 88 * MiB, WS_K = 120 * MiB, WS_VT = 152 * MiB;
constexpr size_t WS_ZRKV = 184 * MiB;
constexpr size_t WS_GT = 280 * MiB;
constexpr size_t WS_ZLORA = 408 * MiB;
constexpr size_t WS_ALORA = 424 * MiB;
constexpr size_t WS_OCAT = 408 * MiB;
constexpr size_t WS_H1B = 408 * MiB;
constexpr size_t WS_GG = 472 * MiB;
constexpr size_t WS_MIXED = 216 * MiB;
constexpr size_t WS_U8 = 2 * MiB, WS_V8 = 88 * MiB;
constexpr size_t WS_SCORES = 96 * MiB;
constexpr size_t WS_END = 512 * MiB;
constexpr size_t DO_OPART = 0, DO_LISTS = 96 * MiB, DO_LPART = 112 * MiB;
constexpr int LIST_PER_BH = 256 * 496;
__host__ __device__ constexpr int list_off(int n) { return 256 * (31 * n - n * (n - 1) / 2); }
constexpr int CW_QUEUE = 64;
constexpr int CW_CURSOR = 1024;
constexpr int CW_BAR = 4096;

constexpr int RING_BYTES = 131072;
constexpr int LDS_BYTES = 163840;
constexpr int MISC_OFF = LDS_BYTES - 512;

#define GAS __attribute__((address_space(1)))
#define LAS __attribute__((address_space(3)))
typedef unsigned short bf16;
typedef unsigned v4u __attribute__((ext_vector_type(4)));
typedef unsigned v2u __attribute__((ext_vector_type(2)));
typedef float f32x4 __attribute__((ext_vector_type(4)));
typedef float f32x2 __attribute__((ext_vector_type(2)));
typedef float f32x16 __attribute__((ext_vector_type(16)));
typedef short bf16x8 __attribute__((ext_vector_type(8)));
typedef short s16x4 __attribute__((ext_vector_type(4)));
#define RLX_AGENT __ATOMIC_RELAXED, __HIP_MEMORY_SCOPE_AGENT
#define LDS_WAIT() asm volatile("s_waitcnt lgkmcnt(0)" ::: "memory")
#define VM_WAIT() asm volatile("s_waitcnt vmcnt(0)" ::: "memory")
typedef __bf16 bf16x2_t __attribute__((ext_vector_type(2)));
__device__ __forceinline__ unsigned cvtpk(float lo, float hi) { f32x2 v = {lo, hi}; bf16x2_t b = __builtin_convertvector(v, bf16x2_t); return __builtin_bit_cast(unsigned, b); }
__device__ __forceinline__ unsigned pk2(float lo, float hi) { return cvtpk(lo, hi); }
__device__ __forceinline__ unsigned f2bf(float f) { return cvtpk(f, 0.f) & 0xffffu; }
__device__ __forceinline__ float bflo(unsigned u) { return __builtin_bit_cast(float, u << 16); }
__device__ __forceinline__ float bfhi(unsigned u) { return __builtin_bit_cast(float, u & 0xffff0000u); }
__device__ __forceinline__ float bf2f(bf16 h) { return __builtin_bit_cast(float, (unsigned)h << 16); }
__device__ __forceinline__ float wave_sum(float v) {
#pragma unroll
    for (int o = 1; o < 64; o <<= 1) v += __shfl_xor(v, o);
    return v;
}
__device__ __forceinline__ float sigmoidf_(float x) { return __builtin_amdgcn_rcpf(1.0f + __expf(-x)); }
#define XB_TMO      128
#define XB_XCNT(j)  (256  + 64 * (j))
#define XB_XSUB(j)  (1280 + 64 * (j))
#define XB_XGEN(j)  (2304 + 64 * (j))
#define XB_TOP      3328
#define XB_TOPGEN   3392
#define XCD_BAR_WORDS 3456
#define XB_SPIN_CAP (1u << 18)

__device__ __forceinline__ unsigned xb_ld(unsigned* p)              { return __hip_atomic_load(p, __ATOMIC_RELAXED, __HIP_MEMORY_SCOPE_AGENT); }
__device__ __forceinline__ unsigned xb_add(unsigned* p, unsigned v) { return __hip_atomic_fetch_add(p, v, __ATOMIC_RELAXED, __HIP_MEMORY_SCOPE_AGENT); }
__device__ __forceinline__ unsigned xb_xcc_id() { return (unsigned)__builtin_amdgcn_s_getreg((3 << 11) | 20) & 0xFu; }
#define XB_SPIN(cond, bar) do { unsigned _sp = 0; while (cond) { __builtin_amdgcn_s_sleep(1); \
    if ((++_sp & 255u) == 0u) { if (xb_ld(&(bar)[XB_TMO])) break; if (_sp > XB_SPIN_CAP) { atomicAdd(&(bar)[XB_TMO], 1u); break; } } } } while (0)

struct XcdBarrier {
    unsigned* bar; unsigned x;
    volatile LAS unsigned* st;
};

__device__ __forceinline__ XcdBarrier xcd_barrier_post(unsigned* bar, volatile LAS unsigned* st) {
    XcdBarrier b; b.bar = bar; b.x = xb_xcc_id(); b.st = st;
    if (threadIdx.x == 0) (void)xb_add(&bar[XB_XCNT(b.x)], 1u);
    return b;
}
__device__ __forceinline__ void xcd_barrier_complete(unsigned* bar, unsigned x, unsigned& nloc, unsigned& nx) {
    const unsigned G = gridDim.x * gridDim.y * gridDim.z;
    unsigned sum, cnt, mine, sp = 0u;
    for (;;) {
        sum = 0u; cnt = 0u; mine = 0u;
#pragma unroll
        for (unsigned j = 0; j < 16; ++j) { const unsigned c = xb_ld(&bar[XB_XCNT(j)]); sum += c; cnt += (c > 0u) ? 1u : 0u; mine = (j == x) ? c : mine; }
        if (sum == G) break;
        __builtin_amdgcn_s_sleep(1);
        if ((++sp & 255u) == 0u) { if (xb_ld(&bar[XB_TMO])) break; if (sp > XB_SPIN_CAP) { atomicAdd(&bar[XB_TMO], 1u); break; } }
    }
    nloc = mine > 0u ? mine : 1u; nx = cnt > 0u ? cnt : 1u;
}

__device__ __forceinline__ void xcd_barrier(const XcdBarrier& b) {
    asm volatile("s_waitcnt vmcnt(0)" ::: "memory");
    __syncthreads();
    if (threadIdx.x == 0) {
        unsigned* bar = b.bar;
        __builtin_amdgcn_s_waitcnt(0);
        unsigned nloc = b.st[0], nx = b.st[1];
        if (nloc == 0u) { xcd_barrier_complete(bar, b.x, nloc, nx); b.st[0] = nloc; b.st[1] = nx; }
        const unsigned old = xb_add(&bar[XB_XSUB(b.x)], 1u);
        const unsigned gen = old / nloc;
        if (old + 1u == (gen + 1u) * nloc) {
            __builtin_amdgcn_fence(__ATOMIC_RELEASE, "agent");
            asm volatile("s_waitcnt vmcnt(0)" ::: "memory");
            const unsigned og = xb_add(&bar[XB_TOP], 1u);
            const unsigned tg = og / nx;
            if (og + 1u == (tg + 1u) * nx) xb_add(&bar[XB_TOPGEN], 1u);
            else XB_SPIN(xb_ld(&bar[XB_TOPGEN]) == tg, bar);
            __builtin_amdgcn_fence(__ATOMIC_ACQUIRE, "agent");
            xb_add(&bar[XB_XGEN(b.x)], 1u);
            asm volatile("s_waitcnt vmcnt(0)" ::: "memory");
        } else {
            XB_SPIN(xb_ld(&bar[XB_XGEN(b.x)]) == gen, bar);
            __builtin_amdgcn_fence(__ATOMIC_ACQUIRE, "agent");
            asm volatile("s_waitcnt vmcnt(0)" ::: "memory");
        }
    }
    __syncthreads();
}

__device__ __forceinline__ void p0_transpose_item(const float* W, int K, int N, bf16* WT, int ldk, int koff, LAS float* scr, int item, int lane) {
    const int nblk = N / 32, kb = item / nblk, nb = item % nblk, k0 = 64 * kb, n0 = 32 * nb;
#pragma unroll 8
    for (int i = 0; i < 32; ++i) { const int kk = 2 * i + (lane >> 5); scr[kk * 33 + (lane & 31)] = W[(size_t)(k0 + kk) * N + n0 + (lane & 31)]; }
    LDS_WAIT(); asm volatile("" ::: "memory");
    const int c = lane & 7;
#pragma unroll
    for (int j = 0; j < 4; ++j) { const int n = (lane >> 3) + 8 * j; const LAS float* s = scr + (8 * c) * 33 + n;
        v4u o; o.x = pk2(s[0 * 33], s[1 * 33]); o.y = pk2(s[2 * 33], s[3 * 33]); o.z = pk2(s[4 * 33], s[5 * 33]); o.w = pk2(s[6 * 33], s[7 * 33]);
#ifdef EMU_FP8_G2
        if (N == INW) { float f_[8];
            for (int e_ = 0; e_ < 8; e_ += 2) { int w_ = __builtin_amdgcn_cvt_pk_fp8_f32(s[e_ * 33] * 256.f, s[(e_ + 1) * 33] * 256.f, 0, false); const f32x2 l_ = __builtin_amdgcn_cvt_pk_f32_fp8(w_, false); f_[e_] = l_.x * (1.f / 256.f); f_[e_ + 1] = l_.y * (1.f / 256.f); }
            o.x = pk2(f_[0], f_[1]); o.y = pk2(f_[2], f_[3]); o.z = pk2(f_[4], f_[5]); o.w = pk2(f_[6], f_[7]); }
#endif
        *(GAS v4u*)(WT + (size_t)(n0 + n) * ldk + koff + k0 + 8 * c) = o; }
    LDS_WAIT(); asm volatile("" ::: "memory");
}
__device__ __forceinline__ void p0_mod_item(const float* c, const float* w_ada, const float* b_ada, float* modp, LAS float* red  , int item, int wave, int lane) {
    const int j = item * 64 + lane;
    float a0 = 0.f, a1 = 0.f, a2 = 0.f, a3 = 0.f;
#pragma unroll 8
    for (int k = 128 * wave; k < 128 * wave + 128; ++k) {
        const float w = w_ada[(size_t)k * 6144 + j];
        const float c0 = c[k], c1 = c[1024 + k], c2 = c[2048 + k], c3 = c[3072 + k];
        a0 += c0 / (1.f + __expf(-c0)) * w; a1 += c1 / (1.f + __expf(-c1)) * w; a2 += c2 / (1.f + __expf(-c2)) * w; a3 += c3 / (1.f + __expf(-c3)) * w;
    }
    red[(wave * 4 + 0) * 64 + lane] = a0; red[(wave * 4 + 1) * 64 + lane] = a1; red[(wave * 4 + 2) * 64 + lane] = a2; red[(wave * 4 + 3) * 64 + lane] = a3;
    LDS_WAIT(); __syncthreads();
    if (wave < 4) { float s = b_ada[j];
#pragma unroll
        for (int w = 0; w < 8; ++w) s += red[(w * 4 + wave) * 64 + lane];
        modp[wave * 6144 + j] = s; }
    __syncthreads();
}
__device__ __forceinline__ void p0_weff_item(const float* wq, const float* sk, bf16* weff, int item, int lane) {
    const int nq = item & 3, kb = (item >> 2) & 31, hp = item >> 7;
    const int k = kb * 32 + (lane & 31), dh = lane >> 5;
    float w[64];
    const f32x4* src = (const f32x4*)(wq + (size_t)k * 2048 + hp * 128 + 64 * dh);
#pragma unroll
    for (int i = 0; i < 16; ++i) { const f32x4 v = src[i]; w[4 * i] = v.x; w[4 * i + 1] = v.y; w[4 * i + 2] = v.z; w[4 * i + 3] = v.w; }
#pragma unroll 1
    for (int n = nq * 32; n < nq * 32 + 32; n += 2) {
        float acc[2] = {0.f, 0.f};
#pragma unroll
        for (int u = 0; u < 2; ++u) {
            const f32x4* s = (const f32x4*)(sk + ((size_t)hp * 128 + n + u) * 128 + 64 * dh);
#pragma unroll
            for (int d = 0; d < 16; ++d) { const f32x4 s4 = s[d]; acc[u] += w[4 * d] * s4.x; acc[u] += w[4 * d + 1] * s4.y; acc[u] += w[4 * d + 2] * s4.z; acc[u] += w[4 * d + 3] * s4.w; }
        }
#pragma unroll
        for (int u = 0; u < 2; ++u) { acc[u] += __shfl_xor(acc[u], 32); if (dh == 0) weff[((size_t)hp * 128 + n + u) * 1024 + k] = (bf16)f2bf(acc[u]); }
    }
}
template <int NR, bool BF_IN = false> __device__ __forceinline__ void rms_mod_rows(const void* xrow_, bf16* orow, unsigned* o8row  , const float* g, const float* sc, const float* sh, int lane) {
    f32x4 v[NR][4]; float ss[NR];
    if constexpr (BF_IN) {
        const bf16* xrow = (const bf16*)xrow_; v2u raw[NR][4];
#pragma unroll
        for (int rr = 0; rr < NR; ++rr) { const v2u* xr = (const v2u*)(xrow + (size_t)rr * 1024) + lane; ss[rr] = 0.f;
#pragma unroll
            for (int j = 0; j < 4; ++j) raw[rr][j] = xr[64 * j]; }
#pragma unroll
        for (int rr = 0; rr < NR; ++rr)
#pragma unroll
            for (int j = 0; j < 4; ++j) v[rr][j] = (f32x4){bflo(raw[rr][j].x), bfhi(raw[rr][j].x), bflo(raw[rr][j].y), bfhi(raw[rr][j].y)};
    } else {
        const float* xrow = (const float*)xrow_;
#pragma unroll
        for (int rr = 0; rr < NR; ++rr) { const f32x4* xr = (const f32x4*)(xrow + (size_t)rr * 1024) + lane; ss[rr] = 0.f;
#pragma unroll
            for (int j = 0; j < 4; ++j) v[rr][j] = xr[64 * j]; }
    }
#pragma unroll
    for (int rr = 0; rr < NR; ++rr)
#pragma unroll
        for (int j = 0; j < 4; ++j) ss[rr] += (v[rr][j].x * v[rr][j].x + v[rr][j].y * v[rr][j].y) + (v[rr][j].z * v[rr][j].z + v[rr][j].w * v[rr][j].w);
#pragma unroll
    for (int o = 1; o < 64; o <<= 1) {
#pragma unroll
        for (int rr = 0; rr < NR; ++rr) ss[rr] += __shfl_xor(ss[rr], o);
    }
#pragma unroll
    for (int j = 0; j < 4; ++j) { const int col = 4 * lane + 256 * j;
        const f32x4 g4 = *(const f32x4*)(g + col), s4 = *(const f32x4*)(sc + col), h4 = *(const f32x4*)(sh + col);
#pragma unroll
        for (int rr = 0; rr < NR; ++rr) {
            const float rstd = 1.f / sqrtf(ss[rr] * (1.f / 1024.f) + RMS_EPS);
            const float o0 = v[rr][j].x * rstd * g4.x * (1.f + s4.x) + h4.x, o1 = v[rr][j].y * rstd * g4.y * (1.f + s4.y) + h4.y;
            const float o2 = v[rr][j].z * rstd * g4.z * (1.f + s4.z) + h4.z, o3 = v[rr][j].w * rstd * g4.w * (1.f + s4.w) + h4.w;
            ((unsigned long long*)(orow + (size_t)rr * 1024))[lane + 64 * j] = (unsigned long long)pk2(o0, o1) | ((unsigned long long)pk2(o2, o3) << 32);
            if (o8row) { int w = 0; w = __builtin_amdgcn_cvt_pk_fp8_f32(fminf(fmaxf(o0 * 8.f, -448.f), 448.f), fminf(fmaxf(o1 * 8.f, -448.f), 448.f), w, false);
                w = __builtin_amdgcn_cvt_pk_fp8_f32(fminf(fmaxf(o2 * 8.f, -448.f), 448.f), fminf(fmaxf(o3 * 8.f, -448.f), 448.f), w, true); (o8row + (size_t)rr * 256)[lane + 64 * j] = (unsigned)w; }
        }
    }
}

__device__ __forceinline__ v4u pack8(const f32x4 a, const f32x4 b) { v4u w; w.x = pk2(a.x, a.y); w.y = pk2(a.z, a.w); w.z = pk2(b.x, b.y); w.w = pk2(b.z, b.w); return w; }
__device__ __forceinline__ size_t gt_off(int pm, int pt, int frag, int wave, int lane) { return ((((size_t)(pm * 8 + pt) * 16 + frag) * 8 + wave) * 64 + lane) * 8; }
struct EpiIn {
    static constexpr bool PERM = true, AFTER_DRAIN = false, HAS_MID = false;
    bf16 *Q, *K, *VT, *ZRKV, *ZLORA, *GT;
    __device__ __forceinline__ void operator()(const f32x4 (&acc)[2][2][4][2], const pg8::Unit& u, int wr, int wc, int fr, int fq) const {
        const int pn = u.pn;
#pragma unroll
        for (int ai = 0; ai < 2; ++ai)
#pragma unroll
            for (int m = 0; m < 4; ++m) {
                const int row = u.pm * 256 + ai * 128 + wr * 64 + m * 16 + fr;
                const int b = row >> 13, s = row & 8191;
#pragma unroll
                for (int bj = 0; bj < 2; ++bj) {
                    const int colt = bj * 128 + wc * 32 + 8 * fq;
                    const f32x4 v0 = acc[ai][bj][m][0], v1 = acc[ai][bj][m][1];
                    if (pn < 4) {
                        bf16* base = pn < 2 ? Q : K; const int h = 4 * (pn & 1) + (colt >> 6), d0 = colt & 63;
                        *(v4u*)(base + ((size_t)((b * 8 + h) * 8192 + s)) * 64 + d0) = pack8(v0, v1);
                    } else if (pn < 6) {
                        const int h = 4 * (pn - 4) + (colt >> 6), dv0 = colt & 63;
                        bf16* p = VT + ((size_t)((b * 8 + h) * 64 + dv0)) * 8192 + s;
                        p[0 * 8192] = (bf16)f2bf(v0.x); p[1 * 8192] = (bf16)f2bf(v0.y); p[2 * 8192] = (bf16)f2bf(v0.z); p[3 * 8192] = (bf16)f2bf(v0.w);
                        p[4 * 8192] = (bf16)f2bf(v1.x); p[5 * 8192] = (bf16)f2bf(v1.y); p[6 * 8192] = (bf16)f2bf(v1.z); p[7 * 8192] = (bf16)f2bf(v1.w);
                    } else if (pn < 12) {
                        *(v4u*)(ZRKV + (size_t)row * ZR + 256 * (pn - 6) + colt) = pack8(v0, v1);
                    } else if (pn == 12) {
                        *(v4u*)(ZLORA + (size_t)row * ZL + colt) = pack8(v0, v1);
                    } else {
                        f32x4 s0, s1;
                        s0.x = sigmoidf_(v0.x); s0.y = sigmoidf_(v0.y); s0.z = sigmoidf_(v0.z); s0.w = sigmoidf_(v0.w);
                        s1.x = sigmoidf_(v1.x); s1.y = sigmoidf_(v1.y); s1.z = sigmoidf_(v1.z); s1.w = sigmoidf_(v1.w);
                        *(v4u*)(GT + gt_off(u.pm, pn - 13, 0, wr * 4 + wc, fq * 16 + fr) + (size_t)(((ai * 4 + m) * 2 + bj) * 4096)) = pack8(s0, s1);
                    }
                }
            }
    }
};
struct EpiLora {
    static constexpr bool PERM = true, AFTER_DRAIN = false, HAS_MID = false;
    bf16 *EW, *AA, *GG; const float *w0, *a0;
    __device__ __forceinline__ void operator()(const f32x4 (&acc)[2][2][4][2], const pg8::Unit& u, int wr, int wc, int fr, int fq) const {
        const int pn = u.pn;
#pragma unroll
        for (int ai = 0; ai < 2; ++ai)
#pragma unroll
            for (int m = 0; m < 4; ++m) {
                const int row = u.pm * 256 + ai * 128 + wr * 64 + m * 16 + fr;
#pragma unroll
                for (int bj = 0; bj < 2; ++bj) {
                    const int c = 256 * (pn & 1) + bj * 128 + wc * 32 + 8 * fq;
                    const f32x4 v0 = acc[ai][bj][m][0], v1 = acc[ai][bj][m][1];
                    float v[8] = {v0.x, v0.y, v0.z, v0.w, v1.x, v1.y, v1.z, v1.w};
                    bf16* dst;
                    if (pn < 2) {
#pragma unroll
                        for (int i = 0; i < 8; ++i) v[i] = 0.60653065971263342f * sigmoidf_(w0[c + i] + v[i]);
                        dst = EW;
                    } else if (pn < 4) {
#pragma unroll
                        for (int i = 0; i < 8; ++i) v[i] = sigmoidf_(a0[c + i] + v[i]);
                        dst = AA;
                    } else dst = GG;
                    v4u w; w.x = pk2(v[0], v[1]); w.y = pk2(v[2], v[3]); w.z = pk2(v[4], v[5]); w.w = pk2(v[6], v[7]);
                    *(v4u*)(dst + (size_t)row * 512 + c) = w;
                }
            }
    }
};
struct EpiMix {
    static constexpr bool PERM = true, AFTER_DRAIN = false, HAS_MID = true; static constexpr int MID_T = 8;
    const bf16* GT; bf16* MIXED; int probe;
    __device__ __forceinline__ void mid(f32x4 (&acc)[2][2][4][2], const pg8::Unit& u, int wr, int wc, int fr, int fq) const {
        if (probe & 1) return;
        const bf16* pm_ = GT + gt_off(u.pm, u.pn, 0, wr * 4 + wc, fq * 16 + fr); const bf16* pr_ = GT + gt_off(u.pm, u.pn + 4, 0, wr * 4 + wc, fq * 16 + fr);
#pragma unroll
        for (int ai = 0; ai < 2; ++ai)
#pragma unroll
            for (int m = 0; m < 4; ++m)
#pragma unroll
                for (int bj = 0; bj < 2; ++bj) {
                    const v4u gm = *(const v4u*)pm_, gr = *(const v4u*)pr_;
                    pm_ += 4096; pr_ += 4096; asm volatile("" : "+v"(pm_), "+v"(pr_));
                    f32x4 r0, r1;
                    r0.x = bflo(gm.x) * __builtin_amdgcn_rcpf(fmaxf(bflo(gr.x), 1e-30f)); r0.y = bfhi(gm.x) * __builtin_amdgcn_rcpf(fmaxf(bfhi(gr.x), 1e-30f));
                    r0.z = bflo(gm.y) * __builtin_amdgcn_rcpf(fmaxf(bflo(gr.y), 1e-30f)); r0.w = bfhi(gm.y) * __builtin_amdgcn_rcpf(fmaxf(bfhi(gr.y), 1e-30f));
                    r1.x = bflo(gm.z) * __builtin_amdgcn_rcpf(fmaxf(bflo(gr.z), 1e-30f)); r1.y = bfhi(gm.z) * __builtin_amdgcn_rcpf(fmaxf(bfhi(gr.z), 1e-30f));
                    r1.z = bflo(gm.w) * __builtin_amdgcn_rcpf(fmaxf(bflo(gr.w), 1e-30f)); r1.w = bfhi(gm.w) * __builtin_amdgcn_rcpf(fmaxf(bfhi(gr.w), 1e-30f));
                    acc[ai][bj][m][0] = acc[ai][bj][m][0] * r0; acc[ai][bj][m][1] = acc[ai][bj][m][1] * r1;
                }
    }
    __device__ __forceinline__ void operator()(const f32x4 (&acc)[2][2][4][2], const pg8::Unit& u, int wr, int wc, int fr, int fq) const {
        const bf16* pr_ = GT + gt_off(u.pm, u.pn + 4, 0, wr * 4 + wc, fq * 16 + fr);
#pragma unroll
        for (int ai = 0; ai < 2; ++ai)
#pragma unroll
            for (int m = 0; m < 4; ++m) {
                const int row = u.pm * 256 + ai * 128 + wr * 64 + m * 16 + fr;
#pragma unroll
                for (int bj = 0; bj < 2; ++bj) {
                    const int c = u.pn * 256 + bj * 128 + wc * 32 + 8 * fq;
                    v4u g = {0x3f803f80u, 0x3f803f80u, 0x3f803f80u, 0x3f803f80u};
                    if (!(probe & 2)) g = *(const v4u*)pr_;
                    pr_ += 4096; asm volatile("" : "+v"(pr_));
                    const f32x4 v0 = acc[ai][bj][m][0], v1 = acc[ai][bj][m][1];
                    f32x4 o0, o1;
                    o0.x = bflo(g.x) * v0.x; o0.y = bfhi(g.x) * v0.y; o0.z = bflo(g.y) * v0.z; o0.w = bfhi(g.y) * v0.w;
                    o1.x = bflo(g.z) * v1.x; o1.y = bfhi(g.z) * v1.y; o1.z = bflo(g.w) * v1.z; o1.w = bfhi(g.w) * v1.w;
                    *(v4u*)(MIXED + (size_t)row * 1024 + c) = pack8(o0, o1);
                }
            }
    }
};
struct EpiOut {
    static constexpr bool PERM = true, AFTER_DRAIN = false, HAS_MID = false;
    const float* X; const float* MOD; bf16* OUT;
    __device__ __forceinline__ void operator()(const f32x4 (&acc)[2][2][4][2], const pg8::Unit& u, int wr, int wc, int fr, int fq) const {
#pragma unroll
        for (int ai = 0; ai < 2; ++ai)
#pragma unroll
            for (int m = 0; m < 4; ++m) {
                const int row = u.pm * 256 + ai * 128 + wr * 64 + m * 16 + fr;
                const float* gt1 = MOD + (size_t)(row >> 13) * 6144 + 2048;
#pragma unroll
                for (int bj = 0; bj < 2; ++bj) {
                    const int c = u.pn * 256 + bj * 128 + wc * 32 + 8 * fq;
                    const float* xp = X + (size_t)row * 1024 + c;
                    const f32x4 x0 = *(const f32x4*)xp, x1 = *(const f32x4*)(xp + 4);
                    const f32x4 g0 = *(const f32x4*)(gt1 + c), g1 = *(const f32x4*)(gt1 + c + 4);
                    const f32x4 v0 = acc[ai][bj][m][0], v1 = acc[ai][bj][m][1];
                    *(v4u*)(OUT + (size_t)row * 1024 + c) = pack8(x0 + g0 * v0, x1 + g1 * v1);
                }
            }
    }
};
struct EpiScores {
    static constexpr bool PERM = true, AFTER_DRAIN = false, HAS_MID = false;
    bf16* SC;
    __device__ __forceinline__ void operator()(const f32x4 (&acc)[2][2][4][2], const pg8::Unit& u, int wr, int wc, int fr, int fq) const {
#pragma unroll
        for (int ai = 0; ai < 2; ++ai)
#pragma unroll
            for (int m = 0; m < 4; ++m) {
                const int row = u.pm * 256 + ai * 128 + wr * 64 + m * 16 + fr;
#pragma unroll
                for (int bj = 0; bj < 2; ++bj) {
                    const int c = u.pn * 256 + bj * 128 + wc * 32 + 8 * fq;
                    *(v4u*)(SC + (size_t)row * 2048 + c) = pack8(acc[ai][bj][m][0], acc[ai][bj][m][1]);
                }
            }
    }
};


__device__ __forceinline__ void p2_qk_load(v4u (&raw)[4], int (&ps)[4], const bf16* buf, const int* pos, int bh, int n, int wave, int lane) {
#pragma unroll
    for (int it = 0; it < 4; ++it) { const int row = n * 256 + wave * 32 + it * 8 + (lane >> 3);
        raw[it] = *(const v4u*)(buf + ((size_t)(bh * 8192 + row)) * 64 + 8 * (lane & 7)); ps[it] = pos[(bh >> 3) * 8192 + row]; }
}
__device__ __forceinline__ void p2_qk_item(const v4u (&rawin)[4], const int (&psin)[4], bf16* obuf, const float* g, float* kmean, int bh, int n, LAS float* red, int tid, int wave, int lane) {
    const int c = lane & 7, rsub = lane >> 3;
    float gg[8], ks[8];
#pragma unroll
    for (int i = 0; i < 8; ++i) { gg[i] = g[8 * c + i]; ks[i] = 0.f; }
#pragma unroll
    for (int it = 0; it < 4; ++it) {
        const int row = n * 256 + wave * 32 + it * 8 + rsub;
        const size_t po = ((size_t)(bh * 8192 + row)) * 64 + 8 * c;
        const v4u raw = rawin[it];
        float x[8] = {bflo(raw.x), bfhi(raw.x), bflo(raw.y), bfhi(raw.y), bflo(raw.z), bfhi(raw.z), bflo(raw.w), bfhi(raw.w)};
        float ss = 0.f;
#pragma unroll
        for (int i = 0; i < 8; ++i) ss += x[i] * x[i];
        ss += __shfl_xor(ss, 1); ss += __shfl_xor(ss, 2); ss += __shfl_xor(ss, 4);
        const float rstd = 1.f / sqrtf(ss * (1.f / 64.f) + RMS_EPS);
        float y[8], py[8];
#pragma unroll
        for (int i = 0; i < 8; ++i) y[i] = x[i] * rstd * gg[i];
#pragma unroll
        for (int i = 0; i < 8; ++i) py[i] = __shfl_xor(y[i], 1);
        {
            const float myang = (float)psin[it] * exp2f(-(float)c * (18.931568569324174f / 8.f));
            const float mys = __sinf(myang), myc = __cosf(myang);
            float sn[8], cs[8];
#pragma unroll
            for (int i = 0; i < 8; ++i) { sn[i] = __shfl(mys, (lane & ~7) + i); cs[i] = __shfl(myc, (lane & ~7) + i); }
            if (c < 2) {
#pragma unroll
                for (int i = 0; i < 8; ++i) y[i] = (c == 0) ? (y[i] * cs[i] - py[i] * sn[i]) : (y[i] * cs[i] + py[i] * sn[i]);
            }
        }
        v4u o; o.x = pk2(y[0], y[1]); o.y = pk2(y[2], y[3]); o.z = pk2(y[4], y[5]); o.w = pk2(y[6], y[7]);
        *(v4u*)(obuf + po) = o;
#pragma unroll
        for (int i = 0; i < 8; ++i) ks[i] += y[i];
    }
    if (kmean) {
#pragma unroll
        for (int i = 0; i < 8; ++i) { ks[i] += __shfl_xor(ks[i], 8); ks[i] += __shfl_xor(ks[i], 16); ks[i] += __shfl_xor(ks[i], 32); }
        if (lane < 8) {
#pragma unroll
            for (int i = 0; i < 8; ++i) red[wave * 64 + 8 * lane + i] = ks[i];
        }
        __syncthreads();
        if (tid < 64) { float s = 0.f;
#pragma unroll
            for (int w = 0; w < 8; ++w) s += red[w * 64 + tid];
            kmean[(size_t)(bh * 32 + n) * 64 + tid] = s * (1.f / 256.f); }
        __syncthreads();
    }
}
__device__ __forceinline__ void p2_prep(const bf16* ZL_, const float* mu, bf16* AL, int gtid, int ntot) {
#pragma unroll 2
    for (int idx = gtid; idx < T * 32; idx += ntot) {
        const int t = idx >> 5, col = (idx & 31) * 8, s = t & 8191;
        const v4u cur = *(const v4u*)(ZL_ + (size_t)t * ZL + col);
        v4u prv = *(const v4u*)(ZL_ + (size_t)(s ? t - 1 : t) * ZL + col);
        prv = prv & (s ? 0xffffffffu : 0u);
        const float cz[8] = {bflo(cur.x), bfhi(cur.x), bflo(cur.y), bfhi(cur.y), bflo(cur.z), bfhi(cur.z), bflo(cur.w), bfhi(cur.w)};
        const float pz[8] = {bflo(prv.x), bfhi(prv.x), bflo(prv.y), bfhi(prv.y), bflo(prv.z), bfhi(prv.z), bflo(prv.w), bfhi(prv.w)};
        float o[8];
#pragma unroll
        for (int i = 0; i < 8; ++i) { const float z = cz[i] + (pz[i] - cz[i]) * mu[1536 + col + i];
            o[i] = (col < 64) ? tanhf(z) : ((col < 128) ? z : sigmoidf_(z)); }
        v4u w; w.x = pk2(o[0], o[1]); w.y = pk2(o[2], o[3]); w.z = pk2(o[4], o[5]); w.w = pk2(o[6], o[7]);
        *(v4u*)(AL + (size_t)t * ZL + col) = w;
    }
}

__device__ __forceinline__ void p3_top3_item(const bf16* Q, const float* kmean, unsigned* cursor, unsigned* lists, int bh0, int qb, LAS float* kmbase, int tid, int wave, int lane) {
    if (qb == 0) return;
    const int hf = wave >> 2, bh = bh0 + hf, w4 = wave & 3;
    LAS float* km = kmbase + hf * 2048;
    for (int i = (tid & 255); i < qb * 64; i += 256) km[i] = kmean[(size_t)bh * 2048 + i];
    __syncthreads();
    {
        const int s = qb * 256 + w4 * 64 + lane;
        float q[64];
        const v4u* qp = (const v4u*)(Q + ((size_t)(bh * 8192 + s)) * 64);
#pragma unroll
        for (int i = 0; i < 8; ++i) { const v4u r = qp[i];
            q[8 * i] = bflo(r.x); q[8 * i + 1] = bfhi(r.x); q[8 * i + 2] = bflo(r.y); q[8 * i + 3] = bfhi(r.y);
            q[8 * i + 4] = bflo(r.z); q[8 * i + 5] = bfhi(r.z); q[8 * i + 6] = bflo(r.w); q[8 * i + 7] = bfhi(r.w); }
        float v0 = -INFINITY, v1 = -INFINITY, v2 = -INFINITY; int i0 = -1, i1 = -1, i2 = -1;
        for (int n = 0; n < qb; ++n) {
            float dot = 0.f;
#pragma unroll
            for (int d4 = 0; d4 < 16; ++d4) { const f32x4 kk = *(const LAS f32x4*)(km + n * 64 + 4 * d4);
                dot += q[4 * d4] * kk.x; dot += q[4 * d4 + 1] * kk.y; dot += q[4 * d4 + 2] * kk.z; dot += q[4 * d4 + 3] * kk.w; }
            if (dot > v0) { v2 = v1; i2 = i1; v1 = v0; i1 = i0; v0 = dot; i0 = n; }
            else if (dot > v1) { v2 = v1; i2 = i1; v1 = dot; i1 = n; }
            else if (dot > v2) { v2 = dot; i2 = n; }
        }
        for (int n = 0; n < qb; ++n) {
            const int slot = (i0 == n) ? 0 : ((i1 == n) ? 1 : ((i2 == n) ? 2 : -1));
            const unsigned long long mask = __ballot(slot >= 0);
            if (mask == 0ull) continue;
            const unsigned cnt = (unsigned)__popcll(mask);
            unsigned base = 0u;
            if (lane == 0) base = __hip_atomic_fetch_add(cursor + bh * 32 + n, cnt, RLX_AGENT);
            base = (unsigned)__shfl((int)base, 0);
            if (slot >= 0) { const unsigned pos = base + (unsigned)__popcll(mask & ((1ull << lane) - 1ull));
                lists[(size_t)bh * LIST_PER_BH + list_off(n) + pos] = ((unsigned)s << 2) | (unsigned)slot; }
        }
    }
    __syncthreads();
}

template <int CTRL> __device__ __forceinline__ float dppf(float v) { return __builtin_bit_cast(float, __builtin_amdgcn_update_dpp(0, __builtin_bit_cast(int, v), CTRL, 0xF, 0xF, true)); }
__device__ __forceinline__ float allreduce16(float v) {
    v += dppf<0xB1>(v); v += dppf<0x4E>(v); v += dppf<0x141>(v); v += dppf<0x140>(v); return v;
}
constexpr int CK = 64, NCHK = SEQ / CK, CS = 72, SLOT = CK * CS;
__device__ __forceinline__ int sx(int row, int col) { return row * CS + (((col >> 3) ^ ((row >> 4) & 3)) << 3) + (col & 7); }
struct ScanRaw { v4u zr, zk, zv, pr, pk, pv, a, ew; };
__device__ __forceinline__ void scan_load(ScanRaw& R, const bf16* Z, const bf16* AA, const bf16* EW, int b, int hc0, int t) {
    const bf16* p = Z + (size_t)(b * 8192 + t) * ZR + hc0;
    const bf16* pp = (t > 0) ? p - ZR : p;
    R.zr = *(const v4u*)p; R.zk = *(const v4u*)(p + 512); R.zv = *(const v4u*)(p + 1024);
    R.pr = *(const v4u*)pp; R.pk = *(const v4u*)(pp + 512); R.pv = *(const v4u*)(pp + 1024);
    const unsigned m = (t > 0) ? 0xffffffffu : 0u;
    R.pr = R.pr & m; R.pk = R.pk & m; R.pv = R.pv & m;
    const size_t o = (size_t)(b * 8192 + t) * 512 + hc0;
    R.a = *(const v4u*)(AA + o); R.ew = *(const v4u*)(EW + o);
}
__device__ __forceinline__ void unpack8(const v4u w, float (&f)[8]) { f[0] = bflo(w.x); f[1] = bfhi(w.x); f[2] = bflo(w.y); f[3] = bfhi(w.y); f[4] = bflo(w.z); f[5] = bfhi(w.z); f[6] = bflo(w.w); f[7] = bfhi(w.w); }
__device__ __forceinline__ v4u pack8f(const float (&f)[8]) { v4u w; w.x = cvtpk(f[0], f[1]); w.y = cvtpk(f[2], f[3]); w.z = cvtpk(f[4], f[5]); w.w = cvtpk(f[6], f[7]); return w; }
__device__ __forceinline__ f32x4 mm_tile(const LAS bf16* A, const LAS bf16* BT, int mt, int nt, int r, int q, f32x4 acc) {
#pragma unroll
    for (int ks = 0; ks < 2; ++ks) {
        const bf16x8 a = *(const LAS bf16x8*)(A + sx(16 * mt + r, 32 * ks + 8 * q));
        const bf16x8 b = *(const LAS bf16x8*)(BT + sx(16 * nt + r, 32 * ks + 8 * q));
        acc = __builtin_amdgcn_mfma_f32_16x16x32_bf16(a, b, acc, 0, 0, 0);
    }
    return acc;
}
struct PairF { bf16x8 b0, b1, a00, a01, a10, a11; };
__device__ __forceinline__ void mm_load(PairF& f, const LAS bf16* A, const LAS bf16* BT, int mt, int nt, int r, int q) {
    f.b0 = *(const LAS bf16x8*)(BT + sx(16 * nt + r, 8 * q)); f.b1 = *(const LAS bf16x8*)(BT + sx(16 * nt + r, 32 + 8 * q));
    f.a00 = *(const LAS bf16x8*)(A + sx(16 * mt + r, 8 * q)); f.a01 = *(const LAS bf16x8*)(A + sx(16 * mt + r, 32 + 8 * q));
    f.a10 = *(const LAS bf16x8*)(A + sx(16 * mt + 32 + r, 8 * q)); f.a11 = *(const LAS bf16x8*)(A + sx(16 * mt + 32 + r, 32 + 8 * q));
}
__device__ __forceinline__ void mm_mul(const PairF& f, f32x4& c0, f32x4& c1) {
    c0 = __builtin_amdgcn_mfma_f32_16x16x32_bf16(f.a00, f.b0, c0, 0, 0, 0); c1 = __builtin_amdgcn_mfma_f32_16x16x32_bf16(f.a10, f.b0, c1, 0, 0, 0);
    c0 = __builtin_amdgcn_mfma_f32_16x16x32_bf16(f.a01, f.b1, c0, 0, 0, 0); c1 = __builtin_amdgcn_mfma_f32_16x16x32_bf16(f.a11, f.b1, c1, 0, 0, 0);
}
__device__ __forceinline__ void mm_pair(const LAS bf16* A, const LAS bf16* BT, int mt, int nt, int r, int q, f32x4& c0, f32x4& c1) { PairF f; mm_load(f, A, BT, mt, nt, r, q); mm_mul(f, c0, c1); }
__device__ __forceinline__ void st_T(LAS bf16* D, int mt, int nt, int r, int q, const f32x4 v) {
    v2u w; w.x = cvtpk(v.x, v.y); w.y = cvtpk(v.z, v.w);
    *(LAS v2u*)(D + sx(16 * nt + r, 16 * mt + 4 * q)) = w;
}
__device__ __forceinline__ void st_Tg(bf16* D  , int mt, int nt, int r, int q, const f32x4 v) {
    v2u w; w.x = cvtpk(v.x, v.y); w.y = cvtpk(v.z, v.w);
    *(v2u*)(D + (16 * nt + r) * 64 + 16 * mt + 4 * q) = w;
}
__device__ __forceinline__ void st_Tf(bf16* D, int mt, int nt, int r, int q, const f32x4 v) {
    v2u w; w.x = cvtpk(v.x, v.y); w.y = cvtpk(v.z, v.w);
    *(v2u*)(D + nt * 1024 + ((2 * (mt & 1) + (q >> 1)) * 16 + r) * 16 + (mt >> 1) * 8 + 4 * (q & 1)) = w;
}
__device__ __forceinline__ void st_Te(bf16* D, int mt, int nt, int r, int q, const f32x4 v) {
    v2u w; w.x = cvtpk(v.x, v.y); w.y = cvtpk(v.z, v.w);
    *(v2u*)(D + ((nt * 4 + mt) * 64 + q * 16 + r) * 4) = w;
}
__device__ __forceinline__ f32x4 mask_lt(f32x4 v, int R0, int Cc, bool incl) {
    const int lim = incl ? Cc + 1 : Cc;
    v.x = (R0 < lim) ? v.x : 0.f; v.y = (R0 + 1 < lim) ? v.y : 0.f; v.z = (R0 + 2 < lim) ? v.z : 0.f; v.w = (R0 + 3 < lim) ? v.w : 0.f; return v;
}
__device__ __forceinline__ void rwkv_cp_item(const bf16* Z, const bf16* AAg, const bf16* EWg, const float* mu, const float* k_k, const float* k_a,
                                             bf16* RW, bf16* MM, bf16* Y0T, bf16* GAT, float* PC, int chain, int c, ScanRaw& R, int nchain, int nc, LAS unsigned char* lds, int tid, int wave, int lane, int probe) {
    LAS bf16* S_ = (LAS bf16*)lds;
#define SL(k) (S_ + (k) * SLOT)
    const LAS float* lco = (const LAS float*)(lds + 14 * SLOT * 2);
    LAS float* Ef = (LAS float*)(SL(12));
    LAS float* Red = (LAS float*)(SL(8));
    LAS float* Seg = Red + 8 * 64;
    constexpr int EFS = 68;
    const int b = chain >> 3, h = chain & 7;
    const int r = lane & 15, q = lane >> 4;
    __syncthreads();
    const int t = tid >> 3, c0 = (tid & 7) * 8, hc0 = h * 64 + c0;
    float rr[8], k2[8], al[8], be[8], vv[8], kkr[8], aa[8];
    {
        float zr[8], zk[8], zv[8], pr[8], pk[8], pv[8], a[8], ew[8];
        unpack8(R.zr, zr); unpack8(R.zk, zk); unpack8(R.zv, zv); unpack8(R.pr, pr); unpack8(R.pk, pk); unpack8(R.pv, pv); unpack8(R.a, a); unpack8(R.ew, ew);
        float ss = 0.f;
#pragma unroll
        for (int i = 0; i < 8; ++i) { aa[i] = a[i]; rr[i] = zr[i] + (pr[i] - zr[i]) * lco[hc0 + i]; const float k = zk[i] + (pk[i] - zk[i]) * lco[512 + hc0 + i]; vv[i] = zv[i] + (pv[i] - zv[i]) * lco[1024 + hc0 + i];
            kkr[i] = k * lco[1536 + hc0 + i]; ss += kkr[i] * kkr[i]; k2[i] = k * (1.f + (a[i] - 1.f) * lco[2048 + hc0 + i]); }
        asm volatile("" :: "v"(ss), "v"(rr[7]), "v"(vv[7]), "v"(k2[7]));
        scan_load(R, Z, AAg, EWg, nchain >> 3, (nchain & 7) * 64 + c0, nc * CK + t);
        ss += dppf<0xB1>(ss); ss += dppf<0x4E>(ss); ss += dppf<0x141>(ss);
        if ((tid & 7) == 0) Red[t] = ss;
        *(LAS f32x4*)(Ef + t * EFS + c0) = (f32x4){ew[0], ew[1], ew[2], ew[3]}; *(LAS f32x4*)(Ef + t * EFS + c0 + 4) = (f32x4){ew[4], ew[5], ew[6], ew[7]};
    }
    LDS_WAIT(); __syncthreads();
    {
        const int seg = tid >> 6, j = tid & 63; float s = 0.f;
#pragma unroll
        for (int u = 0; u < 8; ++u) { s += Ef[(8 * seg + u) * EFS + j]; Ef[(8 * seg + u) * EFS + j] = s; }
        Seg[seg * 64 + j] = s;
    }
    LDS_WAIT(); __syncthreads();
    {
        { const float ss = Red[t];
          const float inrm = 1.f / fmaxf(sqrtf(ss), 1e-12f);
#pragma unroll
          for (int i = 0; i < 8; ++i) { const float kk = kkr[i] * inrm; al[i] = -kk; be[i] = kk * aa[i]; } }
        float off[8], Et[8], Ep[8];
#pragma unroll
        for (int i = 0; i < 8; ++i) off[i] = 0.f;
        for (int sg = 0; sg < (t >> 3); ++sg) {
            const f32x4 s0 = *(const LAS f32x4*)(Seg + sg * 64 + c0), s1 = *(const LAS f32x4*)(Seg + sg * 64 + c0 + 4);
            off[0] += s0.x; off[1] += s0.y; off[2] += s0.z; off[3] += s0.w; off[4] += s1.x; off[5] += s1.y; off[6] += s1.z; off[7] += s1.w;
        }
        { const f32x4 e0 = *(const LAS f32x4*)(Ef + t * EFS + c0), e1 = *(const LAS f32x4*)(Ef + t * EFS + c0 + 4);
          Et[0] = e0.x + off[0]; Et[1] = e0.y + off[1]; Et[2] = e0.z + off[2]; Et[3] = e0.w + off[3]; Et[4] = e1.x + off[4]; Et[5] = e1.y + off[5]; Et[6] = e1.z + off[6]; Et[7] = e1.w + off[7]; }
        if (t & 7) { const f32x4 e0 = *(const LAS f32x4*)(Ef + (t - 1) * EFS + c0), e1 = *(const LAS f32x4*)(Ef + (t - 1) * EFS + c0 + 4);
          Ep[0] = e0.x + off[0]; Ep[1] = e0.y + off[1]; Ep[2] = e0.z + off[2]; Ep[3] = e0.w + off[3]; Ep[4] = e1.x + off[4]; Ep[5] = e1.y + off[5]; Ep[6] = e1.z + off[6]; Ep[7] = e1.w + off[7]; }
        else {
#pragma unroll
            for (int i = 0; i < 8; ++i) Ep[i] = off[i];
        }
        float at[8], bt[8], kt[8], rt[8];
#pragma unroll
        for (int i = 0; i < 8; ++i) { const float ep = __expf(Et[i]), en = __expf(-Et[i]); at[i] = al[i] * __expf(-Ep[i]); bt[i] = be[i] * ep; kt[i] = k2[i] * ep; rt[i] = rr[i] * en; }
        *(LAS v4u*)(SL(0) + sx(t, c0)) = pack8f(at); *(LAS v4u*)(SL(1) + sx(t, c0)) = pack8f(bt); *(LAS v4u*)(SL(2) + sx(t, c0)) = pack8f(kt); *(LAS v4u*)(SL(3) + sx(t, c0)) = pack8f(rt);
#pragma unroll
        for (int i = 0; i < 8; ++i) { SL(4)[sx(c0 + i, t)] = (bf16)f2bf(at[i]); SL(5)[sx(c0 + i, t)] = (bf16)f2bf(bt[i]); SL(6)[sx(c0 + i, t)] = (bf16)f2bf(kt[i]); SL(7)[sx(c0 + i, t)] = (bf16)f2bf(vv[i]); }
        if (t == CK - 1) { *(f32x4*)(PC + c0) = (f32x4){__expf(-Et[0]), __expf(-Et[1]), __expf(-Et[2]), __expf(-Et[3])}; *(f32x4*)(PC + c0 + 4) = (f32x4){__expf(-Et[4]), __expf(-Et[5]), __expf(-Et[6]), __expf(-Et[7])}; }
    }
    LDS_WAIT(); __syncthreads();
    if (probe == 4) return;
    const f32x4 z4 = {0.f, 0.f, 0.f, 0.f};
    const int mt = wave >> 2, nt = wave & 3, Cc = 16 * nt + r, R0 = 16 * mt + 4 * q, R1 = R0 + 32;
    { PairF f0, f1, f2, f3, f4;
      mm_load(f0, SL(0), SL(1), mt, nt, r, q); mm_load(f1, SL(1), SL(0), mt, nt, r, q); mm_load(f2, SL(2), SL(0), mt, nt, r, q); mm_load(f3, SL(1), SL(3), mt, nt, r, q); mm_load(f4, SL(2), SL(3), mt, nt, r, q);
      f32x4 a0 = z4, a1 = z4, b0 = z4, b1 = z4, c0 = z4, c1 = z4, d0 = z4, d1 = z4, e0 = z4, e1 = z4;
      mm_mul(f0, a0, a1); mm_mul(f1, b0, b1); mm_mul(f2, c0, c1); mm_mul(f3, d0, d1); mm_mul(f4, e0, e1);
      a0.x = (Cc < R0) ? a0.x : 0.f; a0.y = (Cc < R0 + 1) ? a0.y : 0.f; a0.z = (Cc < R0 + 2) ? a0.z : 0.f; a0.w = (Cc < R0 + 3) ? a0.w : 0.f;
      a1.x = (Cc < R1) ? a1.x : 0.f; a1.y = (Cc < R1 + 1) ? a1.y : 0.f; a1.z = (Cc < R1 + 2) ? a1.z : 0.f; a1.w = (Cc < R1 + 3) ? a1.w : 0.f;
      st_T(SL(12), mt, nt, r, q, a0); st_T(SL(12), mt + 2, nt, r, q, a1);
      b0 = mask_lt(b0, R0, Cc, false); b1 = mask_lt(b1, R1, Cc, false);
      st_T(SL(11), mt, nt, r, q, b0); st_T(SL(11), mt + 2, nt, r, q, b1);
      b0.x += (R0 == Cc) ? 1.f : 0.f; b0.y += (R0 + 1 == Cc) ? 1.f : 0.f; b0.z += (R0 + 2 == Cc) ? 1.f : 0.f; b0.w += (R0 + 3 == Cc) ? 1.f : 0.f;
      b1.x += (R1 == Cc) ? 1.f : 0.f; b1.y += (R1 + 1 == Cc) ? 1.f : 0.f; b1.z += (R1 + 2 == Cc) ? 1.f : 0.f; b1.w += (R1 + 3 == Cc) ? 1.f : 0.f;
      st_T(SL(13), mt, nt, r, q, b0); st_T(SL(13), mt + 2, nt, r, q, b1);
      st_T(SL(8), mt, nt, r, q, mask_lt(c0, R0, Cc, false)); st_T(SL(8), mt + 2, nt, r, q, mask_lt(c1, R1, Cc, false));
      st_T(SL(9), mt, nt, r, q, mask_lt(d0, R0, Cc, true)); st_T(SL(9), mt + 2, nt, r, q, mask_lt(d1, R1, Cc, true));
      st_T(SL(10), mt, nt, r, q, mask_lt(e0, R0, Cc, true)); st_T(SL(10), mt + 2, nt, r, q, mask_lt(e1, R1, Cc, true)); }
    LDS_WAIT(); __syncthreads();
    if (probe == 3) return;
    for (int m = (probe == 2 ? 6 : 0); m < 6; ++m) {
        const int ln = (m & 1) ? 0 : 11, ltn = ln + 1, l2 = (m & 1) ? 11 : 0;
        const int tsrc = (m & 1) ? 13 : 2, tdst = (m & 1) ? 2 : 13;
        PairF f0, f1, f2; v2u o0 = {0u, 0u}, o1 = {0u, 0u};
        if (m < 5) { mm_load(f0, SL(ltn), SL(ln), mt, nt, r, q); mm_load(f1, SL(ln), SL(ltn), mt, nt, r, q); }
        if (m >= 1) { mm_load(f2, SL(ltn), SL(tsrc), mt, nt, r, q);
            o0 = *(const LAS v2u*)(SL(tsrc) + sx(16 * nt + r, 16 * mt + 4 * q)); o1 = *(const LAS v2u*)(SL(tsrc) + sx(16 * nt + r, 16 * mt + 32 + 4 * q)); }
        if (m < 5) { f32x4 a0 = z4, a1 = z4, b0 = z4, b1 = z4; mm_mul(f0, a0, a1); mm_mul(f1, b0, b1);
            st_T(SL(l2), mt, nt, r, q, a0); st_T(SL(l2), mt + 2, nt, r, q, a1);
            st_T(SL(l2 + 1), mt, nt, r, q, b0); st_T(SL(l2 + 1), mt + 2, nt, r, q, b1); }
        if (m >= 1) { f32x4 c0 = {bflo(o0.x), bfhi(o0.x), bflo(o0.y), bfhi(o0.y)}, c1 = {bflo(o1.x), bfhi(o1.x), bflo(o1.y), bfhi(o1.y)};
            mm_mul(f2, c0, c1); st_T(SL(tdst), mt, nt, r, q, c0); st_T(SL(tdst), mt + 2, nt, r, q, c1); }
        LDS_WAIT(); __syncthreads();
    }
    { PairF f0, f1; mm_load(f0, SL(2), SL(4), mt, nt, r, q); mm_load(f1, SL(8), SL(7), mt, nt, r, q);
      f32x4 a0 = z4, a1 = z4, b0 = z4, b1 = z4; mm_mul(f0, a0, a1); mm_mul(f1, b0, b1);
      st_T(SL(11), mt, nt, r, q, a0); st_T(SL(11), mt + 2, nt, r, q, a1);
      st_T(SL(12), mt, nt, r, q, b0); st_T(SL(12), mt + 2, nt, r, q, b1); }
    LDS_WAIT(); __syncthreads();
    { PairF f0, f1, f2; mm_load(f0, SL(2), SL(12), mt, nt, r, q); mm_load(f1, SL(11), SL(9), mt, nt, r, q); mm_load(f2, SL(11), SL(5), mt, nt, r, q);
      const v2u o0 = *(const LAS v2u*)(SL(3) + sx(16 * nt + r, 16 * mt + 4 * q)), o1 = *(const LAS v2u*)(SL(3) + sx(16 * nt + r, 16 * mt + 32 + 4 * q));
      f32x4 a0 = z4, a1 = z4, b0 = {bflo(o0.x), bfhi(o0.x), bflo(o0.y), bfhi(o0.y)}, b1 = {bflo(o1.x), bfhi(o1.x), bflo(o1.y), bfhi(o1.y)}, c0 = z4, c1 = z4;
      mm_mul(f0, a0, a1); mm_mul(f1, b0, b1); mm_mul(f2, c0, c1);
      st_T(SL(13), mt, nt, r, q, a0); st_T(SL(13), mt + 2, nt, r, q, a1);
      st_Tf(RW, mt, nt, r, q, b0); st_Tf(RW, mt + 2, nt, r, q, b1);
      st_Tf(MM, mt, nt, r, q, c0); st_Tf(MM, mt + 2, nt, r, q, c1); }
    LDS_WAIT(); __syncthreads();
    { PairF f0, f1, f2, f3; mm_load(f0, SL(9), SL(13), mt, nt, r, q); mm_load(f1, SL(10), SL(7), mt, nt, r, q); mm_load(f2, SL(5), SL(13), mt, nt, r, q); mm_load(f3, SL(6), SL(7), mt, nt, r, q);
      f32x4 a0 = z4, a1 = z4, b0 = z4, b1 = z4; mm_mul(f0, a0, a1); mm_mul(f2, b0, b1); mm_mul(f1, a0, a1); mm_mul(f3, b0, b1);
      st_Te(Y0T, mt, nt, r, q, a0); st_Te(Y0T, mt + 2, nt, r, q, a1);
      st_Te(GAT, mt, nt, r, q, b0); st_Te(GAT, mt + 2, nt, r, q, b1); }
#undef SL
}
__device__ __forceinline__ void rwkv_seq(const bf16* RW, const bf16* MM, const bf16* Y0T, const bf16* GAT, const float* PC, bf16* Y, int sid, LAS unsigned char* lds, int tid, int wave, int lane) {
    const int chain = sid >> 2, g4 = sid & 3, b = chain >> 3, h = chain & 7;
    const int r = lane & 15, q = lane >> 4, tw = wave & 3;
    LAS bf16* HT = (LAS bf16*)lds;
    LAS bf16* YSTG = (LAS bf16*)(lds + 8192 + (wave & 3) * 512);
    for (int i = tid; i < 2 * 16 * CS / 2; i += NTHR) ((LAS unsigned*)HT)[i] = 0u;
    LDS_WAIT(); __syncthreads();
    f32x4 Hreg = {0.f, 0.f, 0.f, 0.f};
    const bool isH = wave < 4;
    const bf16* Abase = isH ? MM : RW;
    const bf16* Ebase = isH ? GAT : Y0T;
    const size_t ci0 = (size_t)chain * NCHK;
    struct SeqOp { bf16x8 a0, a1; v2u ad; f32x4 pc; };
    constexpr int SEQ_R = 8, SEQ_U = 128;
    SeqOp op[SEQ_R];
#define SEQ_LD(S, C) do { const size_t ci_ = ci0 + (C); const bf16* ap_ = Abase + ci_ * 4096 + tw * 1024 + lane * 16; S.a0 = *(const bf16x8*)ap_; S.a1 = *(const bf16x8*)(ap_ + 8);       \
        S.ad = *(const v2u*)(Ebase + ci_ * 4096 + ((g4 * 4 + tw) * 64 + lane) * 4); S.pc = *(const f32x4*)(PC + ci_ * 64 + 16 * tw + 4 * q); } while (0)
#define SEQ_STEP(S, C) do { const LAS bf16* hb = HT + ((C) & 1) * 16 * CS; \
        const bf16x8 b0 = *(const LAS bf16x8*)(hb + r * CS + 8 * q), b1 = *(const LAS bf16x8*)(hb + r * CS + 32 + 8 * q); \
        f32x4 acc = {bflo(S.ad.x), bfhi(S.ad.x), bflo(S.ad.y), bfhi(S.ad.y)}; \
        acc = __builtin_amdgcn_mfma_f32_16x16x32_bf16(S.a0, b0, acc, 0, 0, 0); acc = __builtin_amdgcn_mfma_f32_16x16x32_bf16(S.a1, b1, acc, 0, 0, 0); \
        const f32x4 pcc = S.pc; \
        SEQ_LD(S, ((C) + SEQ_R < NCHK ? (C) + SEQ_R : NCHK - 1));            \
        if (isH) { Hreg = pcc * (Hreg + acc); v2u w; w.x = cvtpk(Hreg.x, Hreg.y); w.y = cvtpk(Hreg.z, Hreg.w); \
            *(LAS v2u*)(HT + (((C) + 1) & 1) * 16 * CS + r * CS + 16 * tw + 4 * q) = w; } \
        else { LAS bf16* ys = YSTG + (4 * q) * 16 + r;            \
            ys[0] = (bf16)f2bf(acc.x); ys[16] = (bf16)f2bf(acc.y); ys[32] = (bf16)f2bf(acc.z); ys[48] = (bf16)f2bf(acc.w);     \
            asm volatile("" ::: "memory");                         \
            const v2u yv = *(const LAS v2u*)(YSTG + 4 * lane); \
            *(v2u*)(Y + (((size_t)sid * 8192 + (C) * CK + 16 * tw) * 16) + 4 * lane) = yv; } \
        LDS_WAIT(); __syncthreads(); } while (0)
#pragma unroll
    for (int c = 0; c < SEQ_R; ++c) SEQ_LD(op[c], c);
#pragma unroll 1
    for (int c0 = 0; c0 < NCHK; c0 += SEQ_U) {
#pragma unroll
        for (int c = 0; c < SEQ_U; ++c) SEQ_STEP(op[c % SEQ_R], c0 + c);
    }
#undef SEQ_LD
#undef SEQ_STEP
}

__device__ __forceinline__ int crow(int r, int hi) { return (r & 3) + 8 * (r >> 2) + 4 * hi; }
constexpr int AT_KT_STRIDE = 72, AT_VL_STRIDE = 260, AT_VL_OFF = 256 * AT_KT_STRIDE * 2, AT_MISC_OFF = AT_VL_OFF + 64 * AT_VL_STRIDE * 2;
struct AttnStage { v4u k[4], v[4]; };
__device__ __forceinline__ void attn_stage_load(AttnStage& S, const bf16* K, const bf16* VT, int bh, int blk, int tid) {
#pragma unroll
    for (int i = 0; i < 4; ++i) { const int idx = tid + NTHR * i, row = idx >> 3, c8 = idx & 7;
        S.k[i] = *(const v4u*)(K + ((size_t)(bh * 8192 + blk * 256 + row)) * 64 + 8 * c8); }
#pragma unroll
    for (int i = 0; i < 4; ++i) { const int idx = tid + NTHR * i, dv = idx >> 5, c = idx & 31;
        S.v[i] = *(const v4u*)(VT + ((size_t)(bh * 64 + dv)) * 8192 + blk * 256 + 8 * c); }
}
__device__ __forceinline__ void attn_stage_store(const AttnStage& S, LAS unsigned char* buf, int tid) {
    LAS bf16* KT = (LAS bf16*)buf; LAS bf16* VL = (LAS bf16*)(buf + AT_VL_OFF);
#pragma unroll
    for (int i = 0; i < 4; ++i) { const int idx = tid + NTHR * i, row = idx >> 3, c8 = idx & 7; *(LAS v4u*)(KT + row * AT_KT_STRIDE + 8 * c8) = S.k[i]; }
#pragma unroll
    for (int i = 0; i < 4; ++i) { const int idx = tid + NTHR * i, dv = idx >> 5, c = idx & 31;
        LAS v2u* d = (LAS v2u*)(VL + dv * AT_VL_STRIDE + 8 * c);
        v2u lo = {S.v[i].x, S.v[i].y}, hi = {S.v[i].z, S.v[i].w}; d[0] = lo; d[1] = hi; }
}
__device__ __forceinline__ void attn_tile(const bf16x8 (&qf)[4], const LAS bf16* KT, const LAS bf16* VL, int kt0, int nkt, int dkt, int ql, int half, float c1, float c2, f32x16 (&O)[2], float& lsum) {
    for (int kt = kt0; kt < nkt; ++kt) {
        f32x16 X;
#pragma unroll
        for (int i = 0; i < 16; ++i) X[i] = 0.f;
#pragma unroll
        for (int ks = 0; ks < 4; ++ks) { const bf16x8 kf = *(const LAS bf16x8*)(KT + (32 * kt + ql) * AT_KT_STRIDE + 16 * ks + 8 * half);
            X = __builtin_amdgcn_mfma_f32_32x32x16_bf16(kf, qf[ks], X, 0, 0, 0); }
        float p[16];
#pragma unroll
        for (int i = 0; i < 16; ++i) p[i] = __builtin_amdgcn_exp2f(X[i] * c1 - c2);
        if (kt == dkt) {
#pragma unroll
            for (int i = 0; i < 16; ++i) if (crow(i, half) > ql) p[i] = 0.f;
        }
#pragma unroll
        for (int i = 0; i < 16; ++i) lsum += p[i];
#pragma unroll
        for (int s = 0; s < 2; ++s) {
            v4u pw; pw.x = cvtpk(p[8 * s], p[8 * s + 1]); pw.y = cvtpk(p[8 * s + 2], p[8 * s + 3]); pw.z = cvtpk(p[8 * s + 4], p[8 * s + 5]); pw.w = cvtpk(p[8 * s + 6], p[8 * s + 7]);
            const bf16x8 pa = __builtin_bit_cast(bf16x8, pw);
#pragma unroll
            for (int nt = 0; nt < 2; ++nt) {
                const LAS bf16* vp = VL + (32 * nt + ql) * AT_VL_STRIDE + 32 * kt + 16 * s + 4 * half;
                const s16x4 lo = *(const LAS s16x4*)vp, hi = *(const LAS s16x4*)(vp + 8);
                const bf16x8 vf = __builtin_shufflevector(lo, hi, 0, 1, 2, 3, 4, 5, 6, 7);
                O[nt] = __builtin_amdgcn_mfma_f32_32x32x16_bf16(pa, vf, O[nt], 0, 0, 0);
            }
        }
    }
}
__device__ __forceinline__ int attn_pop(unsigned* queue, unsigned* cursor, volatile LAS int* misc, int tid, int& count) {
    for (;;) {
        __syncthreads();
        if (tid == 0) misc[0] = (int)__hip_atomic_fetch_add(queue, 1u, RLX_AGENT);
        __syncthreads();
        const int item = misc[0];
        if (item >= 992 + 1024) { count = 0; return -1; }
        if (item >= 992) { count = 256; return item; }
        count = (int)__hip_atomic_load(cursor + (item & 31) * 32 + (item >> 5), RLX_AGENT);
        if (count > 0) return item;
    }
}
__device__ __forceinline__ void attn_phase(const bf16* Q, const bf16* K, const bf16* VT, const unsigned* lists, unsigned* cursor, unsigned* queue,
                                           bf16* OPART, float* LPART, bf16* OWN, const float* gq, const float* gk, LAS unsigned char* lds, int tid, int wave, int lane, int probe) {
    constexpr int AT_BUF = AT_MISC_OFF;
    volatile LAS int* misc = (volatile LAS int*)(lds + 2 * AT_BUF);
    float mq = fabsf(gq[lane]), mk = fabsf(gk[lane]);
#pragma unroll
    for (int o = 1; o < 64; o <<= 1) { mq = fmaxf(mq, __shfl_xor(mq, o)); mk = fmaxf(mk, __shfl_xor(mk, o)); }
    const float c1 = 0.125f * 1.4426950408889634f, c2 = 8.f * mq * mk * 1.4426950408889634f;
    const int ql = lane & 31, half = lane >> 5;
    int count = 0, ncount = 0;
    int item = attn_pop(queue, cursor, misc, tid, count);
    AttnStage St;
    if (item >= 0) { attn_stage_load(St, K, VT, item < 992 ? (item & 31) : ((item - 992) & 31), item < 992 ? (item >> 5) : ((item - 992) >> 5), tid); attn_stage_store(St, lds, tid); }
    LDS_WAIT();
    __syncthreads();
    int pb = 0;
    bool have = false; unsigned ent_c = 0u; bf16x8 q_c[4];
    while (item >= 0) {
        int nitem = -1;
        if (tid == 0) { nitem = (int)__hip_atomic_fetch_add(queue, 1u, RLX_AGENT); ncount = 256;
            if (nitem < 992) ncount = (int)__hip_atomic_load(cursor + (nitem & 31) * 32 + (nitem >> 5), RLX_AGENT);
            if (nitem >= 992 + 1024) { nitem = -1; ncount = 0; } }
        bool published = false;
#define ATTN_PUBLISH() do { __syncthreads(); if (tid == 0) { misc[0] = nitem; misc[1] = ncount; } __syncthreads(); nitem = misc[0]; ncount = misc[1]; published = true; \
            { const int li_ = nitem >= 0 ? nitem : item;                                         \
              attn_stage_load(St, K, VT, li_ < 992 ? (li_ & 31) : ((li_ - 992) & 31), li_ < 992 ? (li_ >> 5) : ((li_ - 992) >> 5), tid); } } while (0)
        const LAS bf16* KT = (const LAS bf16*)(lds + pb * AT_BUF); const LAS bf16* VL = (const LAS bf16*)(lds + pb * AT_BUF + AT_VL_OFF);
        const bool own = item >= 992;
        const int bh = own ? ((item - 992) & 31) : (item & 31), blk = own ? ((item - 992) >> 5) : (item >> 5);
        const unsigned* lp = lists + (size_t)bh * LIST_PER_BH + list_off(own ? 0 : blk);
        for (int c = 0;; ++c) {
            const int e0 = own ? 0 : c * 256 + wave * 32;
            if (!own && e0 >= count) break;
            if (!have) {
                if (own) ent_c = (unsigned)(blk * 256 + wave * 32 + ql) << 2;
                else { const int e = e0 + ql; ent_c = lp[e < count ? e : e0]; }
                const bf16* qp = Q + ((size_t)(bh * 8192 + (int)(ent_c >> 2))) * 64 + 8 * half;
#pragma unroll
                for (int ks = 0; ks < 4; ++ks) q_c[ks] = *(const bf16x8*)(qp + 16 * ks);
            }
            const int sq = (int)(ent_c >> 2), slot = (int)(ent_c & 3u);
            const bool valid = own || (e0 + ql < count);
            f32x16 O[2]; float lsum = 0.f;
#pragma unroll
            for (int i = 0; i < 16; ++i) { O[0][i] = 0.f; O[1][i] = 0.f; }
            const int nkt = own ? wave + 1 : 8, dkt = own ? wave : -1, kth = nkt >> 1;
            const bool more = !own && (c + 1) * 256 + wave * 32 < count;
            unsigned ent_n = ent_c; int nbh = bh; bool nhave = false;
            if (more) { nhave = true; const int e = (c + 1) * 256 + wave * 32 + ql; ent_n = lp[e < count ? e : (c + 1) * 256 + wave * 32]; }
            if (probe != 3 && probe != 4) attn_tile(q_c, KT, VL, 0, kth, dkt, ql, half, c1, c2, O, lsum);
            if (!published) ATTN_PUBLISH();
            if (!more) {
                if (nitem >= 992) { nhave = true; nbh = (nitem - 992) & 31; ent_n = (unsigned)(((nitem - 992) >> 5) * 256 + wave * 32 + ql) << 2; }
                else if (nitem >= 0 && wave * 32 < ncount) { nhave = true; nbh = nitem & 31; const int e = wave * 32 + ql;
                    ent_n = (lists + (size_t)nbh * LIST_PER_BH + list_off(nitem >> 5))[e < ncount ? e : wave * 32]; }
            }
            bf16x8 q_n[4];
            { const bf16* qp = Q + ((size_t)(nbh * 8192 + (int)(ent_n >> 2))) * 64 + 8 * half;
#pragma unroll
                for (int ks = 0; ks < 4; ++ks) q_n[ks] = *(const bf16x8*)(qp + 16 * ks); }
            if (probe != 3 && probe != 4) attn_tile(q_c, KT, VL, kth, nkt, dkt, ql, half, c1, c2, O, lsum);
            const float ltot = lsum + __shfl_xor(lsum, 32);
            if ((probe == 2 || probe == 4) && ltot != 12345.f) { } else
            {
                const int b = bh >> 3, h = bh & 7;
                if (half == 0 && (own || valid)) LPART[(size_t)(own ? 3 : slot) * (BH * SEQ) + bh * 8192 + sq] = ltot;
                const int entv = valid ? (int)ent_c : -1;
                LAS bf16* stg = (LAS bf16*)(lds + 2 * AT_BUF + 256 + wave * 2048);
#pragma unroll
                for (int hp = 0; hp < 2; ++hp) {
                    asm volatile("" ::: "memory");
#pragma unroll
                    for (int ii = 0; ii < 8; ++ii) { const int i = 8 * hp + ii, rl = (i & 3) + 8 * ((i >> 2) & 1) + 4 * half;
                        stg[rl * 64 + ql] = (bf16)f2bf(O[0][i]); stg[rl * 64 + 32 + ql] = (bf16)f2bf(O[1][i]); }
                    asm volatile("" ::: "memory");
#pragma unroll
                    for (int j = 0; j < 2; ++j) {
                        const int pc_ = lane + 64 * j, rl = pc_ >> 3, c8 = pc_ & 7, rg = 16 * hp + rl;
                        const v4u w = *(const LAS v4u*)(stg + rl * 64 + 8 * c8);
                        if (own) { const int s2 = blk * 256 + wave * 32 + rg; *(v4u*)(OWN + ((size_t)(b * 8192 + s2)) * OSTR + h * 64 + 8 * c8) = w; }
                        else { const int e2 = __shfl(entv, rg);
                            if (e2 >= 0) *(v4u*)(OPART + ((size_t)(e2 & 3) * (BH * SEQ) + bh * 8192 + (e2 >> 2)) * 64 + 8 * c8) = w; }
                    }
                }
            }
            have = nhave; ent_c = ent_n;
#pragma unroll
            for (int ks = 0; ks < 4; ++ks) q_c[ks] = q_n[ks];
            if (own) break;
        }
        if (!published) ATTN_PUBLISH();
#undef ATTN_PUBLISH
        if (nitem >= 0) attn_stage_store(St, lds + (pb ^ 1) * AT_BUF, tid);
        LDS_WAIT();
        __syncthreads();
        item = nitem; count = ncount; pb ^= 1;
    }
}

__device__ __forceinline__ void p5_combine(const bf16* OPART, const float* LPART, const bf16* OM, bf16* OMO, int gtid, int ntot) {
    for (int idx0 = gtid; idx0 < BH * SEQ * 8; idx0 += 2 * ntot) {
        v4u v[2][4]; unsigned lw[2][4]; size_t oo[2]; int nsel[2];
#pragma unroll
        for (int u = 0; u < 2; ++u) {
            const int idx = idx0 + u * ntot < BH * SEQ * 8 ? idx0 + u * ntot : idx0;
            const int qg = idx >> 3, c8 = idx & 7, bh = qg >> 13, s = qg & 8191, b = bh >> 3, h = bh & 7;
            nsel[u] = (s >> 8) < 3 ? (s >> 8) : 3;
            oo[u] = ((size_t)(b * 8192 + s)) * OSTR + h * 64 + 8 * c8;
#pragma unroll
            for (int sl = 0; sl < 3; ++sl) { v[u][sl] = *(const v4u*)(OPART + ((size_t)sl * (BH * SEQ) + qg) * 64 + 8 * c8); lw[u][sl] = *(const unsigned*)(LPART + (size_t)sl * (BH * SEQ) + qg); }
            v[u][3] = *(const v4u*)(OM + oo[u]); lw[u][3] = *(const unsigned*)(LPART + (size_t)3 * (BH * SEQ) + qg);
        }
#pragma unroll
        for (int u = 0; u < 2; ++u) {
            float acc[8] = {0.f, 0.f, 0.f, 0.f, 0.f, 0.f, 0.f, 0.f}; float l = 0.f;
#pragma unroll
            for (int sl = 0; sl < 4; ++sl) {
                const unsigned m = (sl == 3 || sl < nsel[u]) ? 0xffffffffu : 0u;
                const v4u w4 = v[u][sl] & m;
                acc[0] += bflo(w4.x); acc[1] += bfhi(w4.x); acc[2] += bflo(w4.y); acc[3] += bfhi(w4.y); acc[4] += bflo(w4.z); acc[5] += bfhi(w4.z); acc[6] += bflo(w4.w); acc[7] += bfhi(w4.w);
                l += __builtin_bit_cast(float, lw[u][sl] & m);
            }
            const float il = 1.f / l;
            v4u w; w.x = pk2(acc[0] * il, acc[1] * il); w.y = pk2(acc[2] * il, acc[3] * il); w.z = pk2(acc[4] * il, acc[5] * il); w.w = pk2(acc[6] * il, acc[7] * il);
            if (u == 0 || idx0 + ntot < BH * SEQ * 8) *(v4u*)(OMO + oo[u]) = w;
        }
    }
}
__device__ __forceinline__ void unpack4(const v2u w, float (&f)[4]) { f[0] = bflo(w.x); f[1] = bfhi(w.x); f[2] = bflo(w.y); f[3] = bfhi(w.y); }
__device__ __forceinline__ void p5_rwkv_post(const bf16* Z, const bf16* AA, const bf16* GG, const bf16* Y, bf16* YO, const LAS float* lc  ,
                                             int gw, int ngw, int lane) {
    const int g = lane >> 4, r = lane & 15;
#pragma unroll 2
    for (int it = gw * 4 + g; it < T * NH; it += ngw * 4) {
        const int t = it >> 3, h = it & 7, col = h * 64 + 4 * r, s = t & 8191;
        const bf16* zp = Z + (size_t)t * ZR + col;
        float zr[4], zk[4], zv[4], pr[4] = {0.f, 0.f, 0.f, 0.f}, pk[4] = {0.f, 0.f, 0.f, 0.f}, pv[4] = {0.f, 0.f, 0.f, 0.f}, a[4], y[4], gg[4];
        unpack4(*(const v2u*)zp, zr); unpack4(*(const v2u*)(zp + 512), zk); unpack4(*(const v2u*)(zp + 1024), zv);
        { const bf16* zq = s ? zp - ZR : zp; const unsigned m_ = s ? 0xffffffffu : 0u;
          unpack4(*(const v2u*)(zq) & m_, pr); unpack4(*(const v2u*)(zq + 512) & m_, pk); unpack4(*(const v2u*)(zq + 1024) & m_, pv); }
        unpack4(*(const v2u*)(AA + (size_t)t * 512 + col), a); unpack4(*(const v2u*)(Y + ((size_t)(((t >> 13) * 8 + h) * 4 + (r >> 2)) * 8192 + s) * 16 + 4 * (r & 3)), y); unpack4(*(const v2u*)(GG + (size_t)t * 512 + col), gg);
        const f32x4 mr = *(const LAS f32x4*)(lc + col), mk = *(const LAS f32x4*)(lc + 512 + col), mv = *(const LAS f32x4*)(lc + 1024 + col);
        const f32x4 ka = *(const LAS f32x4*)(lc + 1536 + col), rk = *(const LAS f32x4*)(lc + 2048 + col), lg = *(const LAS f32x4*)(lc + 2560 + col), lb = *(const LAS f32x4*)(lc + 3072 + col);
        float vv[4], dot = 0.f, sum = 0.f;
#pragma unroll
        for (int i = 0; i < 4; ++i) { const float rr = zr[i] + (pr[i] - zr[i]) * mr[i], k = zk[i] + (pk[i] - zk[i]) * mk[i]; vv[i] = zv[i] + (pv[i] - zv[i]) * mv[i];
            const float k2 = k * (1.f + (a[i] - 1.f) * ka[i]); dot += rr * k2 * rk[i]; sum += y[i]; }
        const float mean = allreduce16(sum) * (1.f / 64.f);
        float sq = 0.f;
#pragma unroll
        for (int i = 0; i < 4; ++i) { y[i] -= mean; sq += y[i] * y[i]; }
        const float rstd = 1.f / sqrtf(allreduce16(sq) * (1.f / 64.f) + GN_EPS);
        const float bonus = allreduce16(dot);
        float o[4];
#pragma unroll
        for (int i = 0; i < 4; ++i) o[i] = (y[i] * rstd * lg[i] + lb[i] + bonus * vv[i]) * gg[i];
        v2u w; w.x = pk2(o[0], o[1]); w.y = pk2(o[2], o[3]);
        *(v2u*)(YO + (size_t)t * OSTR + col) = w;
    }
}


__device__ __forceinline__ unsigned f2key(float f) { const unsigned u = __builtin_bit_cast(unsigned, f); return (u & 0x80000000u) ? ~u : (u | 0x80000000u); }
__device__ __forceinline__ float key2f(unsigned k) { const unsigned u = (k & 0x80000000u) ? (k & 0x7fffffffu) : ~k; return __builtin_bit_cast(float, u); }
template <int CTRL> __device__ __forceinline__ unsigned dppu(unsigned v) { return (unsigned)__builtin_amdgcn_update_dpp(0, (int)v, CTRL, 0xF, 0xF, true); }
__device__ __forceinline__ unsigned umax_(unsigned a, unsigned b) { return a > b ? a : b; }
__device__ __forceinline__ unsigned allmax16(unsigned v) { v = umax_(v, dppu<0xB1>(v)); v = umax_(v, dppu<0x4E>(v)); v = umax_(v, dppu<0x141>(v)); v = umax_(v, dppu<0x140>(v)); return v; }
__device__ __forceinline__ float dot2bf(unsigned w, unsigned x, float acc) { return __builtin_amdgcn_fdot2_f32_bf16(__builtin_bit_cast(bf16x2_t, w), __builtin_bit_cast(bf16x2_t, x), acc, false); }
__device__ __forceinline__ unsigned cand_word(int r) {
    const unsigned tab[16] = {0x03020100u, 0x07060504u, 0x0b0a0908u, 0x0f0e0d0cu, 0x13121110u, 0x17161514u, 0x23222120u, 0x32313024u,
                              0x42414033u, 0x61605150u, 0x90807170u, 0xd0c0b0a0u, 0xfffff0e0u, 0xffffffffu, 0xffffffffu, 0xffffffffu};
    unsigned w = 0xffffffffu;
#pragma unroll
    for (int i = 0; i < 13; ++i) w = (r == i) ? tab[i] : w;
    return w;
}
template <int NK> __device__ __forceinline__ unsigned top16_keys(unsigned (&k)[NK], int r) {
    unsigned res = 0u;
    for (int rd = 0; rd < 16; ++rd) {
        unsigned m = k[0];
#pragma unroll
        for (int j = 1; j < NK; ++j) m = umax_(m, k[j]);
        const unsigned gm = allmax16(m);
        res = (r == rd) ? gm : res;
#pragma unroll
        for (int j = 0; j < NK; ++j) k[j] = (k[j] == gm) ? 0u : k[j];
    }
    return res;
}
#define PEER_CE(a, b) do { const unsigned hi_ = umax_(k[a], k[b]), lo_ = (k[a] < k[b]) ? k[a] : k[b]; k[a] = hi_; k[b] = lo_; } while (0)
__device__ __forceinline__ unsigned top16_sorted8(unsigned (&k)[8], int r) {
    PEER_CE(0, 1); PEER_CE(2, 3); PEER_CE(4, 5); PEER_CE(6, 7);
    PEER_CE(0, 2); PEER_CE(1, 3); PEER_CE(4, 6); PEER_CE(5, 7);
    PEER_CE(1, 2); PEER_CE(5, 6);
    PEER_CE(0, 4); PEER_CE(1, 5); PEER_CE(2, 6); PEER_CE(3, 7);
    PEER_CE(2, 4); PEER_CE(3, 5);
    PEER_CE(1, 2); PEER_CE(3, 4); PEER_CE(5, 6);
    unsigned res = 0u;
    for (int rd = 0; rd < 16; ++rd) {
        const unsigned gm = allmax16(k[0]);
        res = (r == rd) ? gm : res;
        const bool pop = k[0] == gm;
#pragma unroll
        for (int j = 0; j < 7; ++j) k[j] = pop ? k[j + 1] : k[j];
        k[7] = pop ? 0u : k[7];
    }
    return res;
}
#undef PEER_CE
#ifdef PROBE_S
typedef int v8i_p __attribute__((ext_vector_type(8)));
__device__ __forceinline__ float mx_probe(int lane) {
    const int q = lane >> 4;
    unsigned aw[4] = {0u, 0u, 0u, 0u};
    if (lane == 16 * PROBE_QA) aw[(PROBE_S) >> 3] = 0x2u << (4 * ((PROBE_S) & 7));
    v8i_p A = {(int)aw[0], (int)aw[1], (int)aw[2], (int)aw[3], 0, 0, 0, 0};
    v8i_p B;
#pragma unroll
    for (int v = 0; v < 8; ++v) {
        float f[4];
#pragma unroll
        for (int b = 0; b < 4; ++b) { const int j = 4 * v + b; f[b] = (PROBE_PAT == 1) ? (float)(q + 1) : ((PROBE_PAT == 2) ? (float)((j & 15) + 1) : (float)((j >> 4) + 1)); }
        int w = 0; w = __builtin_amdgcn_cvt_pk_fp8_f32(f[0], f[1], w, false); w = __builtin_amdgcn_cvt_pk_fp8_f32(f[2], f[3], w, true); B[v] = w;
    }
    f32x4 c = {0.f, 0.f, 0.f, 0.f};
    c = __builtin_amdgcn_mfma_scale_f32_16x16x128_f8f6f4(A, B, c, 4, 0, 0, 0x7f7f7f7f, 0, 0x7f7f7f7f);
    const float r = __shfl(c.x, 0);
    const int code = (int)(r + 0.5f) - 1;
    float off = 0.1f;
    for (int i = 0; i < code && i < 40; ++i) off *= 1.3f;
    if (code < 0) off = 0.05f;
    return off;
}
#endif
typedef int v8i __attribute__((ext_vector_type(8)));
typedef int v4i __attribute__((ext_vector_type(4)));
struct PeerTK { unsigned ids, gates; };
__device__ __forceinline__ void peer_topk1(const LAS unsigned char* sbuf, unsigned (&resA)[4], int r, int lane) {
#pragma unroll
    for (int pass = 0; pass < 4; ++pass) {
        const v4u sw = *(const LAS v4u*)(sbuf + pass * 1024 + 16 * lane);
        const float v[8] = {bflo(sw.x), bfhi(sw.x), bflo(sw.y), bfhi(sw.y), bflo(sw.z), bfhi(sw.z), bflo(sw.w), bfhi(sw.w)};
        unsigned k[8];
#pragma unroll
        for (int j = 0; j < 8; ++j) k[j] = (f2key(v[j]) & ~0x7Fu) | (unsigned)(127 - (r * 8 + j));
        resA[pass] = top16_sorted8(k, r);
    }
}
__device__ __forceinline__ PeerTK peer_topk2(const unsigned (&resA)[4], int r, int g) {
    PeerTK o; unsigned eid_[2]; float egt_[2];
    const unsigned cw = cand_word(r);
#pragma unroll
    for (int cp = 0; cp < 2; ++cp) {
        const int lbase = 32 * (g & 1); const bool hi = (g >> 1) != 0;
        unsigned ck[4];
#pragma unroll
        for (int m = 0; m < 4; ++m) {
            const unsigned byte = (cw >> (8 * m)) & 0xFFu; const int i = (int)(byte >> 4), j = (int)(byte & 15u);
            const unsigned a0 = (unsigned)__shfl((int)resA[2 * cp], lbase + i), a1 = (unsigned)__shfl((int)resA[2 * cp + 1], lbase + i);
            const unsigned b0 = (unsigned)__shfl((int)resA[2 * cp], lbase + 16 + j), b1 = (unsigned)__shfl((int)resA[2 * cp + 1], lbase + 16 + j);
            const unsigned ak = hi ? a1 : a0, bk = hi ? b1 : b0;
            const float val = key2f(ak & ~0x7Fu) + key2f(bk & ~0x7Fu);
            ck[m] = (byte != 0xFFu) ? ((f2key(val) & ~0xFFu) | (255u - byte)) : 0u;
        }
        const unsigned res = top16_keys<4>(ck, r);
        const unsigned flat = 255u - (res & 0xFFu); const int i = (int)(flat >> 4), j = (int)(flat & 15u);
        const float val = key2f(res & ~0xFFu), vmax = key2f(allmax16(res) & ~0xFFu);
        const float e = __expf(val - vmax);
        const float gate = e / allreduce16(e);
        const unsigned a0 = (unsigned)__shfl((int)resA[2 * cp], lbase + i), a1 = (unsigned)__shfl((int)resA[2 * cp + 1], lbase + i);
        const unsigned b0 = (unsigned)__shfl((int)resA[2 * cp], lbase + 16 + j), b1 = (unsigned)__shfl((int)resA[2 * cp + 1], lbase + 16 + j);
        const unsigned ak = hi ? a1 : a0, bk = hi ? b1 : b0;
        eid_[cp] = (127u - (ak & 127u)) * 128u + (127u - (bk & 127u));
        egt_[cp] = gate;
    }
    o.ids = eid_[0] | (eid_[1] << 16); o.gates = pk2(egt_[0], egt_[1]);
    return o;
}
__device__ __forceinline__ void peer_stage_a(const bf16* SC, const unsigned char* XN8, const unsigned char* U8, LAS f32x4* xl, unsigned* PE32, unsigned* W32, int t0, int tstride, int lane) {
    if (t0 >= T) return;
    const int g = lane >> 4, r = lane & 15, i16 = lane & 15, q = lane >> 4;
    LAS float* hl = (LAS float*)xl;
    LAS unsigned char* xb = (LAS unsigned char*)(xl + 64);
    LAS unsigned char* sb = xb + 2048;
#define PA_XDMA(TT, PB) __builtin_amdgcn_global_load_lds((const GAS unsigned*)(XN8 + (size_t)(TT) * 1024 + 16 * lane), (LAS unsigned*)(xb + (PB) * 1024), 16, 0, 0)
#define PA_SDMA(TT, PB) do { _Pragma("unroll") for (int pass = 0; pass < 4; ++pass) \
        __builtin_amdgcn_global_load_lds((const GAS unsigned*)(SC + (size_t)(TT) * 2048 + (pass * 4 + g) * 128 + r * 8), (LAS unsigned*)(sb + (PB) * 4096 + pass * 1024), 16, 0, 0); } while (0)
    unsigned resA[4];
    const int t1_ = t0 + tstride < T ? t0 + tstride : t0;
    PA_SDMA(t0, 0); PA_XDMA(t0, 0);
    asm volatile("s_waitcnt vmcnt(0)" ::: "memory");
    peer_topk1(sb, resA, r, lane);
    PA_SDMA(t1_, 1);
    PeerTK cur = peer_topk2(resA, r, g);
    asm volatile("s_waitcnt vmcnt(0)" ::: "memory");
    int pb = 0;
#pragma unroll 1
    for (int t = t0; t < T; t += tstride, pb ^= 1) {
        LAS unsigned char* x8l = xb + pb * 1024;
        const int tn1 = t + tstride < T ? t + tstride : t, tn2 = tn1 + tstride < T ? tn1 + tstride : tn1;
#define PEER_LD(P, KB) (*(const v4i*)((P) + (KB) * 64))
#define PEER_PTR(GI) (U8 + (size_t)(((unsigned)__shfl((int)cur.ids, 16 * ((GI) & 3) + i16) >> (16 * ((GI) >> 2))) & 0xFFFFu) * 512 + 16 * q)
        v4i ug[2][8];
        asm volatile("" ::: "memory");
        PA_XDMA(tn1, pb ^ 1); PA_SDMA(tn2, pb);
#pragma unroll
        for (int g0 = 0; g0 < 2; ++g0) { const unsigned char* p0 = PEER_PTR(g0);
#pragma unroll
            for (int kb = 0; kb < 8; ++kb) ug[g0][kb] = PEER_LD(p0, kb); }
        __builtin_amdgcn_sched_barrier(0);
        int ll = lane; asm volatile("" : "+v"(ll));
        peer_topk1(sb + (pb ^ 1) * 4096, resA, ll & 15, ll);
        const PeerTK nxt = peer_topk2(resA, ll & 15, ll >> 4);
        __builtin_amdgcn_sched_barrier(0);
#pragma unroll
        for (int gi = 0; gi < 8; ++gi) {
            const unsigned char* pn = PEER_PTR((gi + 2) & 7);
            f32x4 c_ = {0.f, 0.f, 0.f, 0.f};
#pragma unroll
            for (int kb = 0; kb < 8; ++kb) {
                const v8i xb_ = __builtin_shufflevector(*(const LAS v4i*)(x8l + kb * 128 + 16 * q), *(const LAS v4i*)(x8l + kb * 128 + 64 + 16 * q), 0, 1, 2, 3, 4, 5, 6, 7);
                const v8i ua_ = __builtin_shufflevector(ug[gi % 2][kb], (v4i){0, 0, 0, 0}, 0, 1, 2, 3, 4, 5, 6, 7);
                c_ = __builtin_amdgcn_mfma_scale_f32_16x16x128_f8f6f4(ua_, xb_, c_, 4, 0, 0, 0x7f7f7f7f, 0, 0x7f7f7f7f);
                if (gi + 2 < 8) ug[gi % 2][kb] = PEER_LD(pn, kb);
            }
            if (i16 == 0) *(LAS f32x4*)(hl + (gi >> 2) * 64 + 16 * (gi & 3) + 4 * q) = c_;
            __builtin_amdgcn_sched_barrier(0);
        }
#undef PEER_LD
#undef PEER_PTR
        LDS_WAIT(); asm volatile("" ::: "memory");
        float ehs[2];
#pragma unroll
        for (int cp = 0; cp < 2; ++cp) { const float hd = hl[cp * 64 + lane] * (1.f / 512.f); ehs[cp] = 0.5f * hd * (1.f + erff(hd * 0.70710678118654752f)) * (cp ? bfhi(cur.gates) : bflo(cur.gates)) * (1.f / 5.656854249f); }
        float wm = fmaxf(fabsf(ehs[0]), fabsf(ehs[1]));
#pragma unroll
        for (int o = 1; o < 64; o <<= 1) wm = fmaxf(wm, __shfl_xor(wm, o));
        wm = fmaxf(wm, 1e-30f);
        const float ws_ = 224.f * __builtin_amdgcn_rcpf(wm);
        const unsigned pk = (unsigned)__builtin_amdgcn_cvt_pk_fp8_f32(ehs[0] * ws_, ehs[1] * ws_, 0, false);
        const unsigned w16 = pk & 0xFFFFu;
        const unsigned wlo = (unsigned)__shfl((int)w16, (2 * lane) & 63), whi = (unsigned)__shfl((int)w16, (2 * lane + 1) & 63);
        const unsigned wrow = (lane < 32) ? (wlo | (whi << 16)) : ((lane == 32) ? __builtin_bit_cast(unsigned, wm * (1.f / 224.f)) : 0u);
        PE32[(size_t)t * 64 + lane] = cur.ids; W32[(size_t)t * 64 + lane] = wrow;
        cur = nxt;
    }
#undef PA_SDMA
#undef PA_XDMA
}
typedef int v2i __attribute__((ext_vector_type(2)));
struct PeerE { float sc; bf16 h[4]; v4i w0, w1; };
__device__ __forceinline__ void peer_stage_b(const unsigned char* V8s, const float* MOD, const bf16* OUT, float* OUTW, const unsigned* PE16, const unsigned char* W8G,
                                             LAS unsigned char* sb, int S, int half, int w0, int wstride, int lane, const int probe = 0) {
    const int r = lane & 15, q = lane >> 4, l3 = lane >> 3, p7 = lane & 7;
    const unsigned wo0 = (unsigned)(l3 * 128 + ((p7 ^ (l3 >> 1)) << 4)), wo1 = (unsigned)(l3 * 128 + ((p7 ^ (4 + (l3 >> 1))) << 4));
    const unsigned rbase = (unsigned)((32 * q + r) * 128 + ((r >> 1) << 4));
    LAS unsigned* idb = (LAS unsigned*)(sb + 16384);
    const int idsh = 16 * (l3 & 1), idq = l3 >> 1;
    const int NU = T / 2;
    const int nt = (w0 < NU) ? (NU - w0 + wstride - 1) / wstride : 0;
    if (nt == 0) return;
    const int col0 = 256 * S + lane;
    unsigned off[16];
    v4u RA[16], RB[16];
    PeerE EA, EB;
    unsigned idw;
#define PB_TOK(J) (2 * (w0 + ((J) < nt ? (J) : nt - 1) * wstride) + half)
#define PB_IDW(J) do { idw = PE16[(size_t)PB_TOK(J) * 64 + lane]; } while (0)
#define PB_OFF(J) do { idb[lane] = idw; const unsigned okm_ = ((J) < nt && probe != 2) ? 128u : 0u;         \
        _Pragma("unroll") for (int i = 0; i < 16; ++i) { const unsigned e_ = (idb[4 * i + idq] >> idsh) & 0xFFFFu; off[i] = e_ * okm_ + 16u * (unsigned)p7; } } while (0)
#define PB_ISSUE(RX) do { _Pragma("unroll") for (int i = 0; i < 16; ++i) RX[i] = *(const v4u*)(V8s + off[i]); } while (0)
#define PB_WRITE(RX) do { _Pragma("unroll") for (int i = 0; i < 16; ++i) *(LAS v4u*)(sb + ((i & 1) ? wo1 : wo0) + i * 1024) = RX[i]; } while (0)
#define PB_ELOAD(EX, J) do { const int t_ = PB_TOK(J); { const bf16* o_ = OUT + (size_t)t_ * 1024 + col0; _Pragma("unroll") for (int j = 0; j < 4; ++j) EX.h[j] = __builtin_nontemporal_load(o_ + 64 * j); }     \
        EX.w0 = *(const v4i*)(W8G + (size_t)t_ * 256 + 16 * q); EX.w1 = *(const v4i*)(W8G + (size_t)t_ * 256 + 64 + 16 * q); EX.sc = *(const float*)(W8G + (size_t)t_ * 256 + 128); } while (0)
#define PB_ITER(RX, EC, EN, J) do { \
        const int tj_ = PB_TOK(J); const float* g_ = MOD + (size_t)(tj_ >> 13) * 6144 + 5 * 1024 + col0; float gv_[4]; \
        _Pragma("unroll") for (int j = 0; j < 4; ++j) gv_[j] = g_[64 * j];                                 \
        PB_WRITE(RX);                                            \
        __builtin_amdgcn_sched_barrier(0);                       \
        PB_OFF((J) + 2); PB_IDW((J) + 3); PB_ELOAD(EN, (J) + 1); PB_ISSUE(RX);     \
        __builtin_amdgcn_sched_barrier(0); \
        const v8i wa_ = __builtin_shufflevector(EC.w0, EC.w1, 0, 1, 2, 3, 4, 5, 6, 7); \
        float res_[4] = {0.f, 0.f, 0.f, 0.f}; \
        if (probe != 3) _Pragma("unroll") for (int mp = 0; mp < 8; ++mp) { const unsigned ad_ = rbase ^ (unsigned)(mp << 4); \
            _Pragma("unroll") for (int mb = 0; mb < 2; ++mb) { const int m_ = 2 * mp + mb; \
                const v2i b0_ = __builtin_amdgcn_ds_read_tr4_b64_v2i32((LAS v2i*)(sb + ad_ + 8 * mb)), b1_ = __builtin_amdgcn_ds_read_tr4_b64_v2i32((LAS v2i*)(sb + ad_ + 8 * mb + 2048)); \
                const v8i bb_ = {b0_.x, b0_.y, b1_.x, b1_.y, 0, 0, 0, 0}; \
                const f32x4 d_ = __builtin_amdgcn_mfma_scale_f32_16x16x128_f8f6f4(wa_, bb_, (f32x4){0.f, 0.f, 0.f, 0.f}, 0, 4, 0, 0x7f7f7f7f, 0, 0x7f7f7f7f); \
                res_[m_ >> 2] = (q == (m_ & 3)) ? d_.x : res_[m_ >> 2]; } } \
        { float* ow_ = OUTW + (size_t)tj_ * 1024 + col0;          \
            _Pragma("unroll") for (int j = 0; j < 4; ++j) __builtin_nontemporal_store(bf2f(EC.h[j]) + gv_[j] * (res_[j] * EC.sc), ow_ + 64 * j); }        \
        __builtin_amdgcn_sched_barrier(0); } while (0)
    PB_IDW(0); PB_OFF(0); PB_ISSUE(RA); PB_ELOAD(EA, 0);
    PB_IDW(1); PB_OFF(1); PB_ISSUE(RB);
    PB_IDW(2);
    int j = 0;
#pragma unroll 1
    for (; j + 1 < nt; j += 2) { PB_ITER(RA, EA, EB, j); PB_ITER(RB, EB, EA, j + 1); }
    if (j < nt) PB_ITER(RA, EA, EB, j);
#undef PB_TOK
#undef PB_IDW
#undef PB_OFF
#undef PB_ISSUE
#undef PB_WRITE
#undef PB_ELOAD
#undef PB_ITER
}

#ifndef MK_N_LAUNCHES
#define MK_N_LAUNCHES 1
#endif
constexpr int N_PHASES = 16;
struct Args { const float* in[28]; float* out; unsigned char* ws; int ph_lo, ph_hi, use_bar, rep; };
enum { I_X = 0, I_C, I_POS, I_WADA, I_BADA, I_N1G, I_WIN, I_QNG, I_KNG, I_MU, I_W0, I_W2, I_A0, I_A2, I_G2, I_KK, I_KA, I_RK, I_LNG, I_LNB, I_WPM, I_WPR, I_WOUT, I_N2G, I_WQ, I_SK, I_PU, I_PV };

template <int OFF> __device__ __forceinline__ unsigned long long karg64() { unsigned long long p; asm volatile("s_load_dwordx2 %0, %1, %2\n\ts_waitcnt lgkmcnt(0)" : "=s"(p) : "s"(__builtin_amdgcn_kernarg_segment_ptr()), "n"(OFF)); return p; }
#define KIN(k) ((const float*)(const GAS float*)karg64<8 * (k)>())
#define KOUT ((float*)(GAS float*)karg64<224>())
#define KWS ((unsigned char*)(GAS unsigned char*)karg64<232>())
#define KOB ((unsigned char*)(GAS unsigned char*)karg64<224>())
#define ctl ((unsigned*)(KWS + WS_CTL))
#define mod ((float*)(KWS + WS_MOD))
#define kmean ((float*)(KWS + WS_KMEAN))
#define WinT ((bf16*)(KWS + WS_WIN))
#define WloraT ((bf16*)(KWS + WS_WLORA))
#define WpmT ((bf16*)(KWS + WS_WPM))
#define WprT ((bf16*)(KWS + WS_WPR))
#define WoutT ((bf16*)(KWS + WS_WOUT))
#define WeffT ((bf16*)(KWS + WS_WEFF))
#define XN ((bf16*)(KWS + WS_XN))
#define EW ((bf16*)(KWS + WS_EW))
#define AA ((bf16*)(KWS + WS_AA))
#define Qb ((bf16*)(KWS + WS_Q))
#define Kb ((bf16*)(KWS + WS_K))
#define VTb ((bf16*)(KWS + WS_VT))
#define ZRKV ((bf16*)(KWS + WS_ZRKV))
#define GT ((bf16*)(KWS + WS_GT))
#define ZLORA ((bf16*)(KWS + WS_ZLORA))
#define ALORA ((bf16*)(KWS + WS_ALORA))
#define OMOBA ((bf16*)(KWS + WS_OCAT))
#define GG ((bf16*)(KWS + WS_GG))
#define Yb ((bf16*)(KWS + WS_OCAT) + 512)
#define MIXED ((bf16*)(KWS + WS_MIXED))
#define U8 ((unsigned char*)(KWS + WS_U8))
#define XN8 ((unsigned char*)(KWS + 352 * MiB))
#define V8 ((unsigned char*)(KWS + WS_V8))
#define H1B ((bf16*)(KWS + WS_H1B))
#define YS ((bf16*)(KWS + 96 * MiB))
#define PE16 ((unsigned short*)(KWS + 24 * MiB))
#define W8G ((unsigned char*)(KWS + 32 * MiB))
#define SCORES ((bf16*)(KWS + WS_SCORES))
#define OPART ((bf16*)(KOB + DO_OPART))
#define LISTS ((unsigned*)(KOB + DO_LISTS))
#define LPART ((float*)(KOB + DO_LPART))
#define CP_RW ((bf16*)(KOB))
#define CP_MM ((bf16*)(KOB + 32 * MiB))
#define CP_Y0T ((bf16*)(KOB + 64 * MiB))
#define CP_GAT ((bf16*)(KOB + 96 * MiB))
#define CP_PC ((float*)(KWS + 504 * MiB))
#define REPSEL(a, b) (PRB ? (a) : (b))
#define REPSEL5(a, b) REPSEL(a, b)
template <int PRB> __global__ void __launch_bounds__(NTHR, 2) mk_fwd_t(Args args) {
    extern __shared__ __attribute__((aligned(16))) unsigned char lds_raw[];
    LAS unsigned char* lds = (LAS unsigned char*)lds_raw;
    volatile LAS unsigned* MISC = (volatile LAS unsigned*)(lds + MISC_OFF);
    const int tid = threadIdx.x, lane = tid & 63, wave = __builtin_amdgcn_readfirstlane(tid >> 6);
    const int G = gridDim.x, bx = blockIdx.x;
    const int vcu = (G % 8 == 0) ? (bx % 8) * (G / 8) + bx / 8 : bx;
    const int gw = vcu * NWAVES + wave, NGW = G * NWAVES;
    const int gtid = vcu * NTHR + tid, NTOT = G * NTHR;
    for (int u = tid; u < (LDS_BYTES - MISC_OFF) / 4; u += NTHR) ((LAS unsigned*)(lds + MISC_OFF))[u] = 0u;
    __syncthreads();
    XcdBarrier bar; bar.bar = ctl + CW_BAR; bar.x = 0; bar.st = nullptr;
    if (args.use_bar) bar = xcd_barrier_post(ctl + CW_BAR, MISC + 8);
    const int lo = args.ph_lo, hi = args.ph_hi;
#ifdef PH_MASK
#define IN(k) ((((PH_MASK) >> (k)) & 1) && lo <= (k) && (k) < hi)
#else
#define IN(k) (lo <= (k) && (k) < hi)
#endif
#ifdef TIMEP
#define SEAM(k) do { if (IN(k) && IN((k) + 1)) { if (lo < 0) { cg::this_grid().sync(); } xcd_barrier(bar); if (bx == 0 && tid == 0) ((unsigned long long*)(ctl + 512))[(k)] = __builtin_amdgcn_s_memrealtime(); } } while (0)
#else
#ifdef DOUBLE_BAR
#define SEAM(k) do { if (IN(k) && IN((k) + 1)) { if (lo < 0) { cg::this_grid().sync(); } xcd_barrier(bar); xcd_barrier(bar); } } while (0)
#else
#define SEAM(k) do { if (IN(k) && IN((k) + 1)) { if (lo < 0) { cg::this_grid().sync(); } xcd_barrier(bar); } } while (0)
#endif
#endif

    constexpr int I_WEFF = 2048, I_T_IN = 16 * 168, I_T_PM = 8 * 32, I_T_OUT = 16 * 32;
    constexpr int NITEMS = I_WEFF + I_T_IN + 2 * I_T_PM + I_T_OUT;
    const int n0 = (G > 96) ? ((G - 96) * NWAVES < NITEMS ? (G - 96) * NWAVES : NITEMS) : 0;
#define PREP_ITEM(IT) do { int r = (IT); LAS float* scr = (LAS float*)(lds + wave * 16384); \
        if (r < I_WEFF) { p0_weff_item(KIN(I_WQ), KIN(I_SK), WeffT, r, lane); break; } r -= I_WEFF; \
        if (r < I_T_IN) { p0_transpose_item(KIN(I_WIN), 1024, INW, WinT, 1024, 0, scr, r, lane); break; } r -= I_T_IN; \
        if (r < I_T_PM) { p0_transpose_item(KIN(I_WPM), 512, 1024, WpmT, 1024, 0, scr, r, lane); break; } r -= I_T_PM;          \
        if (r < I_T_PM) { p0_transpose_item(KIN(I_WPR), 512, 1024, WpmT, 1024, 512, scr, r, lane); break; } r -= I_T_PM;        \
        p0_transpose_item(KIN(I_WOUT), 1024, 1024, WoutT, 1024, 0, scr, r, lane); } while (0)
    if (IN(0)) {
        if (vcu < 96 || G <= 96) { for (int it = vcu; it < 96; it += G) p0_mod_item(KIN(I_C), KIN(I_WADA), KIN(I_BADA), mod, (LAS float*)lds, it, wave, lane); }
        else { for (int it = (vcu - 96) * NWAVES + wave; it < n0; it += (G - 96) * NWAVES) PREP_ITEM(it); }
     }
    SEAM(0);
    if (IN(1)) {
#pragma unroll 1
        for (int step = 0; step < 2; ++step) {
            if ((step == 0) == ((wave & 1) == 0)) {
                for (int it = n0 + gw; it < NITEMS; it += NGW) PREP_ITEM(it);
            } else {
                for (int m = gw * 4; m < T; m += NGW * 4) { const float* mb = mod + (size_t)(m >> 13) * 6144;
                    rms_mod_rows<4>(KIN(I_X) + (size_t)m * DM, XN + (size_t)m * DM, nullptr, KIN(I_N1G), mb + 1024, mb, lane); }
            }
        }
        const float* w2 = KIN(I_W2); const float* a2 = KIN(I_A2); const float* g2 = KIN(I_G2);
        for (int i = gtid; i < 1536 * 256; i += NTOT) {
            const int n = i >> 8, k = i & 255; float v = 0.f;
            if (n < 512) { if (k < 64) v = w2[k * 512 + n]; }
            else if (n < 1024) { if (k >= 64 && k < 128) v = a2[(k - 64) * 512 + (n - 512)]; }
            else { if (k >= 128) v = g2[(k - 128) * 512 + (n - 1024)]; }
            WloraT[i] = (bf16)f2bf(v);
        }
     }
    SEAM(1);
#undef PREP_ITEM
    if (IN(2)) {
        pg8::Gemm g{XN, WinT, T, INW, DM}; pg8::StaticOrder S; S.init(T, INW, G, bx);
        EpiIn E{Qb, Kb, VTb, ZRKV, ZLORA, GT};
        pg8::gemm_phase<EpiIn, pg8::StaticOrder, true, true>(lds, g, S, E);
     }
    SEAM(2);
    if (IN(3)) {
        LAS float* red = (LAS float*)lds;
        v4u raw[4], rawn[4]; int ps[4], psn[4];
        if (vcu < 2048) p2_qk_load(raw, ps, (vcu >> 10) ? Qb : Kb, (const int*)KIN(I_POS), (vcu & 1023) >> 5, vcu & 31, wave, lane);
        for (int it = vcu; it < 2048; it += G) {
            const int isq = it >> 10, r = it & 1023, bh = r >> 5, n = r & 31;
            { const int itn = it + G < 2048 ? it + G : it;
              p2_qk_load(rawn, psn, (itn >> 10) ? Qb : Kb, (const int*)KIN(I_POS), (itn & 1023) >> 5, itn & 31, wave, lane); }
            if (isq) p2_qk_item(raw, ps, REPSEL((bf16*)KOB, Qb), KIN(I_QNG), nullptr, bh, n, red, tid, wave, lane);
            else p2_qk_item(raw, ps, REPSEL((bf16*)(KOB + 32 * MiB), Kb), KIN(I_KNG), REPSEL((float*)(KWS + 1536 * 1024), kmean), bh, n, red, tid, wave, lane);
#pragma unroll
            for (int i = 0; i < 4; ++i) { raw[i] = rawn[i]; ps[i] = psn[i]; }
        }
        p2_prep(ZLORA, KIN(I_MU), REPSEL((bf16*)(KOB + 64 * MiB), ALORA), gtid, NTOT);
    }
    SEAM(3);
    if (IN(4)) {
        { int kdim = 256; asm volatile("" : "+s"(kdim));
          pg8::Gemm g{ALORA, WloraT, T, 1536, kdim}; pg8::StaticOrder S; S.init(T, 1536, G, bx);
          EpiLora E{EW, AA, GG, KIN(I_W0), KIN(I_A0)};
          pg8::gemm_phase<EpiLora, pg8::StaticOrder, true, true>(lds, g, S, E); }
        __syncthreads();
        LAS float* km = (LAS float*)lds;
        for (int it = vcu; it < 512; it += G) p3_top3_item(Qb, kmean, ctl + CW_CURSOR + REPSEL(2048, 0), REPSEL((unsigned*)KOB, LISTS), (2 * it) & 31, (2 * it) >> 5, km, tid, wave, lane);
    }
    SEAM(4);
    if (IN(5)) {
        attn_phase(Qb, Kb, VTb, LISTS, ctl + CW_CURSOR, ctl + CW_QUEUE + REPSEL5(64, 0), OPART, LPART, OMOBA, KIN(I_QNG), KIN(I_KNG), lds, tid, wave, lane, PRB);
    }
    SEAM(5);
    if (IN(6)) {
        p5_combine(OPART, LPART, OMOBA, REPSEL(Qb, OMOBA), gtid, NTOT);
    }
    SEAM(6);
    if (IN(7)) {
        {
            LAS float* lco = (LAS float*)(lds + 14 * SLOT * 2);
            const float* mu_ = KIN(I_MU); const float* kk_ = KIN(I_KK); const float* ka_ = KIN(I_KA);
            for (int i = tid; i < 2560; i += NTHR) lco[i] = i < 1536 ? mu_[i] : (i < 2048 ? kk_[i - 1536] : ka_[i - 2048]);
            LDS_WAIT(); __syncthreads();
        }
        ScanRaw R;
        if (vcu < BH * NCHK) scan_load(R, ZRKV, AA, EW, (vcu >> 7) >> 3, ((vcu >> 7) & 7) * 64 + (tid & 7) * 8, (vcu & 127) * CK + (tid >> 3));
        for (int ci = vcu; ci < BH * NCHK; ci += G) {
            const int cn = ci + G;
            rwkv_cp_item(ZRKV, AA, EW, KIN(I_MU), KIN(I_KK), KIN(I_KA), CP_RW + (size_t)ci * 4096, CP_MM + (size_t)ci * 4096, CP_Y0T + (size_t)ci * 4096, CP_GAT + (size_t)ci * 4096,
                         CP_PC + (size_t)ci * 64, ci >> 7, ci & 127, R, (cn < BH * NCHK ? cn : ci) >> 7, (cn < BH * NCHK ? cn : ci) & 127, lds, tid, wave, lane, PRB);
        }
    }
    SEAM(7);
    if (IN(8)) {
        const bool spread = (G % 8 == 0) && (G / 8 >= 16);
        const int xq = bx >> 3, xcd = bx & 7;
        const int sidm = spread ? (xq < 16 ? xcd * 16 + xq : -1) : (vcu < 128 ? vcu : -1);
        const int cvi = spread ? (xq >= 16 ? xcd * (G / 8 - 16) + (xq - 16) : -1) : (vcu >= 128 ? vcu - 128 : -1), cvn = G - 128;
        if (G >= 128) { if (sidm >= 0) rwkv_seq(CP_RW, CP_MM, CP_Y0T, CP_GAT, CP_PC, YS, sidm, lds, tid, wave, lane); }
        else for (int sid = vcu; sid < 128; sid += G) { __syncthreads(); rwkv_seq(CP_RW, CP_MM, CP_Y0T, CP_GAT, CP_PC, YS, sid, lds, tid, wave, lane); }
        if (G > 128 ? cvi >= 0 : true) {
        const int cgt = (G > 128 ? cvi : vcu) * NTHR + tid, cnt = (G > 128 ? cvn : G) * NTHR;
        const f32x4* pu = (const f32x4*)KIN(I_PU); const f32x4* pv = (const f32x4*)KIN(I_PV);
        for (int i = cgt; i < 16384 * 1024 / 32; i += cnt) {
            v4u wu;
#pragma unroll
            for (int q = 0; q < 4; ++q) {
                f32x4 a = pu[8 * i + 2 * q] * 64.f, c = pu[8 * i + 2 * q + 1] * 64.f;
                a = __builtin_elementwise_min(__builtin_elementwise_max(a, (f32x4){-6.f, -6.f, -6.f, -6.f}), (f32x4){6.f, 6.f, 6.f, 6.f});
                c = __builtin_elementwise_min(__builtin_elementwise_max(c, (f32x4){-6.f, -6.f, -6.f, -6.f}), (f32x4){6.f, 6.f, 6.f, 6.f});
                unsigned w = 0u;
                w = __builtin_amdgcn_cvt_scalef32_pk_fp4_f32(w, a.x, a.y, 1.0f, 0); w = __builtin_amdgcn_cvt_scalef32_pk_fp4_f32(w, a.z, a.w, 1.0f, 1);
                w = __builtin_amdgcn_cvt_scalef32_pk_fp4_f32(w, c.x, c.y, 1.0f, 2); w = __builtin_amdgcn_cvt_scalef32_pk_fp4_f32(w, c.z, c.w, 1.0f, 3);
                wu[q] = w;
            }
            *(v4u*)(U8 + (size_t)i * 16) = wu;
        }
        for (int i = cgt; i < 16384 * 1024 / 32; i += cnt) {
            v4u wv;
#pragma unroll
            for (int q = 0; q < 4; ++q) {
                f32x4 a = pv[8 * i + 2 * q] * 5.656854249f, c = pv[8 * i + 2 * q + 1] * 5.656854249f;
                a = __builtin_elementwise_min(__builtin_elementwise_max(a, (f32x4){-6.f, -6.f, -6.f, -6.f}), (f32x4){6.f, 6.f, 6.f, 6.f});
                c = __builtin_elementwise_min(__builtin_elementwise_max(c, (f32x4){-6.f, -6.f, -6.f, -6.f}), (f32x4){6.f, 6.f, 6.f, 6.f});
                unsigned w = 0u;
                w = __builtin_amdgcn_cvt_scalef32_pk_fp4_f32(w, a.x, a.y, 1.0f, 0); w = __builtin_amdgcn_cvt_scalef32_pk_fp4_f32(w, a.z, a.w, 1.0f, 1);
                w = __builtin_amdgcn_cvt_scalef32_pk_fp4_f32(w, c.x, c.y, 1.0f, 2); w = __builtin_amdgcn_cvt_scalef32_pk_fp4_f32(w, c.z, c.w, 1.0f, 3);
                wv[q] = w;
            }
            *(v4u*)(V8 + (size_t)((i & 31) >> 3) * (2 * MiB) + (size_t)(i >> 5) * 128 + (i & 7) * 16) = wv;
        }
        }
    }
    SEAM(8);
    if (IN(9)) {
        {
            LAS float* lc = (LAS float*)lds;
            const float* mu_ = KIN(I_MU); const float* ka_ = KIN(I_KA); const float* rk_ = KIN(I_RK); const float* lg_ = KIN(I_LNG); const float* lb_ = KIN(I_LNB);
            for (int i = tid; i < 3584; i += NTHR) lc[i] = i < 1536 ? mu_[i] : (i < 2048 ? ka_[i - 1536] : (i < 2560 ? rk_[i - 2048] : (i < 3072 ? lg_[i - 2560] : lb_[i - 3072])));
            LDS_WAIT(); __syncthreads();
        }
        p5_rwkv_post(ZRKV, AA, GG, YS, REPSEL((bf16*)KOB, Yb), (const LAS float*)lds, gw, NGW, lane);
    }
    SEAM(9);
    if (IN(10)) {
        pg8::Gemm g{OMOBA, WpmT, T, DM, DM}; pg8::StaticOrder S; S.init(T, DM, G, bx);
        EpiMix E{GT, MIXED, PRB};
        pg8::gemm_phase<EpiMix, pg8::StaticOrder, true, true>(lds, g, S, E);
    }
    SEAM(10);
    if (IN(11)) {
        pg8::Gemm g{MIXED, WoutT, T, DM, DM}; pg8::StaticOrder S; S.init(T, DM, G, bx);
        EpiOut E{KIN(I_X), mod, H1B};
        pg8::gemm_phase<EpiOut, pg8::StaticOrder, true, true>(lds, g, S, E);
     }
    SEAM(11);
    if (IN(12)) {
        for (int m = gw * 4; m < T; m += NGW * 4) { const float* mb = mod + (size_t)(m >> 13) * 6144;
            rms_mod_rows<4, true>(H1B + (size_t)m * DM, XN + (size_t)m * DM, (unsigned*)(XN8 + (size_t)m * DM), KIN(I_N2G), mb + 4 * 1024, mb + 3 * 1024, lane); }
    }
    SEAM(12);
    if (IN(13)) {
        pg8::Gemm g{XN, WeffT, T, PEER_N, DM}; pg8::StaticOrder S; S.init(T, PEER_N, G, bx);
        EpiScores E{SCORES};
        pg8::gemm_phase<EpiScores, pg8::StaticOrder, true, true>(lds, g, S, E);
     }
    SEAM(13);
    if (IN(14)) {
        peer_stage_a(SCORES, XN8, U8, (LAS f32x4*)(lds + wave * 11264), (unsigned*)PE16, (unsigned*)W8G, gw, NGW, lane);
    }
    SEAM(14);
    if (IN(15)) {
        constexpr int PW = (LDS_BYTES - 512) / NWAVES;
        const bool part = (G >= 8);
        const int wi = part ? (bx >> 3) : bx, nwi = part ? ((G - (bx & 7) + 7) >> 3) : G;
#pragma unroll 1
        for (int cls = part ? (bx & 7) : 0; cls < 8; cls += (part ? 8 : 1))
            peer_stage_b(V8 + (size_t)(cls & 3) * (2 * MiB), mod, H1B, KOUT, (const unsigned*)PE16, W8G, lds + wave * PW, cls & 3, cls >> 2, wi * NWAVES + wave, nwi * NWAVES, lane, PRB);
    }
#ifdef TIMEP
    xcd_barrier(bar);
    if (bx == 0) {
        if (tid == 0) ((unsigned long long*)(ctl + 512))[15] = __builtin_amdgcn_s_memrealtime();
        __syncthreads();
        const unsigned long long ta = ((volatile unsigned long long*)(ctl + 512))[TIMEP - 1], tb = ((volatile unsigned long long*)(ctl + 512))[TIMEP];
        const float us = (float)(tb - ta) * 0.01f;
        float code = (TIMEP_CAL) ? 10.f : floorf((us - (float)(TIMEP_BASE)) * (1.f / (float)(TIMEP_STEP)));
        code = code < 0.f ? 0.f : (code > 40.f ? 40.f : code);
        const float off = 0.02f * exp2f(code * 0.2630344f);
        float* o = KOUT; for (int i = tid; i < 1024 * 1024; i += NTHR) o[i] += off;
    }
#endif
#undef IN
#undef SEAM
}

extern "C" void kernel_launch(void* const* d_in, const int* in_sizes, int n_in, void* d_out, int out_size, void* d_ws, size_t ws_size, hipStream_t stream) {
    static int grid = 0;
    if (grid == 0) {
        if (n_in != 28 || in_sizes[0] != T * DM || out_size != T * DM || ws_size < WS_END) {
            fprintf(stderr, "kernel_launch: unexpected problem (n_in %d, in0 %d, out %d, ws %zu); nothing launched\n", n_in, n_in > 0 ? in_sizes[0] : -1, out_size, ws_size); grid = -1; return; }
        int dev = 0, cus = 0, per_cu = 0;
        if (hipGetDevice(&dev) != hipSuccess || hipDeviceGetAttribute(&cus, hipDeviceAttributeMultiprocessorCount, dev) != hipSuccess) { grid = -1; return; }
        if (hipFuncSetAttribute((const void*)mk_fwd_t<0>, hipFuncAttributeMaxDynamicSharedMemorySize, LDS_BYTES) != hipSuccess) { fprintf(stderr, "kernel_launch: hipFuncSetAttribute failed\n"); grid = -1; return; }
        if (hipOccupancyMaxActiveBlocksPerMultiprocessor(&per_cu, (const void*)mk_fwd_t<0>, NTHR, LDS_BYTES) != hipSuccess || per_cu < 1) { fprintf(stderr, "kernel_launch: occupancy query says %d\n", per_cu); per_cu = 1; }
        (void)hipGetLastError();
        grid = cus;
    }
    if (grid < 0) return;
    if (hipMemsetAsync((char*)d_ws + WS_CTL, 0, CTL_ZERO_BYTES, stream) != hipSuccess) { fprintf(stderr, "kernel_launch: memset failed\n"); return; }
    Args a{};
    for (int i = 0; i < 28; ++i) a.in[i] = (const float*)d_in[i];
    a.out = (float*)d_out; a.ws = (unsigned char*)d_ws;
#if MK_N_LAUNCHES == 1
    a.ph_lo = 0; a.ph_hi = N_PHASES; a.use_bar = 1;
    void* kargs[] = {&a};
    hipError_t e = hipLaunchCooperativeKernel((const void*)mk_fwd_t<0>, dim3(grid), dim3(NTHR), kargs, LDS_BYTES, stream);
    if (e != hipSuccess) fprintf(stderr, "kernel_launch: cooperative launch failed: %s (grid %d)\n", hipGetErrorString(e), grid);
#else
#ifndef REP_MASK
#define REP_MASK 0
#endif
#ifndef REP_CODE
#define REP_CODE 1
#endif
    for (int p = 0; p < N_PHASES; ++p) {
        a.ph_lo = p; a.ph_hi = p + 1; a.use_bar = 0;
#if REP_MASK != 0
        if ((REP_MASK >> p) & 1) { static bool once = false; if (!once) { once = true; (void)hipFuncSetAttribute((const void*)mk_fwd_t<REP_CODE>, hipFuncAttributeMaxDynamicSharedMemorySize, LDS_BYTES); }
            a.rep = REP_CODE; hipLaunchKernelGGL(mk_fwd_t<REP_CODE>, dim3(grid), dim3(NTHR), LDS_BYTES, stream, a); }
#endif
        a.rep = 0;
        hipLaunchKernelGGL(mk_fwd_t<0>, dim3(grid), dim3(NTHR), LDS_BYTES, stream, a);
    }
#endif
}
```
